# Optimizing an MI355X kernel written in HIP

```python
import math
import jax, jax.numpy as jnp
from jax import lax
import numpy as np

D_MODEL = 2048
BATCH = 4
SEQ = 2048
DEPTH = 1
DEC_BATCH = 128
DEC_SEQ = 1
PAST_LEN = 16384
PAGE_SIZE = 128

D_MIX = D_MODEL
D_A = D_MIX // 2
D_CONV = D_MIX - D_A
N_HEADS_A = 4
HEAD_V = D_A // N_HEADS_A
D_K = D_A // 2
HEAD_K = D_K // N_HEADS_A
GATE_RANK = 16
GATE_NORM = 16.0
CHUNK = 16
CONV_W = 31
CONV_GROUPS = 8
D_FF = ((8 * D_MODEL // 3 + 255) // 256) * 256
IN_SIZES = (D_K, D_K, D_A, GATE_RANK, D_A, 2 * D_CONV)
IN_COLS = sum(IN_SIZES)
IN_SPLITS = tuple(int(s) for s in np.cumsum(IN_SIZES)[:-1])
RMS_EPS = 1e-6
LN_EPS = 1e-5

kernel_name = "hymba_gla_conformerconv_decode_step"


def rmsnorm(x, g):
    xf = x.astype(jnp.float32)
    y = xf * lax.rsqrt(jnp.mean(xf * xf, axis=-1, keepdims=True) + RMS_EPS)
    return (y * g.astype(jnp.float32)).astype(x.dtype)


def layernorm(x, g, b):
    xf = x.astype(jnp.float32)
    mu = jnp.mean(xf, axis=-1, keepdims=True)
    xc = xf - mu
    y = xc * lax.rsqrt(jnp.mean(xc * xc, axis=-1, keepdims=True) + LN_EPS)
    return (y * g.astype(jnp.float32) + b.astype(jnp.float32)).astype(x.dtype)


def gla_recurrence(q, k, v, log_a, s0):
    B, T, H, DK = q.shape
    DV = v.shape[-1]
    n = -(-T // CHUNK)
    pad = n * CHUNK - T
    padf = lambda a: jnp.pad(a.astype(jnp.float32), ((0, 0), (0, pad), (0, 0), (0, 0)))
    to_chunks = lambda a: padf(a).reshape(B, n, CHUNK, H, a.shape[-1]).transpose(1, 0, 3, 2, 4)
    qc, kc, vc, gc = to_chunks(q), to_chunks(k), to_chunks(v), to_chunks(log_a)
    causal = jnp.tril(jnp.ones((CHUNK, CHUNK), dtype=bool))[:, :, None]

    def step(S, inp):
        qi, ki, vi, gi = inp
        b = jnp.cumsum(gi, axis=-2)
        diff = b[..., :, None, :] - b[..., None, :, :]
        decay = jnp.exp(jnp.where(causal, diff, -jnp.inf))
        A = jnp.einsum('bhid,bhjd,bhijd->bhij', qi, ki, decay)
        o = jnp.einsum('bhij,bhjv->bhiv', A, vi) + jnp.einsum('bhid,bhdv->bhiv', qi * jnp.exp(b), S)
        b_last = b[..., -1:, :]
        S = jnp.exp(b_last[..., 0, :])[..., None] * S + jnp.einsum(
            'bhjd,bhjv->bhdv', ki * jnp.exp(b_last - b), vi)
        return S, o

    S, o = lax.scan(step, s0.astype(jnp.float32), (qc, kc, vc, gc))
    o = o.transpose(1, 0, 3, 2, 4).reshape(B, n * CHUNK, H, DV)[:, :T]
    return o, S


def causal_depthwise_conv(u, buf, w, b):
    full = jnp.concatenate([buf.astype(u.dtype), u], axis=1)
    y = lax.conv_general_dilated(
        full, w.astype(u.dtype)[:, None, :], window_strides=(1,), padding='VALID',
        dimension_numbers=('NWC', 'WIO', 'NWC'), feature_group_count=u.shape[-1])
    return y + b.astype(u.dtype), full[:, -(CONV_W - 1):]


def hybrid_layer(x, s_gla, s_conv, norm_mix, w_in, w_gate_up, b_gate, gla_norm,
                 conv_w, conv_b, conv_ln_g, conv_ln_b, w_out, norm_ffn, w_ffn_in, w_ffn_out):
    B, T, _ = x.shape
    h = rmsnorm(x, norm_mix)
    z = h @ w_in
    q, k, v, g_lr, g_out, u = jnp.split(z, IN_SPLITS, axis=-1)
    q = q.reshape(B, T, N_HEADS_A, HEAD_K) * (HEAD_K ** -0.5)
    k = k.reshape(B, T, N_HEADS_A, HEAD_K)
    v = v.reshape(B, T, N_HEADS_A, HEAD_V)
    gate_logit = (g_lr @ w_gate_up + b_gate).astype(jnp.float32)
    log_a = (jax.nn.log_sigmoid(gate_logit) / GATE_NORM).reshape(B, T, N_HEADS_A, HEAD_K)
    o, S_new = gla_recurrence(q, k, v, log_a, s_gla)
    o = rmsnorm(o, gla_norm) * jax.nn.silu(g_out.reshape(B, T, N_HEADS_A, HEAD_V).astype(jnp.float32))
    o_a = o.reshape(B, T, D_A).astype(x.dtype)
    ua, ug = jnp.split(u, 2, axis=-1)
    glu = ua * jax.nn.sigmoid(ug)
    c, conv_buf_new = causal_depthwise_conv(glu, s_conv, conv_w, conv_b)
    c = jax.nn.silu(layernorm(c, conv_ln_g, conv_ln_b))
    x = x + jnp.concatenate([o_a, c], axis=-1) @ w_out
    hf = rmsnorm(x, norm_ffn) @ w_ffn_in
    f_gate, f_up = jnp.split(hf, 2, axis=-1)
    x = x + (jax.nn.silu(f_gate) * f_up) @ w_ffn_out
    return x, S_new.astype(x.dtype), conv_buf_new.astype(x.dtype)


def setup_inputs(seed: int = 0) -> dict:
    key = jax.random.key(seed)
    ks = jax.random.split(key, 20)
    nrm = lambda k, shape, s: jax.random.normal(k, shape, jnp.float32) * s
    return {
        "x_prompt": nrm(ks[0], (BATCH, SEQ, D_MODEL), 1.0),
        "x_sample": nrm(ks[1], (DEC_BATCH, DEC_SEQ, D_MODEL), 1.0),
        "state_gla": nrm(ks[2], (DEPTH, DEC_BATCH, N_HEADS_A, HEAD_K, HEAD_V), 0.5),
        "state_conv": nrm(ks[3], (DEPTH, DEC_BATCH, CONV_W - 1, D_CONV), 0.5),
        "norm_mix": 1.0 + nrm(ks[4], (DEPTH, D_MODEL), 0.02),
        "w_in": nrm(ks[5], (DEPTH, D_MODEL, IN_COLS), D_MODEL ** -0.5),
        "w_gate_up": nrm(ks[6], (DEPTH, GATE_RANK, D_K), GATE_RANK ** -0.5),
        "b_gate": nrm(ks[7], (DEPTH, D_K), 0.1),
        "gla_norm": 1.0 + nrm(ks[8], (DEPTH, HEAD_V), 0.02),
        "conv_w": nrm(ks[9], (DEPTH, CONV_W, D_CONV), CONV_W ** -0.5),
        "conv_b": nrm(ks[10], (DEPTH, D_CONV), 0.01),
        "conv_ln_g": 1.0 + nrm(ks[11], (DEPTH, D_CONV), 0.02),
        "conv_ln_b": nrm(ks[12], (DEPTH, D_CONV), 0.01),
        "w_out": nrm(ks[13], (DEPTH, D_MIX, D_MODEL), D_MIX ** -0.5),
        "norm_ffn": 1.0 + nrm(ks[14], (DEPTH, D_MODEL), 0.02),
        "w_ffn_in": nrm(ks[15], (DEPTH, D_MODEL, 2 * D_FF), D_MODEL ** -0.5),
        "w_ffn_out": nrm(ks[16], (DEPTH, D_FF, D_MODEL), D_FF ** -0.5),
        "norm_final": 1.0 + nrm(ks[17], (D_MODEL,), 0.02),
    }


def reference(x_prompt, x_sample, state_gla, state_conv, norm_mix, w_in, w_gate_up, b_gate,
              gla_norm, conv_w, conv_b, conv_ln_g, conv_ln_b, w_out, norm_ffn, w_ffn_in,
              w_ffn_out, norm_final):
    yp, ys = x_prompt, x_sample
    bp = x_prompt.shape[0]
    gla_p, conv_p, gla_s, conv_s = [], [], [], []
    for l in range(DEPTH):
        params = (norm_mix[l], w_in[l], w_gate_up[l], b_gate[l], gla_norm[l], conv_w[l], conv_b[l],
                  conv_ln_g[l], conv_ln_b[l], w_out[l], norm_ffn[l], w_ffn_in[l], w_ffn_out[l])
        s0 = jnp.zeros((bp, N_HEADS_A, HEAD_K, HEAD_V), jnp.float32)
        c0 = jnp.zeros((bp, CONV_W - 1, D_CONV), x_prompt.dtype)
        yp, sp, cp = hybrid_layer(yp, s0, c0, *params)
        ys, ss, cs = hybrid_layer(ys, state_gla[l], state_conv[l], *params)
        gla_p.append(sp)
        conv_p.append(cp)
        gla_s.append(ss)
        conv_s.append(cs)
    yp = rmsnorm(yp, norm_final)
    ys = rmsnorm(ys, norm_final)
    return (yp, ys, jnp.stack(gla_p), jnp.stack(conv_p), jnp.stack(gla_s), jnp.stack(conv_s))
```

```cpp
#include <hip/hip_runtime.h>
#include <cstdio>
#include <cstdint>
constexpr int PG8_DUMMY = 0;
namespace pg8 {
#define PG8_LAS __attribute__((address_space(3)))
typedef unsigned short bf16_t;
typedef short bf16x8 __attribute__((ext_vector_type(8)));
typedef float f32x4 __attribute__((ext_vector_type(4)));
typedef unsigned u32x4 __attribute__((ext_vector_type(4)));
constexpr int BM = 256, BK = 64, HALF = 128, HTB = HALF * BK * 2  , STAGE_BYTES = 8 * HTB, NXCD = 8, WGM = 8;

__host__ __device__ __forceinline__ int lds_byte(int r, int c) { const int st = (r >> 4) * 2 + (c >> 5), rr = r & 15, cc = c & 31, ob = rr * 64 + cc * 2; return st * 1024 + (ob ^ (((ob >> 9) & 1) << 5)); }
__host__ __device__ __forceinline__ void stage_rc(int b, int& R, int& C) { const int st = b / 1024, sb = b % 1024, swz = sb ^ (((sb >> 9) & 1) << 5); R = (st >> 1) * 16 + swz / 64; C = (st & 1) * 32 + (swz % 64) / 2; }
__host__ __device__ __forceinline__ int perm32(int rho) { const int n = rho >> 4, i = rho & 15; return 8 * (i >> 2) + 4 * n + (i & 3); }

struct Unit { int pm, pn; };
struct Gemm { const bf16_t* A; const bf16_t* Bt; int M, N, K; };

struct StaticOrder {
    int nM, nN, nwg, G, c;
    __host__ __device__ void init(int M, int N, int G_, int c_) { nM = M / BM; nN = N / BM; nwg = nM * nN; G = G_; c = c_; }
    __host__ __device__ bool next(int i, Unit& u) const {
        const long L = (long)i * G + c; if (L >= nwg) return false;
        int wgid = (int)L; { const int q = nwg / NXCD, r = nwg % NXCD, xcd = wgid % NXCD, off = wgid / NXCD; wgid = (xcd < r ? xcd * (q + 1) : r * (q + 1) + (xcd - r) * q) + off; }
        const int nig = WGM * nN, gid = wgid / nig, fm = gid * WGM, gsz = (nM - fm) < WGM ? (nM - fm) : WGM;
        u.pm = fm + ((wgid % nig) % gsz); u.pn = (wgid % nig) / gsz; return true;
    }
    __device__ __forceinline__ void a_ready(const Unit&) const {}
    __device__ __forceinline__ void done(const Unit&) const {}
};
__device__ __forceinline__ unsigned cvt_pk_bf16(float lo, float hi) { unsigned r; asm volatile("v_cvt_pk_bf16_f32 %0, %1, %2" : "=v"(r) : "v"(lo), "v"(hi)); return r; }
typedef float f32x2 __attribute__((ext_vector_type(2)));
typedef unsigned u32x2v __attribute__((ext_vector_type(2)));
__device__ __forceinline__ float silu_f(float x) { return x * __builtin_amdgcn_rcpf(1.0f + __expf(-x)); }
struct EpiStoreBf16 {
    static constexpr bool PERM = true, AFTER_DRAIN = false;
    bf16_t* O; int ldc;
    __device__ __forceinline__ void operator()(const f32x4 (&acc)[2][2][4][2], const Unit& u, int wr, int wc, int fr, int fq) const {
        const int row0 = u.pm * BM + wr * 64 + fr, col0 = u.pn * BM + wc * 32 + 8 * fq;
#pragma unroll
        for (int ai = 0; ai < 2; ++ai)
#pragma unroll
            for (int m = 0; m < 4; ++m) { bf16_t* rowp = O + (size_t)(row0 + ai * HALF + m * 16) * ldc + col0;
#pragma unroll
                for (int bj = 0; bj < 2; ++bj) { const f32x4 v0 = acc[ai][bj][m][0], v1 = acc[ai][bj][m][1];
                    u32x4 w; w.x = cvt_pk_bf16(v0[0], v0[1]); w.y = cvt_pk_bf16(v0[2], v0[3]); w.z = cvt_pk_bf16(v1[0], v1[1]); w.w = cvt_pk_bf16(v1[2], v1[3]);
                    *(u32x4*)(rowp + bj * HALF) = w; } }
    }
};
struct EpiSwiglu {
    static constexpr bool PERM = true, AFTER_DRAIN = false;
    bf16_t* O; int ldc;
    __device__ __forceinline__ void operator()(const f32x4 (&acc)[2][2][4][2], const Unit& u, int wr, int wc, int fr, int fq) const {
        const int row0 = u.pm * BM + wr * 64 + fr, col0 = u.pn * HALF + wc * 32 + 8 * fq;
#pragma unroll
        for (int ai = 0; ai < 2; ++ai)
#pragma unroll
            for (int m = 0; m < 4; ++m) { bf16_t* rowp = O + (size_t)(row0 + ai * HALF + m * 16) * ldc + col0;
                float h[8];
#pragma unroll
                for (int n = 0; n < 2; ++n)
#pragma unroll
                    for (int e = 0; e < 4; ++e) h[4 * n + e] = silu_f(acc[ai][0][m][n][e]) * acc[ai][1][m][n][e];
                u32x4 w; w.x = cvt_pk_bf16(h[0], h[1]); w.y = cvt_pk_bf16(h[2], h[3]); w.z = cvt_pk_bf16(h[4], h[5]); w.w = cvt_pk_bf16(h[6], h[7]);
                *(u32x4*)rowp = w; }
    }
};
struct EpiResF32 {
    static constexpr bool PERM = false, AFTER_DRAIN = false;
    const float* base0; const float* base1; float* out; int ldc, msplit, mreal;
    __device__ __forceinline__ void operator()(const f32x4 (&acc)[2][2][4][2], const Unit& u, int wr, int wc, int fr, int fq) const {
        const int row0 = u.pm * BM + wr * 64 + fr, col0 = u.pn * BM + wc * 32 + 4 * fq;
#pragma unroll
        for (int ai = 0; ai < 2; ++ai)
#pragma unroll
            for (int m = 0; m < 4; ++m) { const int row = row0 + ai * HALF + m * 16;
                if (row < mreal) {
                    const float* bp = (row < msplit ? base0 + (size_t)row * ldc : base1 + (size_t)(row - msplit) * ldc) + col0; float* op = out + (size_t)row * ldc + col0;
                    f32x4 b[2][2];
#pragma unroll
                    for (int bj = 0; bj < 2; ++bj)
#pragma unroll
                        for (int n = 0; n < 2; ++n) b[bj][n] = *(const f32x4*)(bp + bj * HALF + n * 16);
#pragma unroll
                    for (int bj = 0; bj < 2; ++bj)
#pragma unroll
                        for (int n = 0; n < 2; ++n) *(f32x4*)(op + bj * HALF + n * 16) = b[bj][n] + acc[ai][bj][m][n];
                } }
    }
};
template <class Epi, class Sched, bool ALIGN_EPI = false, bool SP2 = false>
__device__ __forceinline__ void gemm_phase(PG8_LAS unsigned char* lds, const Gemm g, const Sched& S, const Epi& E) {
    const int tid = threadIdx.x, wid = __builtin_amdgcn_readfirstlane(tid >> 6), lane = tid & 63, wr = wid >> 2, wc = wid & 3, fr = lane & 15, fq = lane >> 4;
    const int K = g.K, nt = K / BK;
    unsigned voffA[2], voffB[2];
#pragma unroll
    for (int i = 0; i < 2; ++i) { int R, C; stage_rc(tid * 16 + i * 8192, R, C); const int Rb = Epi::PERM ? ((R & ~31) + perm32(R & 31)) : R;
        voffA[i] = (unsigned)(R * K + C) * 2u; voffB[i] = (unsigned)(Rb * K + C) * 2u; }
    const size_t kstep = (size_t)(BK * 2);
    const size_t hstep = (size_t)HALF * K * 2;
    const size_t tstep = 2 * hstep;
    const unsigned ldsw = (unsigned)wid * 1024u;
    const int aoff = lds_byte(wr * 64 + fr, fq * 8), boff = lds_byte(wc * 32 + fr, fq * 8);
#define PG8_SA(b, h) (((b) * 2 + (h)) * HTB)
#define PG8_SB(b, h) ((4 + (b) * 2 + (h)) * HTB)
#define PG8_STAGE(bufoff, gbase, voff) do { _Pragma("unroll") for (int _i = 0; _i < 2; ++_i) \
        __builtin_amdgcn_global_load_lds((const unsigned*)((const char*)(gbase) + (voff)[_i]), (PG8_LAS unsigned*)(lds + (bufoff) + ldsw + _i * 8192), 16, 0, 0); } while (0)
#define PG8_LDA(dst, b, h) do { _Pragma("unroll") for (int m = 0; m < 4; ++m) _Pragma("unroll") for (int k = 0; k < 2; ++k) dst[m][k] = *(const PG8_LAS bf16x8*)(lds + PG8_SA(b, h) + aoff + m * 2048 + k * 1024); } while (0)
#define PG8_LDB(dst, b, h) do { _Pragma("unroll") for (int n = 0; n < 2; ++n) _Pragma("unroll") for (int k = 0; k < 2; ++k) dst[n][k] = *(const PG8_LAS bf16x8*)(lds + PG8_SB(b, h) + boff + n * 2048 + k * 1024); } while (0)
#define PG8_MMA(ai, bj, At, Bt) do { __builtin_amdgcn_s_setprio(1); _Pragma("unroll") for (int m = 0; m < 4; ++m) _Pragma("unroll") for (int n = 0; n < 2; ++n) _Pragma("unroll") for (int k = 0; k < 2; ++k) \
        acc[ai][bj][m][n] = __builtin_amdgcn_mfma_f32_16x16x32_bf16(Bt[n][k], At[m][k], acc[ai][bj][m][n], 0, 0, 0); __builtin_amdgcn_s_setprio(0); } while (0)
#define PG8_WAIT_V(n) asm volatile("s_waitcnt vmcnt(" #n ")" ::: "memory")
#define PG8_WAIT_L(n) asm volatile("s_waitcnt lgkmcnt(" #n ")" ::: "memory")
#define PG8_BAR __builtin_amdgcn_s_barrier()
#define PG8_SCHED __builtin_amdgcn_sched_barrier(0)
    Unit cur, nxt; int ui = 0;
    if (!S.next(0, cur)) return;
    f32x4 acc[2][2][4][2];
#pragma unroll
    for (int a = 0; a < 2; ++a)
#pragma unroll
        for (int b = 0; b < 2; ++b)
#pragma unroll
            for (int m = 0; m < 4; ++m)
#pragma unroll
                for (int n = 0; n < 2; ++n) acc[a][b][m][n] = (f32x4){0.f, 0.f, 0.f, 0.f};
    bf16x8 At[4][2], B0[2][2], B1[2][2];
    const char* cA = (const char*)g.A + (size_t)cur.pm * tstep; const char* cB = (const char*)g.Bt + (size_t)cur.pn * tstep;
    S.a_ready(cur);
    if constexpr (SP2) {
        PG8_STAGE(PG8_SB(0, 0), cB, voffB); PG8_STAGE(PG8_SB(0, 1), cB + hstep, voffB); PG8_STAGE(PG8_SA(0, 0), cA, voffA); PG8_STAGE(PG8_SA(0, 1), cA + hstep, voffA);
        if (wr == 1) PG8_BAR;
        PG8_WAIT_V(2); PG8_BAR;
        PG8_STAGE(PG8_SB(1, 0), cB + kstep, voffB); PG8_STAGE(PG8_SA(1, 0), cA + kstep, voffA); PG8_STAGE(PG8_SB(1, 1), cB + hstep + kstep, voffB);
        PG8_WAIT_V(6); PG8_BAR;
    } else {
        PG8_STAGE(PG8_SB(0, 0), cB, voffB); PG8_STAGE(PG8_SA(0, 0), cA, voffA); PG8_STAGE(PG8_SB(0, 1), cB + hstep, voffB); PG8_STAGE(PG8_SA(0, 1), cA + hstep, voffA);
        if (wr == 1) PG8_BAR;
        PG8_WAIT_V(4); PG8_BAR;
        PG8_STAGE(PG8_SB(1, 0), cB + kstep, voffB); PG8_STAGE(PG8_SA(1, 0), cA + kstep, voffA); PG8_STAGE(PG8_SB(1, 1), cB + hstep + kstep, voffB);
        PG8_WAIT_V(6); PG8_BAR;
    }
    for (;;) {
        const bool has_next = S.next(ui + 1, nxt);
        const char* nA = has_next ? (const char*)g.A + (size_t)nxt.pm * tstep : cA; const char* nB = has_next ? (const char*)g.Bt + (size_t)nxt.pn * tstep : cB;
        for (int t = 0; t < nt; t += 2) {
            const bool last = (t == nt - 2);
            const char* a1 = cA + (size_t)(t + 1) * kstep;
            const char* a2 = last ? nA : cA + (size_t)(t + 2) * kstep; const char* b2 = last ? nB : cB + (size_t)(t + 2) * kstep;
            const char* a3 = a2 + kstep; const char* b3 = b2 + kstep;
            if (last && has_next) S.a_ready(nxt);
            if constexpr (SP2) {
            PG8_LDB(B0, 0, 0); PG8_LDB(B1, 0, 1); PG8_SCHED; PG8_LDA(At, 0, 0); PG8_STAGE(PG8_SA(1, 1), a1 + hstep, voffA);
            PG8_WAIT_V(8); PG8_WAIT_L(0); PG8_BAR; PG8_MMA(0, 0, At, B0); PG8_MMA(0, 1, At, B1); PG8_BAR; PG8_SCHED;
            PG8_LDA(At, 0, 1); PG8_STAGE(PG8_SB(0, 0), b2, voffB); PG8_STAGE(PG8_SB(0, 1), b2 + hstep, voffB); PG8_STAGE(PG8_SA(0, 0), a2, voffA);
            PG8_WAIT_V(8); PG8_WAIT_L(0); PG8_BAR; PG8_MMA(1, 0, At, B0); PG8_MMA(1, 1, At, B1); PG8_BAR; PG8_SCHED;
            PG8_LDB(B0, 1, 0); PG8_LDB(B1, 1, 1); PG8_SCHED; PG8_LDA(At, 1, 0); PG8_STAGE(PG8_SA(0, 1), a2 + hstep, voffA);
            PG8_WAIT_V(8); PG8_WAIT_L(0); PG8_BAR; PG8_MMA(0, 0, At, B0); PG8_MMA(0, 1, At, B1); PG8_BAR; PG8_SCHED;
            PG8_LDA(At, 1, 1); PG8_STAGE(PG8_SB(1, 0), b3, voffB); PG8_STAGE(PG8_SB(1, 1), b3 + hstep, voffB); PG8_STAGE(PG8_SA(1, 0), a3, voffA);
            PG8_WAIT_V(8); PG8_WAIT_L(0); PG8_BAR; PG8_MMA(1, 0, At, B0); PG8_MMA(1, 1, At, B1); PG8_BAR; PG8_SCHED;
            } else {
            PG8_LDB(B0, 0, 0); PG8_SCHED; PG8_LDA(At, 0, 0); PG8_STAGE(PG8_SA(1, 1), a1 + hstep, voffA);
            PG8_WAIT_L(8); PG8_BAR; PG8_WAIT_L(0); PG8_MMA(0, 0, At, B0); PG8_BAR; PG8_SCHED;
            PG8_LDB(B1, 0, 1); PG8_STAGE(PG8_SB(0, 0), b2, voffB);
            PG8_BAR; PG8_WAIT_L(0); PG8_MMA(0, 1, At, B1); PG8_BAR;
            PG8_LDA(At, 0, 1); PG8_STAGE(PG8_SA(0, 0), a2, voffA);
            PG8_BAR; PG8_WAIT_L(0); PG8_MMA(1, 0, At, B0); PG8_BAR; PG8_SCHED;
            PG8_STAGE(PG8_SB(0, 1), b2 + hstep, voffB);
            PG8_WAIT_V(6); PG8_BAR; PG8_MMA(1, 1, At, B1); PG8_BAR;
            PG8_LDB(B0, 1, 0); PG8_SCHED; PG8_LDA(At, 1, 0); PG8_STAGE(PG8_SA(0, 1), a2 + hstep, voffA);
            PG8_WAIT_L(8); PG8_BAR; PG8_WAIT_L(0); PG8_MMA(0, 0, At, B0); PG8_BAR; PG8_SCHED;
            PG8_LDB(B1, 1, 1); PG8_STAGE(PG8_SB(1, 0), b3, voffB);
            PG8_BAR; PG8_WAIT_L(0); PG8_MMA(0, 1, At, B1); PG8_BAR;
            PG8_LDA(At, 1, 1); PG8_STAGE(PG8_SA(1, 0), a3, voffA);
            PG8_BAR; PG8_WAIT_L(0); PG8_MMA(1, 0, At, B0); PG8_BAR; PG8_SCHED;
            PG8_STAGE(PG8_SB(1, 1), b3 + hstep, voffB);
            PG8_WAIT_V(6); PG8_BAR; PG8_MMA(1, 1, At, B1); PG8_BAR;
            }
        }
        if constexpr (ALIGN_EPI) { if (wr == 0) PG8_BAR; }
        if constexpr (!Epi::AFTER_DRAIN) { E(acc, cur, wr, wc, fr, fq); S.done(cur); }
        if (!has_next) break;
#pragma unroll
        for (int a = 0; a < 2; ++a)
#pragma unroll
            for (int b = 0; b < 2; ++b)
#pragma unroll
                for (int m = 0; m < 4; ++m)
#pragma unroll
                    for (int n = 0; n < 2; ++n) acc[a][b][m][n] = (f32x4){0.f, 0.f, 0.f, 0.f};
        cur = nxt; cA = nA; cB = nB; ++ui;
        if constexpr (ALIGN_EPI) { if (wr == 1) PG8_BAR; }
    }
    PG8_WAIT_V(0);
    if constexpr (!ALIGN_EPI) { if (wr == 0) PG8_BAR; }
    PG8_BAR;
    if constexpr (Epi::AFTER_DRAIN) { E.fused(acc, cur, wr, wc, fr, fq, lds, wid, lane); S.done(cur); }
#undef PG8_SA
#undef PG8_SB
#undef PG8_STAGE
#undef PG8_LDA
#undef PG8_LDB
#undef PG8_MMA
#undef PG8_WAIT_V
#undef PG8_WAIT_L
#undef PG8_BAR
#undef PG8_SCHED
}
}

constexpr int NWAVES = 8;
constexpr int DM = 2048, MP = 8192, MS = 128, MR = MP + MS  , MPAD = 8448  , SEQ = 2048, NB = 4;
constexpr int NH = 4, HK = 128, HV = 256, DK = 512, DA = 1024, DC_ = 1024, GR = 16, CW = 31, DFF = 5632;
constexpr int N1 = 5136, N1P = 5376;
constexpr int ZQ = 0, ZK = 512, ZV = 1024, ZGO = 2048, ZUA = 3072, ZUG = 4096, ZGL = 5120;
constexpr int CH = 64, NCH = SEQ / CH;
constexpr float RMS_EPS = 1e-6f, LN_EPS = 1e-5f;
constexpr size_t O_YP = 0, O_YS = (size_t)MP * DM, O_GP = O_YS + (size_t)MS * DM, O_CP = O_GP + (size_t)NB * NH * HK * HV, O_GS = O_CP + (size_t)NB * 30 * DC_,
                 O_CS = O_GS + (size_t)MS * NH * HK * HV, O_END = O_CS + (size_t)MS * 30 * DC_;
constexpr size_t MiB = 1u << 20;
constexpr size_t WS_CTL = 0, CTL_ZERO_BYTES = 1 * MiB;
constexpr size_t WS_W1 = 2 * MiB;
constexpr size_t WS_W2 = 23 * MiB;
constexpr size_t WS_W3 = 31 * MiB;
constexpr size_t WS_W4 = 75 * MiB;
constexpr size_t WS_H = 97 * MiB;
constexpr size_t WS_QT = WS_H, WS_KH = WS_H + 8 * MiB, WS_VT = WS_H + 16 * MiB;
constexpr size_t WS_Z = 130 * MiB;
constexpr size_t WS_MIX = 217 * MiB;
constexpr size_t WS_HID = 130 * MiB;
constexpr size_t WS_END = 250 * MiB;
static_assert(WS_Z + (size_t)MPAD * N1P * 2 <= WS_MIX && WS_HID + (size_t)MPAD * DFF * 2 <= WS_END && WS_W1 + (size_t)N1P * DM * 2 <= WS_W2 && WS_W3 + (size_t)2 * DFF * DM * 2 <= WS_W4 && WS_W4 + (size_t)DM * DFF * 2 <= WS_H, "d_ws map");
constexpr size_t DO_O32 = 0, DO_AM = 32 * MiB, DO_DC = 36 * MiB;
constexpr int CW_TMO = 0, CW_BAR = 4096;
constexpr int RING_OFF = 0, RING_BYTES = 131072;
constexpr int LDSCTL_OFF = RING_BYTES, MISC_OFF = LDSCTL_OFF + 320;
constexpr int LDS_BYTES = 147456;

#define GAS __attribute__((address_space(1)))
#define LAS __attribute__((address_space(3)))
typedef unsigned short bf16;
typedef unsigned v4u __attribute__((ext_vector_type(4)));
typedef unsigned v2u __attribute__((ext_vector_type(2)));
typedef float f32x4 __attribute__((ext_vector_type(4)));
typedef float f32x2 __attribute__((ext_vector_type(2)));
typedef short bf16x8 __attribute__((ext_vector_type(8)));
typedef GAS unsigned gu32;
typedef GAS unsigned long long gu64;
#define RLX_AGENT __ATOMIC_RELAXED, __HIP_MEMORY_SCOPE_AGENT
#define LDS_WAIT() asm volatile("s_waitcnt lgkmcnt(0)" ::: "memory")
#define VM_WAIT() asm volatile("s_waitcnt vmcnt(0)" ::: "memory")
__device__ __forceinline__ unsigned f2bf(float f) { unsigned u = __builtin_bit_cast(unsigned, f); return (u + 0x7fffu + ((u >> 16) & 1u)) >> 16; }
__device__ __forceinline__ unsigned pk2(float lo, float hi) { return f2bf(lo) | (f2bf(hi) << 16); }
__device__ __forceinline__ float bf2f(unsigned short b) { return __builtin_bit_cast(float, (unsigned)b << 16); }
__device__ __forceinline__ float bflo(unsigned w) { return __builtin_bit_cast(float, w << 16); }
__device__ __forceinline__ float bfhi(unsigned w) { return __builtin_bit_cast(float, w & 0xffff0000u); }
__device__ __forceinline__ float sigmoid_f(float x) { return __builtin_amdgcn_rcpf(1.0f + __expf(-x)); }
__device__ __forceinline__ float silu_f(float x) { return x * sigmoid_f(x); }
__device__ __forceinline__ float logsigmoid_f(float x) { return fminf(x, 0.f) - log1pf(__expf(-fabsf(x))); }
#define XB_TMO      128
#define XB_XCNT(j)  (256  + 64 * (j))
#define XB_XSUB(j)  (1280 + 64 * (j))
#define XB_XGEN(j)  (2304 + 64 * (j))
#define XB_TOP      3328
#define XB_TOPGEN   3392
#define XCD_BAR_WORDS 3456
#define XB_SPIN_CAP (1u << 18)

__device__ __forceinline__ unsigned xb_ld(unsigned* p)              { return __hip_atomic_load(p, __ATOMIC_RELAXED, __HIP_MEMORY_SCOPE_AGENT); }
__device__ __forceinline__ unsigned xb_add(unsigned* p, unsigned v) { return __hip_atomic_fetch_add(p, v, __ATOMIC_RELAXED, __HIP_MEMORY_SCOPE_AGENT); }
__device__ __forceinline__ unsigned xb_xcc_id() { return (unsigned)__builtin_amdgcn_s_getreg((3 << 11) | 20) & 0xFu; }
#define XB_SPIN(cond, bar) do { unsigned _sp = 0; while (cond) { __builtin_amdgcn_s_sleep(1); \
    if ((++_sp & 255u) == 0u) { if (xb_ld(&(bar)[XB_TMO])) break; if (_sp > XB_SPIN_CAP) { atomicAdd(&(bar)[XB_TMO], 1u); break; } } } } while (0)

struct XcdBarrier {
    unsigned* bar; unsigned x;
    volatile LAS unsigned* st;
};

__device__ __forceinline__ XcdBarrier xcd_barrier_post(unsigned* bar, volatile LAS unsigned* st) {
    XcdBarrier b; b.bar = bar; b.x = xb_xcc_id(); b.st = st;
    if (threadIdx.x == 0) (void)xb_add(&bar[XB_XCNT(b.x)], 1u);
    return b;
}
__device__ __forceinline__ void xcd_barrier_complete(unsigned* bar, unsigned x, unsigned& nloc, unsigned& nx) {
    const unsigned G = gridDim.x * gridDim.y * gridDim.z;
    unsigned sum, cnt, mine, sp = 0u;
    for (;;) {
        sum = 0u; cnt = 0u; mine = 0u;
#pragma unroll
        for (unsigned j = 0; j < 16; ++j) { const unsigned c = xb_ld(&bar[XB_XCNT(j)]); sum += c; cnt += (c > 0u) ? 1u : 0u; mine = (j == x) ? c : mine; }
        if (sum == G) break;
        __builtin_amdgcn_s_sleep(1);
        if ((++sp & 255u) == 0u) { if (xb_ld(&bar[XB_TMO])) break; if (sp > XB_SPIN_CAP) { atomicAdd(&bar[XB_TMO], 1u); break; } }
    }
    nloc = mine > 0u ? mine : 1u; nx = cnt > 0u ? cnt : 1u;
}

__device__ __forceinline__ void xcd_barrier(const XcdBarrier& b) {
    asm volatile("s_waitcnt vmcnt(0)" ::: "memory");
    __syncthreads();
    if (threadIdx.x == 0) {
        unsigned* bar = b.bar;
        __builtin_amdgcn_s_waitcnt(0);
        unsigned nloc = b.st[0], nx = b.st[1];
        if (nloc == 0u) { xcd_barrier_complete(bar, b.x, nloc, nx); b.st[0] = nloc; b.st[1] = nx; }
        const unsigned old = xb_add(&bar[XB_XSUB(b.x)], 1u);
        const unsigned gen = old / nloc;
        if (old + 1u == (gen + 1u) * nloc) {
            __builtin_amdgcn_fence(__ATOMIC_RELEASE, "agent");
            asm volatile("s_waitcnt vmcnt(0)" ::: "memory");
            const unsigned og = xb_add(&bar[XB_TOP], 1u);
            const unsigned tg = og / nx;
            if (og + 1u == (tg + 1u) * nx) xb_add(&bar[XB_TOPGEN], 1u);
            else XB_SPIN(xb_ld(&bar[XB_TOPGEN]) == tg, bar);
            __builtin_amdgcn_fence(__ATOMIC_ACQUIRE, "agent");
            xb_add(&bar[XB_XGEN(b.x)], 1u);
            asm volatile("s_waitcnt vmcnt(0)" ::: "memory");
        } else {
            XB_SPIN(xb_ld(&bar[XB_XGEN(b.x)]) == gen, bar);
            __builtin_amdgcn_fence(__ATOMIC_ACQUIRE, "agent");
            asm volatile("s_waitcnt vmcnt(0)" ::: "memory");
        }
    }
    __syncthreads();
}
struct Args { const float* in[18]; float* out; unsigned char* ws; int ph_lo, ph_hi; };
#define P_xp (A.in[0])
#define P_xs (A.in[1])
#define P_sgla (A.in[2])
#define P_sconv (A.in[3])
#define P_norm_mix (A.in[4])
#define P_w_in (A.in[5])
#define P_wgu (A.in[6])
#define P_bgate (A.in[7])
#define P_gla_norm (A.in[8])
#define P_conv_w (A.in[9])
#define P_conv_b (A.in[10])
#define P_ln_g (A.in[11])
#define P_ln_b (A.in[12])
#define P_w_out (A.in[13])
#define P_norm_ffn (A.in[14])
#define P_w_ffn_in (A.in[15])
#define P_w_ffn_out (A.in[16])
#define P_norm_final (A.in[17])
#define P_W1t ((bf16*)(A.ws + WS_W1))
#define P_W2t ((bf16*)(A.ws + WS_W2))
#define P_W3t ((bf16*)(A.ws + WS_W3))
#define P_W4t ((bf16*)(A.ws + WS_W4))
#define P_H ((bf16*)(A.ws + WS_H))
#define P_Z ((bf16*)(A.ws + WS_Z))
#define P_MIX ((bf16*)(A.ws + WS_MIX))
#define P_HID ((bf16*)(A.ws + WS_HID))
#define P_QT ((bf16*)(A.ws + WS_QT))
#define P_KH ((bf16*)(A.ws + WS_KH))
#define P_VT ((bf16*)(A.ws + WS_VT))
#define P_out (A.out)
#define P_O32 ((float*)((unsigned char*)A.out + DO_O32))
#define P_AM ((bf16*)((unsigned char*)A.out + DO_AM))
#define P_DCb ((float*)((unsigned char*)A.out + DO_DC))

struct Frame {
    LAS unsigned char* lds;
    volatile LAS unsigned* MISC;
    gu32* ctl;
    int tid, lane, wave, vcu, G;
};
__device__ __forceinline__ float wave_sum(float v) {
#pragma unroll
    for (int o = 1; o < 64; o <<= 1) v += __shfl_xor(v, o);
    return v;
}
__device__ __forceinline__ float dot4(f32x4 a, f32x4 b) { return (a.x * b.x + a.y * b.y) + (a.z * b.z + a.w * b.w); }

template <int MAP> __device__ __forceinline__ int srccol(int n) {
    if (MAP == 1) return n < 2048 ? n : (n < 5120 ? n + 16 : (n < 5136 ? n - 3072 : -1));
    if (MAP == 3) { const int t = n >> 8, r = n & 255; return r < 128 ? 128 * t + r : DFF + 128 * t + (r - 128); }
    return n;
}
template <int MAP> __device__ __forceinline__ void p0_transpose_item(const float* W, int K, int Nsrc, int Ndst, bf16* WT, LAS float* scr, int item, int lane) {
    const int nblk = Ndst / 32, kb = item / nblk, nb = item % nblk, k0 = 64 * kb, n0 = 32 * nb;
    const int sc = srccol<MAP>(n0 + (lane & 31));
    const float* src = W + (size_t)k0 * Nsrc + (sc >= 0 ? sc : 0);
#pragma unroll 8
    for (int i = 0; i < 32; ++i) { const int kk = 2 * i + (lane >> 5); const float v = src[(size_t)kk * Nsrc]; scr[kk * 33 + (lane & 31)] = sc >= 0 ? v : 0.f; }
    LDS_WAIT(); asm volatile("" ::: "memory");
    const int c = lane & 7;
#pragma unroll
    for (int j = 0; j < 4; ++j) { const int n = (lane >> 3) + 8 * j; const LAS float* s = scr + (8 * c) * 33 + n;
        v4u o; o.x = pk2(s[0 * 33], s[1 * 33]); o.y = pk2(s[2 * 33], s[3 * 33]); o.z = pk2(s[4 * 33], s[5 * 33]); o.w = pk2(s[6 * 33], s[7 * 33]);
        *(GAS v4u*)(WT + (size_t)(n0 + n) * K + k0 + 8 * c) = o; }
    LDS_WAIT(); asm volatile("" ::: "memory");
}
__device__ __forceinline__ void rms_row_to_bf16(const float* xrow, const float* gain, bf16* orow, int lane) {
    const GAS f32x4* xr = (const GAS f32x4*)xrow + lane; const GAS f32x4* gr = (const GAS f32x4*)gain + lane;
    f32x4 v[8]; float s = 0.f;
#pragma unroll
    for (int j = 0; j < 8; ++j) { v[j] = xr[64 * j]; s += dot4(v[j], v[j]); }
    const float rstd = 1.0f / sqrtf(wave_sum(s) * (1.f / DM) + RMS_EPS);
    GAS v2u* o8 = (GAS v2u*)orow + lane;
#pragma unroll
    for (int j = 0; j < 8; ++j) { const f32x4 g = gr[64 * j]; v2u o; o.x = pk2(v[j].x * rstd * g.x, v[j].y * rstd * g.y); o.y = pk2(v[j].z * rstd * g.z, v[j].w * rstd * g.w); o8[64 * j] = o; }
}
__device__ __forceinline__ void rms_row_inplace(float* xrow, const float* gain, int lane) {
    GAS f32x4* xr = (GAS f32x4*)xrow + lane; const GAS f32x4* gr = (const GAS f32x4*)gain + lane;
    f32x4 v[8]; float s = 0.f;
#pragma unroll
    for (int j = 0; j < 8; ++j) { v[j] = xr[64 * j]; s += dot4(v[j], v[j]); }
    const float rstd = 1.0f / sqrtf(wave_sum(s) * (1.f / DM) + RMS_EPS);
#pragma unroll
    for (int j = 0; j < 8; ++j) { const f32x4 g = gr[64 * j]; xr[64 * j] = v[j] * rstd * g; }
}
__device__ __forceinline__ void p0_prologue(Frame& F, const Args& A) {
    LAS float* scr = (LAS float*)(F.lds + RING_OFF + F.wave * 16384);
    const int gw = F.vcu * NWAVES + F.wave, NGW = F.G * NWAVES;
    constexpr int I_1 = (DM / 64) * (N1P / 32), I_2 = (DM / 64) * (DM / 32), I_3 = (DM / 64) * (2 * DFF / 32), I_4 = (DFF / 64) * (DM / 32);
    constexpr int NITEMS = I_1 + I_2 + I_3 + I_4;
    for (int it = gw; it < NITEMS; it += NGW) {
        int r = it;
        if (r < I_1) { p0_transpose_item<1>(P_w_in, DM, N1, N1P, P_W1t, scr, r, F.lane); continue; } r -= I_1;
        if (r < I_2) { p0_transpose_item<0>(P_w_out, DM, DM, DM, P_W2t, scr, r, F.lane); continue; } r -= I_2;
        if (r < I_3) { p0_transpose_item<3>(P_w_ffn_in, DM, 2 * DFF, 2 * DFF, P_W3t, scr, r, F.lane); continue; } r -= I_3;
        p0_transpose_item<0>(P_w_ffn_out, DFF, DM, DM, P_W4t, scr, r, F.lane);
    }
    for (int m = gw; m < MPAD; m += NGW) {
        if (m < MR) rms_row_to_bf16(m < MP ? P_xp + (size_t)m * DM : P_xs + (size_t)(m - MP) * DM, P_norm_mix, P_H + (size_t)m * DM, F.lane);
        else { GAS v4u* o = (GAS v4u*)(P_H + (size_t)m * DM) + F.lane;
#pragma unroll
            for (int j = 0; j < 4; ++j) o[64 * j] = (v4u){0u, 0u, 0u, 0u}; }
    }
}

__device__ __forceinline__ void gla_prep_unit(Frame& F, const Args& A, int bh, int c) {
    const int tid = F.tid, b = bh >> 2, h = bh & 3, row0 = b * SEQ + c * CH;
    LAS float* GL = (LAS float*)(F.lds + RING_OFF);
    LAS float* BL = (LAS float*)(F.lds + RING_OFF + 4608);
    LAS bf16* QS = (LAS bf16*)(F.lds + RING_OFF + 8192);
    LAS bf16* KS = (LAS bf16*)(F.lds + RING_OFF + 25600);
    const size_t uc = (size_t)bh * NCH + c;
    for (int e = tid; e < CH * GR; e += NWAVES * 64) { const int i = e >> 4, r = e & 15; GL[i * 17 + r] = bf2f(P_Z[(size_t)(row0 + i) * N1P + ZGL + r]); }
    const int d = tid & 127, g = tid >> 7;
    float wg[16];
#pragma unroll
    for (int r = 0; r < 16; ++r) wg[r] = P_wgu[r * DK + h * HK + d];
    const float bg = P_bgate[h * HK + d];
    __syncthreads();
    float bcum[16]; float run = 0.f;
#pragma unroll
    for (int ii = 0; ii < 16; ++ii) { const int i = g * 16 + ii; float x = bg;
#pragma unroll
        for (int r = 0; r < 16; ++r) x += GL[i * 17 + r] * wg[r];
        run += logsigmoid_f(x) * (1.0f / 16.0f); bcum[ii] = run; }
    BL[g * 128 + d] = run;
    __syncthreads();
    float off = 0.f, tot = 0.f;
#pragma unroll
    for (int gg = 0; gg < 4; ++gg) { const float t = BL[gg * 128 + d]; off += (gg < g) ? t : 0.f; tot += t; }
    const float scale = 0.08838834764831845f;
    const int d5 = d & 31, pd = (d & ~31) + 8 * ((d5 >> 2) & 3) + 4 * (d5 >> 4) + (d5 & 3);
    unsigned khw[8];
#pragma unroll
    for (int ii = 0; ii < 16; ++ii) { const int i = g * 16 + ii; const float bb = bcum[ii] + off;
        const bf16* zr = P_Z + (size_t)(row0 + i) * N1P;
        const float q = bf2f(zr[ZQ + h * HK + d]) * scale * __expf(bb);
        const float kv = bf2f(zr[ZK + h * HK + d]);
        const unsigned qb = f2bf(q), ktb = f2bf(kv * __expf(-bb)), khb = f2bf(kv * __expf(tot - bb));
        QS[i * 136 + d] = (bf16)qb; KS[i * 136 + d] = (bf16)ktb;
        P_QT[(uc * 64 + i) * 128 + pd] = (bf16)qb;
        if (ii & 1) khw[ii >> 1] |= khb << 16; else khw[ii >> 1] = khb; }
    { GAS v4u* kp = (GAS v4u*)(P_KH + (uc * 128 + d) * 64 + g * 16);
      kp[0] = (v4u){khw[0], khw[1], khw[2], khw[3]}; kp[1] = (v4u){khw[4], khw[5], khw[6], khw[7]}; }
    if (g == 0) P_DCb[uc * 128 + d] = __expf(tot);
    { const int n = tid & 255, jh = tid >> 8; unsigned vw[16];
#pragma unroll
      for (int jj = 0; jj < 32; ++jj) { const unsigned v = P_Z[(size_t)(row0 + 32 * jh + jj) * N1P + ZV + h * HV + n];
          if (jj & 1) vw[jj >> 1] |= v << 16; else vw[jj >> 1] = v; }
      GAS v4u* vp = (GAS v4u*)(P_VT + (uc * 256 + n) * 64 + 32 * jh);
#pragma unroll
      for (int k = 0; k < 4; ++k) vp[k] = (v4u){vw[4 * k], vw[4 * k + 1], vw[4 * k + 2], vw[4 * k + 3]}; }
    __syncthreads();
    { const int fr = F.lane & 15, fq = F.lane >> 4;
#pragma unroll
      for (int tt = 0; tt < 2; ++tt) { const int id = 2 * F.wave + tt, it = id >> 2, jt = id & 3;
          f32x4 acc = (f32x4){0.f, 0.f, 0.f, 0.f};
          if (jt <= it) {
#pragma unroll
              for (int s = 0; s < 4; ++s) { const bf16x8 a = *(const LAS bf16x8*)(KS + (jt * 16 + fr) * 136 + 32 * s + 8 * fq); const bf16x8 bq = *(const LAS bf16x8*)(QS + (it * 16 + fr) * 136 + 32 * s + 8 * fq);
                  acc = __builtin_amdgcn_mfma_f32_16x16x32_bf16(a, bq, acc, 0, 0, 0); } }
          const int i = it * 16 + fr, j0 = jt * 16 + 4 * fq;
#pragma unroll
          for (int r = 0; r < 4; ++r) if (j0 + r > i) acc[r] = 0.f;
          v2u o; o.x = pk2(acc[0], acc[1]); o.y = pk2(acc[2], acc[3]);
          *(GAS v2u*)(P_AM + (uc * 64 + i) * 64 + j0) = o; } }
    __syncthreads();
}
__device__ __forceinline__ void ln_silu_row(const LAS float* cs, const float* lng, const float* lnb, bf16* orow, int lane) {
    f32x4 x[4]; float s = 0.f;
#pragma unroll
    for (int j = 0; j < 4; ++j) { x[j] = *(const LAS f32x4*)(cs + 256 * j + 4 * lane); s += (x[j].x + x[j].y) + (x[j].z + x[j].w); }
    const float mean = wave_sum(s) * (1.f / DC_); float q = 0.f;
#pragma unroll
    for (int j = 0; j < 4; ++j) { x[j] = x[j] - mean; q += dot4(x[j], x[j]); }
    const float rstd = 1.0f / sqrtf(wave_sum(q) * (1.f / DC_) + LN_EPS);
#pragma unroll
    for (int j = 0; j < 4; ++j) { const f32x4 g = *(const GAS f32x4*)(lng + 256 * j + 4 * lane), bb = *(const GAS f32x4*)(lnb + 256 * j + 4 * lane);
        const f32x4 y = x[j] * rstd * g + bb; v2u o; o.x = pk2(silu_f(y.x), silu_f(y.y)); o.y = pk2(silu_f(y.z), silu_f(y.w));
        *(GAS v2u*)(orow + 256 * j + 4 * lane) = o; }
}
__device__ __forceinline__ void conv_prompt_unit(Frame& F, const Args& A, int b, int tb) {
    LAS float* CS = (LAS float*)(F.lds + RING_OFF);
    const int t0 = tb * 16;
#pragma unroll 1
    for (int pass = 0; pass < 2; ++pass) { const int c = F.tid + 512 * pass;
        float wt[31];
#pragma unroll
        for (int w = 0; w < 31; ++w) wt[w] = P_conv_w[w * DC_ + c];
        const float bias = P_conv_b[c];
        float g[46];
#pragma unroll
        for (int r = 0; r < 46; ++r) { const int t = t0 - 30 + r, tc = t < 0 ? 0 : t; const bf16* zr = P_Z + (size_t)(b * SEQ + tc) * N1P;
            const float v = bf2f(zr[ZUA + c]) * sigmoid_f(bf2f(zr[ZUG + c])); g[r] = t >= 0 ? v : 0.f; }
#pragma unroll
        for (int tt = 0; tt < 16; ++tt) { float acc = bias;
#pragma unroll
            for (int w = 0; w < 31; ++w) acc += g[tt + w] * wt[w];
            CS[tt * 1024 + c] = acc; }
        if (tb == SEQ / 16 - 1) {
#pragma unroll
            for (int rr = 0; rr < 30; ++rr) P_out[O_CP + ((size_t)b * 30 + rr) * DC_ + c] = g[rr + 16]; }
    }
    __syncthreads();
#pragma unroll
    for (int k = 0; k < 2; ++k) { const int tt = 2 * F.wave + k; ln_silu_row(CS + tt * 1024, P_ln_g, P_ln_b, P_MIX + (size_t)(b * SEQ + t0 + tt) * DM + DA, F.lane); }
    __syncthreads();
}
__device__ __forceinline__ void conv_sample_unit(Frame& F, const Args& A, int b) {
    LAS float* CS = (LAS float*)(F.lds + RING_OFF);
    const bf16* zr = P_Z + (size_t)(MP + b) * N1P;
#pragma unroll 1
    for (int pass = 0; pass < 2; ++pass) { const int c = F.tid + 512 * pass;
        float acc = P_conv_b[c];
#pragma unroll
        for (int w = 0; w < 30; ++w) { const float v = P_sconv[((size_t)b * 30 + w) * DC_ + c]; acc += v * P_conv_w[w * DC_ + c]; if (w >= 1) P_out[O_CS + ((size_t)b * 30 + (w - 1)) * DC_ + c] = v; }
        const float gl = bf2f(zr[ZUA + c]) * sigmoid_f(bf2f(zr[ZUG + c]));
        acc += gl * P_conv_w[30 * DC_ + c]; P_out[O_CS + ((size_t)b * 30 + 29) * DC_ + c] = gl;
        CS[c] = acc; }
    __syncthreads();
    if (F.wave == 0) ln_silu_row(CS, P_ln_g, P_ln_b, P_MIX + (size_t)(MP + b) * DM + DA, F.lane);
    __syncthreads();
}
__device__ __forceinline__ void gla_sample_item(Frame& F, const Args& A, int item) {
    const int b = item >> 2, h = item & 3, tid = F.tid;
    LAS float* AD = (LAS float*)(F.lds + RING_OFF);
    LAS float* KD = AD + 128; LAS float* QD = AD + 256; LAS float* VD = AD + 384;
    LAS float* OP = AD + 640;
    const bf16* zr = P_Z + (size_t)(MP + b) * N1P;
    if (tid < 128) { const int d = tid; float x = P_bgate[h * HK + d];
#pragma unroll
        for (int r = 0; r < 16; ++r) x += bf2f(zr[ZGL + r]) * P_wgu[r * DK + h * HK + d];
        AD[d] = __expf(logsigmoid_f(x) * (1.0f / 16.0f)); KD[d] = bf2f(zr[ZK + h * HK + d]); QD[d] = bf2f(zr[ZQ + h * HK + d]) * 0.08838834764831845f; }
    else if (tid < 384) { const int n = tid - 128; VD[n] = bf2f(zr[ZV + h * HV + n]); }
    __syncthreads();
    const int n4 = 4 * F.lane; const f32x4 v4 = *(const LAS f32x4*)(VD + n4);
    const float* Sin = P_sgla + (size_t)(b * NH + h) * HK * HV; float* Sout = P_out + O_GS + (size_t)(b * NH + h) * HK * HV;
    f32x4 oacc = (f32x4){0.f, 0.f, 0.f, 0.f};
#pragma unroll 4
    for (int dd = 0; dd < 16; ++dd) { const int d = 16 * F.wave + dd; const f32x4 s = *(const GAS f32x4*)(Sin + (size_t)d * HV + n4);
        const f32x4 sn = s * AD[d] + v4 * KD[d]; *(GAS f32x4*)(Sout + (size_t)d * HV + n4) = sn; oacc += sn * QD[d]; }
    *(LAS f32x4*)(OP + F.wave * 256 + n4) = oacc;
    __syncthreads();
    if (F.wave == 0) { f32x4 o4 = (f32x4){0.f, 0.f, 0.f, 0.f};
#pragma unroll
        for (int w = 0; w < 8; ++w) o4 += *(const LAS f32x4*)(OP + w * 256 + n4);
        const float rstd = 1.0f / sqrtf(wave_sum(dot4(o4, o4)) * (1.f / HV) + RMS_EPS);
        const f32x4 gn = *(const GAS f32x4*)(P_gla_norm + n4); const v2u go = *(const GAS v2u*)(zr + ZGO + h * HV + n4);
        v2u o; o.x = pk2(o4.x * rstd * gn.x * silu_f(bflo(go.x)), o4.y * rstd * gn.y * silu_f(bfhi(go.x))); o.y = pk2(o4.z * rstd * gn.z * silu_f(bflo(go.y)), o4.w * rstd * gn.w * silu_f(bfhi(go.y)));
        *(GAS v2u*)(P_MIX + (size_t)(MP + b) * DM + h * HV + n4) = o; }
    __syncthreads();
}

__device__ __forceinline__ void gla_seq_item(Frame& F, const Args& A, int item) {
    const int bh = item >> 4, n0 = (item & 15) * 16, b = bh >> 2, h = bh & 3, fr = F.lane & 15, fq = F.lane >> 4;
    f32x4 S[8];
#pragma unroll
    for (int dt = 0; dt < 8; ++dt) S[dt] = (f32x4){0.f, 0.f, 0.f, 0.f};
#pragma unroll 1
    for (int c = 0; c < NCH; ++c) {
        const size_t uc = (size_t)bh * NCH + c;
        const bf16* AMc = P_AM + uc * 64 * 64; const bf16* VTc = P_VT + uc * 256 * 64; const bf16* QTc = P_QT + uc * 64 * 128; const bf16* KHc = P_KH + uc * 128 * 64; const float* DCc = P_DCb + uc * 128;
        bf16x8 vt[2];
#pragma unroll
        for (int ks = 0; ks < 2; ++ks) vt[ks] = *(const GAS bf16x8*)(VTc + (n0 + fr) * 64 + 32 * ks + 8 * fq);
        f32x4 o[4];
#pragma unroll
        for (int m = 0; m < 4; ++m) { o[m] = (f32x4){0.f, 0.f, 0.f, 0.f};
#pragma unroll
            for (int ks = 0; ks < 2; ++ks) { const bf16x8 a = *(const GAS bf16x8*)(AMc + (16 * m + fr) * 64 + 32 * ks + 8 * fq); o[m] = __builtin_amdgcn_mfma_f32_16x16x32_bf16(a, vt[ks], o[m], 0, 0, 0); } }
        bf16x8 sb[4];
#pragma unroll
        for (int s = 0; s < 4; ++s) { v4u w; w.x = pk2(S[2 * s][0], S[2 * s][1]); w.y = pk2(S[2 * s][2], S[2 * s][3]); w.z = pk2(S[2 * s + 1][0], S[2 * s + 1][1]); w.w = pk2(S[2 * s + 1][2], S[2 * s + 1][3]); sb[s] = __builtin_bit_cast(bf16x8, w); }
#pragma unroll
        for (int m = 0; m < 4; ++m)
#pragma unroll
            for (int s = 0; s < 4; ++s) { const bf16x8 a = *(const GAS bf16x8*)(QTc + (16 * m + fr) * 128 + 32 * s + 8 * fq); o[m] = __builtin_amdgcn_mfma_f32_16x16x32_bf16(a, sb[s], o[m], 0, 0, 0); }
#pragma unroll
        for (int m = 0; m < 4; ++m)
#pragma unroll
            for (int r = 0; r < 4; ++r) P_O32[(size_t)(b * SEQ + c * CH + 16 * m + 4 * fq + r) * DA + h * HV + n0 + fr] = o[m][r];
#pragma unroll
        for (int dt = 0; dt < 8; ++dt) { const f32x4 dc = *(const GAS f32x4*)(DCc + 16 * dt + 4 * fq); S[dt] = S[dt] * dc;
#pragma unroll
            for (int ks = 0; ks < 2; ++ks) { const bf16x8 a = *(const GAS bf16x8*)(KHc + (16 * dt + fr) * 64 + 32 * ks + 8 * fq); S[dt] = __builtin_amdgcn_mfma_f32_16x16x32_bf16(a, vt[ks], S[dt], 0, 0, 0); } }
    }
#pragma unroll
    for (int dt = 0; dt < 8; ++dt)
#pragma unroll
        for (int r = 0; r < 4; ++r) P_out[O_GP + ((size_t)bh * HK + 16 * dt + 4 * fq + r) * HV + n0 + fr] = S[dt][r];
}
__device__ __forceinline__ void gla_onorm_item(Frame& F, const Args& A, int row, int h) {
    const int n4 = 4 * F.lane;
    const f32x4 o4 = *(const GAS f32x4*)(P_O32 + (size_t)row * DA + h * HV + n4);
    const float rstd = 1.0f / sqrtf(wave_sum(dot4(o4, o4)) * (1.f / HV) + RMS_EPS);
    const f32x4 gn = *(const GAS f32x4*)(P_gla_norm + n4); const v2u go = *(const GAS v2u*)(P_Z + (size_t)row * N1P + ZGO + h * HV + n4);
    v2u o; o.x = pk2(o4.x * rstd * gn.x * silu_f(bflo(go.x)), o4.y * rstd * gn.y * silu_f(bfhi(go.x))); o.y = pk2(o4.z * rstd * gn.z * silu_f(bflo(go.y)), o4.w * rstd * gn.w * silu_f(bfhi(go.y)));
    *(GAS v2u*)(P_MIX + (size_t)row * DM + h * HV + n4) = o;
}

#ifndef MK_N_LAUNCHES
#define MK_N_LAUNCHES 10
#endif
constexpr int N_PHASES = 10;
constexpr int N_LAUNCHES = MK_N_LAUNCHES;
__global__ void __launch_bounds__(NWAVES * 64, 2) hymba_fwd(Args args) {
    extern __shared__ __attribute__((aligned(16))) unsigned char lds[];
    Frame F;
    F.lds = (LAS unsigned char*)lds;
    F.MISC = (volatile LAS unsigned*)(F.lds + MISC_OFF);
    F.tid = threadIdx.x; F.lane = F.tid & 63; F.wave = __builtin_amdgcn_readfirstlane(F.tid >> 6);
    F.G = gridDim.x; { const int bx = blockIdx.x; F.vcu = (F.G % 8 == 0) ? (bx % 8) * (F.G / 8) + bx / 8 : bx; }
    const Args& A = args;
    F.ctl = (gu32*)(args.ws + WS_CTL);
    for (int u = F.tid; u < (LDS_BYTES - LDSCTL_OFF) / 4; u += NWAVES * 64) ((LAS unsigned*)(F.lds + LDSCTL_OFF))[u] = 0u;
    __syncthreads();
    XcdBarrier bar; bar.bar = (unsigned*)(F.ctl + CW_BAR); bar.x = 0; bar.st = nullptr;
    if (N_LAUNCHES == 1) bar = xcd_barrier_post((unsigned*)(F.ctl + CW_BAR), F.MISC + 8);
    const int lo = args.ph_lo, hi = args.ph_hi;
#ifndef P2A_MASK
#define P2A_MASK 15
#endif
#ifndef PH_MASK
#define PH_MASK 0x3ff
#endif
#define IN(k) (((PH_MASK >> (k)) & 1) && lo <= (k) && (k) < hi)
#define SEAM(k) do { if (IN(k) && IN((k) + 1)) xcd_barrier(bar); } while (0)
    const int gw = F.vcu * NWAVES + F.wave, NGW = F.G * NWAVES;

    if (IN(0)) { p0_prologue(F, A); }
    SEAM(0);
    if (IN(1)) {
        pg8::Gemm g{P_H, P_W1t, MPAD, N1P, DM}; pg8::StaticOrder S; S.init(MPAD, N1P, F.G, (int)blockIdx.x);
        pg8::EpiStoreBf16 E{P_Z, N1P};
        pg8::gemm_phase<pg8::EpiStoreBf16, pg8::StaticOrder, true, true>(F.lds + RING_OFF, g, S, E);
    }
    SEAM(1);
    if (IN(2)) {
        constexpr int U_PREP = NB * NH * NCH, U_CONVP = NB * (SEQ / 16), U_CONVS = MS, U_GLAS = MS * NH;
        if (P2A_MASK & 1) { for (int r = F.vcu; r < U_GLAS; r += F.G) gla_sample_item(F, A, r); }
        if (P2A_MASK & 2) { for (int r = F.vcu; r < U_PREP; r += F.G) gla_prep_unit(F, A, r / NCH, r % NCH); }
        if (P2A_MASK & 4) { for (int r = F.vcu; r < U_CONVP; r += F.G) conv_prompt_unit(F, A, r / (SEQ / 16), r % (SEQ / 16)); }
        if (P2A_MASK & 8) { for (int r = F.G - 1 - F.vcu; r < U_CONVS; r += F.G) conv_sample_unit(F, A, r); }
    }
    SEAM(2);
    if (IN(3)) {
        if (F.wave == 0) { for (int it = F.vcu; it < NB * NH * 16; it += F.G) gla_seq_item(F, A, it); }
    }
    SEAM(3);
    if (IN(4)) { for (int it = gw; it < MP * NH; it += NGW) gla_onorm_item(F, A, it >> 2, it & 3); }
    SEAM(4);
    if (IN(5)) {
        pg8::Gemm g{P_MIX, P_W2t, MPAD, DM, DM}; pg8::StaticOrder S; S.init(MPAD, DM, F.G, (int)blockIdx.x);
        pg8::EpiResF32 E{P_xp, P_xs, P_out, DM, MP, MR};
        pg8::gemm_phase<pg8::EpiResF32, pg8::StaticOrder, true, true>(F.lds + RING_OFF, g, S, E);
    }
    SEAM(5);
    if (IN(6)) { for (int m = gw; m < MR; m += NGW) rms_row_to_bf16(P_out + (size_t)m * DM, P_norm_ffn, P_H + (size_t)m * DM, F.lane); }
    SEAM(6);
    if (IN(7)) {
        pg8::Gemm g{P_H, P_W3t, MPAD, 2 * DFF, DM}; pg8::StaticOrder S; S.init(MPAD, 2 * DFF, F.G, (int)blockIdx.x);
        pg8::EpiSwiglu E{P_HID, DFF};
        pg8::gemm_phase<pg8::EpiSwiglu, pg8::StaticOrder, true, true>(F.lds + RING_OFF, g, S, E);
    }
    SEAM(7);
    if (IN(8)) {
        pg8::Gemm g{P_HID, P_W4t, MPAD, DM, DFF}; pg8::StaticOrder S; S.init(MPAD, DM, F.G, (int)blockIdx.x);
        pg8::EpiResF32 E{P_out, P_out, P_out, DM, MR, MR};
        pg8::gemm_phase<pg8::EpiResF32, pg8::StaticOrder, true, true>(F.lds + RING_OFF, g, S, E);
    }
    SEAM(8);
    if (IN(9)) { for (int m = gw; m < MR; m += NGW) rms_row_inplace(P_out + (size_t)m * DM, P_norm_final, F.lane); }
#undef IN
#undef SEAM
}

extern "C" void kernel_launch(void* const* d_in, const int* in_sizes, int n_in, void* d_out, int out_size, void* d_ws, size_t ws_size, hipStream_t stream) {
    static int grid = 0;
    if (grid == 0) {
        if (n_in != 18 || in_sizes[0] != MP * DM || (size_t)out_size != O_END || ws_size < WS_END) {
            fprintf(stderr, "kernel_launch: shape mismatch: n_in %d in0 %d out %d ws %zu (need %zu); nothing launched\n", n_in, n_in > 0 ? in_sizes[0] : -1, out_size, ws_size, (size_t)WS_END); grid = -1; return; }
        int dev = 0, cus = 0, per_cu = 0;
        if (hipGetDevice(&dev) != hipSuccess || hipDeviceGetAttribute(&cus, hipDeviceAttributeMultiprocessorCount, dev) != hipSuccess) { grid = -1; return; }
        if (hipFuncSetAttribute((const void*)hymba_fwd, hipFuncAttributeMaxDynamicSharedMemorySize, LDS_BYTES) != hipSuccess) { fprintf(stderr, "kernel_launch: hipFuncSetAttribute failed\n"); grid = -1; return; }
        if (hipOccupancyMaxActiveBlocksPerMultiprocessor(&per_cu, (const void*)hymba_fwd, NWAVES * 64, LDS_BYTES) != hipSuccess || per_cu < 1)
            fprintf(stderr, "kernel_launch: note: occupancy query reports %d workgroups per CU\n", per_cu);
        (void)hipGetLastError();
        grid = cus;
    }
    if (grid < 0) return;
    if (N_LAUNCHES == 1) { if (hipMemsetAsync((char*)d_ws + WS_CTL, 0, CTL_ZERO_BYTES, stream) != hipSuccess) return; }
    Args a{};
    for (int i = 0; i < 18; ++i) a.in[i] = (const float*)d_in[i];
    a.out = (float*)d_out; a.ws = (unsigned char*)d_ws;
    for (int li = 0; li < N_LAUNCHES; ++li) {
        a.ph_lo = (N_LAUNCHES == 1) ? 0 : li; a.ph_hi = (N_LAUNCHES == 1) ? N_PHASES : li + 1;
        hipLaunchKernelGGL(hymba_fwd, dim3(grid), dim3(NWAVES * 64), LDS_BYTES, stream, a);
        const hipError_t le = hipPeekAtLastError();
        if (le != hipSuccess) { fprintf(stderr, "kernel_launch: launch %d failed: %s\n", li, hipGetErrorName(le)); break; }
    }
}
```

```cpp
#include <hip/hip_runtime.h>
#include <cstdio>
#include <cstdint>
constexpr int PG8_DUMMY = 0;
namespace pg8 {
#define PG8_LAS __attribute__((address_space(3)))
typedef unsigned short bf16_t;
typedef short bf16x8 __attribute__((ext_vector_type(8)));
typedef float f32x4 __attribute__((ext_vector_type(4)));
typedef unsigned u32x4 __attribute__((ext_vector_type(4)));
constexpr int BM = 256, BK = 64, HALF = 128, HTB = HALF * BK * 2  , STAGE_BYTES = 8 * HTB, NXCD = 8, WGM = 8;

__host__ __device__ __forceinline__ int lds_byte(int r, int c) { const int st = (r >> 4) * 2 + (c >> 5), rr = r & 15, cc = c & 31, ob = rr * 64 + cc * 2; return st * 1024 + (ob ^ (((ob >> 9) & 1) << 5)); }
__host__ __device__ __forceinline__ void stage_rc(int b, int& R, int& C) { const int st = b / 1024, sb = b % 1024, swz = sb ^ (((sb >> 9) & 1) << 5); R = (st >> 1) * 16 + swz / 64; C = (st & 1) * 32 + (swz % 64) / 2; }
__host__ __device__ __forceinline__ int perm32(int rho) { const int n = rho >> 4, i = rho & 15; return 8 * (i >> 2) + 4 * n + (i & 3); }

struct Unit { int pm, pn; };
struct Gemm { const bf16_t* A; const bf16_t* Bt; int M, N, K; };

struct StaticOrder {
    int nM, nN, nwg, G, c;
    __host__ __device__ void init(int M, int N, int G_, int c_) { nM = M / BM; nN = N / BM; nwg = nM * nN; G = G_; c = c_; }
    __host__ __device__ bool next(int i, Unit& u) const {
        const long L = (long)i * G + c; if (L >= nwg) return false;
        int wgid = (int)L; { const int q = nwg / NXCD, r = nwg % NXCD, xcd = wgid % NXCD, off = wgid / NXCD; wgid = (xcd < r ? xcd * (q + 1) : r * (q + 1) + (xcd - r) * q) + off; }
        const int nig = WGM * nN, gid = wgid / nig, fm = gid * WGM, gsz = (nM - fm) < WGM ? (nM - fm) : WGM;
        u.pm = fm + ((wgid % nig) % gsz); u.pn = (wgid % nig) / gsz; return true;
    }
    __device__ __forceinline__ void a_ready(const Unit&) const {}
    __device__ __forceinline__ void done(const Unit&) const {}
};
__device__ __forceinline__ unsigned cvt_pk_bf16(float lo, float hi) { unsigned r; asm volatile("v_cvt_pk_bf16_f32 %0, %1, %2" : "=v"(r) : "v"(lo), "v"(hi)); return r; }
typedef float f32x2 __attribute__((ext_vector_type(2)));
typedef unsigned u32x2v __attribute__((ext_vector_type(2)));
__device__ __forceinline__ float silu_f(float x) { return x * __builtin_amdgcn_rcpf(1.0f + __expf(-x)); }
struct EpiStoreBf16 {
    static constexpr bool PERM = true, AFTER_DRAIN = false;
    bf16_t* O; int ldc;
    __device__ __forceinline__ void operator()(const f32x4 (&acc)[2][2][4][2], const Unit& u, int wr, int wc, int fr, int fq) const {
        const int row0 = u.pm * BM + wr * 64 + fr, col0 = u.pn * BM + wc * 32 + 8 * fq;
#pragma unroll
        for (int ai = 0; ai < 2; ++ai)
#pragma unroll
            for (int m = 0; m < 4; ++m) { bf16_t* rowp = O + (size_t)(row0 + ai * HALF + m * 16) * ldc + col0;
#pragma unroll
                for (int bj = 0; bj < 2; ++bj) { const f32x4 v0 = acc[ai][bj][m][0], v1 = acc[ai][bj][m][1];
                    u32x4 w; w.x = cvt_pk_bf16(v0[0], v0[1]); w.y = cvt_pk_bf16(v0[2], v0[3]); w.z = cvt_pk_bf16(v1[0], v1[1]); w.w = cvt_pk_bf16(v1[2], v1[3]);
                    *(u32x4*)(rowp + bj * HALF) = w; } }
    }
};
struct EpiSwiglu {
    static constexpr bool PERM = true, AFTER_DRAIN = false;
    bf16_t* O; int ldc;
    __device__ __forceinline__ void operator()(const f32x4 (&acc)[2][2][4][2], const Unit& u, int wr, int wc, int fr, int fq) const {
        const int row0 = u.pm * BM + wr * 64 + fr, col0 = u.pn * HALF + wc * 32 + 8 * fq;
#pragma unroll
        for (int ai = 0; ai < 2; ++ai)
#pragma unroll
            for (int m = 0; m < 4; ++m) { bf16_t* rowp = O + (size_t)(row0 + ai * HALF + m * 16) * ldc + col0;
                float h[8];
#pragma unroll
                for (int n = 0; n < 2; ++n)
#pragma unroll
                    for (int e = 0; e < 4; ++e) h[4 * n + e] = silu_f(acc[ai][0][m][n][e]) * acc[ai][1][m][n][e];
                u32x4 w; w.x = cvt_pk_bf16(h[0], h[1]); w.y = cvt_pk_bf16(h[2], h[3]); w.z = cvt_pk_bf16(h[4], h[5]); w.w = cvt_pk_bf16(h[6], h[7]);
                *(u32x4*)rowp = w; }
    }
};
struct EpiResF32 {
    static constexpr bool PERM = false, AFTER_DRAIN = false;
    const float* base0; const float* base1; float* out; int ldc, msplit, mreal;
    __device__ __forceinline__ void operator()(const f32x4 (&acc)[2][2][4][2], const Unit& u, int wr, int wc, int fr, int fq) const {
        const int row0 = u.pm * BM + wr * 64 + fr, col0 = u.pn * BM + wc * 32 + 4 * fq;
#pragma unroll
        for (int ai = 0; ai < 2; ++ai)
#pragma unroll
            for (int m = 0; m < 4; ++m) { const int row = row0 + ai * HALF + m * 16;
                if (row < mreal) {
                    const float* bp = (row < msplit ? base0 + (size_t)row * ldc : base1 + (size_t)(row - msplit) * ldc) + col0; float* op = out + (size_t)row * ldc + col0;
                    f32x4 b[2][2];
#pragma unroll
                    for (int bj = 0; bj < 2; ++bj)
#pragma unroll
                        for (int n = 0; n < 2; ++n) b[bj][n] = *(const f32x4*)(bp + bj * HALF + n * 16);
#pragma unroll
                    for (int bj = 0; bj < 2; ++bj)
#pragma unroll
                        for (int n = 0; n < 2; ++n) *(f32x4*)(op + bj * HALF + n * 16) = b[bj][n] + acc[ai][bj][m][n];
                } }
    }
};
template <class Epi, class Sched, bool ALIGN_EPI = false, bool SP2 = false>
__device__ __forceinline__ void gemm_phase(PG8_LAS unsigned char* lds, const Gemm g, const Sched& S, const Epi& E) {
    const int tid = threadIdx.x, wid = __builtin_amdgcn_readfirstlane(tid >> 6), lane = tid & 63, wr = wid >> 2, wc = wid & 3, fr = lane & 15, fq = lane >> 4;
    const int K = g.K, nt = K / BK;
    unsigned voffA[2], voffB[2];
#pragma unroll
    for (int i = 0; i < 2; ++i) { int R, C; stage_rc(tid * 16 + i * 8192, R, C); const int Rb = Epi::PERM ? ((R & ~31) + perm32(R & 31)) : R;
        voffA[i] = (unsigned)(R * K + C) * 2u; voffB[i] = (unsigned)(Rb * K + C) * 2u; }
    const size_t kstep = (size_t)(BK * 2);
    const size_t hstep = (size_t)HALF * K * 2;
    const size_t tstep = 2 * hstep;
    const unsigned ldsw = (unsigned)wid * 1024u;
    const int aoff = lds_byte(wr * 64 + fr, fq * 8), boff = lds_byte(wc * 32 + fr, fq * 8);
#define PG8_SA(b, h) (((b) * 2 + (h)) * HTB)
#define PG8_SB(b, h) ((4 + (b) * 2 + (h)) * HTB)
#define PG8_STAGE(bufoff, gbase, voff) do { _Pragma("unroll") for (int _i = 0; _i < 2; ++_i) \
        __builtin_amdgcn_global_load_lds((const unsigned*)((const char*)(gbase) + (voff)[_i]), (PG8_LAS unsigned*)(lds + (bufoff) + ldsw + _i * 8192), 16, 0, 0); } while (0)
#define PG8_LDA(dst, b, h) do { _Pragma("unroll") for (int m = 0; m < 4; ++m) _Pragma("unroll") for (int k = 0; k < 2; ++k) dst[m][k] = *(const PG8_LAS bf16x8*)(lds + PG8_SA(b, h) + aoff + m * 2048 + k * 1024); } while (0)
#define PG8_LDB(dst, b, h) do { _Pragma("unroll") for (int n = 0; n < 2; ++n) _Pragma("unroll") for (int k = 0; k < 2; ++k) dst[n][k] = *(const PG8_LAS bf16x8*)(lds + PG8_SB(b, h) + boff + n * 2048 + k * 1024); } while (0)
#define PG8_MMA(ai, bj, At, Bt) do { __builtin_amdgcn_s_setprio(1); _Pragma("unroll") for (int m = 0; m < 4; ++m) _Pragma("unroll") for (int n = 0; n < 2; ++n) _Pragma("unroll") for (int k = 0; k < 2; ++k) \
        acc[ai][bj][m][n] = __builtin_amdgcn_mfma_f32_16x16x32_bf16(Bt[n][k], At[m][k], acc[ai][bj][m][n], 0, 0, 0); __builtin_amdgcn_s_setprio(0); } while (0)
#define PG8_WAIT_V(n) asm volatile("s_waitcnt vmcnt(" #n ")" ::: "memory")
#define PG8_WAIT_L(n) asm volatile("s_waitcnt lgkmcnt(" #n ")" ::: "memory")
#define PG8_BAR __builtin_amdgcn_s_barrier()
#define PG8_SCHED __builtin_amdgcn_sched_barrier(0)
    Unit cur, nxt; int ui = 0;
    if (!S.next(0, cur)) return;
    f32x4 acc[2][2][4][2];
#pragma unroll
    for (int a = 0; a < 2; ++a)
#pragma unroll
        for (int b = 0; b < 2; ++b)
#pragma unroll
            for (int m = 0; m < 4; ++m)
#pragma unroll
                for (int n = 0; n < 2; ++n) acc[a][b][m][n] = (f32x4){0.f, 0.f, 0.f, 0.f};
    bf16x8 At[4][2], B0[2][2], B1[2][2];
    const char* cA = (const char*)g.A + (size_t)cur.pm * tstep; const char* cB = (const char*)g.Bt + (size_t)cur.pn * tstep;
    S.a_ready(cur);
    if constexpr (SP2) {
        PG8_STAGE(PG8_SB(0, 0), cB, voffB); PG8_STAGE(PG8_SB(0, 1), cB + hstep, voffB); PG8_STAGE(PG8_SA(0, 0), cA, voffA); PG8_STAGE(PG8_SA(0, 1), cA + hstep, voffA);
        if (wr == 1) PG8_BAR;
        PG8_WAIT_V(2); PG8_BAR;
        PG8_STAGE(PG8_SB(1, 0), cB + kstep, voffB); PG8_STAGE(PG8_SA(1, 0), cA + kstep, voffA); PG8_STAGE(PG8_SB(1, 1), cB + hstep + kstep, voffB);
        PG8_WAIT_V(6); PG8_BAR;
    } else {
        PG8_STAGE(PG8_SB(0, 0), cB, voffB); PG8_STAGE(PG8_SA(0, 0), cA, voffA); PG8_STAGE(PG8_SB(0, 1), cB + hstep, voffB); PG8_STAGE(PG8_SA(0, 1), cA + hstep, voffA);
        if (wr == 1) PG8_BAR;
        PG8_WAIT_V(4); PG8_BAR;
        PG8_STAGE(PG8_SB(1, 0), cB + kstep, voffB); PG8_STAGE(PG8_SA(1, 0), cA + kstep, voffA); PG8_STAGE(PG8_SB(1, 1), cB + hstep + kstep, voffB);
        PG8_WAIT_V(6); PG8_BAR;
    }
    for (;;) {
        const bool has_next = S.next(ui + 1, nxt);
        const char* nA = has_next ? (const char*)g.A + (size_t)nxt.pm * tstep : cA; const char* nB = has_next ? (const char*)g.Bt + (size_t)nxt.pn * tstep : cB;
        for (int t = 0; t < nt; t += 2) {
            const bool last = (t == nt - 2);
            const char* a1 = cA + (size_t)(t + 1) * kstep;
            const char* a2 = last ? nA : cA + (size_t)(t + 2) * kstep; const char* b2 = last ? nB : cB + (size_t)(t + 2) * kstep;
            const char* a3 = a2 + kstep; const char* b3 = b2 + kstep;
            if (last && has_next) S.a_ready(nxt);
            if constexpr (SP2) {
            PG8_LDB(B0, 0, 0); PG8_LDB(B1, 0, 1); PG8_SCHED; PG8_LDA(At, 0, 0); PG8_STAGE(PG8_SA(1, 1), a1 + hstep, voffA);
            PG8_WAIT_V(8); PG8_WAIT_L(0); PG8_BAR; PG8_MMA(0, 0, At, B0); PG8_MMA(0, 1, At, B1); PG8_BAR; PG8_SCHED;
            PG8_LDA(At, 0, 1); PG8_STAGE(PG8_SB(0, 0), b2, voffB); PG8_STAGE(PG8_SB(0, 1), b2 + hstep, voffB); PG8_STAGE(PG8_SA(0, 0), a2, voffA);
            PG8_WAIT_V(8); PG8_WAIT_L(0); PG8_BAR; PG8_MMA(1, 0, At, B0); PG8_MMA(1, 1, At, B1); PG8_BAR; PG8_SCHED;
            PG8_LDB(B0, 1, 0); PG8_LDB(B1, 1, 1); PG8_SCHED; PG8_LDA(At, 1, 0); PG8_STAGE(PG8_SA(0, 1), a2 + hstep, voffA);
            PG8_WAIT_V(8); PG8_WAIT_L(0); PG8_BAR; PG8_MMA(0, 0, At, B0); PG8_MMA(0, 1, At, B1); PG8_BAR; PG8_SCHED;
            PG8_LDA(At, 1, 1); PG8_STAGE(PG8_SB(1, 0), b3, voffB); PG8_STAGE(PG8_SB(1, 1), b3 + hstep, voffB); PG8_STAGE(PG8_SA(1, 0), a3, voffA);
            PG8_WAIT_V(8); PG8_WAIT_L(0); PG8_BAR; PG8_MMA(1, 0, At, B0); PG8_MMA(1, 1, At, B1); PG8_BAR; PG8_SCHED;
            } else {
            PG8_LDB(B0, 0, 0); PG8_SCHED; PG8_LDA(At, 0, 0); PG8_STAGE(PG8_SA(1, 1), a1 + hstep, voffA);
            PG8_WAIT_L(8); PG8_BAR; PG8_WAIT_L(0); PG8_MMA(0, 0, At, B0); PG8_BAR; PG8_SCHED;
            PG8_LDB(B1, 0, 1); PG8_STAGE(PG8_SB(0, 0), b2, voffB);
            PG8_BAR; PG8_WAIT_L(0); PG8_MMA(0, 1, At, B1); PG8_BAR;
            PG8_LDA(At, 0, 1); PG8_STAGE(PG8_SA(0, 0), a2, voffA);
            PG8_BAR; PG8_WAIT_L(0); PG8_MMA(1, 0, At, B0); PG8_BAR; PG8_SCHED;
            PG8_STAGE(PG8_SB(0, 1), b2 + hstep, voffB);
            PG8_WAIT_V(6); PG8_BAR; PG8_MMA(1, 1, At, B1); PG8_BAR;
            PG8_LDB(B0, 1, 0); PG8_SCHED; PG8_LDA(At, 1, 0); PG8_STAGE(PG8_SA(0, 1), a2 + hstep, voffA);
            PG8_WAIT_L(8); PG8_BAR; PG8_WAIT_L(0); PG8_MMA(0, 0, At, B0); PG8_BAR; PG8_SCHED;
            PG8_LDB(B1, 1, 1); PG8_STAGE(PG8_SB(1, 0), b3, voffB);
            PG8_BAR; PG8_WAIT_L(0); PG8_MMA(0, 1, At, B1); PG8_BAR;
            PG8_LDA(At, 1, 1); PG8_STAGE(PG8_SA(1, 0), a3, voffA);
            PG8_BAR; PG8_WAIT_L(0); PG8_MMA(1, 0, At, B0); PG8_BAR; PG8_SCHED;
            PG8_STAGE(PG8_SB(1, 1), b3 + hstep, voffB);
            PG8_WAIT_V(6); PG8_BAR; PG8_MMA(1, 1, At, B1); PG8_BAR;
            }
        }
        if constexpr (ALIGN_EPI) { if (wr == 0) PG8_BAR; }
        if constexpr (!Epi::AFTER_DRAIN) { E(acc, cur, wr, wc, fr, fq); S.done(cur); }
        if (!has_next) break;
#pragma unroll
        for (int a = 0; a < 2; ++a)
#pragma unroll
            for (int b = 0; b < 2; ++b)
#pragma unroll
                for (int m = 0; m < 4; ++m)
#pragma unroll
                    for (int n = 0; n < 2; ++n) acc[a][b][m][n] = (f32x4){0.f, 0.f, 0.f, 0.f};
        cur = nxt; cA = nA; cB = nB; ++ui;
        if constexpr (ALIGN_EPI) { if (wr == 1) PG8_BAR; }
    }
    PG8_WAIT_V(0);
    if constexpr (!ALIGN_EPI) { if (wr == 0) PG8_BAR; }
    PG8_BAR;
    if constexpr (Epi::AFTER_DRAIN) { E.fused(acc, cur, wr, wc, fr, fq, lds, wid, lane); S.done(cur); }
#undef PG8_SA
#undef PG8_SB
#undef PG8_STAGE
#undef PG8_LDA
#undef PG8_LDB
#undef PG8_MMA
#undef PG8_WAIT_V
#undef PG8_WAIT_L
#undef PG8_BAR
#undef PG8_SCHED
}
}

constexpr int NWAVES = 8;
constexpr int DM = 2048, MP = 8192, MS = 128, MR = MP + MS  , MPAD = 8448  , SEQ = 2048, NB = 4;
constexpr int NH = 4, HK = 128, HV = 256, DK = 512, DA = 1024, DC_ = 1024, GR = 16, CW = 31, DFF = 5632;
constexpr int N1 = 5136, N1P = 5376;
constexpr int ZQ = 0, ZK = 512, ZV = 1024, ZGO = 2048, ZUA = 3072, ZUG = 4096, ZGL = 5120;
constexpr int CH = 64, NCH = SEQ / CH;
constexpr float RMS_EPS = 1e-6f, LN_EPS = 1e-5f;
constexpr size_t O_YP = 0, O_YS = (size_t)MP * DM, O_GP = O_YS + (size_t)MS * DM, O_CP = O_GP + (size_t)NB * NH * HK * HV, O_GS = O_CP + (size_t)NB * 30 * DC_,
                 O_CS = O_GS + (size_t)MS * NH * HK * HV, O_END = O_CS + (size_t)MS * 30 * DC_;
constexpr size_t MiB = 1u << 20;
constexpr size_t WS_CTL = 0, CTL_ZERO_BYTES = 1 * MiB;
constexpr size_t WS_W1 = 2 * MiB;
constexpr size_t WS_W2 = 23 * MiB;
constexpr size_t WS_W3 = 31 * MiB;
constexpr size_t WS_W4 = 75 * MiB;
constexpr size_t WS_H = 97 * MiB;
constexpr size_t WS_QT = WS_H, WS_KH = WS_H + 8 * MiB, WS_VT = WS_H + 16 * MiB;
constexpr size_t WS_Z = 130 * MiB;
constexpr size_t WS_MIX = 217 * MiB;
constexpr size_t WS_HID = 130 * MiB;
constexpr size_t WS_END = 250 * MiB;
static_assert(WS_Z + (size_t)MPAD * N1P * 2 <= WS_MIX && WS_HID + (size_t)MPAD * DFF * 2 <= WS_END && WS_W1 + (size_t)N1P * DM * 2 <= WS_W2 && WS_W3 + (size_t)2 * DFF * DM * 2 <= WS_W4 && WS_W4 + (size_t)DM * DFF * 2 <= WS_H, "d_ws map");
constexpr size_t DO_O32 = 0, DO_AM = 32 * MiB, DO_DC = 36 * MiB;
constexpr int CW_TMO = 0, CW_BAR = 4096;
constexpr int RING_OFF = 0, RING_BYTES = 131072;
constexpr int LDSCTL_OFF = RING_BYTES, MISC_OFF = LDSCTL_OFF + 320;
constexpr int LDS_BYTES = 147456;

#define GAS __attribute__((address_space(1)))
#define LAS __attribute__((address_space(3)))
typedef unsigned short bf16;
typedef unsigned v4u __attribute__((ext_vector_type(4)));
typedef unsigned v2u __attribute__((ext_vector_type(2)));
typedef float f32x4 __attribute__((ext_vector_type(4)));
typedef float f32x2 __attribute__((ext_vector_type(2)));
typedef short bf16x8 __attribute__((ext_vector_type(8)));
typedef GAS unsigned gu32;
typedef GAS unsigned long long gu64;
#define RLX_AGENT __ATOMIC_RELAXED, __HIP_MEMORY_SCOPE_AGENT
#define LDS_WAIT() asm volatile("s_waitcnt lgkmcnt(0)" ::: "memory")
#define VM_WAIT() asm volatile("s_waitcnt vmcnt(0)" ::: "memory")
__device__ __forceinline__ unsigned f2bf(float f) { unsigned u = __builtin_bit_cast(unsigned, f); return (u + 0x7fffu + ((u >> 16) & 1u)) >> 16; }
__device__ __forceinline__ unsigned pk2(float lo, float hi) { return f2bf(lo) | (f2bf(hi) << 16); }
__device__ __forceinline__ float bf2f(unsigned short b) { return __builtin_bit_cast(float, (unsigned)b << 16); }
__device__ __forceinline__ float bflo(unsigned w) { return __builtin_bit_cast(float, w << 16); }
__device__ __forceinline__ float bfhi(unsigned w) { return __builtin_bit_cast(float, w & 0xffff0000u); }
__device__ __forceinline__ float sigmoid_f(float x) { return __builtin_amdgcn_rcpf(1.0f + __expf(-x)); }
__device__ __forceinline__ float silu_f(float x) { return x * sigmoid_f(x); }
__device__ __forceinline__ float logsigmoid_f(float x) { return fminf(x, 0.f) - log1pf(__expf(-fabsf(x))); }
#define XB_TMO      128
#define XB_XCNT(j)  (256  + 64 * (j))
#define XB_XSUB(j)  (1280 + 64 * (j))
#define XB_XGEN(j)  (2304 + 64 * (j))
#define XB_TOP      3328
#define XB_TOPGEN   3392
#define XCD_BAR_WORDS 3456
#define XB_SPIN_CAP (1u << 18)

__device__ __forceinline__ unsigned xb_ld(unsigned* p)              { return __hip_atomic_load(p, __ATOMIC_RELAXED, __HIP_MEMORY_SCOPE_AGENT); }
__device__ __forceinline__ unsigned xb_add(unsigned* p, unsigned v) { return __hip_atomic_fetch_add(p, v, __ATOMIC_RELAXED, __HIP_MEMORY_SCOPE_AGENT); }
__device__ __forceinline__ unsigned xb_xcc_id() { return (unsigned)__builtin_amdgcn_s_getreg((3 << 11) | 20) & 0xFu; }
#define XB_SPIN(cond, bar) do { unsigned _sp = 0; while (cond) { __builtin_amdgcn_s_sleep(1); \
    if ((++_sp & 255u) == 0u) { if (xb_ld(&(bar)[XB_TMO])) break; if (_sp > XB_SPIN_CAP) { atomicAdd(&(bar)[XB_TMO], 1u); break; } } } } while (0)

struct XcdBarrier {
    unsigned* bar; unsigned x;
    volatile LAS unsigned* st;
};

__device__ __forceinline__ XcdBarrier xcd_barrier_post(unsigned* bar, volatile LAS unsigned* st) {
    XcdBarrier b; b.bar = bar; b.x = xb_xcc_id(); b.st = st;
    if (threadIdx.x == 0) (void)xb_add(&bar[XB_XCNT(b.x)], 1u);
    return b;
}
__device__ __forceinline__ void xcd_barrier_complete(unsigned* bar, unsigned x, unsigned& nloc, unsigned& nx) {
    const unsigned G = gridDim.x * gridDim.y * gridDim.z;
    unsigned sum, cnt, mine, sp = 0u;
    for (;;) {
        sum = 0u; cnt = 0u; mine = 0u;
#pragma unroll
        for (unsigned j = 0; j < 16; ++j) { const unsigned c = xb_ld(&bar[XB_XCNT(j)]); sum += c; cnt += (c > 0u) ? 1u : 0u; mine = (j == x) ? c : mine; }
        if (sum == G) break;
        __builtin_amdgcn_s_sleep(1);
        if ((++sp & 255u) == 0u) { if (xb_ld(&bar[XB_TMO])) break; if (sp > XB_SPIN_CAP) { atomicAdd(&bar[XB_TMO], 1u); break; } }
    }
    nloc = mine > 0u ? mine : 1u; nx = cnt > 0u ? cnt : 1u;
}

__device__ __forceinline__ void xcd_barrier(const XcdBarrier& b) {
    asm volatile("s_waitcnt vmcnt(0)" ::: "memory");
    __syncthreads();
    if (threadIdx.x == 0) {
        unsigned* bar = b.bar;
        __builtin_amdgcn_s_waitcnt(0);
        unsigned nloc = b.st[0], nx = b.st[1];
        if (nloc == 0u) { xcd_barrier_complete(bar, b.x, nloc, nx); b.st[0] = nloc; b.st[1] = nx; }
        const unsigned old = xb_add(&bar[XB_XSUB(b.x)], 1u);
        const unsigned gen = old / nloc;
        if (old + 1u == (gen + 1u) * nloc) {
            __builtin_amdgcn_fence(__ATOMIC_RELEASE, "agent");
            asm volatile("s_waitcnt vmcnt(0)" ::: "memory");
            const unsigned og = xb_add(&bar[XB_TOP], 1u);
            const unsigned tg = og / nx;
            if (og + 1u == (tg + 1u) * nx) xb_add(&bar[XB_TOPGEN], 1u);
            else XB_SPIN(xb_ld(&bar[XB_TOPGEN]) == tg, bar);
            __builtin_amdgcn_fence(__ATOMIC_ACQUIRE, "agent");
            xb_add(&bar[XB_XGEN(b.x)], 1u);
            asm volatile("s_waitcnt vmcnt(0)" ::: "memory");
        } else {
            XB_SPIN(xb_ld(&bar[XB_XGEN(b.x)]) == gen, bar);
            __builtin_amdgcn_fence(__ATOMIC_ACQUIRE, "agent");
            asm volatile("s_waitcnt vmcnt(0)" ::: "memory");
        }
    }
    __syncthreads();
}
struct Args { const float* in[18]; float* out; unsigned char* ws; int ph_lo, ph_hi; };
#define P_xp (A.in[0])
#define P_xs (A.in[1])
#define P_sgla (A.in[2])
#define P_sconv (A.in[3])
#define P_norm_mix (A.in[4])
#define P_w_in (A.in[5])
#define P_wgu (A.in[6])
#define P_bgate (A.in[7])
#define P_gla_norm (A.in[8])
#define P_conv_w (A.in[9])
#define P_conv_b (A.in[10])
#define P_ln_g (A.in[11])
#define P_ln_b (A.in[12])
#define P_w_out (A.in[13])
#define P_norm_ffn (A.in[14])
#define P_w_ffn_in (A.in[15])
#define P_w_ffn_out (A.in[16])
#define P_norm_final (A.in[17])
#define P_W1t ((bf16*)(A.ws + WS_W1))
#define P_W2t ((bf16*)(A.ws + WS_W2))
#define P_W3t ((bf16*)(A.ws + WS_W3))
#define P_W4t ((bf16*)(A.ws + WS_W4))
#define P_H ((bf16*)(A.ws + WS_H))
#define P_Z ((bf16*)(A.ws + WS_Z))
#define P_MIX ((bf16*)(A.ws + WS_MIX))
#define P_HID ((bf16*)(A.ws + WS_HID))
#define P_QT ((bf16*)(A.ws + WS_QT))
#define P_KH ((bf16*)(A.ws + WS_KH))
#define P_VT ((bf16*)(A.ws + WS_VT))
#define P_out (A.out)
#define P_O32 ((float*)((unsigned char*)A.out + DO_O32))
#define P_AM ((bf16*)((unsigned char*)A.out + DO_AM))
#define P_DCb ((float*)((unsigned char*)A.out + DO_DC))

struct Frame {
    LAS unsigned char* lds;
    volatile LAS unsigned* MISC;
    gu32* ctl;
    int tid, lane, wave, vcu, G;
};
__device__ __forceinline__ float wave_sum(float v) {
#pragma unroll
    for (int o = 1; o < 64; o <<= 1) v += __shfl_xor(v, o);
    return v;
}
__device__ __forceinline__ float dot4(f32x4 a, f32x4 b) { return (a.x * b.x + a.y * b.y) + (a.z * b.z + a.w * b.w); }

template <int MAP> __device__ __forceinline__ int srccol(int n) {
    if (MAP == 1) return n < 2048 ? n : (n < 5120 ? n + 16 : (n < 5136 ? n - 3072 : -1));
    if (MAP == 3) { const int t = n >> 8, r = n & 255; return r < 128 ? 128 * t + r : DFF + 128 * t + (r - 128); }
    return n;
}
template <int MAP> __device__ __forceinline__ void p0_transpose_item(const float* W, int K, int Nsrc, int Ndst, bf16* WT, LAS float* scr, int item, int lane) {
    const int nblk = Ndst / 32, kb = item / nblk, nb = item % nblk, k0 = 64 * kb, n0 = 32 * nb;
    const int sc = srccol<MAP>(n0 + (lane & 31));
    const float* src = W + (size_t)k0 * Nsrc + (sc >= 0 ? sc : 0);
#pragma unroll 8
    for (int i = 0; i < 32; ++i) { const int kk = 2 * i + (lane >> 5); const float v = src[(size_t)kk * Nsrc]; scr[kk * 33 + (lane & 31)] = sc >= 0 ? v : 0.f; }
    LDS_WAIT(); asm volatile("" ::: "memory");
    const int c = lane & 7;
#pragma unroll
    for (int j = 0; j < 4; ++j) { const int n = (lane >> 3) + 8 * j; const LAS float* s = scr + (8 * c) * 33 + n;
        v4u o; o.x = pk2(s[0 * 33], s[1 * 33]); o.y = pk2(s[2 * 33], s[3 * 33]); o.z = pk2(s[4 * 33], s[5 * 33]); o.w = pk2(s[6 * 33], s[7 * 33]);
        *(GAS v4u*)(WT + (size_t)(n0 + n) * K + k0 + 8 * c) = o; }
    LDS_WAIT(); asm volatile("" ::: "memory");
}
__device__ __forceinline__ void rms_row_to_bf16(const float* xrow, const float* gain, bf16* orow, int lane) {
    const GAS f32x4* xr = (const GAS f32x4*)xrow + lane; const GAS f32x4* gr = (const GAS f32x4*)gain + lane;
    f32x4 v[8]; float s = 0.f;
#pragma unroll
    for (int j = 0; j < 8; ++j) { v[j] = xr[64 * j]; s += dot4(v[j], v[j]); }
    const float rstd = 1.0f / sqrtf(wave_sum(s) * (1.f / DM) + RMS_EPS);
    GAS v2u* o8 = (GAS v2u*)orow + lane;
#pragma unroll
    for (int j = 0; j < 8; ++j) { const f32x4 g = gr[64 * j]; v2u o; o.x = pk2(v[j].x * rstd * g.x, v[j].y * rstd * g.y); o.y = pk2(v[j].z * rstd * g.z, v[j].w * rstd * g.w); o8[64 * j] = o; }
}
__device__ __forceinline__ void rms_row_inplace(float* xrow, const float* gain, int lane) {
    GAS f32x4* xr = (GAS f32x4*)xrow + lane; const GAS f32x4* gr = (const GAS f32x4*)gain + lane;
    f32x4 v[8]; float s = 0.f;
#pragma unroll
    for (int j = 0; j < 8; ++j) { v[j] = xr[64 * j]; s += dot4(v[j], v[j]); }
    const float rstd = 1.0f / sqrtf(wave_sum(s) * (1.f / DM) + RMS_EPS);
#pragma unroll
    for (int j = 0; j < 8; ++j) { const f32x4 g = gr[64 * j]; xr[64 * j] = v[j] * rstd * g; }
}
__device__ __forceinline__ void p0_prologue(Frame& F, const Args& A) {
    LAS float* scr = (LAS float*)(F.lds + RING_OFF + F.wave * 16384);
    const int gw = F.vcu * NWAVES + F.wave, NGW = F.G * NWAVES;
    constexpr int I_1 = (DM / 64) * (N1P / 32), I_2 = (DM / 64) * (DM / 32), I_3 = (DM / 64) * (2 * DFF / 32), I_4 = (DFF / 64) * (DM / 32);
    constexpr int NITEMS = I_1 + I_2 + I_3 + I_4;
    for (int it = gw; it < NITEMS; it += NGW) {
        int r = it;
        if (r < I_1) { p0_transpose_item<1>(P_w_in, DM, N1, N1P, P_W1t, scr, r, F.lane); continue; } r -= I_1;
        if (r < I_2) { p0_transpose_item<0>(P_w_out, DM, DM, DM, P_W2t, scr, r, F.lane); continue; } r -= I_2;
        if (r < I_3) { p0_transpose_item<3>(P_w_ffn_in, DM, 2 * DFF, 2 * DFF, P_W3t, scr, r, F.lane); continue; } r -= I_3;
        p0_transpose_item<0>(P_w_ffn_out, DFF, DM, DM, P_W4t, scr, r, F.lane);
    }
    for (int m = gw; m < MPAD; m += NGW) {
        if (m < MR) rms_row_to_bf16(m < MP ? P_xp + (size_t)m * DM : P_xs + (size_t)(m - MP) * DM, P_norm_mix, P_H + (size_t)m * DM, F.lane);
        else { GAS v4u* o = (GAS v4u*)(P_H + (size_t)m * DM) + F.lane;
#pragma unroll
            for (int j = 0; j < 4; ++j) o[64 * j] = (v4u){0u, 0u, 0u, 0u}; }
    }
}

__device__ __forceinline__ void gla_prep_unit(Frame& F, const Args& A, int bh, int c) {
    const int tid = F.tid, b = bh >> 2, h = bh & 3, row0 = b * SEQ + c * CH;
    LAS float* GL = (LAS float*)(F.lds + RING_OFF);
    LAS float* BL = (LAS float*)(F.lds + RING_OFF + 4608);
    LAS bf16* QS = (LAS bf16*)(F.lds + RING_OFF + 8192);
    LAS bf16* KS = (LAS bf16*)(F.lds + RING_OFF + 25600);
    const size_t uc = (size_t)bh * NCH + c;
    for (int e = tid; e < CH * GR; e += NWAVES * 64) { const int i = e >> 4, r = e & 15; GL[i * 17 + r] = bf2f(P_Z[(size_t)(row0 + i) * N1P + ZGL + r]); }
    const int d = tid & 127, g = tid >> 7;
    float wg[16];
#pragma unroll
    for (int r = 0; r < 16; ++r) wg[r] = P_wgu[r * DK + h * HK + d];
    const float bg = P_bgate[h * HK + d];
    __syncthreads();
    float bcum[16]; float run = 0.f;
#pragma unroll
    for (int ii = 0; ii < 16; ++ii) { const int i = g * 16 + ii; float x = bg;
#pragma unroll
        for (int r = 0; r < 16; ++r) x += GL[i * 17 + r] * wg[r];
        run += logsigmoid_f(x) * (1.0f / 16.0f); bcum[ii] = run; }
    BL[g * 128 + d] = run;
    __syncthreads();
    float off = 0.f, tot = 0.f;
#pragma unroll
    for (int gg = 0; gg < 4; ++gg) { const float t = BL[gg * 128 + d]; off += (gg < g) ? t : 0.f; tot += t; }
    const float scale = 0.08838834764831845f;
    const int d5 = d & 31, pd = (d & ~31) + 8 * ((d5 >> 2) & 3) + 4 * (d5 >> 4) + (d5 & 3);
    unsigned khw[8];
#pragma unroll
    for (int ii = 0; ii < 16; ++ii) { const int i = g * 16 + ii; const float bb = bcum[ii] + off;
        const bf16* zr = P_Z + (size_t)(row0 + i) * N1P;
        const float q = bf2f(zr[ZQ + h * HK + d]) * scale * __expf(bb);
        const float kv = bf2f(zr[ZK + h * HK + d]);
        const unsigned qb = f2bf(q), ktb = f2bf(kv * __expf(-bb)), khb = f2bf(kv * __expf(tot - bb));
        QS[i * 136 + d] = (bf16)qb; KS[i * 136 + d] = (bf16)ktb;
        P_QT[(uc * 64 + i) * 128 + pd] = (bf16)qb;
        if (ii & 1) khw[ii >> 1] |= khb << 16; else khw[ii >> 1] = khb; }
    { GAS v4u* kp = (GAS v4u*)(P_KH + (uc * 128 + d) * 64 + g * 16);
      kp[0] = (v4u){khw[0], khw[1], khw[2], khw[3]}; kp[1] = (v4u){khw[4], khw[5], khw[6], khw[7]}; }
    if (g == 0) P_DCb[uc * 128 + d] = __expf(tot);
    { const int n = tid & 255, jh = tid >> 8; unsigned vw[16];
#pragma unroll
      for (int jj = 0; jj < 32; ++jj) { const unsigned v = P_Z[(size_t)(row0 + 32 * jh + jj) * N1P + ZV + h * HV + n];
          if (jj & 1) vw[jj >> 1] |= v << 16; else vw[jj >> 1] = v; }
      GAS v4u* vp = (GAS v4u*)(P_VT + (uc * 256 + n) * 64 + 32 * jh);
#pragma unroll
      for (int k = 0; k < 4; ++k) vp[k] = (v4u){vw[4 * k], vw[4 * k + 1], vw[4 * k + 2], vw[4 * k + 3]}; }
    __syncthreads();
    { const int fr = F.lane & 15, fq = F.lane >> 4;
#pragma unroll
      for (int tt = 0; tt < 2; ++tt) { const int id = 2 * F.wave + tt, it = id >> 2, jt = id & 3;
          f32x4 acc = (f32x4){0.f, 0.f, 0.f, 0.f};
          if (jt <= it) {
#pragma unroll
              for (int s = 0; s < 4; ++s) { const bf16x8 a = *(const LAS bf16x8*)(KS + (jt * 16 + fr) * 136 + 32 * s + 8 * fq); const bf16x8 bq = *(const LAS bf16x8*)(QS + (it * 16 + fr) * 136 + 32 * s + 8 * fq);
                  acc = __builtin_amdgcn_mfma_f32_16x16x32_bf16(a, bq, acc, 0, 0, 0); } }
          const int i = it * 16 + fr, j0 = jt * 16 + 4 * fq;
#pragma unroll
          for (int r = 0; r < 4; ++r) if (j0 + r > i) acc[r] = 0.f;
          v2u o; o.x = pk2(acc[0], acc[1]); o.y = pk2(acc[2], acc[3]);
          *(GAS v2u*)(P_AM + (uc * 64 + i) * 64 + j0) = o; } }
    __syncthreads();
}
__device__ __forceinline__ void ln_silu_row(const LAS float* cs, const float* lng, const float* lnb, bf16* orow, int lane) {
    f32x4 x[4]; float s = 0.f;
#pragma unroll
    for (int j = 0; j < 4; ++j) { x[j] = *(const LAS f32x4*)(cs + 256 * j + 4 * lane); s += (x[j].x + x[j].y) + (x[j].z + x[j].w); }
    const float mean = wave_sum(s) * (1.f / DC_); float q = 0.f;
#pragma unroll
    for (int j = 0; j < 4; ++j) { x[j] = x[j] - mean; q += dot4(x[j], x[j]); }
    const float rstd = 1.0f / sqrtf(wave_sum(q) * (1.f / DC_) + LN_EPS);
#pragma unroll
    for (int j = 0; j < 4; ++j) { const f32x4 g = *(const GAS f32x4*)(lng + 256 * j + 4 * lane), bb = *(const GAS f32x4*)(lnb + 256 * j + 4 * lane);
        const f32x4 y = x[j] * rstd * g + bb; v2u o; o.x = pk2(silu_f(y.x), silu_f(y.y)); o.y = pk2(silu_f(y.z), silu_f(y.w));
        *(GAS v2u*)(orow + 256 * j + 4 * lane) = o; }
}
__device__ __forceinline__ void conv_prompt_unit(Frame& F, const Args& A, int b, int tb) {
    LAS float* CS = (LAS float*)(F.lds + RING_OFF);
    const int t0 = tb * 16;
#pragma unroll 1
    for (int pass = 0; pass < 2; ++pass) { const int c = F.tid + 512 * pass;
        float wt[31];
#pragma unroll
        for (int w = 0; w < 31; ++w) wt[w] = P_conv_w[w * DC_ + c];
        const float bias = P_conv_b[c];
        float g[46];
#pragma unroll
        for (int r = 0; r < 46; ++r) { const int t = t0 - 30 + r, tc = t < 0 ? 0 : t; const bf16* zr = P_Z + (size_t)(b * SEQ + tc) * N1P;
            const float v = bf2f(zr[ZUA + c]) * sigmoid_f(bf2f(zr[ZUG + c])); g[r] = t >= 0 ? v : 0.f; }
#pragma unroll
        for (int tt = 0; tt < 16; ++tt) { float acc = bias;
#pragma unroll
            for (int w = 0; w < 31; ++w) acc += g[tt + w] * wt[w];
            CS[tt * 1024 + c] = acc; }
        if (tb == SEQ / 16 - 1) {
#pragma unroll
            for (int rr = 0; rr < 30; ++rr) P_out[O_CP + ((size_t)b * 30 + rr) * DC_ + c] = g[rr + 16]; }
    }
    __syncthreads();
#pragma unroll
    for (int k = 0; k < 2; ++k) { const int tt = 2 * F.wave + k; ln_silu_row(CS + tt * 1024, P_ln_g, P_ln_b, P_MIX + (size_t)(b * SEQ + t0 + tt) * DM + DA, F.lane); }
    __syncthreads();
}
__device__ __forceinline__ void conv_sample_unit(Frame& F, const Args& A, int b) {
    LAS float* CS = (LAS float*)(F.lds + RING_OFF);
    const bf16* zr = P_Z + (size_t)(MP + b) * N1P;
#pragma unroll 1
    for (int pass = 0; pass < 2; ++pass) { const int c = F.tid + 512 * pass;
        float acc = P_conv_b[c];
#pragma unroll
        for (int w = 0; w < 30; ++w) { const float v = P_sconv[((size_t)b * 30 + w) * DC_ + c]; acc += v * P_conv_w[w * DC_ + c]; if (w >= 1) P_out[O_CS + ((size_t)b * 30 + (w - 1)) * DC_ + c] = v; }
        const float gl = bf2f(zr[ZUA + c]) * sigmoid_f(bf2f(zr[ZUG + c]));
        acc += gl * P_conv_w[30 * DC_ + c]; P_out[O_CS + ((size_t)b * 30 + 29) * DC_ + c] = gl;
        CS[c] = acc; }
    __syncthreads();
    if (F.wave == 0) ln_silu_row(CS, P_ln_g, P_ln_b, P_MIX + (size_t)(MP + b) * DM + DA, F.lane);
    __syncthreads();
}
__device__ __forceinline__ void gla_sample_item(Frame& F, const Args& A, int item) {
    const int b = item >> 2, h = item & 3, tid = F.tid;
    LAS float* AD = (LAS float*)(F.lds + RING_OFF);
    LAS float* KD = AD + 128; LAS float* QD = AD + 256; LAS float* VD = AD + 384;
    LAS float* OP = AD + 640;
    const bf16* zr = P_Z + (size_t)(MP + b) * N1P;
    if (tid < 128) { const int d = tid; float x = P_bgate[h * HK + d];
#pragma unroll
        for (int r = 0; r < 16; ++r) x += bf2f(zr[ZGL + r]) * P_wgu[r * DK + h * HK + d];
        AD[d] = __expf(logsigmoid_f(x) * (1.0f / 16.0f)); KD[d] = bf2f(zr[ZK + h * HK + d]); QD[d] = bf2f(zr[ZQ + h * HK + d]) * 0.08838834764831845f; }
    else if (tid < 384) { const int n = tid - 128; VD[n] = bf2f(zr[ZV + h * HV + n]); }
    __syncthreads();
    const int n4 = 4 * F.lane; const f32x4 v4 = *(const LAS f32x4*)(VD + n4);
    const float* Sin = P_sgla + (size_t)(b * NH + h) * HK * HV; float* Sout = P_out + O_GS + (size_t)(b * NH + h) * HK * HV;
    f32x4 oacc = (f32x4){0.f, 0.f, 0.f, 0.f};
#pragma unroll 4
    for (int dd = 0; dd < 16; ++dd) { const int d = 16 * F.wave + dd; const f32x4 s = *(const GAS f32x4*)(Sin + (size_t)d * HV + n4);
        const f32x4 sn = s * AD[d] + v4 * KD[d]; *(GAS f32x4*)(Sout + (size_t)d * HV + n4) = sn; oacc += sn * QD[d]; }
    *(LAS f32x4*)(OP + F.wave * 256 + n4) = oacc;
    __syncthreads();
    if (F.wave == 0) { f32x4 o4 = (f32x4){0.f, 0.f, 0.f, 0.f};
#pragma unroll
        for (int w = 0; w < 8; ++w) o4 += *(const LAS f32x4*)(OP + w * 256 + n4);
        const float rstd = 1.0f / sqrtf(wave_sum(dot4(o4, o4)) * (1.f / HV) + RMS_EPS);
        const f32x4 gn = *(const GAS f32x4*)(P_gla_norm + n4); const v2u go = *(const GAS v2u*)(zr + ZGO + h * HV + n4);
        v2u o; o.x = pk2(o4.x * rstd * gn.x * silu_f(bflo(go.x)), o4.y * rstd * gn.y * silu_f(bfhi(go.x))); o.y = pk2(o4.z * rstd * gn.z * silu_f(bflo(go.y)), o4.w * rstd * gn.w * silu_f(bfhi(go.y)));
        *(GAS v2u*)(P_MIX + (size_t)(MP + b) * DM + h * HV + n4) = o; }
    __syncthreads();
}

__device__ __forceinline__ void gla_seq_item(Frame& F, const Args& A, int item) {
    const int bh = item >> 4, n0 = (item & 15) * 16, b = bh >> 2, h = bh & 3, fr = F.lane & 15, fq = F.lane >> 4;
    f32x4 S[8];
#pragma unroll
    for (int dt = 0; dt < 8; ++dt) S[dt] = (f32x4){0.f, 0.f, 0.f, 0.f};
#pragma unroll 1
    for (int c = 0; c < NCH; ++c) {
        const size_t uc = (size_t)bh * NCH + c;
        const bf16* AMc = P_AM + uc * 64 * 64; const bf16* VTc = P_VT + uc * 256 * 64; const bf16* QTc = P_QT + uc * 64 * 128; const bf16* KHc = P_KH + uc * 128 * 64; const float* DCc = P_DCb + uc * 128;
        bf16x8 vt[2];
#pragma unroll
        for (int ks = 0; ks < 2; ++ks) vt[ks] = *(const GAS bf16x8*)(VTc + (n0 + fr) * 64 + 32 * ks + 8 * fq);
        f32x4 o[4];
#pragma unroll
        for (int m = 0; m < 4; ++m) { o[m] = (f32x4){0.f, 0.f, 0.f, 0.f};
#pragma unroll
            for (int ks = 0; ks < 2; ++ks) { const bf16x8 a = *(const GAS bf16x8*)(AMc + (16 * m + fr) * 64 + 32 * ks + 8 * fq); o[m] = __builtin_amdgcn_mfma_f32_16x16x32_bf16(a, vt[ks], o[m], 0, 0, 0); } }
        bf16x8 sb[4];
#pragma unroll
        for (int s = 0; s < 4; ++s) { v4u w; w.x = pk2(S[2 * s][0], S[2 * s][1]); w.y = pk2(S[2 * s][2], S[2 * s][3]); w.z = pk2(S[2 * s + 1][0], S[2 * s + 1][1]); w.w = pk2(S[2 * s + 1][2], S[2 * s + 1][3]); sb[s] = __builtin_bit_cast(bf16x8, w); }
#pragma unroll
        for (int m = 0; m < 4; ++m)
#pragma unroll
            for (int s = 0; s < 4; ++s) { const bf16x8 a = *(const GAS bf16x8*)(QTc + (16 * m + fr) * 128 + 32 * s + 8 * fq); o[m] = __builtin_amdgcn_mfma_f32_16x16x32_bf16(a, sb[s], o[m], 0, 0, 0); }
#pragma unroll
        for (int m = 0; m < 4; ++m)
#pragma unroll
            for (int r = 0; r < 4; ++r) P_O32[(size_t)(b * SEQ + c * CH + 16 * m + 4 * fq + r) * DA + h * HV + n0 + fr] = o[m][r];
#pragma unroll
        for (int dt = 0; dt < 8; ++dt) { const f32x4 dc = *(const GAS f32x4*)(DCc + 16 * dt + 4 * fq); S[dt] = S[dt] * dc;
#pragma unroll
            for (int ks = 0; ks < 2; ++ks) { const bf16x8 a = *(const GAS bf16x8*)(KHc + (16 * dt + fr) * 64 + 32 * ks + 8 * fq); S[dt] = __builtin_amdgcn_mfma_f32_16x16x32_bf16(a, vt[ks], S[dt], 0, 0, 0); } }
    }
#pragma unroll
    for (int dt = 0; dt < 8; ++dt)
#pragma unroll
        for (int r = 0; r < 4; ++r) P_out[O_GP + ((size_t)bh * HK + 16 * dt + 4 * fq + r) * HV + n0 + fr] = S[dt][r];
}
__device__ __forceinline__ void gla_onorm_item(Frame& F, const Args& A, int row, int h) {
    const int n4 = 4 * F.lane;
    const f32x4 o4 = *(const GAS f32x4*)(P_O32 + (size_t)row * DA + h * HV + n4);
    const float rstd = 1.0f / sqrtf(wave_sum(dot4(o4, o4)) * (1.f / HV) + RMS_EPS);
    const f32x4 gn = *(const GAS f32x4*)(P_gla_norm + n4); const v2u go = *(const GAS v2u*)(P_Z + (size_t)row * N1P + ZGO + h * HV + n4);
    v2u o; o.x = pk2(o4.x * rstd * gn.x * silu_f(bflo(go.x)), o4.y * rstd * gn.y * silu_f(bfhi(go.x))); o.y = pk2(o4.z * rstd * gn.z * silu_f(bflo(go.y)), o4.w * rstd * gn.w * silu_f(bfhi(go.y)));
    *(GAS v2u*)(P_MIX + (size_t)row * DM + h * HV + n4) = o;
}

#ifndef MK_N_LAUNCHES
#define MK_N_LAUNCHES 1
#endif
constexpr int N_PHASES = 10;
constexpr int N_LAUNCHES = MK_N_LAUNCHES;
__global__ void __launch_bounds__(NWAVES * 64, 2) hymba_fwd(Args args) {
    extern __shared__ __attribute__((aligned(16))) unsigned char lds[];
    Frame F;
    F.lds = (LAS unsigned char*)lds;
    F.MISC = (volatile LAS unsigned*)(F.lds + MISC_OFF);
    F.tid = threadIdx.x; F.lane = F.tid & 63; F.wave = __builtin_amdgcn_readfirstlane(F.tid >> 6);
    F.G = gridDim.x; { const int bx = blockIdx.x; F.vcu = (F.G % 8 == 0) ? (bx % 8) * (F.G / 8) + bx / 8 : bx; }
    const Args& A = args;
    F.ctl = (gu32*)(args.ws + WS_CTL);
    for (int u = F.tid; u < (LDS_BYTES - LDSCTL_OFF) / 4; u += NWAVES * 64) ((LAS unsigned*)(F.lds + LDSCTL_OFF))[u] = 0u;
    __syncthreads();
    XcdBarrier bar; bar.bar = (unsigned*)(F.ctl + CW_BAR); bar.x = 0; bar.st = nullptr;
    if (N_LAUNCHES == 1) bar = xcd_barrier_post((unsigned*)(F.ctl + CW_BAR), F.MISC + 8);
    const int lo = args.ph_lo, hi = args.ph_hi;
#ifndef P2A_MASK
#define P2A_MASK 15
#endif
#ifndef PH_MASK
#define PH_MASK 0x3ff
#endif
#define IN(k) (((PH_MASK >> (k)) & 1) && lo <= (k) && (k) < hi)
#define SEAM(k) do { if (IN(k) && IN((k) + 1)) xcd_barrier(bar); } while (0)
    const int gw = F.vcu * NWAVES + F.wave, NGW = F.G * NWAVES;

    if (IN(0)) { p0_prologue(F, A); }
    SEAM(0);
    if (IN(1)) {
        pg8::Gemm g{P_H, P_W1t, MPAD, N1P, DM}; pg8::StaticOrder S; S.init(MPAD, N1P, F.G, (int)blockIdx.x);
        pg8::EpiStoreBf16 E{P_Z, N1P};
        pg8::gemm_phase<pg8::EpiStoreBf16, pg8::StaticOrder, true, true>(F.lds + RING_OFF, g, S, E);
    }
    SEAM(1);
    if (IN(2)) {
        constexpr int U_PREP = NB * NH * NCH, U_CONVP = NB * (SEQ / 16), U_CONVS = MS, U_GLAS = MS * NH;
        if (P2A_MASK & 1) { for (int r = F.vcu; r < U_GLAS; r += F.G) gla_sample_item(F, A, r); }
        if (P2A_MASK & 2) { for (int r = F.vcu; r < U_PREP; r += F.G) gla_prep_unit(F, A, r / NCH, r % NCH); }
        if (P2A_MASK & 4) { for (int r = F.vcu; r < U_CONVP; r += F.G) conv_prompt_unit(F, A, r / (SEQ / 16), r % (SEQ / 16)); }
        if (P2A_MASK & 8) { for (int r = F.G - 1 - F.vcu; r < U_CONVS; r += F.G) conv_sample_unit(F, A, r); }
    }
    SEAM(2);
    if (IN(3)) {
        if (F.wave == 0) { for (int it = F.vcu; it < NB * NH * 16; it += F.G) gla_seq_item(F, A, it); }
    }
    SEAM(3);
    if (IN(4)) { for (int it = gw; it < MP * NH; it += NGW) gla_onorm_item(F, A, it >> 2, it & 3); }
    SEAM(4);
    if (IN(5)) {
        pg8::Gemm g{P_MIX, P_W2t, MPAD, DM, DM}; pg8::StaticOrder S; S.init(MPAD, DM, F.G, (int)blockIdx.x);
        pg8::EpiResF32 E{P_xp, P_xs, P_out, DM, MP, MR};
        pg8::gemm_phase<pg8::EpiResF32, pg8::StaticOrder, true, true>(F.lds + RING_OFF, g, S, E);
    }
    SEAM(5);
    if (IN(6)) { for (int m = gw; m < MR; m += NGW) rms_row_to_bf16(P_out + (size_t)m * DM, P_norm_ffn, P_H + (size_t)m * DM, F.lane); }
    SEAM(6);
    if (IN(7)) {
        pg8::Gemm g{P_H, P_W3t, MPAD, 2 * DFF, DM}; pg8::StaticOrder S; S.init(MPAD, 2 * DFF, F.G, (int)blockIdx.x);
        pg8::EpiSwiglu E{P_HID, DFF};
        pg8::gemm_phase<pg8::EpiSwiglu, pg8::StaticOrder, true, true>(F.lds + RING_OFF, g, S, E);
    }
    SEAM(7);
    if (IN(8)) {
        pg8::Gemm g{P_HID, P_W4t, MPAD, DM, DFF}; pg8::StaticOrder S; S.init(MPAD, DM, F.G, (int)blockIdx.x);
        pg8::EpiResF32 E{P_out, P_out, P_out, DM, MR, MR};
        pg8::gemm_phase<pg8::EpiResF32, pg8::StaticOrder, true, true>(F.lds + RING_OFF, g, S, E);
    }
    SEAM(8);
    if (IN(9)) { for (int m = gw; m < MR; m += NGW) rms_row_inplace(P_out + (size_t)m * DM, P_norm_final, F.lane); }
#undef IN
#undef SEAM
}

extern "C" void kernel_launch(void* const* d_in, const int* in_sizes, int n_in, void* d_out, int out_size, void* d_ws, size_t ws_size, hipStream_t stream) {
    static int grid = 0;
    if (grid == 0) {
        if (n_in != 18 || in_sizes[0] != MP * DM || (size_t)out_size != O_END || ws_size < WS_END) {
            fprintf(stderr, "kernel_launch: shape mismatch: n_in %d in0 %d out %d ws %zu (need %zu); nothing launched\n", n_in, n_in > 0 ? in_sizes[0] : -1, out_size, ws_size, (size_t)WS_END); grid = -1; return; }
        int dev = 0, cus = 0, per_cu = 0;
        if (hipGetDevice(&dev) != hipSuccess || hipDeviceGetAttribute(&cus, hipDeviceAttributeMultiprocessorCount, dev) != hipSuccess) { grid = -1; return; }
        if (hipFuncSetAttribute((const void*)hymba_fwd, hipFuncAttributeMaxDynamicSharedMemorySize, LDS_BYTES) != hipSuccess) { fprintf(stderr, "kernel_launch: hipFuncSetAttribute failed\n"); grid = -1; return; }
        if (hipOccupancyMaxActiveBlocksPerMultiprocessor(&per_cu, (const void*)hymba_fwd, NWAVES * 64, LDS_BYTES) != hipSuccess || per_cu < 1)
            fprintf(stderr, "kernel_launch: note: occupancy query reports %d workgroups per CU\n", per_cu);
        (void)hipGetLastError();
        grid = cus;
    }
    if (grid < 0) return;
    if (N_LAUNCHES == 1) { if (hipMemsetAsync((char*)d_ws + WS_CTL, 0, CTL_ZERO_BYTES, stream) != hipSuccess) return; }
    Args a{};
    for (int i = 0; i < 18; ++i) a.in[i] = (const float*)d_in[i];
    a.out = (float*)d_out; a.ws = (unsigned char*)d_ws;
    for (int li = 0; li < N_LAUNCHES; ++li) {
        a.ph_lo = (N_LAUNCHES == 1) ? 0 : li; a.ph_hi = (N_LAUNCHES == 1) ? N_PHASES : li + 1;
        hipLaunchKernelGGL(hymba_fwd, dim3(grid), dim3(NWAVES * 64), LDS_BYTES, stream, a);
        const hipError_t le = hipPeekAtLastError();
        if (le != hipSuccess) { fprintf(stderr, "kernel_launch: launch %d failed: %s\n", li, hipGetErrorName(le)); break; }
    }
}
```

```cpp
#include <hip/hip_runtime.h>
#include <cstdio>
#include <cstdint>
constexpr int PG8_DUMMY = 0;
namespace pg8 {
#define PG8_LAS __attribute__((address_space(3)))
typedef unsigned short bf16_t;
typedef short bf16x8 __attribute__((ext_vector_type(8)));
typedef float f32x4 __attribute__((ext_vector_type(4)));
typedef unsigned u32x4 __attribute__((ext_vector_type(4)));
constexpr int BM = 256, BK = 64, HALF = 128, HTB = HALF * BK * 2  , STAGE_BYTES = 8 * HTB, NXCD = 8, WGM = 8;

__host__ __device__ __forceinline__ int lds_byte(int r, int c) { const int st = (r >> 4) * 2 + (c >> 5), rr = r & 15, cc = c & 31, ob = rr * 64 + cc * 2; return st * 1024 + (ob ^ (((ob >> 9) & 1) << 5)); }
__host__ __device__ __forceinline__ void stage_rc(int b, int& R, int& C) { const int st = b / 1024, sb = b % 1024, swz = sb ^ (((sb >> 9) & 1) << 5); R = (st >> 1) * 16 + swz / 64; C = (st & 1) * 32 + (swz % 64) / 2; }
__host__ __device__ __forceinline__ int perm32(int rho) { const int n = rho >> 4, i = rho & 15; return 8 * (i >> 2) + 4 * n + (i & 3); }

struct Unit { int pm, pn; };
struct Gemm { const bf16_t* A; const bf16_t* Bt; int M, N, K; };

struct StaticOrder {
    int nM, nN, nwg, G, c;
    __host__ __device__ void init(int M, int N, int G_, int c_) { nM = M / BM; nN = N / BM; nwg = nM * nN; G = G_; c = c_; }
    __host__ __device__ bool next(int i, Unit& u) const {
        const long L = (long)i * G + c; if (L >= nwg) return false;
        int wgid = (int)L; { const int q = nwg / NXCD, r = nwg % NXCD, xcd = wgid % NXCD, off = wgid / NXCD; wgid = (xcd < r ? xcd * (q + 1) : r * (q + 1) + (xcd - r) * q) + off; }
        const int nig = WGM * nN, gid = wgid / nig, fm = gid * WGM, gsz = (nM - fm) < WGM ? (nM - fm) : WGM;
        u.pm = fm + ((wgid % nig) % gsz); u.pn = (wgid % nig) / gsz; return true;
    }
    __device__ __forceinline__ void a_ready(const Unit&) const {}
    __device__ __forceinline__ void done(const Unit&) const {}
};
__device__ __forceinline__ unsigned cvt_pk_bf16(float lo, float hi) { unsigned r; asm volatile("v_cvt_pk_bf16_f32 %0, %1, %2" : "=v"(r) : "v"(lo), "v"(hi)); return r; }
typedef float f32x2 __attribute__((ext_vector_type(2)));
typedef unsigned u32x2v __attribute__((ext_vector_type(2)));
__device__ __forceinline__ float silu_f(float x) { return x * __builtin_amdgcn_rcpf(1.0f + __expf(-x)); }
struct EpiStoreBf16 {
    static constexpr bool PERM = true, AFTER_DRAIN = false;
    bf16_t* O; int ldc;
    __device__ __forceinline__ void operator()(const f32x4 (&acc)[2][2][4][2], const Unit& u, int wr, int wc, int fr, int fq) const {
        const int row0 = u.pm * BM + wr * 64 + fr, col0 = u.pn * BM + wc * 32 + 8 * fq;
#pragma unroll
        for (int ai = 0; ai < 2; ++ai)
#pragma unroll
            for (int m = 0; m < 4; ++m) { bf16_t* rowp = O + (size_t)(row0 + ai * HALF + m * 16) * ldc + col0;
#pragma unroll
                for (int bj = 0; bj < 2; ++bj) { const f32x4 v0 = acc[ai][bj][m][0], v1 = acc[ai][bj][m][1];
                    u32x4 w; w.x = cvt_pk_bf16(v0[0], v0[1]); w.y = cvt_pk_bf16(v0[2], v0[3]); w.z = cvt_pk_bf16(v1[0], v1[1]); w.w = cvt_pk_bf16(v1[2], v1[3]);
                    *(u32x4*)(rowp + bj * HALF) = w; } }
    }
};
struct EpiSwiglu {
    static constexpr bool PERM = true, AFTER_DRAIN = false;
    bf16_t* O; int ldc;
    __device__ __forceinline__ void operator()(const f32x4 (&acc)[2][2][4][2], const Unit& u, int wr, int wc, int fr, int fq) const {
        const int row0 = u.pm * BM + wr * 64 + fr, col0 = u.pn * HALF + wc * 32 + 8 * fq;
#pragma unroll
        for (int ai = 0; ai < 2; ++ai)
#pragma unroll
            for (int m = 0; m < 4; ++m) { bf16_t* rowp = O + (size_t)(row0 + ai * HALF + m * 16) * ldc + col0;
                float h[8];
#pragma unroll
                for (int n = 0; n < 2; ++n)
#pragma unroll
                    for (int e = 0; e < 4; ++e) h[4 * n + e] = silu_f(acc[ai][0][m][n][e]) * acc[ai][1][m][n][e];
                u32x4 w; w.x = cvt_pk_bf16(h[0], h[1]); w.y = cvt_pk_bf16(h[2], h[3]); w.z = cvt_pk_bf16(h[4], h[5]); w.w = cvt_pk_bf16(h[6], h[7]);
                *(u32x4*)rowp = w; }
    }
};
struct EpiResF32 {
    static constexpr bool PERM = false, AFTER_DRAIN = false;
    const float* base0; const float* base1; float* out; int ldc, msplit, mreal;
    __device__ __forceinline__ void operator()(const f32x4 (&acc)[2][2][4][2], const Unit& u, int wr, int wc, int fr, int fq) const {
        const int row0 = u.pm * BM + wr * 64 + fr, col0 = u.pn * BM + wc * 32 + 4 * fq;
#pragma unroll
        for (int ai = 0; ai < 2; ++ai)
#pragma unroll
            for (int m = 0; m < 4; ++m) { const int row = row0 + ai * HALF + m * 16;
                if (row < mreal) {
                    const float* bp = (row < msplit ? base0 + (size_t)row * ldc : base1 + (size_t)(row - msplit) * ldc) + col0; float* op = out + (size_t)row * ldc + col0;
                    f32x4 b[2][2];
#pragma unroll
                    for (int bj = 0; bj < 2; ++bj)
#pragma unroll
                        for (int n = 0; n < 2; ++n) b[bj][n] = *(const f32x4*)(bp + bj * HALF + n * 16);
#pragma unroll
                    for (int bj = 0; bj < 2; ++bj)
#pragma unroll
                        for (int n = 0; n < 2; ++n) *(f32x4*)(op + bj * HALF + n * 16) = b[bj][n] + acc[ai][bj][m][n];
                } }
    }
};
template <class Epi, class Sched, bool ALIGN_EPI = false, bool SP2 = false>
__device__ __forceinline__ void gemm_phase(PG8_LAS unsigned char* lds, const Gemm g, const Sched& S, const Epi& E) {
    const int tid = threadIdx.x, wid = __builtin_amdgcn_readfirstlane(tid >> 6), lane = tid & 63, wr = wid >> 2, wc = wid & 3, fr = lane & 15, fq = lane >> 4;
    const int K = g.K, nt = K / BK;
    unsigned voffA[2], voffB[2];
#pragma unroll
    for (int i = 0; i < 2; ++i) { int R, C; stage_rc(tid * 16 + i * 8192, R, C); const int Rb = Epi::PERM ? ((R & ~31) + perm32(R & 31)) : R;
        voffA[i] = (unsigned)(R * K + C) * 2u; voffB[i] = (unsigned)(Rb * K + C) * 2u; }
    const size_t kstep = (size_t)(BK * 2);
    const size_t hstep = (size_t)HALF * K * 2;
    const size_t tstep = 2 * hstep;
    const unsigned ldsw = (unsigned)wid * 1024u;
    const int aoff = lds_byte(wr * 64 + fr, fq * 8), boff = lds_byte(wc * 32 + fr, fq * 8);
#define PG8_SA(b, h) (((b) * 2 + (h)) * HTB)
#define PG8_SB(b, h) ((4 + (b) * 2 + (h)) * HTB)
#define PG8_STAGE(bufoff, gbase, voff) do { _Pragma("unroll") for (int _i = 0; _i < 2; ++_i) \
        __builtin_amdgcn_global_load_lds((const unsigned*)((const char*)(gbase) + (voff)[_i]), (PG8_LAS unsigned*)(lds + (bufoff) + ldsw + _i * 8192), 16, 0, 0); } while (0)
#define PG8_LDA(dst, b, h) do { _Pragma("unroll") for (int m = 0; m < 4; ++m) _Pragma("unroll") for (int k = 0; k < 2; ++k) dst[m][k] = *(const PG8_LAS bf16x8*)(lds + PG8_SA(b, h) + aoff + m * 2048 + k * 1024); } while (0)
#define PG8_LDB(dst, b, h) do { _Pragma("unroll") for (int n = 0; n < 2; ++n) _Pragma("unroll") for (int k = 0; k < 2; ++k) dst[n][k] = *(const PG8_LAS bf16x8*)(lds + PG8_SB(b, h) + boff + n * 2048 + k * 1024); } while (0)
#define PG8_MMA(ai, bj, At, Bt) do { __builtin_amdgcn_s_setprio(1); _Pragma("unroll") for (int m = 0; m < 4; ++m) _Pragma("unroll") for (int n = 0; n < 2; ++n) _Pragma("unroll") for (int k = 0; k < 2; ++k) \
        acc[ai][bj][m][n] = __builtin_amdgcn_mfma_f32_16x16x32_bf16(Bt[n][k], At[m][k], acc[ai][bj][m][n], 0, 0, 0); __builtin_amdgcn_s_setprio(0); } while (0)
#define PG8_WAIT_V(n) asm volatile("s_waitcnt vmcnt(" #n ")" ::: "memory")
#define PG8_WAIT_L(n) asm volatile("s_waitcnt lgkmcnt(" #n ")" ::: "memory")
#define PG8_BAR __builtin_amdgcn_s_barrier()
#define PG8_SCHED __builtin_amdgcn_sched_barrier(0)
    Unit cur, nxt; int ui = 0;
    if (!S.next(0, cur)) return;
    f32x4 acc[2][2][4][2];
#pragma unroll
    for (int a = 0; a < 2; ++a)
#pragma unroll
        for (int b = 0; b < 2; ++b)
#pragma unroll
            for (int m = 0; m < 4; ++m)
#pragma unroll
                for (int n = 0; n < 2; ++n) acc[a][b][m][n] = (f32x4){0.f, 0.f, 0.f, 0.f};
    bf16x8 At[4][2], B0[2][2], B1[2][2];
    const char* cA = (const char*)g.A + (size_t)cur.pm * tstep; const char* cB = (const char*)g.Bt + (size_t)cur.pn * tstep;
    S.a_ready(cur);
    if constexpr (SP2) {
        PG8_STAGE(PG8_SB(0, 0), cB, voffB); PG8_STAGE(PG8_SB(0, 1), cB + hstep, voffB); PG8_STAGE(PG8_SA(0, 0), cA, voffA); PG8_STAGE(PG8_SA(0, 1), cA + hstep, voffA);
        if (wr == 1) PG8_BAR;
        PG8_WAIT_V(2); PG8_BAR;
        PG8_STAGE(PG8_SB(1, 0), cB + kstep, voffB); PG8_STAGE(PG8_SA(1, 0), cA + kstep, voffA); PG8_STAGE(PG8_SB(1, 1), cB + hstep + kstep, voffB);
        PG8_WAIT_V(6); PG8_BAR;
    } else {
        PG8_STAGE(PG8_SB(0, 0), cB, voffB); PG8_STAGE(PG8_SA(0, 0), cA, voffA); PG8_STAGE(PG8_SB(0, 1), cB + hstep, voffB); PG8_STAGE(PG8_SA(0, 1), cA + hstep, voffA);
        if (wr == 1) PG8_BAR;
        PG8_WAIT_V(4); PG8_BAR;
        PG8_STAGE(PG8_SB(1, 0), cB + kstep, voffB); PG8_STAGE(PG8_SA(1, 0), cA + kstep, voffA); PG8_STAGE(PG8_SB(1, 1), cB + hstep + kstep, voffB);
        PG8_WAIT_V(6); PG8_BAR;
    }
    for (;;) {
        const bool has_next = S.next(ui + 1, nxt);
        const char* nA = has_next ? (const char*)g.A + (size_t)nxt.pm * tstep : cA; const char* nB = has_next ? (const char*)g.Bt + (size_t)nxt.pn * tstep : cB;
        for (int t = 0; t < nt; t += 2) {
            const bool last = (t == nt - 2);
            const char* a1 = cA + (size_t)(t + 1) * kstep;
            const char* a2 = last ? nA : cA + (size_t)(t + 2) * kstep; const char* b2 = last ? nB : cB + (size_t)(t + 2) * kstep;
            const char* a3 = a2 + kstep; const char* b3 = b2 + kstep;
            if (last && has_next) S.a_ready(nxt);
            if constexpr (SP2) {
            PG8_LDB(B0, 0, 0); PG8_LDB(B1, 0, 1); PG8_SCHED; PG8_LDA(At, 0, 0); PG8_STAGE(PG8_SA(1, 1), a1 + hstep, voffA);
            PG8_WAIT_V(8); PG8_WAIT_L(0); PG8_BAR; PG8_MMA(0, 0, At, B0); PG8_MMA(0, 1, At, B1); PG8_BAR; PG8_SCHED;
            PG8_LDA(At, 0, 1); PG8_STAGE(PG8_SB(0, 0), b2, voffB); PG8_STAGE(PG8_SB(0, 1), b2 + hstep, voffB); PG8_STAGE(PG8_SA(0, 0), a2, voffA);
            PG8_WAIT_V(8); PG8_WAIT_L(0); PG8_BAR; PG8_MMA(1, 0, At, B0); PG8_MMA(1, 1, At, B1); PG8_BAR; PG8_SCHED;
            PG8_LDB(B0, 1, 0); PG8_LDB(B1, 1, 1); PG8_SCHED; PG8_LDA(At, 1, 0); PG8_STAGE(PG8_SA(0, 1), a2 + hstep, voffA);
            PG8_WAIT_V(8); PG8_WAIT_L(0); PG8_BAR; PG8_MMA(0, 0, At, B0); PG8_MMA(0, 1, At, B1); PG8_BAR; PG8_SCHED;
            PG8_LDA(At, 1, 1); PG8_STAGE(PG8_SB(1, 0), b3, voffB); PG8_STAGE(PG8_SB(1, 1), b3 + hstep, voffB); PG8_STAGE(PG8_SA(1, 0), a3, voffA);
            PG8_WAIT_V(8); PG8_WAIT_L(0); PG8_BAR; PG8_MMA(1, 0, At, B0); PG8_MMA(1, 1, At, B1); PG8_BAR; PG8_SCHED;
            } else {
            PG8_LDB(B0, 0, 0); PG8_SCHED; PG8_LDA(At, 0, 0); PG8_STAGE(PG8_SA(1, 1), a1 + hstep, voffA);
            PG8_WAIT_L(8); PG8_BAR; PG8_WAIT_L(0); PG8_MMA(0, 0, At, B0); PG8_BAR; PG8_SCHED;
            PG8_LDB(B1, 0, 1); PG8_STAGE(PG8_SB(0, 0), b2, voffB);
            PG8_BAR; PG8_WAIT_L(0); PG8_MMA(0, 1, At, B1); PG8_BAR;
            PG8_LDA(At, 0, 1); PG8_STAGE(PG8_SA(0, 0), a2, voffA);
            PG8_BAR; PG8_WAIT_L(0); PG8_MMA(1, 0, At, B0); PG8_BAR; PG8_SCHED;
            PG8_STAGE(PG8_SB(0, 1), b2 + hstep, voffB);
            PG8_WAIT_V(6); PG8_BAR; PG8_MMA(1, 1, At, B1); PG8_BAR;
            PG8_LDB(B0, 1, 0); PG8_SCHED; PG8_LDA(At, 1, 0); PG8_STAGE(PG8_SA(0, 1), a2 + hstep, voffA);
            PG8_WAIT_L(8); PG8_BAR; PG8_WAIT_L(0); PG8_MMA(0, 0, At, B0); PG8_BAR; PG8_SCHED;
            PG8_LDB(B1, 1, 1); PG8_STAGE(PG8_SB(1, 0), b3, voffB);
            PG8_BAR; PG8_WAIT_L(0); PG8_MMA(0, 1, At, B1); PG8_BAR;
            PG8_LDA(At, 1, 1); PG8_STAGE(PG8_SA(1, 0), a3, voffA);
            PG8_BAR; PG8_WAIT_L(0); PG8_MMA(1, 0, At, B0); PG8_BAR; PG8_SCHED;
            PG8_STAGE(PG8_SB(1, 1), b3 + hstep, voffB);
            PG8_WAIT_V(6); PG8_BAR; PG8_MMA(1, 1, At, B1); PG8_BAR;
            }
        }
        if constexpr (ALIGN_EPI) { if (wr == 0) PG8_BAR; }
        if constexpr (!Epi::AFTER_DRAIN) { E(acc, cur, wr, wc, fr, fq); S.done(cur); }
        if (!has_next) break;
#pragma unroll
        for (int a = 0; a < 2; ++a)
#pragma unroll
            for (int b = 0; b < 2; ++b)
#pragma unroll
                for (int m = 0; m < 4; ++m)
#pragma unroll
                    for (int n = 0; n < 2; ++n) acc[a][b][m][n] = (f32x4){0.f, 0.f, 0.f, 0.f};
        cur = nxt; cA = nA; cB = nB; ++ui;
        if constexpr (ALIGN_EPI) { if (wr == 1) PG8_BAR; }
    }
    PG8_WAIT_V(0);
    if constexpr (!ALIGN_EPI) { if (wr == 0) PG8_BAR; }
    PG8_BAR;
    if constexpr (Epi::AFTER_DRAIN) { E.fused(acc, cur, wr, wc, fr, fq, lds, wid, lane); S.done(cur); }
#undef PG8_SA
#undef PG8_SB
#undef PG8_STAGE
#undef PG8_LDA
#undef PG8_LDB
#undef PG8_MMA
#undef PG8_WAIT_V
#undef PG8_WAIT_L
#undef PG8_BAR
#undef PG8_SCHED
}
}

constexpr int NWAVES = 8;
constexpr int DM = 2048, MP = 8192, MS = 128, MR = MP + MS  , MPAD = 8448  , SEQ = 2048, NB = 4;
constexpr int NH = 4, HK = 128, HV = 256, DK = 512, DA = 1024, DC_ = 1024, GR = 16, CW = 31, DFF = 5632;
constexpr int N1 = 5136, N1P = 5376;
constexpr int ZQ = 0, ZK = 512, ZV = 1024, ZGO = 2048, ZUA = 3072, ZUG = 4096, ZGL = 5120;
constexpr int CH = 64, NCH = SEQ / CH;
constexpr float RMS_EPS = 1e-6f, LN_EPS = 1e-5f;
constexpr size_t O_YP = 0, O_YS = (size_t)MP * DM, O_GP = O_YS + (size_t)MS * DM, O_CP = O_GP + (size_t)NB * NH * HK * HV, O_GS = O_CP + (size_t)NB * 30 * DC_,
                 O_CS = O_GS + (size_t)MS * NH * HK * HV, O_END = O_CS + (size_t)MS * 30 * DC_;
constexpr size_t MiB = 1u << 20;
constexpr size_t WS_CTL = 0, CTL_ZERO_BYTES = 1 * MiB;
constexpr size_t WS_W1 = 2 * MiB;
constexpr size_t WS_W2 = 23 * MiB;
constexpr size_t WS_W3 = 31 * MiB;
constexpr size_t WS_W4 = 75 * MiB;
constexpr size_t WS_H = 97 * MiB;
constexpr size_t WS_QT = WS_H, WS_KH = WS_H + 8 * MiB, WS_VT = WS_H + 16 * MiB;
constexpr size_t WS_Z = 130 * MiB;
constexpr size_t WS_MIX = 217 * MiB;
constexpr size_t WS_HID = 130 * MiB;
constexpr size_t WS_END = 250 * MiB;
static_assert(WS_Z + (size_t)MPAD * N1P * 2 <= WS_MIX && WS_HID + (size_t)MPAD * DFF * 2 <= WS_END && WS_W1 + (size_t)N1P * DM * 2 <= WS_W2 && WS_W3 + (size_t)2 * DFF * DM * 2 <= WS_W4 && WS_W4 + (size_t)DM * DFF * 2 <= WS_H, "d_ws map");
constexpr size_t DO_O32 = 0, DO_AM = 32 * MiB, DO_DC = 36 * MiB;
constexpr int CW_TMO = 0, CW_BAR = 4096;
constexpr int RING_OFF = 0, RING_BYTES = 131072;
constexpr int LDSCTL_OFF = RING_BYTES, MISC_OFF = LDSCTL_OFF + 320;
constexpr int LDS_BYTES = 147456;

#define GAS __attribute__((address_space(1)))
#define LAS __attribute__((address_space(3)))
typedef unsigned short bf16;
typedef unsigned v4u __attribute__((ext_vector_type(4)));
typedef unsigned v2u __attribute__((ext_vector_type(2)));
typedef float f32x4 __attribute__((ext_vector_type(4)));
typedef float f32x2 __attribute__((ext_vector_type(2)));
typedef short bf16x8 __attribute__((ext_vector_type(8)));
typedef GAS unsigned gu32;
typedef GAS unsigned long long gu64;
#define RLX_AGENT __ATOMIC_RELAXED, __HIP_MEMORY_SCOPE_AGENT
#define LDS_WAIT() asm volatile("s_waitcnt lgkmcnt(0)" ::: "memory")
#define VM_WAIT() asm volatile("s_waitcnt vmcnt(0)" ::: "memory")
__device__ __forceinline__ unsigned f2bf(float f) { unsigned u = __builtin_bit_cast(unsigned, f); return (u + 0x7fffu + ((u >> 16) & 1u)) >> 16; }
__device__ __forceinline__ unsigned pk2(float lo, float hi) { return f2bf(lo) | (f2bf(hi) << 16); }
__device__ __forceinline__ float bf2f(unsigned short b) { return __builtin_bit_cast(float, (unsigned)b << 16); }
__device__ __forceinline__ float bflo(unsigned w) { return __builtin_bit_cast(float, w << 16); }
__device__ __forceinline__ float bfhi(unsigned w) { return __builtin_bit_cast(float, w & 0xffff0000u); }
__device__ __forceinline__ float sigmoid_f(float x) { return __builtin_amdgcn_rcpf(1.0f + __expf(-x)); }
__device__ __forceinline__ float silu_f(float x) { return x * sigmoid_f(x); }
__device__ __forceinline__ float logsigmoid_f(float x) { return fminf(x, 0.f) - log1pf(__expf(-fabsf(x))); }
#define XB_TMO      128
#define XB_XCNT(j)  (256  + 64 * (j))
#define XB_XSUB(j)  (1280 + 64 * (j))
#define XB_XGEN(j)  (2304 + 64 * (j))
#define XB_TOP      3328
#define XB_TOPGEN   3392
#define XCD_BAR_WORDS 3456
#define XB_SPIN_CAP (1u << 18)

__device__ __forceinline__ unsigned xb_ld(unsigned* p)              { return __hip_atomic_load(p, __ATOMIC_RELAXED, __HIP_MEMORY_SCOPE_AGENT); }
__device__ __forceinline__ unsigned xb_add(unsigned* p, unsigned v) { return __hip_atomic_fetch_add(p, v, __ATOMIC_RELAXED, __HIP_MEMORY_SCOPE_AGENT); }
__device__ __forceinline__ unsigned xb_xcc_id() { return (unsigned)__builtin_amdgcn_s_getreg((3 << 11) | 20) & 0xFu; }
#define XB_SPIN(cond, bar) do { unsigned _sp = 0; while (cond) { __builtin_amdgcn_s_sleep(1); \
    if ((++_sp & 255u) == 0u) { if (xb_ld(&(bar)[XB_TMO])) break; if (_sp > XB_SPIN_CAP) { atomicAdd(&(bar)[XB_TMO], 1u); break; } } } } while (0)

struct XcdBarrier {
    unsigned* bar; unsigned x;
    volatile LAS unsigned* st;
};

__device__ __forceinline__ XcdBarrier xcd_barrier_post(unsigned* bar, volatile LAS unsigned* st) {
    XcdBarrier b; b.bar = bar; b.x = xb_xcc_id(); b.st = st;
    if (threadIdx.x == 0) (void)xb_add(&bar[XB_XCNT(b.x)], 1u);
    return b;
}
__device__ __forceinline__ void xcd_barrier_complete(unsigned* bar, unsigned x, unsigned& nloc, unsigned& nx) {
    const unsigned G = gridDim.x * gridDim.y * gridDim.z;
    unsigned sum, cnt, mine, sp = 0u;
    for (;;) {
        sum = 0u; cnt = 0u; mine = 0u;
#pragma unroll
        for (unsigned j = 0; j < 16; ++j) { const unsigned c = xb_ld(&bar[XB_XCNT(j)]); sum += c; cnt += (c > 0u) ? 1u : 0u; mine = (j == x) ? c : mine; }
        if (sum == G) break;
        __builtin_amdgcn_s_sleep(1);
        if ((++sp & 255u) == 0u) { if (xb_ld(&bar[XB_TMO])) break; if (sp > XB_SPIN_CAP) { atomicAdd(&bar[XB_TMO], 1u); break; } }
    }
    nloc = mine > 0u ? mine : 1u; nx = cnt > 0u ? cnt : 1u;
}

__device__ __forceinline__ void xcd_barrier(const XcdBarrier& b) {
    asm volatile("s_waitcnt vmcnt(0)" ::: "memory");
    __syncthreads();
    if (threadIdx.x == 0) {
        unsigned* bar = b.bar;
        __builtin_amdgcn_s_waitcnt(0);
        unsigned nloc = b.st[0], nx = b.st[1];
        if (nloc == 0u) { xcd_barrier_complete(bar, b.x, nloc, nx); b.st[0] = nloc; b.st[1] = nx; }
        const unsigned old = xb_add(&bar[XB_XSUB(b.x)], 1u);
        const unsigned gen = old / nloc;
        if (old + 1u == (gen + 1u) * nloc) {
            __builtin_amdgcn_fence(__ATOMIC_RELEASE, "agent");
            asm volatile("s_waitcnt vmcnt(0)" ::: "memory");
            const unsigned og = xb_add(&bar[XB_TOP], 1u);
            const unsigned tg = og / nx;
            if (og + 1u == (tg + 1u) * nx) xb_add(&bar[XB_TOPGEN], 1u);
            else XB_SPIN(xb_ld(&bar[XB_TOPGEN]) == tg, bar);
            __builtin_amdgcn_fence(__ATOMIC_ACQUIRE, "agent");
            xb_add(&bar[XB_XGEN(b.x)], 1u);
            asm volatile("s_waitcnt vmcnt(0)" ::: "memory");
        } else {
            XB_SPIN(xb_ld(&bar[XB_XGEN(b.x)]) == gen, bar);
            __builtin_amdgcn_fence(__ATOMIC_ACQUIRE, "agent");
            asm volatile("s_waitcnt vmcnt(0)" ::: "memory");
        }
    }
    __syncthreads();
}
struct Args { const float* in[18]; float* out; unsigned char* ws; int ph_lo, ph_hi; };
#define P_xp (A.in[0])
#define P_xs (A.in[1])
#define P_sgla (A.in[2])
#define P_sconv (A.in[3])
#define P_norm_mix (A.in[4])
#define P_w_in (A.in[5])
#define P_wgu (A.in[6])
#define P_bgate (A.in[7])
#define P_gla_norm (A.in[8])
#define P_conv_w (A.in[9])
#define P_conv_b (A.in[10])
#define P_ln_g (A.in[11])
#define P_ln_b (A.in[12])
#define P_w_out (A.in[13])
#define P_norm_ffn (A.in[14])
#define P_w_ffn_in (A.in[15])
#define P_w_ffn_out (A.in[16])
#define P_norm_final (A.in[17])
#define P_W1t ((bf16*)(A.ws + WS_W1))
#define P_W2t ((bf16*)(A.ws + WS_W2))
#define P_W3t ((bf16*)(A.ws + WS_W3))
#define P_W4t ((bf16*)(A.ws + WS_W4))
#define P_H ((bf16*)(A.ws + WS_H))
#define P_Z ((bf16*)(A.ws + WS_Z))
#define P_MIX ((bf16*)(A.ws + WS_MIX))
#define P_HID ((bf16*)(A.ws + WS_HID))
#define P_QT ((bf16*)(A.ws + WS_QT))
#define P_KH ((bf16*)(A.ws + WS_KH))
#define P_VT ((bf16*)(A.ws + WS_VT))
#define P_out (A.out)
#define P_O32 ((float*)((unsigned char*)A.out + DO_O32))
#define P_AM ((bf16*)((unsigned char*)A.out + DO_AM))
#define P_DCb ((float*)((unsigned char*)A.out + DO_DC))

struct Frame {
    LAS unsigned char* lds;
    volatile LAS unsigned* MISC;
    gu32* ctl;
    int tid, lane, wave, vcu, G;
};
__device__ __forceinline__ float wave_sum(float v) {
#pragma unroll
    for (int o = 1; o < 64; o <<= 1) v += __shfl_xor(v, o);
    return v;
}
__device__ __forceinline__ float dot4(f32x4 a, f32x4 b) { return (a.x * b.x + a.y * b.y) + (a.z * b.z + a.w * b.w); }

template <int MAP> __device__ __forceinline__ int srccol(int n) {
    if (MAP == 1) return n < 2048 ? n : (n < 5120 ? n + 16 : (n < 5136 ? n - 3072 : -1));
    if (MAP == 3) { const int t = n >> 8, r = n & 255; return r < 128 ? 128 * t + r : DFF + 128 * t + (r - 128); }
    return n;
}
template <int MAP> __device__ __forceinline__ void p0_transpose_item(const float* W, int K, int Nsrc, int Ndst, bf16* WT, LAS float* scr, int item, int lane) {
    const int nblk = Ndst / 32, kb = item / nblk, nb = item % nblk, k0 = 64 * kb, n0 = 32 * nb;
    const int sc = srccol<MAP>(n0 + (lane & 31));
    const float* src = W + (size_t)k0 * Nsrc + (sc >= 0 ? sc : 0);
#pragma unroll 8
    for (int i = 0; i < 32; ++i) { const int kk = 2 * i + (lane >> 5); const float v = src[(size_t)kk * Nsrc]; scr[kk * 33 + (lane & 31)] = sc >= 0 ? v : 0.f; }
    LDS_WAIT(); asm volatile("" ::: "memory");
    const int c = lane & 7;
#pragma unroll
    for (int j = 0; j < 4; ++j) { const int n = (lane >> 3) + 8 * j; const LAS float* s = scr + (8 * c) * 33 + n;
        v4u o; o.x = pk2(s[0 * 33], s[1 * 33]); o.y = pk2(s[2 * 33], s[3 * 33]); o.z = pk2(s[4 * 33], s[5 * 33]); o.w = pk2(s[6 * 33], s[7 * 33]);
        *(GAS v4u*)(WT + (size_t)(n0 + n) * K + k0 + 8 * c) = o; }
    LDS_WAIT(); asm volatile("" ::: "memory");
}
__device__ __forceinline__ void rms_row_to_bf16(const float* xrow, const float* gain, bf16* orow, int lane) {
    const GAS f32x4* xr = (const GAS f32x4*)xrow + lane; const GAS f32x4* gr = (const GAS f32x4*)gain + lane;
    f32x4 v[8]; float s = 0.f;
#pragma unroll
    for (int j = 0; j < 8; ++j) { v[j] = xr[64 * j]; s += dot4(v[j], v[j]); }
    const float rstd = 1.0f / sqrtf(wave_sum(s) * (1.f / DM) + RMS_EPS);
    GAS v2u* o8 = (GAS v2u*)orow + lane;
#pragma unroll
    for (int j = 0; j < 8; ++j) { const f32x4 g = gr[64 * j]; v2u o; o.x = pk2(v[j].x * rstd * g.x, v[j].y * rstd * g.y); o.y = pk2(v[j].z * rstd * g.z, v[j].w * rstd * g.w); o8[64 * j] = o; }
}
__device__ __forceinline__ void rms_row_inplace(float* xrow, const float* gain, int lane) {
    GAS f32x4* xr = (GAS f32x4*)xrow + lane; const GAS f32x4* gr = (const GAS f32x4*)gain + lane;
    f32x4 v[8]; float s = 0.f;
#pragma unroll
    for (int j = 0; j < 8; ++j) { v[j] = xr[64 * j]; s += dot4(v[j], v[j]); }
    const float rstd = 1.0f / sqrtf(wave_sum(s) * (1.f / DM) + RMS_EPS);
#pragma unroll
    for (int j = 0; j < 8; ++j) { const f32x4 g = gr[64 * j]; xr[64 * j] = v[j] * rstd * g; }
}
__device__ __forceinline__ void p0_prologue(Frame& F, const Args& A) {
    LAS float* scr = (LAS float*)(F.lds + RING_OFF + F.wave * 16384);
    const int gw = F.vcu * NWAVES + F.wave, NGW = F.G * NWAVES;
    constexpr int I_1 = (DM / 64) * (N1P / 32), I_2 = (DM / 64) * (DM / 32), I_3 = (DM / 64) * (2 * DFF / 32), I_4 = (DFF / 64) * (DM / 32);
    constexpr int NITEMS = I_1 + I_2 + I_3 + I_4;
    for (int it = gw; it < NITEMS; it += NGW) {
        int r = it;
        if (r < I_1) { p0_transpose_item<1>(P_w_in, DM, N1, N1P, P_W1t, scr, r, F.lane); continue; } r -= I_1;
        if (r < I_2) { p0_transpose_item<0>(P_w_out, DM, DM, DM, P_W2t, scr, r, F.lane); continue; } r -= I_2;
        if (r < I_3) { p0_transpose_item<3>(P_w_ffn_in, DM, 2 * DFF, 2 * DFF, P_W3t, scr, r, F.lane); continue; } r -= I_3;
        p0_transpose_item<0>(P_w_ffn_out, DFF, DM, DM, P_W4t, scr, r, F.lane);
    }
    for (int m = gw; m < MPAD; m += NGW) {
        if (m < MR) rms_row_to_bf16(m < MP ? P_xp + (size_t)m * DM : P_xs + (size_t)(m - MP) * DM, P_norm_mix, P_H + (size_t)m * DM, F.lane);
        else { GAS v4u* o = (GAS v4u*)(P_H + (size_t)m * DM) + F.lane;
#pragma unroll
            for (int j = 0; j < 4; ++j) o[64 * j] = (v4u){0u, 0u, 0u, 0u}; }
    }
}

__device__ __forceinline__ void gla_prep_unit(Frame& F, const Args& A, int bh, int c) {
    const int tid = F.tid, b = bh >> 2, h = bh & 3, row0 = b * SEQ + c * CH;
    LAS float* GL = (LAS float*)(F.lds + RING_OFF);
    LAS float* BL = (LAS float*)(F.lds + RING_OFF + 4608);
    LAS bf16* QS = (LAS bf16*)(F.lds + RING_OFF + 8192);
    LAS bf16* KS = (LAS bf16*)(F.lds + RING_OFF + 25600);
    LAS bf16* VR = (LAS bf16*)(F.lds + RING_OFF + 43008);
    const size_t uc = (size_t)bh * NCH + c;
    const bf16* Zc = P_Z + (size_t)row0 * N1P;
    {
        v4u pq[2], pk[2], pv[4];
#pragma unroll
        for (int k = 0; k < 2; ++k) { const int p = tid + 512 * k, i = p >> 4, ch = p & 15;
            pq[k] = *(const GAS v4u*)(Zc + (size_t)i * N1P + ZQ + h * HK + 8 * ch); pk[k] = *(const GAS v4u*)(Zc + (size_t)i * N1P + ZK + h * HK + 8 * ch); }
#pragma unroll
        for (int k = 0; k < 4; ++k) { const int p = tid + 512 * k, i = p >> 5, ch = p & 31; pv[k] = *(const GAS v4u*)(Zc + (size_t)i * N1P + ZV + h * HV + 8 * ch); }
        v4u pg = (v4u){0u, 0u, 0u, 0u};
        if (tid < 128) pg = *(const GAS v4u*)(Zc + (size_t)(tid >> 1) * N1P + ZGL + 8 * (tid & 1));
#pragma unroll
        for (int k = 0; k < 2; ++k) { const int p = tid + 512 * k, i = p >> 4, ch = p & 15; *(LAS v4u*)(QS + i * 136 + 8 * ch) = pq[k]; *(LAS v4u*)(KS + i * 136 + 8 * ch) = pk[k]; }
#pragma unroll
        for (int k = 0; k < 4; ++k) { const int p = tid + 512 * k, i = p >> 5, ch = p & 31; *(LAS v4u*)(VR + i * 264 + 8 * ch) = pv[k]; }
        if (tid < 128) { LAS float* gp = GL + (tid >> 1) * 17 + 8 * (tid & 1);
            gp[0] = bflo(pg.x); gp[1] = bfhi(pg.x); gp[2] = bflo(pg.y); gp[3] = bfhi(pg.y); gp[4] = bflo(pg.z); gp[5] = bfhi(pg.z); gp[6] = bflo(pg.w); gp[7] = bfhi(pg.w); }
    }
    const int d = tid & 127, g = tid >> 7;
    float wg[16];
#pragma unroll
    for (int r = 0; r < 16; ++r) wg[r] = P_wgu[r * DK + h * HK + d];
    const float bg = P_bgate[h * HK + d];
    __syncthreads();
    float bcum[16]; float run = 0.f;
#pragma unroll
    for (int ii = 0; ii < 16; ++ii) { const int i = g * 16 + ii; float x = bg;
#pragma unroll
        for (int r = 0; r < 16; ++r) x += GL[i * 17 + r] * wg[r];
        run += logsigmoid_f(x) * (1.0f / 16.0f); bcum[ii] = run; }
    BL[g * 128 + d] = run;
    __syncthreads();
    float off = 0.f, tot = 0.f;
#pragma unroll
    for (int gg = 0; gg < 4; ++gg) { const float t = BL[gg * 128 + d]; off += (gg < g) ? t : 0.f; tot += t; }
    const float scale = 0.08838834764831845f;
    unsigned khw[8];
#pragma unroll
    for (int ii = 0; ii < 16; ++ii) { const int i = g * 16 + ii; const float bb = bcum[ii] + off;
        const float q = bf2f(QS[i * 136 + d]) * scale * __expf(bb);
        const float kv = bf2f(KS[i * 136 + d]);
        const unsigned qb = f2bf(q), ktb = f2bf(kv * __expf(-bb)), khb = f2bf(kv * __expf(tot - bb));
        QS[i * 136 + d] = (bf16)qb; KS[i * 136 + d] = (bf16)ktb;
        if (ii & 1) khw[ii >> 1] |= khb << 16; else khw[ii >> 1] = khb; }
    { GAS v4u* kp = (GAS v4u*)(P_KH + (uc * 128 + d) * 64 + g * 16);
      kp[0] = (v4u){khw[0], khw[1], khw[2], khw[3]}; kp[1] = (v4u){khw[4], khw[5], khw[6], khw[7]}; }
    if (g == 0) P_DCb[uc * 128 + d] = __expf(tot);
    { const int n = tid & 255, jh = tid >> 8; unsigned vw[16];
#pragma unroll
      for (int jj = 0; jj < 32; ++jj) { const unsigned v = VR[(32 * jh + jj) * 264 + n];
          if (jj & 1) vw[jj >> 1] |= v << 16; else vw[jj >> 1] = v; }
      GAS v4u* vp = (GAS v4u*)(P_VT + (uc * 256 + n) * 64 + 32 * jh);
#pragma unroll
      for (int k = 0; k < 4; ++k) vp[k] = (v4u){vw[4 * k], vw[4 * k + 1], vw[4 * k + 2], vw[4 * k + 3]}; }
    __syncthreads();
    {
#pragma unroll
        for (int k = 0; k < 2; ++k) { const int p = tid + 512 * k, i = p >> 4, s = (p >> 2) & 3, fq = p & 3;
            const v2u lo = *(const LAS v2u*)(QS + i * 136 + 32 * s + 4 * fq), hi = *(const LAS v2u*)(QS + i * 136 + 32 * s + 16 + 4 * fq);
            *(GAS v4u*)(P_QT + (uc * 64 + i) * 128 + 32 * s + 8 * fq) = (v4u){lo.x, lo.y, hi.x, hi.y}; }
    }
    { const int fr = F.lane & 15, fq = F.lane >> 4;
#pragma unroll
      for (int tt = 0; tt < 2; ++tt) { const int id = 2 * F.wave + tt, it = id >> 2, jt = id & 3;
          f32x4 acc = (f32x4){0.f, 0.f, 0.f, 0.f};
          if (jt <= it) {
#pragma unroll
              for (int s = 0; s < 4; ++s) { const bf16x8 a = *(const LAS bf16x8*)(KS + (jt * 16 + fr) * 136 + 32 * s + 8 * fq); const bf16x8 bq = *(const LAS bf16x8*)(QS + (it * 16 + fr) * 136 + 32 * s + 8 * fq);
                  acc = __builtin_amdgcn_mfma_f32_16x16x32_bf16(a, bq, acc, 0, 0, 0); } }
          const int i = it * 16 + fr, j0 = jt * 16 + 4 * fq;
#pragma unroll
          for (int r = 0; r < 4; ++r) if (j0 + r > i) acc[r] = 0.f;
          v2u o; o.x = pk2(acc[0], acc[1]); o.y = pk2(acc[2], acc[3]);
          *(GAS v2u*)(P_AM + (uc * 64 + i) * 64 + j0) = o; } }
    __syncthreads();
}
__device__ __forceinline__ void ln_silu_row(const LAS float* cs, const float* lng, const float* lnb, bf16* orow, int lane) {
    f32x4 x[4]; float s = 0.f;
#pragma unroll
    for (int j = 0; j < 4; ++j) { x[j] = *(const LAS f32x4*)(cs + 256 * j + 4 * lane); s += (x[j].x + x[j].y) + (x[j].z + x[j].w); }
    const float mean = wave_sum(s) * (1.f / DC_); float q = 0.f;
#pragma unroll
    for (int j = 0; j < 4; ++j) { x[j] = x[j] - mean; q += dot4(x[j], x[j]); }
    const float rstd = 1.0f / sqrtf(wave_sum(q) * (1.f / DC_) + LN_EPS);
#pragma unroll
    for (int j = 0; j < 4; ++j) { const f32x4 g = *(const GAS f32x4*)(lng + 256 * j + 4 * lane), bb = *(const GAS f32x4*)(lnb + 256 * j + 4 * lane);
        const f32x4 y = x[j] * rstd * g + bb; v2u o; o.x = pk2(silu_f(y.x), silu_f(y.y)); o.y = pk2(silu_f(y.z), silu_f(y.w));
        *(GAS v2u*)(orow + 256 * j + 4 * lane) = o; }
}
__device__ __forceinline__ void conv_prompt_unit(Frame& F, const Args& A, int b, int tb) {
    LAS float* CS = (LAS float*)(F.lds + RING_OFF);
    const int t0 = tb * 16, c = 2 * F.tid;
    f32x2 wt[31];
#pragma unroll
    for (int w = 0; w < 31; ++w) wt[w] = *(const GAS f32x2*)(P_conv_w + w * DC_ + c);
    const f32x2 bias = *(const GAS f32x2*)(P_conv_b + c);
    f32x2 acc[16];
#pragma unroll
    for (int tt = 0; tt < 16; ++tt) acc[tt] = bias;
#pragma unroll
    for (int r = 0; r < 46; ++r) { const int t = t0 - 30 + r, tc = t < 0 ? 0 : t; const bf16* zr = P_Z + (size_t)(b * SEQ + tc) * N1P;
        const unsigned ua = *(const GAS unsigned*)(zr + ZUA + c), ug = *(const GAS unsigned*)(zr + ZUG + c);
        const float m = t >= 0 ? 1.f : 0.f;
        f32x2 g; g.x = m * bflo(ua) * sigmoid_f(bflo(ug)); g.y = m * bfhi(ua) * sigmoid_f(bfhi(ug));
#pragma unroll
        for (int tt = 0; tt < 16; ++tt) { if (r - tt >= 0 && r - tt < 31) acc[tt] += g * wt[(r - tt >= 0 && r - tt < 31) ? r - tt : 0]; }
        if ((r & 3) == 3) { asm volatile("" ::: "memory"); __builtin_amdgcn_sched_barrier(0); }
    }
#pragma unroll
    for (int tt = 0; tt < 16; ++tt) *(LAS f32x2*)(CS + tt * 1024 + c) = acc[tt];
    __syncthreads();
#pragma unroll
    for (int k = 0; k < 2; ++k) { const int tt = 2 * F.wave + k; ln_silu_row(CS + tt * 1024, P_ln_g, P_ln_b, P_MIX + (size_t)(b * SEQ + t0 + tt) * DM + DA, F.lane); }
    __syncthreads();
}
__device__ __forceinline__ void conv_state_prompt_row(Frame& F, const Args& A, int b, int rr) {
    const bf16* zr = P_Z + (size_t)(b * SEQ + SEQ - 30 + rr) * N1P; float* orow = P_out + O_CP + ((size_t)b * 30 + rr) * DC_;
#pragma unroll
    for (int j = 0; j < 4; ++j) { const int c = 256 * j + 4 * F.lane; const v2u ua = *(const GAS v2u*)(zr + ZUA + c), ug = *(const GAS v2u*)(zr + ZUG + c);
        f32x4 g; g.x = bflo(ua.x) * sigmoid_f(bflo(ug.x)); g.y = bfhi(ua.x) * sigmoid_f(bfhi(ug.x)); g.z = bflo(ua.y) * sigmoid_f(bflo(ug.y)); g.w = bfhi(ua.y) * sigmoid_f(bfhi(ug.y));
        *(GAS f32x4*)(orow + c) = g; }
}
__device__ __forceinline__ void conv_sample_unit(Frame& F, const Args& A, int b) {
    LAS float* CS = (LAS float*)(F.lds + RING_OFF);
    const bf16* zr = P_Z + (size_t)(MP + b) * N1P;
    const int c = 2 * F.tid;
    f32x2 acc = *(const GAS f32x2*)(P_conv_b + c);
    f32x2 hv[30];
#pragma unroll
    for (int w = 0; w < 30; ++w) hv[w] = *(const GAS f32x2*)(P_sconv + ((size_t)b * 30 + w) * DC_ + c);
    const unsigned ua = *(const GAS unsigned*)(zr + ZUA + c), ug = *(const GAS unsigned*)(zr + ZUG + c);
#pragma unroll
    for (int w = 0; w < 30; ++w) { acc += hv[w] * *(const GAS f32x2*)(P_conv_w + w * DC_ + c); if (w >= 1) *(GAS f32x2*)(P_out + O_CS + ((size_t)b * 30 + (w - 1)) * DC_ + c) = hv[w]; }
    f32x2 gl; gl.x = bflo(ua) * sigmoid_f(bflo(ug)); gl.y = bfhi(ua) * sigmoid_f(bfhi(ug));
    acc += gl * *(const GAS f32x2*)(P_conv_w + 30 * DC_ + c);
    *(GAS f32x2*)(P_out + O_CS + ((size_t)b * 30 + 29) * DC_ + c) = gl;
    *(LAS f32x2*)(CS + c) = acc;
    __syncthreads();
    if (F.wave == 0) ln_silu_row(CS, P_ln_g, P_ln_b, P_MIX + (size_t)(MP + b) * DM + DA, F.lane);
    __syncthreads();
}
__device__ __forceinline__ void gla_sample_item(Frame& F, const Args& A, int item) {
    const int b = item >> 2, h = item & 3, tid = F.tid;
    LAS float* AD = (LAS float*)(F.lds + RING_OFF);
    LAS float* KD = AD + 128; LAS float* QD = AD + 256; LAS float* VD = AD + 384;
    LAS float* OP = AD + 640;
    const bf16* zr = P_Z + (size_t)(MP + b) * N1P;
    const int n4 = 4 * F.lane;
    const float* Sin = P_sgla + (size_t)(b * NH + h) * HK * HV; float* Sout = P_out + O_GS + (size_t)(b * NH + h) * HK * HV;
    f32x4 s[16];
#pragma unroll
    for (int dd = 0; dd < 16; ++dd) s[dd] = *(const GAS f32x4*)(Sin + (size_t)(16 * F.wave + dd) * HV + n4);
    if (tid < 128) { const int d = tid; float x = P_bgate[h * HK + d];
#pragma unroll
        for (int r = 0; r < 16; ++r) x += bf2f(zr[ZGL + r]) * P_wgu[r * DK + h * HK + d];
        AD[d] = __expf(logsigmoid_f(x) * (1.0f / 16.0f)); KD[d] = bf2f(zr[ZK + h * HK + d]); QD[d] = bf2f(zr[ZQ + h * HK + d]) * 0.08838834764831845f; }
    else if (tid < 384) { const int n = tid - 128; VD[n] = bf2f(zr[ZV + h * HV + n]); }
    __syncthreads();
    const f32x4 v4 = *(const LAS f32x4*)(VD + n4);
    f32x4 oacc = (f32x4){0.f, 0.f, 0.f, 0.f};
#pragma unroll
    for (int dd = 0; dd < 16; ++dd) { const int d = 16 * F.wave + dd;
        const f32x4 sn = s[dd] * AD[d] + v4 * KD[d]; *(GAS f32x4*)(Sout + (size_t)d * HV + n4) = sn; oacc += sn * QD[d]; }
    *(LAS f32x4*)(OP + F.wave * 256 + n4) = oacc;
    __syncthreads();
    if (F.wave == 0) { f32x4 o4 = (f32x4){0.f, 0.f, 0.f, 0.f};
#pragma unroll
        for (int w = 0; w < 8; ++w) o4 += *(const LAS f32x4*)(OP + w * 256 + n4);
        const float rstd = 1.0f / sqrtf(wave_sum(dot4(o4, o4)) * (1.f / HV) + RMS_EPS);
        const f32x4 gn = *(const GAS f32x4*)(P_gla_norm + n4); const v2u go = *(const GAS v2u*)(zr + ZGO + h * HV + n4);
        v2u o; o.x = pk2(o4.x * rstd * gn.x * silu_f(bflo(go.x)), o4.y * rstd * gn.y * silu_f(bfhi(go.x))); o.y = pk2(o4.z * rstd * gn.z * silu_f(bflo(go.y)), o4.w * rstd * gn.w * silu_f(bfhi(go.y)));
        *(GAS v2u*)(P_MIX + (size_t)(MP + b) * DM + h * HV + n4) = o; }
    __syncthreads();
}
__device__ __forceinline__ void gla_seq_item(Frame& F, const Args& A, int item) {
    const int bh = item >> 4, n0 = (item & 15) * 16, b = bh >> 2, h = bh & 3, fr = F.lane & 15, fq = F.lane >> 4;
    f32x4 S[8];
#pragma unroll
    for (int dt = 0; dt < 8; ++dt) S[dt] = (f32x4){0.f, 0.f, 0.f, 0.f};
#pragma unroll 1
    for (int c = 0; c < NCH; ++c) {
        const size_t uc = (size_t)bh * NCH + c;
        const bf16* AMc = P_AM + uc * 64 * 64; const bf16* VTc = P_VT + uc * 256 * 64; const bf16* QTc = P_QT + uc * 64 * 128; const bf16* KHc = P_KH + uc * 128 * 64; const float* DCc = P_DCb + uc * 128;
        bf16x8 vt[2];
#pragma unroll
        for (int ks = 0; ks < 2; ++ks) vt[ks] = *(const GAS bf16x8*)(VTc + (n0 + fr) * 64 + 32 * ks + 8 * fq);
        f32x4 o[4];
#pragma unroll
        for (int m = 0; m < 4; ++m) { o[m] = (f32x4){0.f, 0.f, 0.f, 0.f};
#pragma unroll
            for (int ks = 0; ks < 2; ++ks) { const bf16x8 a = *(const GAS bf16x8*)(AMc + (16 * m + fr) * 64 + 32 * ks + 8 * fq); o[m] = __builtin_amdgcn_mfma_f32_16x16x32_bf16(a, vt[ks], o[m], 0, 0, 0); } }
        bf16x8 sb[4];
#pragma unroll
        for (int s = 0; s < 4; ++s) { v4u w; w.x = pk2(S[2 * s][0], S[2 * s][1]); w.y = pk2(S[2 * s][2], S[2 * s][3]); w.z = pk2(S[2 * s + 1][0], S[2 * s + 1][1]); w.w = pk2(S[2 * s + 1][2], S[2 * s + 1][3]); sb[s] = __builtin_bit_cast(bf16x8, w); }
#pragma unroll
        for (int m = 0; m < 4; ++m)
#pragma unroll
            for (int s = 0; s < 4; ++s) { const bf16x8 a = *(const GAS bf16x8*)(QTc + (16 * m + fr) * 128 + 32 * s + 8 * fq); o[m] = __builtin_amdgcn_mfma_f32_16x16x32_bf16(a, sb[s], o[m], 0, 0, 0); }
#pragma unroll
        for (int m = 0; m < 4; ++m)
#pragma unroll
            for (int r = 0; r < 4; ++r) P_O32[(size_t)(b * SEQ + c * CH + 16 * m + 4 * fq + r) * DA + h * HV + n0 + fr] = o[m][r];
#pragma unroll
        for (int dt = 0; dt < 8; ++dt) { const f32x4 dc = *(const GAS f32x4*)(DCc + 16 * dt + 4 * fq); S[dt] = S[dt] * dc;
#pragma unroll
            for (int ks = 0; ks < 2; ++ks) { const bf16x8 a = *(const GAS bf16x8*)(KHc + (16 * dt + fr) * 64 + 32 * ks + 8 * fq); S[dt] = __builtin_amdgcn_mfma_f32_16x16x32_bf16(a, vt[ks], S[dt], 0, 0, 0); } }
    }
#pragma unroll
    for (int dt = 0; dt < 8; ++dt)
#pragma unroll
        for (int r = 0; r < 4; ++r) P_out[O_GP + ((size_t)bh * HK + 16 * dt + 4 * fq + r) * HV + n0 + fr] = S[dt][r];
}
__device__ __forceinline__ void gla_onorm_item(Frame& F, const Args& A, int row, int h) {
    const int n4 = 4 * F.lane;
    const f32x4 o4 = *(const GAS f32x4*)(P_O32 + (size_t)row * DA + h * HV + n4);
    const float rstd = 1.0f / sqrtf(wave_sum(dot4(o4, o4)) * (1.f / HV) + RMS_EPS);
    const f32x4 gn = *(const GAS f32x4*)(P_gla_norm + n4); const v2u go = *(const GAS v2u*)(P_Z + (size_t)row * N1P + ZGO + h * HV + n4);
    v2u o; o.x = pk2(o4.x * rstd * gn.x * silu_f(bflo(go.x)), o4.y * rstd * gn.y * silu_f(bfhi(go.x))); o.y = pk2(o4.z * rstd * gn.z * silu_f(bflo(go.y)), o4.w * rstd * gn.w * silu_f(bfhi(go.y)));
    *(GAS v2u*)(P_MIX + (size_t)row * DM + h * HV + n4) = o;
}

#ifndef MK_N_LAUNCHES
#define MK_N_LAUNCHES 1
#endif
constexpr int N_PHASES = 10;
constexpr int N_LAUNCHES = MK_N_LAUNCHES;
__global__ void __launch_bounds__(NWAVES * 64, 2) hymba_fwd(Args args) {
    extern __shared__ __attribute__((aligned(16))) unsigned char lds[];
    Frame F;
    F.lds = (LAS unsigned char*)lds;
    F.MISC = (volatile LAS unsigned*)(F.lds + MISC_OFF);
    F.tid = threadIdx.x; F.lane = F.tid & 63; F.wave = __builtin_amdgcn_readfirstlane(F.tid >> 6);
    F.G = gridDim.x; { const int bx = blockIdx.x; F.vcu = (F.G % 8 == 0) ? (bx % 8) * (F.G / 8) + bx / 8 : bx; }
    const Args& A = args;
    F.ctl = (gu32*)(args.ws + WS_CTL);
    for (int u = F.tid; u < (LDS_BYTES - LDSCTL_OFF) / 4; u += NWAVES * 64) ((LAS unsigned*)(F.lds + LDSCTL_OFF))[u] = 0u;
    __syncthreads();
    XcdBarrier bar; bar.bar = (unsigned*)(F.ctl + CW_BAR); bar.x = 0; bar.st = nullptr;
    if (N_LAUNCHES == 1) bar = xcd_barrier_post((unsigned*)(F.ctl + CW_BAR), F.MISC + 8);
    const int lo = args.ph_lo, hi = args.ph_hi;
#ifndef REP_MASK
#define REP_MASK 0
#endif
#define REPS(k) (((REP_MASK >> (k)) & 1) ? 2 : 1)
#ifndef P2A_REP
#define P2A_REP 0
#endif
#ifndef P2A_MASK
#define P2A_MASK 15
#endif
#ifndef PH_MASK
#define PH_MASK 0x3ff
#endif
#define IN(k) (((PH_MASK >> (k)) & 1) && lo <= (k) && (k) < hi)
#define SEAM(k) do { if (IN(k) && IN((k) + 1)) xcd_barrier(bar); } while (0)
    const int gw = F.vcu * NWAVES + F.wave, NGW = F.G * NWAVES;

    if (IN(0)) for (int rep_ = 0; rep_ < REPS(0); ++rep_) { p0_prologue(F, A); }
    SEAM(0);
    if (IN(1)) for (int rep_ = 0; rep_ < REPS(1); ++rep_) {
        pg8::Gemm g{P_H, P_W1t, MPAD, N1P, DM}; pg8::StaticOrder S; S.init(MPAD, N1P, F.G, (int)blockIdx.x);
        pg8::EpiStoreBf16 E{P_Z, N1P};
        pg8::gemm_phase<pg8::EpiStoreBf16, pg8::StaticOrder, true, true>(F.lds + RING_OFF, g, S, E);
    }
    SEAM(1);
    if (IN(2)) for (int rep_ = 0; rep_ < REPS(2); ++rep_) {
        constexpr int U_PREP = NB * NH * NCH, U_CONVP = NB * (SEQ / 16), U_CONVS = MS, U_GLAS = MS * NH;
        for (int q_ = 0; q_ < ((P2A_REP & 1) ? 2 : 1); ++q_) if (P2A_MASK & 1) { for (int r = F.vcu; r < U_GLAS; r += F.G) gla_sample_item(F, A, r); }
        for (int q_ = 0; q_ < ((P2A_REP & 2) ? 2 : 1); ++q_) if (P2A_MASK & 2) { for (int r = F.vcu; r < U_PREP; r += F.G) gla_prep_unit(F, A, r / NCH, r % NCH); }
        for (int q_ = 0; q_ < ((P2A_REP & 4) ? 2 : 1); ++q_) if (P2A_MASK & 4) { for (int r = F.vcu; r < U_CONVP; r += F.G) conv_prompt_unit(F, A, r / (SEQ / 16), r % (SEQ / 16)); }
        { const int gw2 = F.vcu * NWAVES + F.wave; for (int r = gw2; r < NB * 30; r += F.G * NWAVES) conv_state_prompt_row(F, A, r / 30, r % 30); }
        for (int q_ = 0; q_ < ((P2A_REP & 8) ? 2 : 1); ++q_) if (P2A_MASK & 8) { for (int r = F.G - 1 - F.vcu; r < U_CONVS; r += F.G) conv_sample_unit(F, A, r); }
    }
    SEAM(2);
    if (IN(3)) for (int rep_ = 0; rep_ < REPS(3); ++rep_) {
        if (F.wave == 0) { for (int it = F.vcu; it < NB * NH * 16; it += F.G) gla_seq_item(F, A, it); }
    }
    SEAM(3);
    if (IN(4)) for (int rep_ = 0; rep_ < REPS(4); ++rep_) { for (int it = gw; it < MP * NH; it += NGW) gla_onorm_item(F, A, it >> 2, it & 3); }
    SEAM(4);
    if (IN(5)) for (int rep_ = 0; rep_ < REPS(5); ++rep_) {
        pg8::Gemm g{P_MIX, P_W2t, MPAD, DM, DM}; pg8::StaticOrder S; S.init(MPAD, DM, F.G, (int)blockIdx.x);
        pg8::EpiResF32 E{P_xp, P_xs, P_out, DM, MP, MR};
        pg8::gemm_phase<pg8::EpiResF32, pg8::StaticOrder, true, true>(F.lds + RING_OFF, g, S, E);
    }
    SEAM(5);
    if (IN(6)) for (int rep_ = 0; rep_ < REPS(6); ++rep_) { for (int m = gw; m < MR; m += NGW) rms_row_to_bf16(P_out + (size_t)m * DM, P_norm_ffn, P_H + (size_t)m * DM, F.lane); }
    SEAM(6);
    if (IN(7)) for (int rep_ = 0; rep_ < REPS(7); ++rep_) {
        pg8::Gemm g{P_H, P_W3t, MPAD, 2 * DFF, DM}; pg8::StaticOrder S; S.init(MPAD, 2 * DFF, F.G, (int)blockIdx.x);
        pg8::EpiSwiglu E{P_HID, DFF};
        pg8::gemm_phase<pg8::EpiSwiglu, pg8::StaticOrder, true, true>(F.lds + RING_OFF, g, S, E);
    }
    SEAM(7);
    if (IN(8)) for (int rep_ = 0; rep_ < REPS(8); ++rep_) {
        pg8::Gemm g{P_HID, P_W4t, MPAD, DM, DFF}; pg8::StaticOrder S; S.init(MPAD, DM, F.G, (int)blockIdx.x);
        pg8::EpiResF32 E{P_out, P_out, P_out, DM, MR, MR};
        pg8::gemm_phase<pg8::EpiResF32, pg8::StaticOrder, true, true>(F.lds + RING_OFF, g, S, E);
    }
    SEAM(8);
    if (IN(9)) for (int rep_ = 0; rep_ < REPS(9); ++rep_) { for (int m = gw; m < MR; m += NGW) rms_row_inplace(P_out + (size_t)m * DM, P_norm_final, F.lane); }
#undef IN
#undef SEAM
}

extern "C" void kernel_launch(void* const* d_in, const int* in_sizes, int n_in, void* d_out, int out_size, void* d_ws, size_t ws_size, hipStream_t stream) {
    static int grid = 0;
    if (grid == 0) {
        if (n_in != 18 || in_sizes[0] != MP * DM || (size_t)out_size != O_END || ws_size < WS_END) {
            fprintf(stderr, "kernel_launch: shape mismatch: n_in %d in0 %d out %d ws %zu (need %zu); nothing launched\n", n_in, n_in > 0 ? in_sizes[0] : -1, out_size, ws_size, (size_t)WS_END); grid = -1; return; }
        int dev = 0, cus = 0, per_cu = 0;
        if (hipGetDevice(&dev) != hipSuccess || hipDeviceGetAttribute(&cus, hipDeviceAttributeMultiprocessorCount, dev) != hipSuccess) { grid = -1; return; }
        if (hipFuncSetAttribute((const void*)hymba_fwd, hipFuncAttributeMaxDynamicSharedMemorySize, LDS_BYTES) != hipSuccess) { fprintf(stderr, "kernel_launch: hipFuncSetAttribute failed\n"); grid = -1; return; }
        if (hipOccupancyMaxActiveBlocksPerMultiprocessor(&per_cu, (const void*)hymba_fwd, NWAVES * 64, LDS_BYTES) != hipSuccess || per_cu < 1)
            fprintf(stderr, "kernel_launch: note: occupancy query reports %d workgroups per CU\n", per_cu);
        (void)hipGetLastError();
        grid = cus;
    }
    if (grid < 0) return;
    if (N_LAUNCHES == 1) { if (hipMemsetAsync((char*)d_ws + WS_CTL, 0, CTL_ZERO_BYTES, stream) != hipSuccess) return; }
    Args a{};
    for (int i = 0; i < 18; ++i) a.in[i] = (const float*)d_in[i];
    a.out = (float*)d_out; a.ws = (unsigned char*)d_ws;
    for (int li = 0; li < N_LAUNCHES; ++li) {
        a.ph_lo = (N_LAUNCHES == 1) ? 0 : li; a.ph_hi = (N_LAUNCHES == 1) ? N_PHASES : li + 1;
        hipLaunchKernelGGL(hymba_fwd, dim3(grid), dim3(NWAVES * 64), LDS_BYTES, stream, a);
        const hipError_t le = hipPeekAtLastError();
        if (le != hipSuccess) { fprintf(stderr, "kernel_launch: launch %d failed: %s\n", li, hipGetErrorName(le)); break; }
    }
}
```

```cpp
#include <hip/hip_runtime.h>
#include <cstdio>
#include <cstdint>
constexpr int PG8_DUMMY = 0;
namespace pg8 {
#define PG8_LAS __attribute__((address_space(3)))
typedef unsigned short bf16_t;
typedef short bf16x8 __attribute__((ext_vector_type(8)));
typedef float f32x4 __attribute__((ext_vector_type(4)));
typedef unsigned u32x4 __attribute__((ext_vector_type(4)));
constexpr int BM = 256, BK = 64, HALF = 128, HTB = HALF * BK * 2  , STAGE_BYTES = 8 * HTB, NXCD = 8, WGM = 8;

__host__ __device__ __forceinline__ int lds_byte(int r, int c) { const int st = (r >> 4) * 2 + (c >> 5), rr = r & 15, cc = c & 31, ob = rr * 64 + cc * 2; return st * 1024 + (ob ^ (((ob >> 9) & 1) << 5)); }
__host__ __device__ __forceinline__ void stage_rc(int b, int& R, int& C) { const int st = b / 1024, sb = b % 1024, swz = sb ^ (((sb >> 9) & 1) << 5); R = (st >> 1) * 16 + swz / 64; C = (st & 1) * 32 + (swz % 64) / 2; }
__host__ __device__ __forceinline__ int perm32(int rho) { const int n = rho >> 4, i = rho & 15; return 8 * (i >> 2) + 4 * n + (i & 3); }

struct Unit { int pm, pn, k0, nk, mode, slot; };
struct Gemm { const bf16_t* A; const bf16_t* Bt; int M, N, K; };

struct StaticOrder {
    static constexpr bool SK = false;
    int nM, nN, nwg, G, c;
    __host__ __device__ __forceinline__ void init(int M, int N, int G_, int c_) { nM = M / BM; nN = N / BM; nwg = nM * nN; G = G_; c = c_; }
    __host__ __device__ __forceinline__ bool next(int i, Unit& u) const {
        const long L = (long)i * G + c; const bool ok = L < nwg;
        int wgid = ok ? (int)L : 0; { const int q = nwg / NXCD, r = nwg % NXCD, xcd = wgid % NXCD, off = wgid / NXCD; wgid = (xcd < r ? xcd * (q + 1) : r * (q + 1) + (xcd - r) * q) + off; }
        const int nig = WGM * nN, gid = wgid / nig, fm = gid * WGM, gsz = (nM - fm) < WGM ? (nM - fm) : WGM;
        u.pm = fm + ((wgid % nig) % gsz); u.pn = (wgid % nig) / gsz; return ok;
    }
    __device__ __forceinline__ void a_ready(const Unit&) const {}
    __device__ __forceinline__ void done(const Unit&) const {}
};
__device__ __forceinline__ unsigned cvt_pk_bf16(float lo, float hi) { unsigned r; asm volatile("v_cvt_pk_bf16_f32 %0, %1, %2" : "=v"(r) : "v"(lo), "v"(hi)); return r; }
typedef float f32x2 __attribute__((ext_vector_type(2)));
typedef unsigned u32x2v __attribute__((ext_vector_type(2)));
__device__ __forceinline__ float silu_f(float x) { return x * __builtin_amdgcn_rcpf(1.0f + __expf(-x)); }
struct EpiStoreBf16 {
    static constexpr bool PERM = true, AFTER_DRAIN = false;
    bf16_t* O; int ldc;
    __device__ __forceinline__ void operator()(const f32x4 (&acc)[2][2][4][2], const Unit& u, int wr, int wc, int fr, int fq) const {
        const int row0 = u.pm * BM + wr * 64 + fr, col0 = u.pn * BM + wc * 32 + 8 * fq;
#pragma unroll
        for (int ai = 0; ai < 2; ++ai)
#pragma unroll
            for (int m = 0; m < 4; ++m) { bf16_t* rowp = O + (size_t)(row0 + ai * HALF + m * 16) * ldc + col0;
#pragma unroll
                for (int bj = 0; bj < 2; ++bj) { const f32x4 v0 = acc[ai][bj][m][0], v1 = acc[ai][bj][m][1];
                    u32x4 w; w.x = cvt_pk_bf16(v0[0], v0[1]); w.y = cvt_pk_bf16(v0[2], v0[3]); w.z = cvt_pk_bf16(v1[0], v1[1]); w.w = cvt_pk_bf16(v1[2], v1[3]);
                    *(u32x4*)(rowp + bj * HALF) = w; } }
    }
};
struct EpiSwiglu {
    static constexpr bool PERM = true, AFTER_DRAIN = false;
    bf16_t* O; int ldc;
    __device__ __forceinline__ void operator()(const f32x4 (&acc)[2][2][4][2], const Unit& u, int wr, int wc, int fr, int fq) const {
        const int row0 = u.pm * BM + wr * 64 + fr, col0 = u.pn * HALF + wc * 32 + 8 * fq;
#pragma unroll
        for (int ai = 0; ai < 2; ++ai)
#pragma unroll
            for (int m = 0; m < 4; ++m) { bf16_t* rowp = O + (size_t)(row0 + ai * HALF + m * 16) * ldc + col0;
                float h[8];
#pragma unroll
                for (int n = 0; n < 2; ++n)
#pragma unroll
                    for (int e = 0; e < 4; ++e) h[4 * n + e] = silu_f(acc[ai][0][m][n][e]) * acc[ai][1][m][n][e];
                u32x4 w; w.x = cvt_pk_bf16(h[0], h[1]); w.y = cvt_pk_bf16(h[2], h[3]); w.z = cvt_pk_bf16(h[4], h[5]); w.w = cvt_pk_bf16(h[6], h[7]);
                *(u32x4*)rowp = w; }
    }
};
struct EpiResF32 {
    static constexpr bool PERM = false, AFTER_DRAIN = false;
    const float* base0; const float* base1; float* out; int ldc, msplit, mreal; float* part;
    __device__ __forceinline__ void operator()(const f32x4 (&acc)[2][2][4][2], const Unit& u, int wr, int wc, int fr, int fq) const {
        const int row0 = u.pm * BM + wr * 64 + fr, col0 = u.pn * BM + wc * 32 + 4 * fq;
#pragma unroll
        for (int ai = 0; ai < 2; ++ai)
#pragma unroll
            for (int m = 0; m < 4; ++m) { const int row = row0 + ai * HALF + m * 16;
                if (row < mreal) {
                    const float* bp = (row < msplit ? base0 + (size_t)row * ldc : base1 + (size_t)(row - msplit) * ldc) + col0; float* op = out + (size_t)row * ldc + col0;
                    f32x4 b[2][2];
#pragma unroll
                    for (int bj = 0; bj < 2; ++bj)
#pragma unroll
                        for (int n = 0; n < 2; ++n) b[bj][n] = *(const f32x4*)(bp + bj * HALF + n * 16);
#pragma unroll
                    for (int bj = 0; bj < 2; ++bj)
#pragma unroll
                        for (int n = 0; n < 2; ++n) *(f32x4*)(op + bj * HALF + n * 16) = b[bj][n] + acc[ai][bj][m][n];
                } }
    }
    __device__ __forceinline__ void partial(const f32x4 (&acc)[2][2][4][2], const Unit& u, int wr, int wc, int fr, int fq) const {
        float* pp = part + ((size_t)u.slot * HALF + wr * 64 + fr) * ldc + u.pn * BM + wc * 32 + 4 * fq;
#pragma unroll
        for (int m = 0; m < 4; ++m)
#pragma unroll
            for (int bj = 0; bj < 2; ++bj)
#pragma unroll
                for (int n = 0; n < 2; ++n) *(f32x4*)(pp + (size_t)(m * 16) * ldc + bj * HALF + n * 16) = acc[0][bj][m][n];
    }
};
struct TailSplitOrder : StaticOrder {
    static constexpr bool SK = true;
    int nkp, npieces, ntfull;
    __device__ __forceinline__ void init_ts(int Mfull, int N, int K, int G_, int c_, int nkp_) { init(Mfull, N, G_, c_); ntfull = K / BK; nkp = nkp_; npieces = nN * (ntfull / nkp_); }
    __device__ __forceinline__ bool next(int i, Unit& u) const {
        Unit t; t.pm = 0; t.pn = 0;
        const bool full = StaticOrder::next(i, t);
        const long p = (long)i * G + c - nwg; const bool piece = !full && p >= 0 && p < npieces;
        const int pp = piece ? (int)p : 0, ks = pp / nN;
        u.pm = full ? t.pm : nM; u.pn = full ? t.pn : pp - ks * nN; u.slot = full ? 0 : ks; u.k0 = full ? 0 : ks * nkp; u.nk = full ? ntfull : nkp; u.mode = full ? 0 : 3;
        return full || piece;
    }
};
#ifndef SKT_PUB
#define SKT_PUB 1
#endif
#ifndef SKT_COMB
#define SKT_COMB 1
#endif
template <class Epi, class Sched, bool ALIGN_EPI = false, bool SP2 = false>
__device__ __forceinline__ void gemm_phase(PG8_LAS unsigned char* lds, const Gemm g, const Sched& S, const Epi& E) {
    const int tid = threadIdx.x, wid = __builtin_amdgcn_readfirstlane(tid >> 6), lane = tid & 63, wr = wid >> 2, wc = wid & 3, fr = lane & 15, fq = lane >> 4;
    const int K = g.K, nt = K / BK;
    unsigned voffA[2], voffB[2];
#pragma unroll
    for (int i = 0; i < 2; ++i) { int R, C; stage_rc(tid * 16 + i * 8192, R, C); const int Rb = Epi::PERM ? ((R & ~31) + perm32(R & 31)) : R;
        voffA[i] = (unsigned)(R * K + C) * 2u; voffB[i] = (unsigned)(Rb * K + C) * 2u; }
    const size_t kstep = (size_t)(BK * 2);
    const size_t hstep = (size_t)HALF * K * 2;
    const size_t tstep = 2 * hstep;
    const unsigned ldsw = (unsigned)wid * 1024u;
    const int aoff = lds_byte(wr * 64 + fr, fq * 8), boff = lds_byte(wc * 32 + fr, fq * 8);
#define PG8_SA(b, h) (((b) * 2 + (h)) * HTB)
#define PG8_SB(b, h) ((4 + (b) * 2 + (h)) * HTB)
#define PG8_STAGE(bufoff, gbase, voff) do { _Pragma("unroll") for (int _i = 0; _i < 2; ++_i) \
        __builtin_amdgcn_global_load_lds((const unsigned*)((const char*)(gbase) + (voff)[_i]), (PG8_LAS unsigned*)(lds + (bufoff) + ldsw + _i * 8192), 16, 0, 0); } while (0)
#define PG8_LDA(dst, b, h) do { _Pragma("unroll") for (int m = 0; m < 4; ++m) _Pragma("unroll") for (int k = 0; k < 2; ++k) dst[m][k] = *(const PG8_LAS bf16x8*)(lds + PG8_SA(b, h) + aoff + m * 2048 + k * 1024); } while (0)
#define PG8_LDB(dst, b, h) do { _Pragma("unroll") for (int n = 0; n < 2; ++n) _Pragma("unroll") for (int k = 0; k < 2; ++k) dst[n][k] = *(const PG8_LAS bf16x8*)(lds + PG8_SB(b, h) + boff + n * 2048 + k * 1024); } while (0)
#define PG8_MMA(ai, bj, At, Bt) do { __builtin_amdgcn_s_setprio(1); _Pragma("unroll") for (int m = 0; m < 4; ++m) _Pragma("unroll") for (int n = 0; n < 2; ++n) _Pragma("unroll") for (int k = 0; k < 2; ++k) \
        acc[ai][bj][m][n] = __builtin_amdgcn_mfma_f32_16x16x32_bf16(Bt[n][k], At[m][k], acc[ai][bj][m][n], 0, 0, 0); __builtin_amdgcn_s_setprio(0); } while (0)
#define PG8_WAIT_V(n) asm volatile("s_waitcnt vmcnt(" #n ")" ::: "memory")
#define PG8_WAIT_L(n) asm volatile("s_waitcnt lgkmcnt(" #n ")" ::: "memory")
#define PG8_BAR __builtin_amdgcn_s_barrier()
#define PG8_SCHED __builtin_amdgcn_sched_barrier(0)
    Unit cur, nxt; int ui = 0;
    if (!S.next(0, cur)) return;
    if constexpr (!Sched::SK) { cur.k0 = 0; cur.nk = nt; cur.mode = 0; cur.slot = 0; }
    f32x4 acc[2][2][4][2];
#pragma unroll
    for (int a = 0; a < 2; ++a)
#pragma unroll
        for (int b = 0; b < 2; ++b)
#pragma unroll
            for (int m = 0; m < 4; ++m)
#pragma unroll
                for (int n = 0; n < 2; ++n) acc[a][b][m][n] = (f32x4){0.f, 0.f, 0.f, 0.f};
    bf16x8 At[4][2], B0[2][2], B1[2][2];
    const char* cA = (const char*)g.A + (size_t)cur.pm * tstep + (size_t)cur.k0 * kstep; const char* cB = (const char*)g.Bt + (size_t)cur.pn * tstep + (size_t)cur.k0 * kstep;
    S.a_ready(cur);
    if constexpr (SP2) {
        PG8_STAGE(PG8_SB(0, 0), cB, voffB); PG8_STAGE(PG8_SB(0, 1), cB + hstep, voffB); PG8_STAGE(PG8_SA(0, 0), cA, voffA); PG8_STAGE(PG8_SA(0, 1), cA + hstep, voffA);
        if (wr == 1) PG8_BAR;
        PG8_WAIT_V(2); PG8_BAR;
        PG8_STAGE(PG8_SB(1, 0), cB + kstep, voffB); PG8_STAGE(PG8_SA(1, 0), cA + kstep, voffA); PG8_STAGE(PG8_SB(1, 1), cB + hstep + kstep, voffB);
        PG8_WAIT_V(6); PG8_BAR;
    } else {
        PG8_STAGE(PG8_SB(0, 0), cB, voffB); PG8_STAGE(PG8_SA(0, 0), cA, voffA); PG8_STAGE(PG8_SB(0, 1), cB + hstep, voffB); PG8_STAGE(PG8_SA(0, 1), cA + hstep, voffA);
        if (wr == 1) PG8_BAR;
        PG8_WAIT_V(4); PG8_BAR;
        PG8_STAGE(PG8_SB(1, 0), cB + kstep, voffB); PG8_STAGE(PG8_SA(1, 0), cA + kstep, voffA); PG8_STAGE(PG8_SB(1, 1), cB + hstep + kstep, voffB);
        PG8_WAIT_V(6); PG8_BAR;
    }
    for (;;) {
        const bool has_next = S.next(ui + 1, nxt);
        if constexpr (!Sched::SK) { nxt.k0 = 0; nxt.nk = nt; nxt.mode = 0; nxt.slot = 0; }
        const int ntc = cur.nk;
        const char* nA = has_next ? (const char*)g.A + (size_t)nxt.pm * tstep + (size_t)nxt.k0 * kstep : cA; const char* nB = has_next ? (const char*)g.Bt + (size_t)nxt.pn * tstep + (size_t)nxt.k0 * kstep : cB;
        for (int t = 0; t < ntc; t += 2) {
            const bool last = (t == ntc - 2);
            const char* a1 = cA + (size_t)(t + 1) * kstep;
            const char* a2 = last ? nA : cA + (size_t)(t + 2) * kstep; const char* b2 = last ? nB : cB + (size_t)(t + 2) * kstep;
            const char* a3 = a2 + kstep; const char* b3 = b2 + kstep;
            if (last && has_next) S.a_ready(nxt);
            if constexpr (SP2) {
            PG8_LDB(B0, 0, 0); PG8_LDB(B1, 0, 1); PG8_SCHED; PG8_LDA(At, 0, 0); PG8_STAGE(PG8_SA(1, 1), a1 + hstep, voffA);
            PG8_WAIT_V(8); PG8_WAIT_L(0); PG8_BAR; PG8_MMA(0, 0, At, B0); PG8_MMA(0, 1, At, B1); PG8_BAR; PG8_SCHED;
            PG8_LDA(At, 0, 1); PG8_STAGE(PG8_SB(0, 0), b2, voffB); PG8_STAGE(PG8_SB(0, 1), b2 + hstep, voffB); PG8_STAGE(PG8_SA(0, 0), a2, voffA);
            PG8_WAIT_V(8); PG8_WAIT_L(0); PG8_BAR; PG8_MMA(1, 0, At, B0); PG8_MMA(1, 1, At, B1); PG8_BAR; PG8_SCHED;
            PG8_LDB(B0, 1, 0); PG8_LDB(B1, 1, 1); PG8_SCHED; PG8_LDA(At, 1, 0); PG8_STAGE(PG8_SA(0, 1), a2 + hstep, voffA);
            PG8_WAIT_V(8); PG8_WAIT_L(0); PG8_BAR; PG8_MMA(0, 0, At, B0); PG8_MMA(0, 1, At, B1); PG8_BAR; PG8_SCHED;
            PG8_LDA(At, 1, 1); PG8_STAGE(PG8_SB(1, 0), b3, voffB); PG8_STAGE(PG8_SB(1, 1), b3 + hstep, voffB); PG8_STAGE(PG8_SA(1, 0), a3, voffA);
            PG8_WAIT_V(8); PG8_WAIT_L(0); PG8_BAR; PG8_MMA(1, 0, At, B0); PG8_MMA(1, 1, At, B1); PG8_BAR; PG8_SCHED;
            } else {
            PG8_LDB(B0, 0, 0); PG8_SCHED; PG8_LDA(At, 0, 0); PG8_STAGE(PG8_SA(1, 1), a1 + hstep, voffA);
            PG8_WAIT_L(8); PG8_BAR; PG8_WAIT_L(0); PG8_MMA(0, 0, At, B0); PG8_BAR; PG8_SCHED;
            PG8_LDB(B1, 0, 1); PG8_STAGE(PG8_SB(0, 0), b2, voffB);
            PG8_BAR; PG8_WAIT_L(0); PG8_MMA(0, 1, At, B1); PG8_BAR;
            PG8_LDA(At, 0, 1); PG8_STAGE(PG8_SA(0, 0), a2, voffA);
            PG8_BAR; PG8_WAIT_L(0); PG8_MMA(1, 0, At, B0); PG8_BAR; PG8_SCHED;
            PG8_STAGE(PG8_SB(0, 1), b2 + hstep, voffB);
            PG8_WAIT_V(6); PG8_BAR; PG8_MMA(1, 1, At, B1); PG8_BAR;
            PG8_LDB(B0, 1, 0); PG8_SCHED; PG8_LDA(At, 1, 0); PG8_STAGE(PG8_SA(0, 1), a2 + hstep, voffA);
            PG8_WAIT_L(8); PG8_BAR; PG8_WAIT_L(0); PG8_MMA(0, 0, At, B0); PG8_BAR; PG8_SCHED;
            PG8_LDB(B1, 1, 1); PG8_STAGE(PG8_SB(1, 0), b3, voffB);
            PG8_BAR; PG8_WAIT_L(0); PG8_MMA(0, 1, At, B1); PG8_BAR;
            PG8_LDA(At, 1, 1); PG8_STAGE(PG8_SA(1, 0), a3, voffA);
            PG8_BAR; PG8_WAIT_L(0); PG8_MMA(1, 0, At, B0); PG8_BAR; PG8_SCHED;
            PG8_STAGE(PG8_SB(1, 1), b3 + hstep, voffB);
            PG8_WAIT_V(6); PG8_BAR; PG8_MMA(1, 1, At, B1); PG8_BAR;
            }
        }
        if constexpr (ALIGN_EPI) { if (wr == 0) PG8_BAR; }
        if constexpr (!Epi::AFTER_DRAIN) {
            if constexpr (Sched::SK) { if (cur.mode == 3) E.partial(acc, cur, wr, wc, fr, fq); else E(acc, cur, wr, wc, fr, fq); }
            else E(acc, cur, wr, wc, fr, fq);
            S.done(cur); }
        if (!has_next) break;
#pragma unroll
        for (int a = 0; a < 2; ++a)
#pragma unroll
            for (int b = 0; b < 2; ++b)
#pragma unroll
                for (int m = 0; m < 4; ++m)
#pragma unroll
                    for (int n = 0; n < 2; ++n) acc[a][b][m][n] = (f32x4){0.f, 0.f, 0.f, 0.f};
        cur = nxt; cA = nA; cB = nB; ++ui;
        if constexpr (ALIGN_EPI) { if (wr == 1) PG8_BAR; }
    }
    PG8_WAIT_V(0);
    if constexpr (!ALIGN_EPI) { if (wr == 0) PG8_BAR; }
    PG8_BAR;
    if constexpr (Epi::AFTER_DRAIN) { E.fused(acc, cur, wr, wc, fr, fq, lds, wid, lane); S.done(cur); }
#undef PG8_SA
#undef PG8_SB
#undef PG8_STAGE
#undef PG8_LDA
#undef PG8_LDB
#undef PG8_MMA
#undef PG8_WAIT_V
#undef PG8_WAIT_L
#undef PG8_BAR
#undef PG8_SCHED
}
}

constexpr int NWAVES = 8;
constexpr int DM = 2048, MP = 8192, MS = 128, MR = MP + MS  , MPAD = 8448  , SEQ = 2048, NB = 4;
constexpr int NH = 4, HK = 128, HV = 256, DK = 512, DA = 1024, DC_ = 1024, GR = 16, CW = 31, DFF = 5632;
constexpr int N1 = 5136, N1P = 5376;
constexpr int ZQ = 0, ZK = 512, ZV = 1024, ZGO = 2048, ZUA = 3072, ZUG = 4096, ZGL = 5120;
constexpr int CH = 64, NCH = SEQ / CH;
constexpr float RMS_EPS = 1e-6f, LN_EPS = 1e-5f;
constexpr size_t O_YP = 0, O_YS = (size_t)MP * DM, O_GP = O_YS + (size_t)MS * DM, O_CP = O_GP + (size_t)NB * NH * HK * HV, O_GS = O_CP + (size_t)NB * 30 * DC_,
                 O_CS = O_GS + (size_t)MS * NH * HK * HV, O_END = O_CS + (size_t)MS * 30 * DC_;
constexpr size_t MiB = 1u << 20;
constexpr size_t WS_CTL = 0, CTL_ZERO_BYTES = 1 * MiB;
constexpr size_t WS_W1 = 2 * MiB;
constexpr size_t WS_W2 = 23 * MiB;
constexpr size_t WS_W3 = 31 * MiB;
constexpr size_t WS_W4 = 75 * MiB;
constexpr size_t WS_H = 97 * MiB;
constexpr size_t WS_QT = WS_H, WS_KH = WS_H + 8 * MiB, WS_VT = WS_H + 16 * MiB;
constexpr size_t WS_Z = 130 * MiB;
constexpr size_t WS_MIX = 217 * MiB;
constexpr size_t WS_HID = 130 * MiB;
constexpr size_t WS_END = 250 * MiB;
static_assert(WS_Z + (size_t)MPAD * N1P * 2 <= WS_MIX && WS_HID + (size_t)MPAD * DFF * 2 <= WS_END && WS_W1 + (size_t)N1P * DM * 2 <= WS_W2 && WS_W3 + (size_t)2 * DFF * DM * 2 <= WS_W4 && WS_W4 + (size_t)DM * DFF * 2 <= WS_H, "d_ws map");
constexpr size_t DO_O32 = 0, DO_AM = 32 * MiB, DO_DC = 36 * MiB;
constexpr int CW_TMO = 0, CW_BAR = 4096, CW_SK2 = 16384, CW_SK4 = 16384 + 264 * 64;
constexpr size_t WS_SK2 = WS_Z, WS_SK4 = WS_W1;
static_assert((size_t)32 * 128 * DM * 4 <= WS_MIX - WS_Z && WS_SK4 + (size_t)44 * 128 * DM * 4 <= WS_W4, "K-split slabs");
constexpr int RING_OFF = 0, RING_BYTES = 131072;
constexpr int LDSCTL_OFF = RING_BYTES, MISC_OFF = LDSCTL_OFF + 320;
constexpr int LDS_BYTES = 147456;

#define GAS __attribute__((address_space(1)))
#define LAS __attribute__((address_space(3)))
typedef unsigned short bf16;
typedef unsigned v4u __attribute__((ext_vector_type(4)));
typedef unsigned v2u __attribute__((ext_vector_type(2)));
typedef float f32x4 __attribute__((ext_vector_type(4)));
typedef float f32x2 __attribute__((ext_vector_type(2)));
typedef short bf16x8 __attribute__((ext_vector_type(8)));
typedef GAS unsigned gu32;
typedef GAS unsigned long long gu64;
#define RLX_AGENT __ATOMIC_RELAXED, __HIP_MEMORY_SCOPE_AGENT
#define LDS_WAIT() asm volatile("s_waitcnt lgkmcnt(0)" ::: "memory")
#define VM_WAIT() asm volatile("s_waitcnt vmcnt(0)" ::: "memory")
__device__ __forceinline__ unsigned f2bf(float f) { unsigned u = __builtin_bit_cast(unsigned, f); return (u + 0x7fffu + ((u >> 16) & 1u)) >> 16; }
__device__ __forceinline__ unsigned pk2(float lo, float hi) { return f2bf(lo) | (f2bf(hi) << 16); }
__device__ __forceinline__ float bf2f(unsigned short b) { return __builtin_bit_cast(float, (unsigned)b << 16); }
__device__ __forceinline__ float bflo(unsigned w) { return __builtin_bit_cast(float, w << 16); }
__device__ __forceinline__ float bfhi(unsigned w) { return __builtin_bit_cast(float, w & 0xffff0000u); }
__device__ __forceinline__ float sigmoid_f(float x) { return __builtin_amdgcn_rcpf(1.0f + __expf(-x)); }
__device__ __forceinline__ float silu_f(float x) { return x * sigmoid_f(x); }
__device__ __forceinline__ float logsigmoid_f(float x) { return fminf(x, 0.f) - log1pf(__expf(-fabsf(x))); }
#define XB_TMO      128
#define XB_XCNT(j)  (256  + 64 * (j))
#define XB_XSUB(j)  (1280 + 64 * (j))
#define XB_XGEN(j)  (2304 + 64 * (j))
#define XB_TOP      3328
#define XB_TOPGEN   3392
#define XCD_BAR_WORDS 3456
#define XB_SPIN_CAP (1u << 18)

__device__ __forceinline__ unsigned xb_ld(unsigned* p)              { return __hip_atomic_load(p, __ATOMIC_RELAXED, __HIP_MEMORY_SCOPE_AGENT); }
__device__ __forceinline__ unsigned xb_add(unsigned* p, unsigned v) { return __hip_atomic_fetch_add(p, v, __ATOMIC_RELAXED, __HIP_MEMORY_SCOPE_AGENT); }
__device__ __forceinline__ unsigned xb_xcc_id() { return (unsigned)__builtin_amdgcn_s_getreg((3 << 11) | 20) & 0xFu; }
#define XB_SPIN(cond, bar) do { unsigned _sp = 0; while (cond) { __builtin_amdgcn_s_sleep(1); \
    if ((++_sp & 255u) == 0u) { if (xb_ld(&(bar)[XB_TMO])) break; if (_sp > XB_SPIN_CAP) { atomicAdd(&(bar)[XB_TMO], 1u); break; } } } } while (0)

struct XcdBarrier {
    unsigned* bar; unsigned x;
    volatile LAS unsigned* st;
};

__device__ __forceinline__ XcdBarrier xcd_barrier_post(unsigned* bar, volatile LAS unsigned* st) {
    XcdBarrier b; b.bar = bar; b.x = xb_xcc_id(); b.st = st;
    if (threadIdx.x == 0) (void)xb_add(&bar[XB_XCNT(b.x)], 1u);
    return b;
}
__device__ __forceinline__ void xcd_barrier_complete(unsigned* bar, unsigned x, unsigned& nloc, unsigned& nx) {
    const unsigned G = gridDim.x * gridDim.y * gridDim.z;
    unsigned sum, cnt, mine, sp = 0u;
    for (;;) {
        sum = 0u; cnt = 0u; mine = 0u;
#pragma unroll
        for (unsigned j = 0; j < 16; ++j) { const unsigned c = xb_ld(&bar[XB_XCNT(j)]); sum += c; cnt += (c > 0u) ? 1u : 0u; mine = (j == x) ? c : mine; }
        if (sum == G) break;
        __builtin_amdgcn_s_sleep(1);
        if ((++sp & 255u) == 0u) { if (xb_ld(&bar[XB_TMO])) break; if (sp > XB_SPIN_CAP) { atomicAdd(&bar[XB_TMO], 1u); break; } }
    }
    nloc = mine > 0u ? mine : 1u; nx = cnt > 0u ? cnt : 1u;
}

__device__ __forceinline__ void xcd_barrier(const XcdBarrier& b) {
    asm volatile("s_waitcnt vmcnt(0)" ::: "memory");
    __syncthreads();
    if (threadIdx.x == 0) {
        unsigned* bar = b.bar;
        __builtin_amdgcn_s_waitcnt(0);
        unsigned nloc = b.st[0], nx = b.st[1];
        if (nloc == 0u) { xcd_barrier_complete(bar, b.x, nloc, nx); b.st[0] = nloc; b.st[1] = nx; }
        const unsigned old = xb_add(&bar[XB_XSUB(b.x)], 1u);
        const unsigned gen = old / nloc;
        if (old + 1u == (gen + 1u) * nloc) {
            __builtin_amdgcn_fence(__ATOMIC_RELEASE, "agent");
            asm volatile("s_waitcnt vmcnt(0)" ::: "memory");
            const unsigned og = xb_add(&bar[XB_TOP], 1u);
            const unsigned tg = og / nx;
            if (og + 1u == (tg + 1u) * nx) xb_add(&bar[XB_TOPGEN], 1u);
            else XB_SPIN(xb_ld(&bar[XB_TOPGEN]) == tg, bar);
            __builtin_amdgcn_fence(__ATOMIC_ACQUIRE, "agent");
            xb_add(&bar[XB_XGEN(b.x)], 1u);
            asm volatile("s_waitcnt vmcnt(0)" ::: "memory");
        } else {
            XB_SPIN(xb_ld(&bar[XB_XGEN(b.x)]) == gen, bar);
            __builtin_amdgcn_fence(__ATOMIC_ACQUIRE, "agent");
            asm volatile("s_waitcnt vmcnt(0)" ::: "memory");
        }
    }
    __syncthreads();
}
struct Args { const float* in[18]; float* out; unsigned char* ws; int ph_lo, ph_hi; };
#define P_xp (A.in[0])
#define P_xs (A.in[1])
#define P_sgla (A.in[2])
#define P_sconv (A.in[3])
#define P_norm_mix (A.in[4])
#define P_w_in (A.in[5])
#define P_wgu (A.in[6])
#define P_bgate (A.in[7])
#define P_gla_norm (A.in[8])
#define P_conv_w (A.in[9])
#define P_conv_b (A.in[10])
#define P_ln_g (A.in[11])
#define P_ln_b (A.in[12])
#define P_w_out (A.in[13])
#define P_norm_ffn (A.in[14])
#define P_w_ffn_in (A.in[15])
#define P_w_ffn_out (A.in[16])
#define P_norm_final (A.in[17])
#define P_W1t ((bf16*)(A.ws + WS_W1))
#define P_W2t ((bf16*)(A.ws + WS_W2))
#define P_W3t ((bf16*)(A.ws + WS_W3))
#define P_W4t ((bf16*)(A.ws + WS_W4))
#define P_H ((bf16*)(A.ws + WS_H))
#define P_Z ((bf16*)(A.ws + WS_Z))
#define P_MIX ((bf16*)(A.ws + WS_MIX))
#define P_HID ((bf16*)(A.ws + WS_HID))
#define P_QT ((bf16*)(A.ws + WS_QT))
#define P_KH ((bf16*)(A.ws + WS_KH))
#define P_VT ((bf16*)(A.ws + WS_VT))
#define P_out (A.out)
#define P_O32 ((float*)((unsigned char*)A.out + DO_O32))
#define P_AM ((bf16*)((unsigned char*)A.out + DO_AM))
#define P_DCb ((float*)((unsigned char*)A.out + DO_DC))

struct Frame {
    LAS unsigned char* lds;
    volatile LAS unsigned* MISC;
    gu32* ctl;
    int tid, lane, wave, vcu, G;
};
__device__ __forceinline__ float wave_sum(float v) {
#pragma unroll
    for (int o = 1; o < 64; o <<= 1) v += __shfl_xor(v, o);
    return v;
}
__device__ __forceinline__ float dot4(f32x4 a, f32x4 b) { return (a.x * b.x + a.y * b.y) + (a.z * b.z + a.w * b.w); }

template <int MAP> __device__ __forceinline__ int srccol(int n) {
    if (MAP == 1) return n < 2048 ? n : (n < 5120 ? n + 16 : (n < 5136 ? n - 3072 : -1));
    if (MAP == 3) { const int t = n >> 8, r = n & 255; return r < 128 ? 128 * t + r : DFF + 128 * t + (r - 128); }
    return n;
}
template <int MAP> __device__ __forceinline__ void p0_transpose_item(const float* W, int K, int Nsrc, int Ndst, bf16* WT, LAS float* scr, int item, int lane) {
    const int nblk = Ndst / 32, kb = item / nblk, nb = item % nblk, k0 = 64 * kb, n0 = 32 * nb;
    const int sc = srccol<MAP>(n0 + (lane & 31));
    const float* src = W + (size_t)k0 * Nsrc + (sc >= 0 ? sc : 0);
#pragma unroll 8
    for (int i = 0; i < 32; ++i) { const int kk = 2 * i + (lane >> 5); const float v = src[(size_t)kk * Nsrc]; scr[kk * 33 + (lane & 31)] = sc >= 0 ? v : 0.f; }
    LDS_WAIT(); asm volatile("" ::: "memory");
    const int c = lane & 7;
#pragma unroll
    for (int j = 0; j < 4; ++j) { const int n = (lane >> 3) + 8 * j; const LAS float* s = scr + (8 * c) * 33 + n;
        v4u o; o.x = pk2(s[0 * 33], s[1 * 33]); o.y = pk2(s[2 * 33], s[3 * 33]); o.z = pk2(s[4 * 33], s[5 * 33]); o.w = pk2(s[6 * 33], s[7 * 33]);
        *(GAS v4u*)(WT + (size_t)(n0 + n) * K + k0 + 8 * c) = o; }
    LDS_WAIT(); asm volatile("" ::: "memory");
}
__device__ __forceinline__ void rms_row_to_bf16(const float* xrow, const float* gain, bf16* orow, int lane, const float* part = nullptr, int ns = 0, size_t pstride = 0, float* xout = nullptr) {
    const GAS f32x4* xr = (const GAS f32x4*)xrow + lane; const GAS f32x4* gr = (const GAS f32x4*)gain + lane;
    f32x4 v[8]; float s = 0.f;
#pragma unroll
    for (int j = 0; j < 8; ++j) v[j] = xr[64 * j];
    for (int k = 0; k < ns; ++k) { const GAS f32x4* pr = (const GAS f32x4*)(part + (size_t)k * pstride) + lane;
#pragma unroll
        for (int j = 0; j < 8; ++j) v[j] += pr[64 * j]; }
    if (xout) { GAS f32x4* xo = (GAS f32x4*)xout + lane;
#pragma unroll
        for (int j = 0; j < 8; ++j) xo[64 * j] = v[j]; }
#pragma unroll
    for (int j = 0; j < 8; ++j) s += dot4(v[j], v[j]);
    const float rstd = 1.0f / sqrtf(wave_sum(s) * (1.f / DM) + RMS_EPS);
    GAS v2u* o8 = (GAS v2u*)orow + lane;
#pragma unroll
    for (int j = 0; j < 8; ++j) { const f32x4 g = gr[64 * j]; v2u o; o.x = pk2(v[j].x * rstd * g.x, v[j].y * rstd * g.y); o.y = pk2(v[j].z * rstd * g.z, v[j].w * rstd * g.w); o8[64 * j] = o; }
}
__device__ __forceinline__ void rms_row_inplace(float* xrow, const float* gain, int lane, const float* part = nullptr, int ns = 0, size_t pstride = 0) {
    GAS f32x4* xr = (GAS f32x4*)xrow + lane; const GAS f32x4* gr = (const GAS f32x4*)gain + lane;
    f32x4 v[8]; float s = 0.f;
#pragma unroll
    for (int j = 0; j < 8; ++j) v[j] = xr[64 * j];
    for (int k = 0; k < ns; ++k) { const GAS f32x4* pr = (const GAS f32x4*)(part + (size_t)k * pstride) + lane;
#pragma unroll
        for (int j = 0; j < 8; ++j) v[j] += pr[64 * j]; }
#pragma unroll
    for (int j = 0; j < 8; ++j) s += dot4(v[j], v[j]);
    const float rstd = 1.0f / sqrtf(wave_sum(s) * (1.f / DM) + RMS_EPS);
#pragma unroll
    for (int j = 0; j < 8; ++j) { const f32x4 g = gr[64 * j]; xr[64 * j] = v[j] * rstd * g; }
}
__device__ __forceinline__ void p0_prologue(Frame& F, const Args& A) {
    LAS float* scr = (LAS float*)(F.lds + RING_OFF + F.wave * 16384);
    const int gw = F.vcu * NWAVES + F.wave, NGW = F.G * NWAVES;
    constexpr int I_1 = (DM / 64) * (N1P / 32), I_2 = (DM / 64) * (DM / 32), I_3 = (DM / 64) * (2 * DFF / 32), I_4 = (DFF / 64) * (DM / 32);
    constexpr int NITEMS = I_1 + I_2 + I_3 + I_4;
    for (int it = gw; it < NITEMS; it += NGW) {
        int r = it;
        if (r < I_1) { p0_transpose_item<1>(P_w_in, DM, N1, N1P, P_W1t, scr, r, F.lane); continue; } r -= I_1;
        if (r < I_2) { p0_transpose_item<0>(P_w_out, DM, DM, DM, P_W2t, scr, r, F.lane); continue; } r -= I_2;
        if (r < I_3) { p0_transpose_item<3>(P_w_ffn_in, DM, 2 * DFF, 2 * DFF, P_W3t, scr, r, F.lane); continue; } r -= I_3;
        p0_transpose_item<0>(P_w_ffn_out, DFF, DM, DM, P_W4t, scr, r, F.lane);
    }
    for (int m = gw; m < MPAD; m += NGW) {
        if (m < MR) rms_row_to_bf16(m < MP ? P_xp + (size_t)m * DM : P_xs + (size_t)(m - MP) * DM, P_norm_mix, P_H + (size_t)m * DM, F.lane);
        else { GAS v4u* o = (GAS v4u*)(P_H + (size_t)m * DM) + F.lane;
#pragma unroll
            for (int j = 0; j < 4; ++j) o[64 * j] = (v4u){0u, 0u, 0u, 0u}; }
    }
}

__device__ __forceinline__ void gla_prep_unit(Frame& F, const Args& A, int bh, int c) {
    const int tid = F.tid, b = bh >> 2, h = bh & 3, row0 = b * SEQ + c * CH;
    LAS float* GL = (LAS float*)(F.lds + RING_OFF);
    LAS float* BL = (LAS float*)(F.lds + RING_OFF + 4608);
    LAS bf16* QS = (LAS bf16*)(F.lds + RING_OFF + 8192);
    LAS bf16* KS = (LAS bf16*)(F.lds + RING_OFF + 25600);
    LAS bf16* VR = (LAS bf16*)(F.lds + RING_OFF + 43008);
    const size_t uc = (size_t)bh * NCH + c;
    const bf16* Zc = P_Z + (size_t)row0 * N1P;
    {
        v4u pq[2], pk[2], pv[4];
#pragma unroll
        for (int k = 0; k < 2; ++k) { const int p = tid + 512 * k, i = p >> 4, ch = p & 15;
            pq[k] = *(const GAS v4u*)(Zc + (size_t)i * N1P + ZQ + h * HK + 8 * ch); pk[k] = *(const GAS v4u*)(Zc + (size_t)i * N1P + ZK + h * HK + 8 * ch); }
#pragma unroll
        for (int k = 0; k < 4; ++k) { const int p = tid + 512 * k, i = p >> 5, ch = p & 31; pv[k] = *(const GAS v4u*)(Zc + (size_t)i * N1P + ZV + h * HV + 8 * ch); }
        v4u pg = (v4u){0u, 0u, 0u, 0u};
        if (tid < 128) pg = *(const GAS v4u*)(Zc + (size_t)(tid >> 1) * N1P + ZGL + 8 * (tid & 1));
#pragma unroll
        for (int k = 0; k < 2; ++k) { const int p = tid + 512 * k, i = p >> 4, ch = p & 15; *(LAS v4u*)(QS + i * 136 + 8 * ch) = pq[k]; *(LAS v4u*)(KS + i * 136 + 8 * ch) = pk[k]; }
#pragma unroll
        for (int k = 0; k < 4; ++k) { const int p = tid + 512 * k, i = p >> 5, ch = p & 31; *(LAS v4u*)(VR + i * 264 + 8 * ch) = pv[k]; }
        if (tid < 128) { LAS float* gp = GL + (tid >> 1) * 17 + 8 * (tid & 1);
            gp[0] = bflo(pg.x); gp[1] = bfhi(pg.x); gp[2] = bflo(pg.y); gp[3] = bfhi(pg.y); gp[4] = bflo(pg.z); gp[5] = bfhi(pg.z); gp[6] = bflo(pg.w); gp[7] = bfhi(pg.w); }
    }
    const int d = tid & 127, g = tid >> 7;
    float wg[16];
#pragma unroll
    for (int r = 0; r < 16; ++r) wg[r] = P_wgu[r * DK + h * HK + d];
    const float bg = P_bgate[h * HK + d];
    __syncthreads();
    float bcum[16]; float run = 0.f;
#pragma unroll
    for (int ii = 0; ii < 16; ++ii) { const int i = g * 16 + ii; float x = bg;
#pragma unroll
        for (int r = 0; r < 16; ++r) x += GL[i * 17 + r] * wg[r];
        run += logsigmoid_f(x) * (1.0f / 16.0f); bcum[ii] = run; }
    BL[g * 128 + d] = run;
    __syncthreads();
    float off = 0.f, tot = 0.f;
#pragma unroll
    for (int gg = 0; gg < 4; ++gg) { const float t = BL[gg * 128 + d]; off += (gg < g) ? t : 0.f; tot += t; }
    const float scale = 0.08838834764831845f;
    unsigned khw[8];
#pragma unroll
    for (int ii = 0; ii < 16; ++ii) { const int i = g * 16 + ii; const float bb = bcum[ii] + off;
        const float q = bf2f(QS[i * 136 + d]) * scale * __expf(bb);
        const float kv = bf2f(KS[i * 136 + d]);
        const unsigned qb = f2bf(q), ktb = f2bf(kv * __expf(-bb)), khb = f2bf(kv * __expf(tot - bb));
        QS[i * 136 + d] = (bf16)qb; KS[i * 136 + d] = (bf16)ktb;
        if (ii & 1) khw[ii >> 1] |= khb << 16; else khw[ii >> 1] = khb; }
    { GAS v4u* kp = (GAS v4u*)(P_KH + (uc * 128 + d) * 64 + g * 16);
      kp[0] = (v4u){khw[0], khw[1], khw[2], khw[3]}; kp[1] = (v4u){khw[4], khw[5], khw[6], khw[7]}; }
    if (g == 0) P_DCb[uc * 128 + d] = __expf(tot);
    { const int n = tid & 255, jh = tid >> 8; unsigned vw[16];
#pragma unroll
      for (int jj = 0; jj < 32; ++jj) { const unsigned v = VR[(32 * jh + jj) * 264 + n];
          if (jj & 1) vw[jj >> 1] |= v << 16; else vw[jj >> 1] = v; }
      GAS v4u* vp = (GAS v4u*)(P_VT + (uc * 256 + n) * 64 + 32 * jh);
#pragma unroll
      for (int k = 0; k < 4; ++k) vp[k] = (v4u){vw[4 * k], vw[4 * k + 1], vw[4 * k + 2], vw[4 * k + 3]}; }
    __syncthreads();
    {
#pragma unroll
        for (int k = 0; k < 2; ++k) { const int p = tid + 512 * k, i = p >> 4, s = (p >> 2) & 3, fq = p & 3;
            const v2u lo = *(const LAS v2u*)(QS + i * 136 + 32 * s + 4 * fq), hi = *(const LAS v2u*)(QS + i * 136 + 32 * s + 16 + 4 * fq);
            *(GAS v4u*)(P_QT + (uc * 64 + i) * 128 + 32 * s + 8 * fq) = (v4u){lo.x, lo.y, hi.x, hi.y}; }
    }
    { const int fr = F.lane & 15, fq = F.lane >> 4;
#pragma unroll
      for (int tt = 0; tt < 2; ++tt) { const int id = 2 * F.wave + tt, it = id >> 2, jt = id & 3;
          f32x4 acc = (f32x4){0.f, 0.f, 0.f, 0.f};
          if (jt <= it) {
#pragma unroll
              for (int s = 0; s < 4; ++s) { const bf16x8 a = *(const LAS bf16x8*)(KS + (jt * 16 + fr) * 136 + 32 * s + 8 * fq); const bf16x8 bq = *(const LAS bf16x8*)(QS + (it * 16 + fr) * 136 + 32 * s + 8 * fq);
                  acc = __builtin_amdgcn_mfma_f32_16x16x32_bf16(a, bq, acc, 0, 0, 0); } }
          const int i = it * 16 + fr, j0 = jt * 16 + 4 * fq;
#pragma unroll
          for (int r = 0; r < 4; ++r) if (j0 + r > i) acc[r] = 0.f;
          v2u o; o.x = pk2(acc[0], acc[1]); o.y = pk2(acc[2], acc[3]);
          *(GAS v2u*)(P_AM + (uc * 64 + i) * 64 + j0) = o; } }
    __syncthreads();
}
__device__ __forceinline__ void ln_silu_row(const LAS float* cs, const float* lng, const float* lnb, bf16* orow, int lane) {
    f32x4 x[4]; float s = 0.f;
#pragma unroll
    for (int j = 0; j < 4; ++j) { x[j] = *(const LAS f32x4*)(cs + 256 * j + 4 * lane); s += (x[j].x + x[j].y) + (x[j].z + x[j].w); }
    const float mean = wave_sum(s) * (1.f / DC_); float q = 0.f;
#pragma unroll
    for (int j = 0; j < 4; ++j) { x[j] = x[j] - mean; q += dot4(x[j], x[j]); }
    const float rstd = 1.0f / sqrtf(wave_sum(q) * (1.f / DC_) + LN_EPS);
#pragma unroll
    for (int j = 0; j < 4; ++j) { const f32x4 g = *(const GAS f32x4*)(lng + 256 * j + 4 * lane), bb = *(const GAS f32x4*)(lnb + 256 * j + 4 * lane);
        const f32x4 y = x[j] * rstd * g + bb; v2u o; o.x = pk2(silu_f(y.x), silu_f(y.y)); o.y = pk2(silu_f(y.z), silu_f(y.w));
        *(GAS v2u*)(orow + 256 * j + 4 * lane) = o; }
}
__device__ __forceinline__ void conv_prompt_unit(Frame& F, const Args& A, int b, int tb) {
    LAS float* CS = (LAS float*)(F.lds + RING_OFF);
    const int t0 = tb * 16, c = 2 * F.tid;
    f32x2 wt[31];
#pragma unroll
    for (int w = 0; w < 31; ++w) wt[w] = *(const GAS f32x2*)(P_conv_w + w * DC_ + c);
    const f32x2 bias = *(const GAS f32x2*)(P_conv_b + c);
    f32x2 acc[16];
#pragma unroll
    for (int tt = 0; tt < 16; ++tt) acc[tt] = bias;
#pragma unroll
    for (int r = 0; r < 46; ++r) { const int t = t0 - 30 + r, tc = t < 0 ? 0 : t; const bf16* zr = P_Z + (size_t)(b * SEQ + tc) * N1P;
        const unsigned ua = *(const GAS unsigned*)(zr + ZUA + c), ug = *(const GAS unsigned*)(zr + ZUG + c);
        const float m = t >= 0 ? 1.f : 0.f;
        f32x2 g; g.x = m * bflo(ua) * sigmoid_f(bflo(ug)); g.y = m * bfhi(ua) * sigmoid_f(bfhi(ug));
#pragma unroll
        for (int tt = 0; tt < 16; ++tt) { if (r - tt >= 0 && r - tt < 31) acc[tt] += g * wt[(r - tt >= 0 && r - tt < 31) ? r - tt : 0]; }
        if ((r & 3) == 3) { asm volatile("" ::: "memory"); __builtin_amdgcn_sched_barrier(0); }
    }
#pragma unroll
    for (int tt = 0; tt < 16; ++tt) *(LAS f32x2*)(CS + tt * 1024 + c) = acc[tt];
    __syncthreads();
#pragma unroll
    for (int k = 0; k < 2; ++k) { const int tt = 2 * F.wave + k; ln_silu_row(CS + tt * 1024, P_ln_g, P_ln_b, P_MIX + (size_t)(b * SEQ + t0 + tt) * DM + DA, F.lane); }
    __syncthreads();
}
__device__ __forceinline__ void conv_state_prompt_row(Frame& F, const Args& A, int b, int rr) {
    const bf16* zr = P_Z + (size_t)(b * SEQ + SEQ - 30 + rr) * N1P; float* orow = P_out + O_CP + ((size_t)b * 30 + rr) * DC_;
#pragma unroll
    for (int j = 0; j < 4; ++j) { const int c = 256 * j + 4 * F.lane; const v2u ua = *(const GAS v2u*)(zr + ZUA + c), ug = *(const GAS v2u*)(zr + ZUG + c);
        f32x4 g; g.x = bflo(ua.x) * sigmoid_f(bflo(ug.x)); g.y = bfhi(ua.x) * sigmoid_f(bfhi(ug.x)); g.z = bflo(ua.y) * sigmoid_f(bflo(ug.y)); g.w = bfhi(ua.y) * sigmoid_f(bfhi(ug.y));
        *(GAS f32x4*)(orow + c) = g; }
}
__device__ __forceinline__ void conv_sample_unit(Frame& F, const Args& A, int b) {
    LAS float* CS = (LAS float*)(F.lds + RING_OFF);
    const bf16* zr = P_Z + (size_t)(MP + b) * N1P;
    const int c = 2 * F.tid;
    f32x2 acc = *(const GAS f32x2*)(P_conv_b + c);
    f32x2 hv[30];
#pragma unroll
    for (int w = 0; w < 30; ++w) hv[w] = *(const GAS f32x2*)(P_sconv + ((size_t)b * 30 + w) * DC_ + c);
    const unsigned ua = *(const GAS unsigned*)(zr + ZUA + c), ug = *(const GAS unsigned*)(zr + ZUG + c);
#pragma unroll
    for (int w = 0; w < 30; ++w) { acc += hv[w] * *(const GAS f32x2*)(P_conv_w + w * DC_ + c); if (w >= 1) *(GAS f32x2*)(P_out + O_CS + ((size_t)b * 30 + (w - 1)) * DC_ + c) = hv[w]; }
    f32x2 gl; gl.x = bflo(ua) * sigmoid_f(bflo(ug)); gl.y = bfhi(ua) * sigmoid_f(bfhi(ug));
    acc += gl * *(const GAS f32x2*)(P_conv_w + 30 * DC_ + c);
    *(GAS f32x2*)(P_out + O_CS + ((size_t)b * 30 + 29) * DC_ + c) = gl;
    *(LAS f32x2*)(CS + c) = acc;
    __syncthreads();
    if (F.wave == 0) ln_silu_row(CS, P_ln_g, P_ln_b, P_MIX + (size_t)(MP + b) * DM + DA, F.lane);
    __syncthreads();
}
__device__ __forceinline__ void gla_sample_item(Frame& F, const Args& A, int item) {
    const int b = item >> 2, h = item & 3, tid = F.tid;
    LAS float* AD = (LAS float*)(F.lds + RING_OFF);
    LAS float* KD = AD + 128; LAS float* QD = AD + 256; LAS float* VD = AD + 384;
    LAS float* OP = AD + 640;
    const bf16* zr = P_Z + (size_t)(MP + b) * N1P;
    const int n4 = 4 * F.lane;
    const float* Sin = P_sgla + (size_t)(b * NH + h) * HK * HV; float* Sout = P_out + O_GS + (size_t)(b * NH + h) * HK * HV;
    f32x4 s[16];
#pragma unroll
    for (int dd = 0; dd < 16; ++dd) s[dd] = *(const GAS f32x4*)(Sin + (size_t)(16 * F.wave + dd) * HV + n4);
    if (tid < 128) { const int d = tid; float x = P_bgate[h * HK + d];
#pragma unroll
        for (int r = 0; r < 16; ++r) x += bf2f(zr[ZGL + r]) * P_wgu[r * DK + h * HK + d];
        AD[d] = __expf(logsigmoid_f(x) * (1.0f / 16.0f)); KD[d] = bf2f(zr[ZK + h * HK + d]); QD[d] = bf2f(zr[ZQ + h * HK + d]) * 0.08838834764831845f; }
    else if (tid < 384) { const int n = tid - 128; VD[n] = bf2f(zr[ZV + h * HV + n]); }
    __syncthreads();
    const f32x4 v4 = *(const LAS f32x4*)(VD + n4);
    f32x4 oacc = (f32x4){0.f, 0.f, 0.f, 0.f};
#pragma unroll
    for (int dd = 0; dd < 16; ++dd) { const int d = 16 * F.wave + dd;
        const f32x4 sn = s[dd] * AD[d] + v4 * KD[d]; *(GAS f32x4*)(Sout + (size_t)d * HV + n4) = sn; oacc += sn * QD[d]; }
    *(LAS f32x4*)(OP + F.wave * 256 + n4) = oacc;
    __syncthreads();
    if (F.wave == 0) { f32x4 o4 = (f32x4){0.f, 0.f, 0.f, 0.f};
#pragma unroll
        for (int w = 0; w < 8; ++w) o4 += *(const LAS f32x4*)(OP + w * 256 + n4);
        const float rstd = 1.0f / sqrtf(wave_sum(dot4(o4, o4)) * (1.f / HV) + RMS_EPS);
        const f32x4 gn = *(const GAS f32x4*)(P_gla_norm + n4); const v2u go = *(const GAS v2u*)(zr + ZGO + h * HV + n4);
        v2u o; o.x = pk2(o4.x * rstd * gn.x * silu_f(bflo(go.x)), o4.y * rstd * gn.y * silu_f(bfhi(go.x))); o.y = pk2(o4.z * rstd * gn.z * silu_f(bflo(go.y)), o4.w * rstd * gn.w * silu_f(bfhi(go.y)));
        *(GAS v2u*)(P_MIX + (size_t)(MP + b) * DM + h * HV + n4) = o; }
    __syncthreads();
}
__device__ __forceinline__ void gla_seq_item(Frame& F, const Args& A, int item) {
    const int bh = item >> 4, n0 = (item & 15) * 16, b = bh >> 2, h = bh & 3, fr = F.lane & 15, fq = F.lane >> 4;
    f32x4 S[8];
#pragma unroll
    for (int dt = 0; dt < 8; ++dt) S[dt] = (f32x4){0.f, 0.f, 0.f, 0.f};
#pragma unroll 1
    for (int c = 0; c < NCH; ++c) {
        const size_t uc = (size_t)bh * NCH + c;
        const bf16* AMc = P_AM + uc * 64 * 64; const bf16* VTc = P_VT + uc * 256 * 64; const bf16* QTc = P_QT + uc * 64 * 128; const bf16* KHc = P_KH + uc * 128 * 64; const float* DCc = P_DCb + uc * 128;
        bf16x8 vt[2];
#pragma unroll
        for (int ks = 0; ks < 2; ++ks) vt[ks] = *(const GAS bf16x8*)(VTc + (n0 + fr) * 64 + 32 * ks + 8 * fq);
        f32x4 o[4];
#pragma unroll
        for (int m = 0; m < 4; ++m) { o[m] = (f32x4){0.f, 0.f, 0.f, 0.f};
#pragma unroll
            for (int ks = 0; ks < 2; ++ks) { const bf16x8 a = *(const GAS bf16x8*)(AMc + (16 * m + fr) * 64 + 32 * ks + 8 * fq); o[m] = __builtin_amdgcn_mfma_f32_16x16x32_bf16(a, vt[ks], o[m], 0, 0, 0); } }
        bf16x8 sb[4];
#pragma unroll
        for (int s = 0; s < 4; ++s) { v4u w; w.x = pk2(S[2 * s][0], S[2 * s][1]); w.y = pk2(S[2 * s][2], S[2 * s][3]); w.z = pk2(S[2 * s + 1][0], S[2 * s + 1][1]); w.w = pk2(S[2 * s + 1][2], S[2 * s + 1][3]); sb[s] = __builtin_bit_cast(bf16x8, w); }
#pragma unroll
        for (int m = 0; m < 4; ++m)
#pragma unroll
            for (int s = 0; s < 4; ++s) { const bf16x8 a = *(const GAS bf16x8*)(QTc + (16 * m + fr) * 128 + 32 * s + 8 * fq); o[m] = __builtin_amdgcn_mfma_f32_16x16x32_bf16(a, sb[s], o[m], 0, 0, 0); }
#pragma unroll
        for (int m = 0; m < 4; ++m)
#pragma unroll
            for (int r = 0; r < 4; ++r) P_O32[(size_t)(b * SEQ + c * CH + 16 * m + 4 * fq + r) * DA + h * HV + n0 + fr] = o[m][r];
#pragma unroll
        for (int dt = 0; dt < 8; ++dt) { const f32x4 dc = *(const GAS f32x4*)(DCc + 16 * dt + 4 * fq); S[dt] = S[dt] * dc;
#pragma unroll
            for (int ks = 0; ks < 2; ++ks) { const bf16x8 a = *(const GAS bf16x8*)(KHc + (16 * dt + fr) * 64 + 32 * ks + 8 * fq); S[dt] = __builtin_amdgcn_mfma_f32_16x16x32_bf16(a, vt[ks], S[dt], 0, 0, 0); } }
    }
#pragma unroll
    for (int dt = 0; dt < 8; ++dt)
#pragma unroll
        for (int r = 0; r < 4; ++r) P_out[O_GP + ((size_t)bh * HK + 16 * dt + 4 * fq + r) * HV + n0 + fr] = S[dt][r];
}
__device__ __forceinline__ void gla_onorm_item(Frame& F, const Args& A, int row, int h) {
    const int n4 = 4 * F.lane;
    const f32x4 o4 = *(const GAS f32x4*)(P_O32 + (size_t)row * DA + h * HV + n4);
    const float rstd = 1.0f / sqrtf(wave_sum(dot4(o4, o4)) * (1.f / HV) + RMS_EPS);
    const f32x4 gn = *(const GAS f32x4*)(P_gla_norm + n4); const v2u go = *(const GAS v2u*)(P_Z + (size_t)row * N1P + ZGO + h * HV + n4);
    v2u o; o.x = pk2(o4.x * rstd * gn.x * silu_f(bflo(go.x)), o4.y * rstd * gn.y * silu_f(bfhi(go.x))); o.y = pk2(o4.z * rstd * gn.z * silu_f(bflo(go.y)), o4.w * rstd * gn.w * silu_f(bfhi(go.y)));
    *(GAS v2u*)(P_MIX + (size_t)row * DM + h * HV + n4) = o;
}
constexpr int NKP2 = 2, NKP4 = 4;

#ifndef MK_N_LAUNCHES
#define MK_N_LAUNCHES 1
#endif
constexpr int N_PHASES = 10;
constexpr int N_LAUNCHES = MK_N_LAUNCHES;
__global__ void __launch_bounds__(NWAVES * 64, 2) hymba_fwd(Args args) {
    extern __shared__ __attribute__((aligned(16))) unsigned char lds[];
    Frame F;
    F.lds = (LAS unsigned char*)lds;
    F.MISC = (volatile LAS unsigned*)(F.lds + MISC_OFF);
    F.tid = threadIdx.x; F.lane = F.tid & 63; F.wave = __builtin_amdgcn_readfirstlane(F.tid >> 6);
    F.G = gridDim.x; { const int bx = blockIdx.x; F.vcu = (F.G % 8 == 0) ? (bx % 8) * (F.G / 8) + bx / 8 : bx; }
    const Args& A = args;
    F.ctl = (gu32*)(args.ws + WS_CTL);
    for (int u = F.tid; u < (LDS_BYTES - LDSCTL_OFF) / 4; u += NWAVES * 64) ((LAS unsigned*)(F.lds + LDSCTL_OFF))[u] = 0u;
    __syncthreads();
    XcdBarrier bar; bar.bar = (unsigned*)(F.ctl + CW_BAR); bar.x = 0; bar.st = nullptr;
    if (N_LAUNCHES == 1) bar = xcd_barrier_post((unsigned*)(F.ctl + CW_BAR), F.MISC + 8);
    const int lo = args.ph_lo, hi = args.ph_hi;
#ifndef REP_MASK
#define REP_MASK 0
#endif
#define REPS(k) (((REP_MASK >> (k)) & 1) ? 2 : 1)
#ifndef P2A_REP
#define P2A_REP 0
#endif
#ifndef P2A_MASK
#define P2A_MASK 15
#endif
#ifndef PH_MASK
#define PH_MASK 0x3ff
#endif
#define IN(k) (((PH_MASK >> (k)) & 1) && lo <= (k) && (k) < hi)
#define SEAM(k) do { if (IN(k) && IN((k) + 1)) xcd_barrier(bar); } while (0)
    const int gw = F.vcu * NWAVES + F.wave, NGW = F.G * NWAVES;

    if (IN(0)) for (int rep_ = 0; rep_ < REPS(0); ++rep_) { p0_prologue(F, A); }
    SEAM(0);
    if (IN(1)) for (int rep_ = 0; rep_ < REPS(1); ++rep_) {
        pg8::Gemm g{P_H, P_W1t, MPAD, N1P, DM}; pg8::StaticOrder S; S.init(MPAD, N1P, F.G, (int)blockIdx.x);
        pg8::EpiStoreBf16 E{P_Z, N1P};
        pg8::gemm_phase<pg8::EpiStoreBf16, pg8::StaticOrder, true, true>(F.lds + RING_OFF, g, S, E);
    }
    SEAM(1);
    if (IN(2)) for (int rep_ = 0; rep_ < REPS(2); ++rep_) {
        constexpr int U_PREP = NB * NH * NCH, U_CONVP = NB * (SEQ / 16), U_CONVS = MS, U_GLAS = MS * NH;
        for (int q_ = 0; q_ < ((P2A_REP & 1) ? 2 : 1); ++q_) if (P2A_MASK & 1) { for (int r = F.vcu; r < U_GLAS; r += F.G) gla_sample_item(F, A, r); }
        for (int q_ = 0; q_ < ((P2A_REP & 2) ? 2 : 1); ++q_) if (P2A_MASK & 2) { for (int r = F.vcu; r < U_PREP; r += F.G) gla_prep_unit(F, A, r / NCH, r % NCH); }
        for (int q_ = 0; q_ < ((P2A_REP & 4) ? 2 : 1); ++q_) if (P2A_MASK & 4) { for (int r = F.vcu; r < U_CONVP; r += F.G) conv_prompt_unit(F, A, r / (SEQ / 16), r % (SEQ / 16)); }
        { const int gw2 = F.vcu * NWAVES + F.wave; for (int r = gw2; r < NB * 30; r += F.G * NWAVES) conv_state_prompt_row(F, A, r / 30, r % 30); }
        for (int q_ = 0; q_ < ((P2A_REP & 8) ? 2 : 1); ++q_) if (P2A_MASK & 8) { for (int r = F.G - 1 - F.vcu; r < U_CONVS; r += F.G) conv_sample_unit(F, A, r); }
    }
    SEAM(2);
    if (IN(3)) for (int rep_ = 0; rep_ < REPS(3); ++rep_) {
        if (F.wave == 0) { for (int it = F.vcu; it < NB * NH * 16; it += F.G) gla_seq_item(F, A, it); }
    }
    SEAM(3);
    if (IN(4)) for (int rep_ = 0; rep_ < REPS(4); ++rep_) { for (int it = gw; it < MP * NH; it += NGW) gla_onorm_item(F, A, it >> 2, it & 3); }
    SEAM(4);
    if (IN(5)) for (int rep_ = 0; rep_ < REPS(5); ++rep_) {
        pg8::Gemm g{P_MIX, P_W2t, MPAD, DM, DM}; pg8::TailSplitOrder S; S.init_ts(MP, DM, DM, F.G, (int)blockIdx.x, NKP2);
        pg8::EpiResF32 E{P_xp, P_xs, P_out, DM, MP, MP, (float*)(A.ws + WS_SK2)};
        pg8::gemm_phase<pg8::EpiResF32, pg8::TailSplitOrder, true, true>(F.lds + RING_OFF, g, S, E);
    }
    SEAM(5);
    if (IN(6)) for (int rep_ = 0; rep_ < REPS(6); ++rep_) { for (int m = gw; m < MR; m += NGW) {
        if (m < MP) rms_row_to_bf16(P_out + (size_t)m * DM, P_norm_ffn, P_H + (size_t)m * DM, F.lane);
        else rms_row_to_bf16(P_xs + (size_t)(m - MP) * DM, P_norm_ffn, P_H + (size_t)m * DM, F.lane, (const float*)(A.ws + WS_SK2) + (size_t)(m - MP) * DM, (DM / 64) / NKP2, (size_t)128 * DM, P_out + (size_t)m * DM); } }
    SEAM(6);
    if (IN(7)) for (int rep_ = 0; rep_ < REPS(7); ++rep_) {
        pg8::Gemm g{P_H, P_W3t, MPAD, 2 * DFF, DM}; pg8::StaticOrder S; S.init(MPAD, 2 * DFF, F.G, (int)blockIdx.x);
        pg8::EpiSwiglu E{P_HID, DFF};
        pg8::gemm_phase<pg8::EpiSwiglu, pg8::StaticOrder, true, true>(F.lds + RING_OFF, g, S, E);
    }
    SEAM(7);
    if (IN(8)) for (int rep_ = 0; rep_ < REPS(8); ++rep_) {
        pg8::Gemm g{P_HID, P_W4t, MPAD, DM, DFF}; pg8::TailSplitOrder S; S.init_ts(MP, DM, DFF, F.G, (int)blockIdx.x, NKP4);
        pg8::EpiResF32 E{P_out, P_out, P_out, DM, MP, MP, (float*)(A.ws + WS_SK4)};
        pg8::gemm_phase<pg8::EpiResF32, pg8::TailSplitOrder, true, true>(F.lds + RING_OFF, g, S, E);
    }
    SEAM(8);
    if (IN(9)) for (int rep_ = 0; rep_ < REPS(9); ++rep_) { for (int m = gw; m < MR; m += NGW) {
        if (m < MP) rms_row_inplace(P_out + (size_t)m * DM, P_norm_final, F.lane);
        else rms_row_inplace(P_out + (size_t)m * DM, P_norm_final, F.lane, (const float*)(A.ws + WS_SK4) + (size_t)(m - MP) * DM, (DFF / 64) / NKP4, (size_t)128 * DM); } }
#undef IN
#undef SEAM
}

extern "C" void kernel_launch(void* const* d_in, const int* in_sizes, int n_in, void* d_out, int out_size, void* d_ws, size_t ws_size, hipStream_t stream) {
    static int grid = 0;
    if (grid == 0) {
        if (n_in != 18 || in_sizes[0] != MP * DM || (size_t)out_size != O_END || ws_size < WS_END) {
            fprintf(stderr, "kernel_launch: shape mismatch: n_in %d in0 %d out %d ws %zu (need %zu); nothing launched\n", n_in, n_in > 0 ? in_sizes[0] : -1, out_size, ws_size, (size_t)WS_END); grid = -1; return; }
        int dev = 0, cus = 0, per_cu = 0;
        if (hipGetDevice(&dev) != hipSuccess || hipDeviceGetAttribute(&cus, hipDeviceAttributeMultiprocessorCount, dev) != hipSuccess) { grid = -1; return; }
        if (hipFuncSetAttribute((const void*)hymba_fwd, hipFuncAttributeMaxDynamicSharedMemorySize, LDS_BYTES) != hipSuccess) { fprintf(stderr, "kernel_launch: hipFuncSetAttribute failed\n"); grid = -1; return; }
        if (hipOccupancyMaxActiveBlocksPerMultiprocessor(&per_cu, (const void*)hymba_fwd, NWAVES * 64, LDS_BYTES) != hipSuccess || per_cu < 1)
            fprintf(stderr, "kernel_launch: note: occupancy query reports %d workgroups per CU\n", per_cu);
        (void)hipGetLastError();
        grid = cus;
    }
    if (grid < 0) return;
    if (N_LAUNCHES == 1) { if (hipMemsetAsync((char*)d_ws + WS_CTL, 0, CTL_ZERO_BYTES, stream) != hipSuccess) return; }
    Args a{};
    for (int i = 0; i < 18; ++i) a.in[i] = (const float*)d_in[i];
    a.out = (float*)d_out; a.ws = (unsigned char*)d_ws;
    for (int li = 0; li < N_LAUNCHES; ++li) {
        a.ph_lo = (N_LAUNCHES == 1) ? 0 : li; a.ph_hi = (N_LAUNCHES == 1) ? N_PHASES : li + 1;
        hipLaunchKernelGGL(hymba_fwd, dim3(grid), dim3(NWAVES * 64), LDS_BYTES, stream, a);
        const hipError_t le = hipPeekAtLastError();
        if (le != hipSuccess) { fprintf(stderr, "kernel_launch: launch %d failed: %s\n", li, hipGetErrorName(le)); break; }
    }
}
```

```cpp
#include <hip/hip_runtime.h>
#include <cstdio>
#include <cstdint>
constexpr int PG8_DUMMY = 0;
namespace pg8 {
#define PG8_LAS __attribute__((address_space(3)))
typedef unsigned short bf16_t;
typedef short bf16x8 __attribute__((ext_vector_type(8)));
typedef float f32x4 __attribute__((ext_vector_type(4)));
typedef unsigned u32x4 __attribute__((ext_vector_type(4)));
constexpr int BM = 256, BK = 64, HALF = 128, HTB = HALF * BK * 2  , STAGE_BYTES = 8 * HTB, NXCD = 8, WGM = 8;

__host__ __device__ __forceinline__ int lds_byte(int r, int c) { const int st = (r >> 4) * 2 + (c >> 5), rr = r & 15, cc = c & 31, ob = rr * 64 + cc * 2; return st * 1024 + (ob ^ (((ob >> 9) & 1) << 5)); }
__host__ __device__ __forceinline__ void stage_rc(int b, int& R, int& C) { const int st = b / 1024, sb = b % 1024, swz = sb ^ (((sb >> 9) & 1) << 5); R = (st >> 1) * 16 + swz / 64; C = (st & 1) * 32 + (swz % 64) / 2; }
__host__ __device__ __forceinline__ int perm32(int rho) { const int n = rho >> 4, i = rho & 15; return 8 * (i >> 2) + 4 * n + (i & 3); }

struct Unit { int pm, pn, k0, nk, mode, slot; };
struct Gemm { const bf16_t* A; const bf16_t* Bt; int M, N, K; };

struct StaticOrder {
    static constexpr bool SK = false;
    int nM, nN, nwg, G, c;
    __host__ __device__ __forceinline__ void init(int M, int N, int G_, int c_) { nM = M / BM; nN = N / BM; nwg = nM * nN; G = G_; c = c_; }
    __host__ __device__ __forceinline__ bool next(int i, Unit& u) const {
        const long L = (long)i * G + c; const bool ok = L < nwg;
        int wgid = ok ? (int)L : 0; { const int q = nwg / NXCD, r = nwg % NXCD, xcd = wgid % NXCD, off = wgid / NXCD; wgid = (xcd < r ? xcd * (q + 1) : r * (q + 1) + (xcd - r) * q) + off; }
        const int nig = WGM * nN, gid = wgid / nig, fm = gid * WGM, gsz = (nM - fm) < WGM ? (nM - fm) : WGM;
        u.pm = fm + ((wgid % nig) % gsz); u.pn = (wgid % nig) / gsz; return ok;
    }
    __device__ __forceinline__ void a_ready(const Unit&) const {}
    __device__ __forceinline__ void done(const Unit&) const {}
};
__device__ __forceinline__ unsigned cvt_pk_bf16(float lo, float hi) { unsigned r; asm volatile("v_cvt_pk_bf16_f32 %0, %1, %2" : "=v"(r) : "v"(lo), "v"(hi)); return r; }
typedef float f32x2 __attribute__((ext_vector_type(2)));
typedef unsigned u32x2v __attribute__((ext_vector_type(2)));
__device__ __forceinline__ float silu_f(float x) { return x * __builtin_amdgcn_rcpf(1.0f + __expf(-x)); }
struct EpiStoreBf16 {
    static constexpr bool PERM = true, AFTER_DRAIN = false;
    bf16_t* O; int ldc;
    __device__ __forceinline__ void operator()(const f32x4 (&acc)[2][2][4][2], const Unit& u, int wr, int wc, int fr, int fq) const {
        const int row0 = u.pm * BM + wr * 64 + fr, col0 = u.pn * BM + wc * 32 + 8 * fq;
#pragma unroll
        for (int ai = 0; ai < 2; ++ai)
#pragma unroll
            for (int m = 0; m < 4; ++m) { bf16_t* rowp = O + (size_t)(row0 + ai * HALF + m * 16) * ldc + col0;
#pragma unroll
                for (int bj = 0; bj < 2; ++bj) { const f32x4 v0 = acc[ai][bj][m][0], v1 = acc[ai][bj][m][1];
                    u32x4 w; w.x = cvt_pk_bf16(v0[0], v0[1]); w.y = cvt_pk_bf16(v0[2], v0[3]); w.z = cvt_pk_bf16(v1[0], v1[1]); w.w = cvt_pk_bf16(v1[2], v1[3]);
                    *(u32x4*)(rowp + bj * HALF) = w; } }
    }
};
struct EpiSwiglu {
    static constexpr bool PERM = true, AFTER_DRAIN = false;
    bf16_t* O; int ldc;
    __device__ __forceinline__ void operator()(const f32x4 (&acc)[2][2][4][2], const Unit& u, int wr, int wc, int fr, int fq) const {
        const int row0 = u.pm * BM + wr * 64 + fr, col0 = u.pn * HALF + wc * 32 + 8 * fq;
#pragma unroll
        for (int ai = 0; ai < 2; ++ai)
#pragma unroll
            for (int m = 0; m < 4; ++m) { bf16_t* rowp = O + (size_t)(row0 + ai * HALF + m * 16) * ldc + col0;
                float h[8];
#pragma unroll
                for (int n = 0; n < 2; ++n)
#pragma unroll
                    for (int e = 0; e < 4; ++e) h[4 * n + e] = silu_f(acc[ai][0][m][n][e]) * acc[ai][1][m][n][e];
                u32x4 w; w.x = cvt_pk_bf16(h[0], h[1]); w.y = cvt_pk_bf16(h[2], h[3]); w.z = cvt_pk_bf16(h[4], h[5]); w.w = cvt_pk_bf16(h[6], h[7]);
                *(u32x4*)rowp = w; }
    }
};
struct EpiResF32 {
    static constexpr bool PERM = false, AFTER_DRAIN = false;
    const float* base0; const float* base1; float* out; int ldc, msplit, mreal; float* part;
    __device__ __forceinline__ void operator()(const f32x4 (&acc)[2][2][4][2], const Unit& u, int wr, int wc, int fr, int fq) const {
        const int row0 = u.pm * BM + wr * 64 + fr, col0 = u.pn * BM + wc * 32 + 4 * fq;
#pragma unroll
        for (int ai = 0; ai < 2; ++ai)
#pragma unroll
            for (int m = 0; m < 4; ++m) { const int row = row0 + ai * HALF + m * 16;
                if (row < mreal) {
                    const float* bp = (row < msplit ? base0 + (size_t)row * ldc : base1 + (size_t)(row - msplit) * ldc) + col0; float* op = out + (size_t)row * ldc + col0;
                    f32x4 b[2][2];
#pragma unroll
                    for (int bj = 0; bj < 2; ++bj)
#pragma unroll
                        for (int n = 0; n < 2; ++n) b[bj][n] = *(const f32x4*)(bp + bj * HALF + n * 16);
#pragma unroll
                    for (int bj = 0; bj < 2; ++bj)
#pragma unroll
                        for (int n = 0; n < 2; ++n) *(f32x4*)(op + bj * HALF + n * 16) = b[bj][n] + acc[ai][bj][m][n];
                } }
    }
    __device__ __forceinline__ void partial(const f32x4 (&acc)[2][2][4][2], const Unit& u, int wr, int wc, int fr, int fq) const {
        float* pp = part + ((size_t)u.slot * HALF + wr * 64 + fr) * ldc + u.pn * BM + wc * 32 + 4 * fq;
#pragma unroll
        for (int m = 0; m < 4; ++m)
#pragma unroll
            for (int bj = 0; bj < 2; ++bj)
#pragma unroll
                for (int n = 0; n < 2; ++n) *(f32x4*)(pp + (size_t)(m * 16) * ldc + bj * HALF + n * 16) = acc[0][bj][m][n];
    }
};
struct TailSplitOrder : StaticOrder {
    static constexpr bool SK = true;
    int nkp, npieces, ntfull;
    __device__ __forceinline__ void init_ts(int Mfull, int N, int K, int G_, int c_, int nkp_) { init(Mfull, N, G_, c_); ntfull = K / BK; nkp = nkp_; npieces = nN * (ntfull / nkp_); }
    __device__ __forceinline__ bool next(int i, Unit& u) const {
        Unit t; t.pm = 0; t.pn = 0;
        const bool full = StaticOrder::next(i, t);
        const long p = (long)i * G + c - nwg; const bool piece = !full && p >= 0 && p < npieces;
        const int pp = piece ? (int)p : 0, ks = pp / nN;
        u.pm = full ? t.pm : nM; u.pn = full ? t.pn : pp - ks * nN; u.slot = full ? 0 : ks; u.k0 = full ? 0 : ks * nkp; u.nk = full ? ntfull : nkp; u.mode = full ? 0 : 3;
        return full || piece;
    }
};
#ifndef SKT_PUB
#define SKT_PUB 1
#endif
#ifndef SKT_COMB
#define SKT_COMB 1
#endif
template <class Epi, class Sched, bool ALIGN_EPI = false, bool SP2 = false>
__device__ __forceinline__ void gemm_phase(PG8_LAS unsigned char* lds, const Gemm g, const Sched& S, const Epi& E) {
    const int tid = threadIdx.x, wid = __builtin_amdgcn_readfirstlane(tid >> 6), lane = tid & 63, wr = wid >> 2, wc = wid & 3, fr = lane & 15, fq = lane >> 4;
    const int K = g.K, nt = K / BK;
    unsigned voffA[2], voffB[2];
#pragma unroll
    for (int i = 0; i < 2; ++i) { int R, C; stage_rc(tid * 16 + i * 8192, R, C); const int Rb = Epi::PERM ? ((R & ~31) + perm32(R & 31)) : R;
        voffA[i] = (unsigned)(R * K + C) * 2u; voffB[i] = (unsigned)(Rb * K + C) * 2u; }
    const size_t kstep = (size_t)(BK * 2);
    const size_t hstep = (size_t)HALF * K * 2;
    const size_t tstep = 2 * hstep;
    const unsigned ldsw = (unsigned)wid * 1024u;
    const int aoff = lds_byte(wr * 64 + fr, fq * 8), boff = lds_byte(wc * 32 + fr, fq * 8);
#define PG8_SA(b, h) (((b) * 2 + (h)) * HTB)
#define PG8_SB(b, h) ((4 + (b) * 2 + (h)) * HTB)
#define PG8_STAGE(bufoff, gbase, voff) do { _Pragma("unroll") for (int _i = 0; _i < 2; ++_i) \
        __builtin_amdgcn_global_load_lds((const unsigned*)((const char*)(gbase) + (voff)[_i]), (PG8_LAS unsigned*)(lds + (bufoff) + ldsw + _i * 8192), 16, 0, 0); } while (0)
#define PG8_LDA(dst, b, h) do { _Pragma("unroll") for (int m = 0; m < 4; ++m) _Pragma("unroll") for (int k = 0; k < 2; ++k) dst[m][k] = *(const PG8_LAS bf16x8*)(lds + PG8_SA(b, h) + aoff + m * 2048 + k * 1024); } while (0)
#define PG8_LDB(dst, b, h) do { _Pragma("unroll") for (int n = 0; n < 2; ++n) _Pragma("unroll") for (int k = 0; k < 2; ++k) dst[n][k] = *(const PG8_LAS bf16x8*)(lds + PG8_SB(b, h) + boff + n * 2048 + k * 1024); } while (0)
#define PG8_MMA(ai, bj, At, Bt) do { __builtin_amdgcn_s_setprio(1); _Pragma("unroll") for (int m = 0; m < 4; ++m) _Pragma("unroll") for (int n = 0; n < 2; ++n) _Pragma("unroll") for (int k = 0; k < 2; ++k) \
        acc[ai][bj][m][n] = __builtin_amdgcn_mfma_f32_16x16x32_bf16(Bt[n][k], At[m][k], acc[ai][bj][m][n], 0, 0, 0); __builtin_amdgcn_s_setprio(0); } while (0)
#define PG8_WAIT_V(n) asm volatile("s_waitcnt vmcnt(" #n ")" ::: "memory")
#define PG8_WAIT_L(n) asm volatile("s_waitcnt lgkmcnt(" #n ")" ::: "memory")
#define PG8_BAR __builtin_amdgcn_s_barrier()
#define PG8_SCHED __builtin_amdgcn_sched_barrier(0)
    Unit cur, nxt; int ui = 0;
    if (!S.next(0, cur)) return;
    if constexpr (!Sched::SK) { cur.k0 = 0; cur.nk = nt; cur.mode = 0; cur.slot = 0; }
    f32x4 acc[2][2][4][2];
#pragma unroll
    for (int a = 0; a < 2; ++a)
#pragma unroll
        for (int b = 0; b < 2; ++b)
#pragma unroll
            for (int m = 0; m < 4; ++m)
#pragma unroll
                for (int n = 0; n < 2; ++n) acc[a][b][m][n] = (f32x4){0.f, 0.f, 0.f, 0.f};
    bf16x8 At[4][2], B0[2][2], B1[2][2];
    const char* cA = (const char*)g.A + (size_t)cur.pm * tstep + (size_t)cur.k0 * kstep; const char* cB = (const char*)g.Bt + (size_t)cur.pn * tstep + (size_t)cur.k0 * kstep;
    S.a_ready(cur);
    if constexpr (SP2) {
        PG8_STAGE(PG8_SB(0, 0), cB, voffB); PG8_STAGE(PG8_SB(0, 1), cB + hstep, voffB); PG8_STAGE(PG8_SA(0, 0), cA, voffA); PG8_STAGE(PG8_SA(0, 1), cA + hstep, voffA);
        if (wr == 1) PG8_BAR;
        PG8_WAIT_V(2); PG8_BAR;
        PG8_STAGE(PG8_SB(1, 0), cB + kstep, voffB); PG8_STAGE(PG8_SA(1, 0), cA + kstep, voffA); PG8_STAGE(PG8_SB(1, 1), cB + hstep + kstep, voffB);
        PG8_WAIT_V(6); PG8_BAR;
    } else {
        PG8_STAGE(PG8_SB(0, 0), cB, voffB); PG8_STAGE(PG8_SA(0, 0), cA, voffA); PG8_STAGE(PG8_SB(0, 1), cB + hstep, voffB); PG8_STAGE(PG8_SA(0, 1), cA + hstep, voffA);
        if (wr == 1) PG8_BAR;
        PG8_WAIT_V(4); PG8_BAR;
        PG8_STAGE(PG8_SB(1, 0), cB + kstep, voffB); PG8_STAGE(PG8_SA(1, 0), cA + kstep, voffA); PG8_STAGE(PG8_SB(1, 1), cB + hstep + kstep, voffB);
        PG8_WAIT_V(6); PG8_BAR;
    }
    for (;;) {
        const bool has_next = S.next(ui + 1, nxt);
        if constexpr (!Sched::SK) { nxt.k0 = 0; nxt.nk = nt; nxt.mode = 0; nxt.slot = 0; }
        const int ntc = cur.nk;
        const char* nA = has_next ? (const char*)g.A + (size_t)nxt.pm * tstep + (size_t)nxt.k0 * kstep : cA; const char* nB = has_next ? (const char*)g.Bt + (size_t)nxt.pn * tstep + (size_t)nxt.k0 * kstep : cB;
        for (int t = 0; t < ntc; t += 2) {
            const bool last = (t == ntc - 2);
            const char* a1 = cA + (size_t)(t + 1) * kstep;
            const char* a2 = last ? nA : cA + (size_t)(t + 2) * kstep; const char* b2 = last ? nB : cB + (size_t)(t + 2) * kstep;
            const char* a3 = a2 + kstep; const char* b3 = b2 + kstep;
            if (last && has_next) S.a_ready(nxt);
            if constexpr (SP2) {
            PG8_LDB(B0, 0, 0); PG8_LDB(B1, 0, 1); PG8_SCHED; PG8_LDA(At, 0, 0); PG8_STAGE(PG8_SA(1, 1), a1 + hstep, voffA);
            PG8_WAIT_V(8); PG8_WAIT_L(0); PG8_BAR; PG8_MMA(0, 0, At, B0); PG8_MMA(0, 1, At, B1); PG8_BAR; PG8_SCHED;
            PG8_LDA(At, 0, 1); PG8_STAGE(PG8_SB(0, 0), b2, voffB); PG8_STAGE(PG8_SB(0, 1), b2 + hstep, voffB); PG8_STAGE(PG8_SA(0, 0), a2, voffA);
            PG8_WAIT_V(8); PG8_WAIT_L(0); PG8_BAR; PG8_MMA(1, 0, At, B0); PG8_MMA(1, 1, At, B1); PG8_BAR; PG8_SCHED;
            PG8_LDB(B0, 1, 0); PG8_LDB(B1, 1, 1); PG8_SCHED; PG8_LDA(At, 1, 0); PG8_STAGE(PG8_SA(0, 1), a2 + hstep, voffA);
            PG8_WAIT_V(8); PG8_WAIT_L(0); PG8_BAR; PG8_MMA(0, 0, At, B0); PG8_MMA(0, 1, At, B1); PG8_BAR; PG8_SCHED;
            PG8_LDA(At, 1, 1); PG8_STAGE(PG8_SB(1, 0), b3, voffB); PG8_STAGE(PG8_SB(1, 1), b3 + hstep, voffB); PG8_STAGE(PG8_SA(1, 0), a3, voffA);
            PG8_WAIT_V(8); PG8_WAIT_L(0); PG8_BAR; PG8_MMA(1, 0, At, B0); PG8_MMA(1, 1, At, B1); PG8_BAR; PG8_SCHED;
            } else {
            PG8_LDB(B0, 0, 0); PG8_SCHED; PG8_LDA(At, 0, 0); PG8_STAGE(PG8_SA(1, 1), a1 + hstep, voffA);
            PG8_WAIT_L(8); PG8_BAR; PG8_WAIT_L(0); PG8_MMA(0, 0, At, B0); PG8_BAR; PG8_SCHED;
            PG8_LDB(B1, 0, 1); PG8_STAGE(PG8_SB(0, 0), b2, voffB);
            PG8_BAR; PG8_WAIT_L(0); PG8_MMA(0, 1, At, B1); PG8_BAR;
            PG8_LDA(At, 0, 1); PG8_STAGE(PG8_SA(0, 0), a2, voffA);
            PG8_BAR; PG8_WAIT_L(0); PG8_MMA(1, 0, At, B0); PG8_BAR; PG8_SCHED;
            PG8_STAGE(PG8_SB(0, 1), b2 + hstep, voffB);
            PG8_WAIT_V(6); PG8_BAR; PG8_MMA(1, 1, At, B1); PG8_BAR;
            PG8_LDB(B0, 1, 0); PG8_SCHED; PG8_LDA(At, 1, 0); PG8_STAGE(PG8_SA(0, 1), a2 + hstep, voffA);
            PG8_WAIT_L(8); PG8_BAR; PG8_WAIT_L(0); PG8_MMA(0, 0, At, B0); PG8_BAR; PG8_SCHED;
            PG8_LDB(B1, 1, 1); PG8_STAGE(PG8_SB(1, 0), b3, voffB);
            PG8_BAR; PG8_WAIT_L(0); PG8_MMA(0, 1, At, B1); PG8_BAR;
            PG8_LDA(At, 1, 1); PG8_STAGE(PG8_SA(1, 0), a3, voffA);
            PG8_BAR; PG8_WAIT_L(0); PG8_MMA(1, 0, At, B0); PG8_BAR; PG8_SCHED;
            PG8_STAGE(PG8_SB(1, 1), b3 + hstep, voffB);
            PG8_WAIT_V(6); PG8_BAR; PG8_MMA(1, 1, At, B1); PG8_BAR;
            }
        }
        if constexpr (ALIGN_EPI) { if (wr == 0) PG8_BAR; }
        if constexpr (!Epi::AFTER_DRAIN) {
            if constexpr (Sched::SK) { if (cur.mode == 3) E.partial(acc, cur, wr, wc, fr, fq); else E(acc, cur, wr, wc, fr, fq); }
            else E(acc, cur, wr, wc, fr, fq);
            S.done(cur); }
        if (!has_next) break;
#pragma unroll
        for (int a = 0; a < 2; ++a)
#pragma unroll
            for (int b = 0; b < 2; ++b)
#pragma unroll
                for (int m = 0; m < 4; ++m)
#pragma unroll
                    for (int n = 0; n < 2; ++n) acc[a][b][m][n] = (f32x4){0.f, 0.f, 0.f, 0.f};
        cur = nxt; cA = nA; cB = nB; ++ui;
        if constexpr (ALIGN_EPI) { if (wr == 1) PG8_BAR; }
    }
    PG8_WAIT_V(0);
    if constexpr (!ALIGN_EPI) { if (wr == 0) PG8_BAR; }
    PG8_BAR;
    if constexpr (Epi::AFTER_DRAIN) { E.fused(acc, cur, wr, wc, fr, fq, lds, wid, lane); S.done(cur); }
#undef PG8_SA
#undef PG8_SB
#undef PG8_STAGE
#undef PG8_LDA
#undef PG8_LDB
#undef PG8_MMA
#undef PG8_WAIT_V
#undef PG8_WAIT_L
#undef PG8_BAR
#undef PG8_SCHED
}
}

constexpr int NWAVES = 8;
constexpr int DM = 2048, MP = 8192, MS = 128, MR = MP + MS  , MPAD = 8448  , SEQ = 2048, NB = 4;
constexpr int NH = 4, HK = 128, HV = 256, DK = 512, DA = 1024, DC_ = 1024, GR = 16, CW = 31, DFF = 5632;
constexpr int N1 = 5136, N1P = 5376;
constexpr int ZQ = 0, ZK = 512, ZV = 1024, ZGO = 2048, ZUA = 3072, ZUG = 4096, ZGL = 5120;
constexpr int CH = 64, NCH = SEQ / CH;
constexpr float RMS_EPS = 1e-6f, LN_EPS = 1e-5f;
constexpr size_t O_YP = 0, O_YS = (size_t)MP * DM, O_GP = O_YS + (size_t)MS * DM, O_CP = O_GP + (size_t)NB * NH * HK * HV, O_GS = O_CP + (size_t)NB * 30 * DC_,
                 O_CS = O_GS + (size_t)MS * NH * HK * HV, O_END = O_CS + (size_t)MS * 30 * DC_;
constexpr size_t MiB = 1u << 20;
constexpr size_t WS_CTL = 0, CTL_ZERO_BYTES = 1 * MiB;
constexpr size_t WS_W1 = 2 * MiB;
constexpr size_t WS_W2 = 23 * MiB;
constexpr size_t WS_W3 = 31 * MiB;
constexpr size_t WS_W4 = 75 * MiB;
constexpr size_t WS_H = 97 * MiB;
constexpr size_t WS_QT = WS_H, WS_KH = WS_H + 8 * MiB, WS_VT = WS_H + 16 * MiB;
constexpr size_t WS_Z = 130 * MiB;
constexpr size_t WS_MIX = 217 * MiB;
constexpr size_t WS_HID = 130 * MiB;
constexpr size_t WS_END = 250 * MiB;
static_assert(WS_Z + (size_t)MPAD * N1P * 2 <= WS_MIX && WS_HID + (size_t)MPAD * DFF * 2 <= WS_END && WS_W1 + (size_t)N1P * DM * 2 <= WS_W2 && WS_W3 + (size_t)2 * DFF * DM * 2 <= WS_W4 && WS_W4 + (size_t)DM * DFF * 2 <= WS_H, "d_ws map");
constexpr size_t DO_O32 = 0, DO_AM = 32 * MiB, DO_DC = 36 * MiB;
constexpr int CW_TMO = 0, CW_BAR = 4096, CW_SK2 = 16384, CW_SK4 = 16384 + 264 * 64;
constexpr size_t WS_SK2 = WS_Z, WS_SK4 = WS_W1;
static_assert((size_t)32 * 128 * DM * 4 <= WS_MIX - WS_Z && WS_SK4 + (size_t)44 * 128 * DM * 4 <= WS_W4, "K-split slabs");
constexpr int RING_OFF = 0, RING_BYTES = 131072;
constexpr int LDSCTL_OFF = RING_BYTES, MISC_OFF = LDSCTL_OFF + 320;
constexpr int LDS_BYTES = 147456;

#define GAS __attribute__((address_space(1)))
#define LAS __attribute__((address_space(3)))
typedef unsigned short bf16;
typedef unsigned v4u __attribute__((ext_vector_type(4)));
typedef unsigned v2u __attribute__((ext_vector_type(2)));
typedef float f32x4 __attribute__((ext_vector_type(4)));
typedef float f32x2 __attribute__((ext_vector_type(2)));
typedef short bf16x8 __attribute__((ext_vector_type(8)));
typedef GAS unsigned gu32;
typedef GAS unsigned long long gu64;
#define RLX_AGENT __ATOMIC_RELAXED, __HIP_MEMORY_SCOPE_AGENT
#define LDS_WAIT() asm volatile("s_waitcnt lgkmcnt(0)" ::: "memory")
#define VM_WAIT() asm volatile("s_waitcnt vmcnt(0)" ::: "memory")
__device__ __forceinline__ unsigned f2bf(float f) { unsigned u = __builtin_bit_cast(unsigned, f); return (u + 0x7fffu + ((u >> 16) & 1u)) >> 16; }
__device__ __forceinline__ unsigned pk2(float lo, float hi) { return f2bf(lo) | (f2bf(hi) << 16); }
__device__ __forceinline__ float bf2f(unsigned short b) { return __builtin_bit_cast(float, (unsigned)b << 16); }
__device__ __forceinline__ float bflo(unsigned w) { return __builtin_bit_cast(float, w << 16); }
__device__ __forceinline__ float bfhi(unsigned w) { return __builtin_bit_cast(float, w & 0xffff0000u); }
__device__ __forceinline__ float sigmoid_f(float x) { return __builtin_amdgcn_rcpf(1.0f + __expf(-x)); }
__device__ __forceinline__ float silu_f(float x) { return x * sigmoid_f(x); }
__device__ __forceinline__ float logsigmoid_f(float x) { return fminf(x, 0.f) - log1pf(__expf(-fabsf(x))); }
#define XB_TMO      128
#define XB_XCNT(j)  (256  + 64 * (j))
#define XB_XSUB(j)  (1280 + 64 * (j))
#define XB_XGEN(j)  (2304 + 64 * (j))
#define XB_TOP      3328
#define XB_TOPGEN   3392
#define XCD_BAR_WORDS 3456
#define XB_SPIN_CAP (1u << 18)

__device__ __forceinline__ unsigned xb_ld(unsigned* p)              { return __hip_atomic_load(p, __ATOMIC_RELAXED, __HIP_MEMORY_SCOPE_AGENT); }
__device__ __forceinline__ unsigned xb_add(unsigned* p, unsigned v) { return __hip_atomic_fetch_add(p, v, __ATOMIC_RELAXED, __HIP_MEMORY_SCOPE_AGENT); }
__device__ __forceinline__ unsigned xb_xcc_id() { return (unsigned)__builtin_amdgcn_s_getreg((3 << 11) | 20) & 0xFu; }
#define XB_SPIN(cond, bar) do { unsigned _sp = 0; while (cond) { __builtin_amdgcn_s_sleep(1); \
    if ((++_sp & 255u) == 0u) { if (xb_ld(&(bar)[XB_TMO])) break; if (_sp > XB_SPIN_CAP) { atomicAdd(&(bar)[XB_TMO], 1u); break; } } } } while (0)

struct XcdBarrier {
    unsigned* bar; unsigned x;
    volatile LAS unsigned* st;
};

__device__ __forceinline__ XcdBarrier xcd_barrier_post(unsigned* bar, volatile LAS unsigned* st) {
    XcdBarrier b; b.bar = bar; b.x = xb_xcc_id(); b.st = st;
    if (threadIdx.x == 0) (void)xb_add(&bar[XB_XCNT(b.x)], 1u);
    return b;
}
__device__ __forceinline__ void xcd_barrier_complete(unsigned* bar, unsigned x, unsigned& nloc, unsigned& nx) {
    const unsigned G = gridDim.x * gridDim.y * gridDim.z;
    unsigned sum, cnt, mine, sp = 0u;
    for (;;) {
        sum = 0u; cnt = 0u; mine = 0u;
#pragma unroll
        for (unsigned j = 0; j < 16; ++j) { const unsigned c = xb_ld(&bar[XB_XCNT(j)]); sum += c; cnt += (c > 0u) ? 1u : 0u; mine = (j == x) ? c : mine; }
        if (sum == G) break;
        __builtin_amdgcn_s_sleep(1);
        if ((++sp & 255u) == 0u) { if (xb_ld(&bar[XB_TMO])) break; if (sp > XB_SPIN_CAP) { atomicAdd(&bar[XB_TMO], 1u); break; } }
    }
    nloc = mine > 0u ? mine : 1u; nx = cnt > 0u ? cnt : 1u;
}

__device__ __forceinline__ void xcd_barrier(const XcdBarrier& b) {
    asm volatile("s_waitcnt vmcnt(0)" ::: "memory");
    __syncthreads();
    if (threadIdx.x == 0) {
        unsigned* bar = b.bar;
        __builtin_amdgcn_s_waitcnt(0);
        unsigned nloc = b.st[0], nx = b.st[1];
        if (nloc == 0u) { xcd_barrier_complete(bar, b.x, nloc, nx); b.st[0] = nloc; b.st[1] = nx; }
        const unsigned old = xb_add(&bar[XB_XSUB(b.x)], 1u);
        const unsigned gen = old / nloc;
        if (old + 1u == (gen + 1u) * nloc) {
            __builtin_amdgcn_fence(__ATOMIC_RELEASE, "agent");
            asm volatile("s_waitcnt vmcnt(0)" ::: "memory");
            const unsigned og = xb_add(&bar[XB_TOP], 1u);
            const unsigned tg = og / nx;
            if (og + 1u == (tg + 1u) * nx) xb_add(&bar[XB_TOPGEN], 1u);
            else XB_SPIN(xb_ld(&bar[XB_TOPGEN]) == tg, bar);
            __builtin_amdgcn_fence(__ATOMIC_ACQUIRE, "agent");
            xb_add(&bar[XB_XGEN(b.x)], 1u);
            asm volatile("s_waitcnt vmcnt(0)" ::: "memory");
        } else {
            XB_SPIN(xb_ld(&bar[XB_XGEN(b.x)]) == gen, bar);
            __builtin_amdgcn_fence(__ATOMIC_ACQUIRE, "agent");
            asm volatile("s_waitcnt vmcnt(0)" ::: "memory");
        }
    }
    __syncthreads();
}
struct Args { const float* in[18]; float* out; unsigned char* ws; int ph_lo, ph_hi; };
#define P_xp (A.in[0])
#define P_xs (A.in[1])
#define P_sgla (A.in[2])
#define P_sconv (A.in[3])
#define P_norm_mix (A.in[4])
#define P_w_in (A.in[5])
#define P_wgu (A.in[6])
#define P_bgate (A.in[7])
#define P_gla_norm (A.in[8])
#define P_conv_w (A.in[9])
#define P_conv_b (A.in[10])
#define P_ln_g (A.in[11])
#define P_ln_b (A.in[12])
#define P_w_out (A.in[13])
#define P_norm_ffn (A.in[14])
#define P_w_ffn_in (A.in[15])
#define P_w_ffn_out (A.in[16])
#define P_norm_final (A.in[17])
#define P_W1t ((bf16*)(A.ws + WS_W1))
#define P_W2t ((bf16*)(A.ws + WS_W2))
#define P_W3t ((bf16*)(A.ws + WS_W3))
#define P_W4t ((bf16*)(A.ws + WS_W4))
#define P_H ((bf16*)(A.ws + WS_H))
#define P_Z ((bf16*)(A.ws + WS_Z))
#define P_MIX ((bf16*)(A.ws + WS_MIX))
#define P_HID ((bf16*)(A.ws + WS_HID))
#define P_QT ((bf16*)(A.ws + WS_QT))
#define P_KH ((bf16*)(A.ws + WS_KH))
#define P_VT ((bf16*)(A.ws + WS_VT))
#define P_out (A.out)
#define P_O32 ((float*)((unsigned char*)A.out + DO_O32))
#define P_AM ((bf16*)((unsigned char*)A.out + DO_AM))
#define P_DCb ((float*)((unsigned char*)A.out + DO_DC))

struct Frame {
    LAS unsigned char* lds;
    volatile LAS unsigned* MISC;
    gu32* ctl;
    int tid, lane, wave, vcu, G;
};
__device__ __forceinline__ float wave_sum(float v) {
#pragma unroll
    for (int o = 1; o < 64; o <<= 1) v += __shfl_xor(v, o);
    return v;
}
__device__ __forceinline__ float dot4(f32x4 a, f32x4 b) { return (a.x * b.x + a.y * b.y) + (a.z * b.z + a.w * b.w); }

template <int MAP> __device__ __forceinline__ int srccol(int n) {
    if (MAP == 1) return n < 2048 ? n : (n < 5120 ? n + 16 : (n < 5136 ? n - 3072 : -1));
    if (MAP == 3) { const int t = n >> 8, r = n & 255; return r < 128 ? 128 * t + r : DFF + 128 * t + (r - 128); }
    return n;
}
template <int MAP> __device__ __forceinline__ void p0_transpose_item(const float* W, int K, int Nsrc, int Ndst, bf16* WT, LAS float* scr, int item, int lane) {
    const int nblk = Ndst / 32, kb = item / nblk, nb = item % nblk, k0 = 64 * kb, n0 = 32 * nb;
    const int sc = srccol<MAP>(n0 + (lane & 31));
    const float* src = W + (size_t)k0 * Nsrc + (sc >= 0 ? sc : 0);
#pragma unroll 8
    for (int i = 0; i < 32; ++i) { const int kk = 2 * i + (lane >> 5); const float v = src[(size_t)kk * Nsrc]; scr[kk * 33 + (lane & 31)] = sc >= 0 ? v : 0.f; }
    LDS_WAIT(); asm volatile("" ::: "memory");
    const int c = lane & 7;
#pragma unroll
    for (int j = 0; j < 4; ++j) { const int n = (lane >> 3) + 8 * j; const LAS float* s = scr + (8 * c) * 33 + n;
        v4u o; o.x = pk2(s[0 * 33], s[1 * 33]); o.y = pk2(s[2 * 33], s[3 * 33]); o.z = pk2(s[4 * 33], s[5 * 33]); o.w = pk2(s[6 * 33], s[7 * 33]);
        *(GAS v4u*)(WT + (size_t)(n0 + n) * K + k0 + 8 * c) = o; }
    LDS_WAIT(); asm volatile("" ::: "memory");
}
__device__ __forceinline__ void rms_row_to_bf16(const float* xrow, const float* gain, bf16* orow, int lane, const float* part = nullptr, int ns = 0, size_t pstride = 0, float* xout = nullptr) {
    const GAS f32x4* xr = (const GAS f32x4*)xrow + lane; const GAS f32x4* gr = (const GAS f32x4*)gain + lane;
    f32x4 v[8]; float s = 0.f;
#pragma unroll
    for (int j = 0; j < 8; ++j) v[j] = xr[64 * j];
    for (int k = 0; k < ns; ++k) { const GAS f32x4* pr = (const GAS f32x4*)(part + (size_t)k * pstride) + lane;
#pragma unroll
        for (int j = 0; j < 8; ++j) v[j] += pr[64 * j]; }
    if (xout) { GAS f32x4* xo = (GAS f32x4*)xout + lane;
#pragma unroll
        for (int j = 0; j < 8; ++j) xo[64 * j] = v[j]; }
#pragma unroll
    for (int j = 0; j < 8; ++j) s += dot4(v[j], v[j]);
    const float rstd = 1.0f / sqrtf(wave_sum(s) * (1.f / DM) + RMS_EPS);
    GAS v2u* o8 = (GAS v2u*)orow + lane;
#pragma unroll
    for (int j = 0; j < 8; ++j) { const f32x4 g = gr[64 * j]; v2u o; o.x = pk2(v[j].x * rstd * g.x, v[j].y * rstd * g.y); o.y = pk2(v[j].z * rstd * g.z, v[j].w * rstd * g.w); o8[64 * j] = o; }
}
__device__ __forceinline__ void rms_row_inplace(float* xrow, const float* gain, int lane, const float* part = nullptr, int ns = 0, size_t pstride = 0) {
    GAS f32x4* xr = (GAS f32x4*)xrow + lane; const GAS f32x4* gr = (const GAS f32x4*)gain + lane;
    f32x4 v[8]; float s = 0.f;
#pragma unroll
    for (int j = 0; j < 8; ++j) v[j] = xr[64 * j];
    for (int k = 0; k < ns; ++k) { const GAS f32x4* pr = (const GAS f32x4*)(part + (size_t)k * pstride) + lane;
#pragma unroll
        for (int j = 0; j < 8; ++j) v[j] += pr[64 * j]; }
#pragma unroll
    for (int j = 0; j < 8; ++j) s += dot4(v[j], v[j]);
    const float rstd = 1.0f / sqrtf(wave_sum(s) * (1.f / DM) + RMS_EPS);
#pragma unroll
    for (int j = 0; j < 8; ++j) { const f32x4 g = gr[64 * j]; xr[64 * j] = v[j] * rstd * g; }
}
__device__ __forceinline__ void p0_prologue(Frame& F, const Args& A) {
    LAS float* scr = (LAS float*)(F.lds + RING_OFF + F.wave * 16384);
    const int gw = F.vcu * NWAVES + F.wave, NGW = F.G * NWAVES;
    constexpr int I_1 = (DM / 64) * (N1P / 32), I_2 = (DM / 64) * (DM / 32), I_3 = (DM / 64) * (2 * DFF / 32), I_4 = (DFF / 64) * (DM / 32);
    constexpr int NITEMS = I_1 + I_2 + I_3 + I_4;
    for (int it = gw; it < NITEMS; it += NGW) {
        int r = it;
        if (r < I_1) { p0_transpose_item<1>(P_w_in, DM, N1, N1P, P_W1t, scr, r, F.lane); continue; } r -= I_1;
        if (r < I_2) { p0_transpose_item<0>(P_w_out, DM, DM, DM, P_W2t, scr, r, F.lane); continue; } r -= I_2;
        if (r < I_3) { p0_transpose_item<3>(P_w_ffn_in, DM, 2 * DFF, 2 * DFF, P_W3t, scr, r, F.lane); continue; } r -= I_3;
        p0_transpose_item<0>(P_w_ffn_out, DFF, DM, DM, P_W4t, scr, r, F.lane);
    }
    for (int m = gw; m < MPAD; m += NGW) {
        if (m < MR) rms_row_to_bf16(m < MP ? P_xp + (size_t)m * DM : P_xs + (size_t)(m - MP) * DM, P_norm_mix, P_H + (size_t)m * DM, F.lane);
        else { GAS v4u* o = (GAS v4u*)(P_H + (size_t)m * DM) + F.lane;
#pragma unroll
            for (int j = 0; j < 4; ++j) o[64 * j] = (v4u){0u, 0u, 0u, 0u}; }
    }
}

__device__ __forceinline__ void gla_prep_unit(Frame& F, const Args& A, int bh, int c) {
    const int tid = F.tid, b = bh >> 2, h = bh & 3, row0 = b * SEQ + c * CH;
    LAS float* GL = (LAS float*)(F.lds + RING_OFF);
    LAS float* BL = (LAS float*)(F.lds + RING_OFF + 4608);
    LAS bf16* QS = (LAS bf16*)(F.lds + RING_OFF + 8192);
    LAS bf16* KS = (LAS bf16*)(F.lds + RING_OFF + 25600);
    LAS bf16* VR = (LAS bf16*)(F.lds + RING_OFF + 43008);
    const size_t uc = (size_t)bh * NCH + c;
    const bf16* Zc = P_Z + (size_t)row0 * N1P;
    {
        v4u pq[2], pk[2], pv[4];
#pragma unroll
        for (int k = 0; k < 2; ++k) { const int p = tid + 512 * k, i = p >> 4, ch = p & 15;
            pq[k] = *(const GAS v4u*)(Zc + (size_t)i * N1P + ZQ + h * HK + 8 * ch); pk[k] = *(const GAS v4u*)(Zc + (size_t)i * N1P + ZK + h * HK + 8 * ch); }
#pragma unroll
        for (int k = 0; k < 4; ++k) { const int p = tid + 512 * k, i = p >> 5, ch = p & 31; pv[k] = *(const GAS v4u*)(Zc + (size_t)i * N1P + ZV + h * HV + 8 * ch); }
        v4u pg = (v4u){0u, 0u, 0u, 0u};
        if (tid < 128) pg = *(const GAS v4u*)(Zc + (size_t)(tid >> 1) * N1P + ZGL + 8 * (tid & 1));
#pragma unroll
        for (int k = 0; k < 2; ++k) { const int p = tid + 512 * k, i = p >> 4, ch = p & 15; *(LAS v4u*)(QS + i * 136 + 8 * ch) = pq[k]; *(LAS v4u*)(KS + i * 136 + 8 * ch) = pk[k]; }
#pragma unroll
        for (int k = 0; k < 4; ++k) { const int p = tid + 512 * k, i = p >> 5, ch = p & 31; *(LAS v4u*)(VR + i * 264 + 8 * ch) = pv[k]; }
        if (tid < 128) { LAS float* gp = GL + (tid >> 1) * 17 + 8 * (tid & 1);
            gp[0] = bflo(pg.x); gp[1] = bfhi(pg.x); gp[2] = bflo(pg.y); gp[3] = bfhi(pg.y); gp[4] = bflo(pg.z); gp[5] = bfhi(pg.z); gp[6] = bflo(pg.w); gp[7] = bfhi(pg.w); }
    }
    const int d = tid & 127, g = tid >> 7;
    float wg[16];
#pragma unroll
    for (int r = 0; r < 16; ++r) wg[r] = P_wgu[r * DK + h * HK + d];
    const float bg = P_bgate[h * HK + d];
    __syncthreads();
    float bcum[16]; float run = 0.f;
#pragma unroll
    for (int ii = 0; ii < 16; ++ii) { const int i = g * 16 + ii; float x = bg;
#pragma unroll
        for (int r = 0; r < 16; ++r) x += GL[i * 17 + r] * wg[r];
        run += logsigmoid_f(x) * (1.0f / 16.0f); bcum[ii] = run; }
    BL[g * 128 + d] = run;
    __syncthreads();
    float off = 0.f, tot = 0.f;
#pragma unroll
    for (int gg = 0; gg < 4; ++gg) { const float t = BL[gg * 128 + d]; off += (gg < g) ? t : 0.f; tot += t; }
    const float scale = 0.08838834764831845f;
    unsigned khw[8];
#pragma unroll
    for (int ii = 0; ii < 16; ++ii) { const int i = g * 16 + ii; const float bb = bcum[ii] + off;
        const float q = bf2f(QS[i * 136 + d]) * scale * __expf(bb);
        const float kv = bf2f(KS[i * 136 + d]);
        const unsigned qb = f2bf(q), ktb = f2bf(kv * __expf(-bb)), khb = f2bf(kv * __expf(tot - bb));
        QS[i * 136 + d] = (bf16)qb; KS[i * 136 + d] = (bf16)ktb;
        if (ii & 1) khw[ii >> 1] |= khb << 16; else khw[ii >> 1] = khb; }
    { GAS v4u* kp = (GAS v4u*)(P_KH + (uc * 128 + d) * 64 + g * 16);
      kp[0] = (v4u){khw[0], khw[1], khw[2], khw[3]}; kp[1] = (v4u){khw[4], khw[5], khw[6], khw[7]}; }
    if (g == 0) P_DCb[uc * 128 + d] = __expf(tot);
    { const int n = tid & 255, jh = tid >> 8; unsigned vw[16];
#pragma unroll
      for (int jj = 0; jj < 32; ++jj) { const unsigned v = VR[(32 * jh + jj) * 264 + n];
          if (jj & 1) vw[jj >> 1] |= v << 16; else vw[jj >> 1] = v; }
      GAS v4u* vp = (GAS v4u*)(P_VT + (uc * 256 + n) * 64 + 32 * jh);
#pragma unroll
      for (int k = 0; k < 4; ++k) vp[k] = (v4u){vw[4 * k], vw[4 * k + 1], vw[4 * k + 2], vw[4 * k + 3]}; }
    __syncthreads();
    {
#pragma unroll
        for (int k = 0; k < 2; ++k) { const int p = tid + 512 * k, i = p >> 4, s = (p >> 2) & 3, fq = p & 3;
            const v2u lo = *(const LAS v2u*)(QS + i * 136 + 32 * s + 4 * fq), hi = *(const LAS v2u*)(QS + i * 136 + 32 * s + 16 + 4 * fq);
            *(GAS v4u*)(P_QT + (uc * 64 + i) * 128 + 32 * s + 8 * fq) = (v4u){lo.x, lo.y, hi.x, hi.y}; }
    }
    { const int fr = F.lane & 15, fq = F.lane >> 4;
#pragma unroll
      for (int tt = 0; tt < 2; ++tt) { const int id = 2 * F.wave + tt, it = id >> 2, jt = id & 3;
          f32x4 acc = (f32x4){0.f, 0.f, 0.f, 0.f};
          if (jt <= it) {
#pragma unroll
              for (int s = 0; s < 4; ++s) { const bf16x8 a = *(const LAS bf16x8*)(KS + (jt * 16 + fr) * 136 + 32 * s + 8 * fq); const bf16x8 bq = *(const LAS bf16x8*)(QS + (it * 16 + fr) * 136 + 32 * s + 8 * fq);
                  acc = __builtin_amdgcn_mfma_f32_16x16x32_bf16(a, bq, acc, 0, 0, 0); } }
          const int i = it * 16 + fr, j0 = jt * 16 + 4 * fq;
#pragma unroll
          for (int r = 0; r < 4; ++r) if (j0 + r > i) acc[r] = 0.f;
          v2u o; o.x = pk2(acc[0], acc[1]); o.y = pk2(acc[2], acc[3]);
          *(GAS v2u*)(P_AM + (uc * 64 + i) * 64 + j0) = o; } }
    __syncthreads();
}
__device__ __forceinline__ void ln_silu_row(const LAS float* cs, const float* lng, const float* lnb, bf16* orow, int lane) {
    f32x4 x[4]; float s = 0.f;
#pragma unroll
    for (int j = 0; j < 4; ++j) { x[j] = *(const LAS f32x4*)(cs + 256 * j + 4 * lane); s += (x[j].x + x[j].y) + (x[j].z + x[j].w); }
    const float mean = wave_sum(s) * (1.f / DC_); float q = 0.f;
#pragma unroll
    for (int j = 0; j < 4; ++j) { x[j] = x[j] - mean; q += dot4(x[j], x[j]); }
    const float rstd = 1.0f / sqrtf(wave_sum(q) * (1.f / DC_) + LN_EPS);
#pragma unroll
    for (int j = 0; j < 4; ++j) { const f32x4 g = *(const GAS f32x4*)(lng + 256 * j + 4 * lane), bb = *(const GAS f32x4*)(lnb + 256 * j + 4 * lane);
        const f32x4 y = x[j] * rstd * g + bb; v2u o; o.x = pk2(silu_f(y.x), silu_f(y.y)); o.y = pk2(silu_f(y.z), silu_f(y.w));
        *(GAS v2u*)(orow + 256 * j + 4 * lane) = o; }
}
__device__ __forceinline__ void conv_prompt_unit(Frame& F, const Args& A, int b, int tb) {
    LAS float* CS = (LAS float*)(F.lds + RING_OFF);
    const int t0 = tb * 16, c = 2 * F.tid;
    f32x2 wt[31];
#pragma unroll
    for (int w = 0; w < 31; ++w) wt[w] = *(const GAS f32x2*)(P_conv_w + w * DC_ + c);
    const f32x2 bias = *(const GAS f32x2*)(P_conv_b + c);
    f32x2 acc[16];
#pragma unroll
    for (int tt = 0; tt < 16; ++tt) acc[tt] = bias;
#pragma unroll
    for (int r = 0; r < 46; ++r) { const int t = t0 - 30 + r, tc = t < 0 ? 0 : t; const bf16* zr = P_Z + (size_t)(b * SEQ + tc) * N1P;
        const unsigned ua = *(const GAS unsigned*)(zr + ZUA + c), ug = *(const GAS unsigned*)(zr + ZUG + c);
        const float m = t >= 0 ? 1.f : 0.f;
        f32x2 g; g.x = m * bflo(ua) * sigmoid_f(bflo(ug)); g.y = m * bfhi(ua) * sigmoid_f(bfhi(ug));
#pragma unroll
        for (int tt = 0; tt < 16; ++tt) { if (r - tt >= 0 && r - tt < 31) acc[tt] += g * wt[(r - tt >= 0 && r - tt < 31) ? r - tt : 0]; }
        if ((r & 3) == 3) { asm volatile("" ::: "memory"); __builtin_amdgcn_sched_barrier(0); }
    }
#pragma unroll
    for (int tt = 0; tt < 16; ++tt) *(LAS f32x2*)(CS + tt * 1024 + c) = acc[tt];
    __syncthreads();
#pragma unroll
    for (int k = 0; k < 2; ++k) { const int tt = 2 * F.wave + k; ln_silu_row(CS + tt * 1024, P_ln_g, P_ln_b, P_MIX + (size_t)(b * SEQ + t0 + tt) * DM + DA, F.lane); }
    __syncthreads();
}
__device__ __forceinline__ void conv_state_prompt_row(Frame& F, const Args& A, int b, int rr) {
    const bf16* zr = P_Z + (size_t)(b * SEQ + SEQ - 30 + rr) * N1P; float* orow = P_out + O_CP + ((size_t)b * 30 + rr) * DC_;
#pragma unroll
    for (int j = 0; j < 4; ++j) { const int c = 256 * j + 4 * F.lane; const v2u ua = *(const GAS v2u*)(zr + ZUA + c), ug = *(const GAS v2u*)(zr + ZUG + c);
        f32x4 g; g.x = bflo(ua.x) * sigmoid_f(bflo(ug.x)); g.y = bfhi(ua.x) * sigmoid_f(bfhi(ug.x)); g.z = bflo(ua.y) * sigmoid_f(bflo(ug.y)); g.w = bfhi(ua.y) * sigmoid_f(bfhi(ug.y));
        *(GAS f32x4*)(orow + c) = g; }
}
__device__ __forceinline__ void conv_sample_unit(Frame& F, const Args& A, int b) {
    LAS float* CS = (LAS float*)(F.lds + RING_OFF);
    const bf16* zr = P_Z + (size_t)(MP + b) * N1P;
    const int c = 2 * F.tid;
    f32x2 acc = *(const GAS f32x2*)(P_conv_b + c);
    f32x2 hv[30];
#pragma unroll
    for (int w = 0; w < 30; ++w) hv[w] = *(const GAS f32x2*)(P_sconv + ((size_t)b * 30 + w) * DC_ + c);
    const unsigned ua = *(const GAS unsigned*)(zr + ZUA + c), ug = *(const GAS unsigned*)(zr + ZUG + c);
#pragma unroll
    for (int w = 0; w < 30; ++w) { acc += hv[w] * *(const GAS f32x2*)(P_conv_w + w * DC_ + c); if (w >= 1) *(GAS f32x2*)(P_out + O_CS + ((size_t)b * 30 + (w - 1)) * DC_ + c) = hv[w]; }
    f32x2 gl; gl.x = bflo(ua) * sigmoid_f(bflo(ug)); gl.y = bfhi(ua) * sigmoid_f(bfhi(ug));
    acc += gl * *(const GAS f32x2*)(P_conv_w + 30 * DC_ + c);
    *(GAS f32x2*)(P_out + O_CS + ((size_t)b * 30 + 29) * DC_ + c) = gl;
    *(LAS f32x2*)(CS + c) = acc;
    __syncthreads();
    if (F.wave == 0) ln_silu_row(CS, P_ln_g, P_ln_b, P_MIX + (size_t)(MP + b) * DM + DA, F.lane);
    __syncthreads();
}
__device__ __forceinline__ void gla_sample_item(Frame& F, const Args& A, int item) {
    const int b = item >> 2, h = item & 3, tid = F.tid;
    LAS float* AD = (LAS float*)(F.lds + RING_OFF);
    LAS float* KD = AD + 128; LAS float* QD = AD + 256; LAS float* VD = AD + 384;
    LAS float* OP = AD + 640;
    const bf16* zr = P_Z + (size_t)(MP + b) * N1P;
    const int n4 = 4 * F.lane;
    const float* Sin = P_sgla + (size_t)(b * NH + h) * HK * HV; float* Sout = P_out + O_GS + (size_t)(b * NH + h) * HK * HV;
    f32x4 s[16];
#pragma unroll
    for (int dd = 0; dd < 16; ++dd) s[dd] = *(const GAS f32x4*)(Sin + (size_t)(16 * F.wave + dd) * HV + n4);
    if (tid < 128) { const int d = tid; float x = P_bgate[h * HK + d];
#pragma unroll
        for (int r = 0; r < 16; ++r) x += bf2f(zr[ZGL + r]) * P_wgu[r * DK + h * HK + d];
        AD[d] = __expf(logsigmoid_f(x) * (1.0f / 16.0f)); KD[d] = bf2f(zr[ZK + h * HK + d]); QD[d] = bf2f(zr[ZQ + h * HK + d]) * 0.08838834764831845f; }
    else if (tid < 384) { const int n = tid - 128; VD[n] = bf2f(zr[ZV + h * HV + n]); }
    __syncthreads();
    const f32x4 v4 = *(const LAS f32x4*)(VD + n4);
    f32x4 oacc = (f32x4){0.f, 0.f, 0.f, 0.f};
#pragma unroll
    for (int dd = 0; dd < 16; ++dd) { const int d = 16 * F.wave + dd;
        const f32x4 sn = s[dd] * AD[d] + v4 * KD[d]; *(GAS f32x4*)(Sout + (size_t)d * HV + n4) = sn; oacc += sn * QD[d]; }
    *(LAS f32x4*)(OP + F.wave * 256 + n4) = oacc;
    __syncthreads();
    if (F.wave == 0) { f32x4 o4 = (f32x4){0.f, 0.f, 0.f, 0.f};
#pragma unroll
        for (int w = 0; w < 8; ++w) o4 += *(const LAS f32x4*)(OP + w * 256 + n4);
        const float rstd = 1.0f / sqrtf(wave_sum(dot4(o4, o4)) * (1.f / HV) + RMS_EPS);
        const f32x4 gn = *(const GAS f32x4*)(P_gla_norm + n4); const v2u go = *(const GAS v2u*)(zr + ZGO + h * HV + n4);
        v2u o; o.x = pk2(o4.x * rstd * gn.x * silu_f(bflo(go.x)), o4.y * rstd * gn.y * silu_f(bfhi(go.x))); o.y = pk2(o4.z * rstd * gn.z * silu_f(bflo(go.y)), o4.w * rstd * gn.w * silu_f(bfhi(go.y)));
        *(GAS v2u*)(P_MIX + (size_t)(MP + b) * DM + h * HV + n4) = o; }
    __syncthreads();
}
constexpr int SQ_AM = 0, SQ_QT = 9216, SQ_KH = 26624, SQ_VT = 45056, SQ_DC = 49664, SQ_BUF = 50176, SQ_NP = 2848, SQ_LT = 384;
__device__ __forceinline__ void seq_issue(v4u (&R)[8], const bf16* AMc, const bf16* QTc, const bf16* KHc, const bf16* VTc, const float* DCc, int lt) {
#pragma unroll
    for (int k = 0; k < 8; ++k) { const int P = lt + SQ_LT * k; const bf16* src = AMc;
        if (P < 512) src = AMc + (P >> 3) * 64 + (P & 7) * 8;
        else if (P < 1536) { const int q = P - 512; src = QTc + (q >> 4) * 128 + (q & 15) * 8; }
        else if (P < 2560) { const int q = P - 1536; src = KHc + (q >> 3) * 64 + (q & 7) * 8; }
        else if (P < 2816) { const int q = P - 2560; src = VTc + (q >> 3) * 64 + (q & 7) * 8; }
        else if (P < SQ_NP) { const int q = P - 2816; src = (const bf16*)DCc + q * 8; }
        R[k] = *(const GAS v4u*)src; }
}
__device__ __forceinline__ void seq_stash(const v4u (&R)[8], LAS unsigned char* buf, int lt) {
#pragma unroll
    for (int k = 0; k < 8; ++k) { const int P = lt + SQ_LT * k; int dst = 0;
        if (P < 512) dst = SQ_AM + (P >> 3) * 144 + (P & 7) * 16;
        else if (P < 1536) { const int q = P - 512; dst = SQ_QT + (q >> 4) * 272 + (q & 15) * 16; }
        else if (P < 2560) { const int q = P - 1536; dst = SQ_KH + (q >> 3) * 144 + (q & 7) * 16; }
        else if (P < 2816) { const int q = P - 2560; dst = SQ_VT + (q >> 3) * 144 + (q & 7) * 16; }
        else { const int q = P - 2816; dst = SQ_DC + q * 16; }
        if (P < SQ_NP) *(LAS v4u*)(buf + dst) = R[k]; }
}
__device__ __forceinline__ void gla_seq_wg(Frame& F, const Args& A, int item) {
    const int bh = item >> 3, grp = item & 7, b = bh >> 2, h = bh & 3, fr = F.lane & 15, fq = F.lane >> 4;
    LAS unsigned char* lds0 = F.lds + RING_OFF;
    const bool loader = F.wave >= 2; const int lt = F.tid - 128;
    const size_t uc0 = (size_t)bh * NCH;
    const bf16* AM0 = P_AM + uc0 * 64 * 64; const bf16* QT0 = P_QT + uc0 * 64 * 128; const bf16* KH0 = P_KH + uc0 * 128 * 64; const bf16* VT0 = P_VT + uc0 * 256 * 64 + (size_t)(grp * 32) * 64; const float* DC0 = P_DCb + uc0 * 128;
    v4u RA[8], RB[8];
    f32x4 S[8];
#pragma unroll
    for (int dt = 0; dt < 8; ++dt) S[dt] = (f32x4){0.f, 0.f, 0.f, 0.f};
#define SEQ_ISSUE(R, CC) do { const size_t o_ = (size_t)(CC); seq_issue(R, AM0 + o_ * 64 * 64, QT0 + o_ * 64 * 128, KH0 + o_ * 128 * 64, VT0 + o_ * 256 * 64, DC0 + o_ * 128, lt); } while (0)
    if (loader) { SEQ_ISSUE(RA, 0); SEQ_ISSUE(RB, 1); seq_stash(RA, lds0, lt); SEQ_ISSUE(RA, 2); }
    __syncthreads();
    const int n0 = grp * 32 + 16 * F.wave;
#define SEQ_COMPUTE(CC) do { \
            const LAS unsigned char* buf = lds0 + ((CC) & 1) * SQ_BUF; \
            bf16x8 vt[2]; \
_Pragma("unroll") \
            for (int ks = 0; ks < 2; ++ks) vt[ks] = *(const LAS bf16x8*)(buf + SQ_VT + (16 * F.wave + fr) * 144 + (32 * ks + 8 * fq) * 2); \
            f32x4 o[4]; \
_Pragma("unroll") \
            for (int m = 0; m < 4; ++m) { o[m] = (f32x4){0.f, 0.f, 0.f, 0.f}; \
_Pragma("unroll") \
                for (int ks = 0; ks < 2; ++ks) { const bf16x8 a = *(const LAS bf16x8*)(buf + SQ_AM + (16 * m + fr) * 144 + (32 * ks + 8 * fq) * 2); o[m] = __builtin_amdgcn_mfma_f32_16x16x32_bf16(vt[ks], a, o[m], 0, 0, 0); } } \
            bf16x8 sb[4]; \
_Pragma("unroll") \
            for (int s = 0; s < 4; ++s) { v4u w; w.x = pk2(S[2 * s][0], S[2 * s][1]); w.y = pk2(S[2 * s][2], S[2 * s][3]); w.z = pk2(S[2 * s + 1][0], S[2 * s + 1][1]); w.w = pk2(S[2 * s + 1][2], S[2 * s + 1][3]); sb[s] = __builtin_bit_cast(bf16x8, w); } \
_Pragma("unroll") \
            for (int m = 0; m < 4; ++m) \
_Pragma("unroll") \
                for (int s = 0; s < 4; ++s) { const bf16x8 a = *(const LAS bf16x8*)(buf + SQ_QT + (16 * m + fr) * 272 + (32 * s + 8 * fq) * 2); o[m] = __builtin_amdgcn_mfma_f32_16x16x32_bf16(sb[s], a, o[m], 0, 0, 0); } \
_Pragma("unroll") \
            for (int m = 0; m < 4; ++m) *(GAS f32x4*)(P_O32 + (size_t)(b * SEQ + (CC) * CH + 16 * m + fr) * DA + h * HV + n0 + 4 * fq) = o[m]; \
_Pragma("unroll") \
            for (int dt = 0; dt < 8; ++dt) { const f32x4 dc = *(const LAS f32x4*)(buf + SQ_DC + (16 * dt + 4 * fq) * 4); S[dt] = S[dt] * dc; \
_Pragma("unroll") \
                for (int ks = 0; ks < 2; ++ks) { const bf16x8 a = *(const LAS bf16x8*)(buf + SQ_KH + (16 * dt + fr) * 144 + (32 * ks + 8 * fq) * 2); S[dt] = __builtin_amdgcn_mfma_f32_16x16x32_bf16(a, vt[ks], S[dt], 0, 0, 0); } } \
        } while (0)
#pragma unroll 1
    for (int c = 0; c < NCH; c += 2) {
        if (loader) { seq_stash(RB, lds0 + SQ_BUF, lt); if (c + 3 < NCH) SEQ_ISSUE(RB, c + 3); }
        else SEQ_COMPUTE(c);
        __syncthreads();
        if (loader) { if (c + 2 < NCH) seq_stash(RA, lds0, lt); if (c + 4 < NCH) SEQ_ISSUE(RA, c + 4); }
        else SEQ_COMPUTE(c + 1);
        __syncthreads();
    }
#undef SEQ_COMPUTE
#undef SEQ_ISSUE
    if (!loader) {
#pragma unroll
        for (int dt = 0; dt < 8; ++dt)
#pragma unroll
            for (int r = 0; r < 4; ++r) P_out[O_GP + ((size_t)bh * HK + 16 * dt + 4 * fq + r) * HV + n0 + fr] = S[dt][r];
    }
}
__device__ __forceinline__ void gla_onorm_item(Frame& F, const Args& A, int row, int h) {
    const int n4 = 4 * F.lane;
    const f32x4 o4 = *(const GAS f32x4*)(P_O32 + (size_t)row * DA + h * HV + n4);
    const float rstd = 1.0f / sqrtf(wave_sum(dot4(o4, o4)) * (1.f / HV) + RMS_EPS);
    const f32x4 gn = *(const GAS f32x4*)(P_gla_norm + n4); const v2u go = *(const GAS v2u*)(P_Z + (size_t)row * N1P + ZGO + h * HV + n4);
    v2u o; o.x = pk2(o4.x * rstd * gn.x * silu_f(bflo(go.x)), o4.y * rstd * gn.y * silu_f(bfhi(go.x))); o.y = pk2(o4.z * rstd * gn.z * silu_f(bflo(go.y)), o4.w * rstd * gn.w * silu_f(bfhi(go.y)));
    *(GAS v2u*)(P_MIX + (size_t)row * DM + h * HV + n4) = o;
}
constexpr int NKP2 = 2, NKP4 = 4;

#ifndef MK_N_LAUNCHES
#define MK_N_LAUNCHES 1
#endif
constexpr int N_PHASES = 10;
constexpr int N_LAUNCHES = MK_N_LAUNCHES;
__global__ void __launch_bounds__(NWAVES * 64, 2) hymba_fwd(Args args) {
    extern __shared__ __attribute__((aligned(16))) unsigned char lds[];
    Frame F;
    F.lds = (LAS unsigned char*)lds;
    F.MISC = (volatile LAS unsigned*)(F.lds + MISC_OFF);
    F.tid = threadIdx.x; F.lane = F.tid & 63; F.wave = __builtin_amdgcn_readfirstlane(F.tid >> 6);
    F.G = gridDim.x; { const int bx = blockIdx.x; F.vcu = (F.G % 8 == 0) ? (bx % 8) * (F.G / 8) + bx / 8 : bx; }
    const Args& A = args;
    F.ctl = (gu32*)(args.ws + WS_CTL);
    for (int u = F.tid; u < (LDS_BYTES - LDSCTL_OFF) / 4; u += NWAVES * 64) ((LAS unsigned*)(F.lds + LDSCTL_OFF))[u] = 0u;
    __syncthreads();
    XcdBarrier bar; bar.bar = (unsigned*)(F.ctl + CW_BAR); bar.x = 0; bar.st = nullptr;
    if (N_LAUNCHES == 1) bar = xcd_barrier_post((unsigned*)(F.ctl + CW_BAR), F.MISC + 8);
    const int lo = args.ph_lo, hi = args.ph_hi;
#ifndef REP_MASK
#define REP_MASK 0
#endif
#define REPS(k) (((REP_MASK >> (k)) & 1) ? 2 : 1)
#ifndef P2A_REP
#define P2A_REP 0
#endif
#ifndef P2A_MASK
#define P2A_MASK 15
#endif
#ifndef PH_MASK
#define PH_MASK 0x3ff
#endif
#define IN(k) (((PH_MASK >> (k)) & 1) && lo <= (k) && (k) < hi)
#define SEAM(k) do { if (IN(k) && IN((k) + 1)) xcd_barrier(bar); } while (0)
    const int gw = F.vcu * NWAVES + F.wave, NGW = F.G * NWAVES;

    if (IN(0)) for (int rep_ = 0; rep_ < REPS(0); ++rep_) { p0_prologue(F, A); }
    SEAM(0);
    if (IN(1)) for (int rep_ = 0; rep_ < REPS(1); ++rep_) {
        pg8::Gemm g{P_H, P_W1t, MPAD, N1P, DM}; pg8::StaticOrder S; S.init(MPAD, N1P, F.G, (int)blockIdx.x);
        pg8::EpiStoreBf16 E{P_Z, N1P};
        pg8::gemm_phase<pg8::EpiStoreBf16, pg8::StaticOrder, true, true>(F.lds + RING_OFF, g, S, E);
    }
    SEAM(1);
    if (IN(2)) for (int rep_ = 0; rep_ < REPS(2); ++rep_) {
        constexpr int U_PREP = NB * NH * NCH, U_CONVP = NB * (SEQ / 16), U_CONVS = MS, U_GLAS = MS * NH;
        for (int q_ = 0; q_ < ((P2A_REP & 1) ? 2 : 1); ++q_) if (P2A_MASK & 1) { for (int r = F.vcu; r < U_GLAS; r += F.G) gla_sample_item(F, A, r); }
        for (int q_ = 0; q_ < ((P2A_REP & 2) ? 2 : 1); ++q_) if (P2A_MASK & 2) { for (int r = F.vcu; r < U_PREP; r += F.G) gla_prep_unit(F, A, r / NCH, r % NCH); }
        for (int q_ = 0; q_ < ((P2A_REP & 4) ? 2 : 1); ++q_) if (P2A_MASK & 4) { for (int r = F.vcu; r < U_CONVP; r += F.G) conv_prompt_unit(F, A, r / (SEQ / 16), r % (SEQ / 16)); }
        { const int gw2 = F.vcu * NWAVES + F.wave; for (int r = gw2; r < NB * 30; r += F.G * NWAVES) conv_state_prompt_row(F, A, r / 30, r % 30); }
        for (int q_ = 0; q_ < ((P2A_REP & 8) ? 2 : 1); ++q_) if (P2A_MASK & 8) { for (int r = F.G - 1 - F.vcu; r < U_CONVS; r += F.G) conv_sample_unit(F, A, r); }
    }
    SEAM(2);
    if (IN(3)) for (int rep_ = 0; rep_ < REPS(3); ++rep_) {
        { const int bx = (int)blockIdx.x; if (bx < NB * NH * 8) gla_seq_wg(F, A, (bx & 7) * (NB * NH) + (bx >> 3)); }
    }
    SEAM(3);
    if (IN(4)) for (int rep_ = 0; rep_ < REPS(4); ++rep_) { for (int it = gw; it < MP * NH; it += NGW) gla_onorm_item(F, A, it >> 2, it & 3); }
    SEAM(4);
    if (IN(5)) for (int rep_ = 0; rep_ < REPS(5); ++rep_) {
        pg8::Gemm g{P_MIX, P_W2t, MPAD, DM, DM}; pg8::TailSplitOrder S; S.init_ts(MP, DM, DM, F.G, (int)blockIdx.x, NKP2);
        pg8::EpiResF32 E{P_xp, P_xs, P_out, DM, MP, MP, (float*)(A.ws + WS_SK2)};
        pg8::gemm_phase<pg8::EpiResF32, pg8::TailSplitOrder, true, true>(F.lds + RING_OFF, g, S, E);
    }
    SEAM(5);
    if (IN(6)) for (int rep_ = 0; rep_ < REPS(6); ++rep_) { for (int m = gw; m < MR; m += NGW) {
        if (m < MP) rms_row_to_bf16(P_out + (size_t)m * DM, P_norm_ffn, P_H + (size_t)m * DM, F.lane);
        else rms_row_to_bf16(P_xs + (size_t)(m - MP) * DM, P_norm_ffn, P_H + (size_t)m * DM, F.lane, (const float*)(A.ws + WS_SK2) + (size_t)(m - MP) * DM, (DM / 64) / NKP2, (size_t)128 * DM, P_out + (size_t)m * DM); } }
    SEAM(6);
    if (IN(7)) for (int rep_ = 0; rep_ < REPS(7); ++rep_) {
        pg8::Gemm g{P_H, P_W3t, MPAD, 2 * DFF, DM}; pg8::StaticOrder S; S.init(MPAD, 2 * DFF, F.G, (int)blockIdx.x);
        pg8::EpiSwiglu E{P_HID, DFF};
        pg8::gemm_phase<pg8::EpiSwiglu, pg8::StaticOrder, true, true>(F.lds + RING_OFF, g, S, E);
    }
    SEAM(7);
    if (IN(8)) for (int rep_ = 0; rep_ < REPS(8); ++rep_) {
        pg8::Gemm g{P_HID, P_W4t, MPAD, DM, DFF}; pg8::TailSplitOrder S; S.init_ts(MP, DM, DFF, F.G, (int)blockIdx.x, NKP4);
        pg8::EpiResF32 E{P_out, P_out, P_out, DM, MP, MP, (float*)(A.ws + WS_SK4)};
        pg8::gemm_phase<pg8::EpiResF32, pg8::TailSplitOrder, true, true>(F.lds + RING_OFF, g, S, E);
    }
    SEAM(8);
    if (IN(9)) for (int rep_ = 0; rep_ < REPS(9); ++rep_) { for (int m = gw; m < MR; m += NGW) {
        if (m < MP) rms_row_inplace(P_out + (size_t)m * DM, P_norm_final, F.lane);
        else rms_row_inplace(P_out + (size_t)m * DM, P_norm_final, F.lane, (const float*)(A.ws + WS_SK4) + (size_t)(m - MP) * DM, (DFF / 64) / NKP4, (size_t)128 * DM); } }
#undef IN
#undef SEAM
}

extern "C" void kernel_launch(void* const* d_in, const int* in_sizes, int n_in, void* d_out, int out_size, void* d_ws, size_t ws_size, hipStream_t stream) {
    static int grid = 0;
    if (grid == 0) {
        if (n_in != 18 || in_sizes[0] != MP * DM || (size_t)out_size != O_END || ws_size < WS_END) {
            fprintf(stderr, "kernel_launch: shape mismatch: n_in %d in0 %d out %d ws %zu (need %zu); nothing launched\n", n_in, n_in > 0 ? in_sizes[0] : -1, out_size, ws_size, (size_t)WS_END); grid = -1; return; }
        int dev = 0, cus = 0, per_cu = 0;
        if (hipGetDevice(&dev) != hipSuccess || hipDeviceGetAttribute(&cus, hipDeviceAttributeMultiprocessorCount, dev) != hipSuccess) { grid = -1; return; }
        if (hipFuncSetAttribute((const void*)hymba_fwd, hipFuncAttributeMaxDynamicSharedMemorySize, LDS_BYTES) != hipSuccess) { fprintf(stderr, "kernel_launch: hipFuncSetAttribute failed\n"); grid = -1; return; }
        if (hipOccupancyMaxActiveBlocksPerMultiprocessor(&per_cu, (const void*)hymba_fwd, NWAVES * 64, LDS_BYTES) != hipSuccess || per_cu < 1)
            fprintf(stderr, "kernel_launch: note: occupancy query reports %d workgroups per CU\n", per_cu);
        (void)hipGetLastError();
        grid = cus;
    }
    if (grid < 0) return;
    if (N_LAUNCHES == 1) { if (hipMemsetAsync((char*)d_ws + WS_CTL, 0, CTL_ZERO_BYTES, stream) != hipSuccess) return; }
    Args a{};
    for (int i = 0; i < 18; ++i) a.in[i] = (const float*)d_in[i];
    a.out = (float*)d_out; a.ws = (unsigned char*)d_ws;
    for (int li = 0; li < N_LAUNCHES; ++li) {
        a.ph_lo = (N_LAUNCHES == 1) ? 0 : li; a.ph_hi = (N_LAUNCHES == 1) ? N_PHASES : li + 1;
        hipLaunchKernelGGL(hymba_fwd, dim3(grid), dim3(NWAVES * 64), LDS_BYTES, stream, a);
        const hipError_t le = hipPeekAtLastError();
        if (le != hipSuccess) { fprintf(stderr, "kernel_launch: launch %d failed: %s\n", li, hipGetErrorName(le)); break; }
    }
}
```

```cpp
#include <hip/hip_runtime.h>
#include <cstdio>
#include <cstdint>
constexpr int PG8_DUMMY = 0;
namespace pg8 {
#define PG8_LAS __attribute__((address_space(3)))
typedef unsigned short bf16_t;
typedef short bf16x8 __attribute__((ext_vector_type(8)));
typedef float f32x4 __attribute__((ext_vector_type(4)));
typedef unsigned u32x4 __attribute__((ext_vector_type(4)));
constexpr int BM = 256, BK = 64, HALF = 128, HTB = HALF * BK * 2  , STAGE_BYTES = 8 * HTB, NXCD = 8, WGM = 8;

__host__ __device__ __forceinline__ int lds_byte(int r, int c) { const int st = (r >> 4) * 2 + (c >> 5), rr = r & 15, cc = c & 31, ob = rr * 64 + cc * 2; return st * 1024 + (ob ^ (((ob >> 9) & 1) << 5)); }
__host__ __device__ __forceinline__ void stage_rc(int b, int& R, int& C) { const int st = b / 1024, sb = b % 1024, swz = sb ^ (((sb >> 9) & 1) << 5); R = (st >> 1) * 16 + swz / 64; C = (st & 1) * 32 + (swz % 64) / 2; }
__host__ __device__ __forceinline__ int perm32(int rho) { const int n = rho >> 4, i = rho & 15; return 8 * (i >> 2) + 4 * n + (i & 3); }

struct Unit { int pm, pn, k0, nk, mode, slot; };
struct Gemm { const bf16_t* A; const bf16_t* Bt; int M, N, K; };

struct StaticOrder {
    static constexpr bool SK = false;
    int nM, nN, nwg, G, c;
    __host__ __device__ __forceinline__ void init(int M, int N, int G_, int c_) { nM = M / BM; nN = N / BM; nwg = nM * nN; G = G_; c = c_; }
    __host__ __device__ __forceinline__ bool next(int i, Unit& u) const {
        const long L = (long)i * G + c; const bool ok = L < nwg;
        int wgid = ok ? (int)L : 0; { const int q = nwg / NXCD, r = nwg % NXCD, xcd = wgid % NXCD, off = wgid / NXCD; wgid = (xcd < r ? xcd * (q + 1) : r * (q + 1) + (xcd - r) * q) + off; }
        const int nig = WGM * nN, gid = wgid / nig, fm = gid * WGM, gsz = (nM - fm) < WGM ? (nM - fm) : WGM;
        u.pm = fm + ((wgid % nig) % gsz); u.pn = (wgid % nig) / gsz; return ok;
    }
    __device__ __forceinline__ void a_ready(const Unit&) const {}
    __device__ __forceinline__ void done(const Unit&) const {}
};
__device__ __forceinline__ unsigned cvt_pk_bf16(float lo, float hi) { unsigned r; asm volatile("v_cvt_pk_bf16_f32 %0, %1, %2" : "=v"(r) : "v"(lo), "v"(hi)); return r; }
typedef float f32x2 __attribute__((ext_vector_type(2)));
typedef unsigned u32x2v __attribute__((ext_vector_type(2)));
__device__ __forceinline__ float silu_f(float x) { return x * __builtin_amdgcn_rcpf(1.0f + __expf(-x)); }
struct EpiStoreBf16 {
    static constexpr bool PERM = true, AFTER_DRAIN = false;
    bf16_t* O; int ldc;
    __device__ __forceinline__ void operator()(const f32x4 (&acc)[2][2][4][2], const Unit& u, int wr, int wc, int fr, int fq) const {
        const int row0 = u.pm * BM + wr * 64 + fr, col0 = u.pn * BM + wc * 32 + 8 * fq;
#pragma unroll
        for (int ai = 0; ai < 2; ++ai)
#pragma unroll
            for (int m = 0; m < 4; ++m) { bf16_t* rowp = O + (size_t)(row0 + ai * HALF + m * 16) * ldc + col0;
#pragma unroll
                for (int bj = 0; bj < 2; ++bj) { const f32x4 v0 = acc[ai][bj][m][0], v1 = acc[ai][bj][m][1];
                    u32x4 w; w.x = cvt_pk_bf16(v0[0], v0[1]); w.y = cvt_pk_bf16(v0[2], v0[3]); w.z = cvt_pk_bf16(v1[0], v1[1]); w.w = cvt_pk_bf16(v1[2], v1[3]);
                    *(u32x4*)(rowp + bj * HALF) = w; } }
    }
};
struct EpiSwiglu {
    static constexpr bool PERM = true, AFTER_DRAIN = false;
    bf16_t* O; int ldc;
    __device__ __forceinline__ void operator()(const f32x4 (&acc)[2][2][4][2], const Unit& u, int wr, int wc, int fr, int fq) const {
        const int row0 = u.pm * BM + wr * 64 + fr, col0 = u.pn * HALF + wc * 32 + 8 * fq;
#pragma unroll
        for (int ai = 0; ai < 2; ++ai)
#pragma unroll
            for (int m = 0; m < 4; ++m) { bf16_t* rowp = O + (size_t)(row0 + ai * HALF + m * 16) * ldc + col0;
                float h[8];
#pragma unroll
                for (int n = 0; n < 2; ++n)
#pragma unroll
                    for (int e = 0; e < 4; ++e) h[4 * n + e] = silu_f(acc[ai][0][m][n][e]) * acc[ai][1][m][n][e];
                u32x4 w; w.x = cvt_pk_bf16(h[0], h[1]); w.y = cvt_pk_bf16(h[2], h[3]); w.z = cvt_pk_bf16(h[4], h[5]); w.w = cvt_pk_bf16(h[6], h[7]);
                *(u32x4*)rowp = w; }
    }
};
struct EpiResF32 {
    static constexpr bool PERM = false, AFTER_DRAIN = false;
    const float* base0; const float* base1; float* out; int ldc, msplit, mreal; float* part;
    __device__ __forceinline__ void operator()(const f32x4 (&acc)[2][2][4][2], const Unit& u, int wr, int wc, int fr, int fq) const {
        const int row0 = u.pm * BM + wr * 64 + fr, col0 = u.pn * BM + wc * 32 + 4 * fq;
#pragma unroll
        for (int ai = 0; ai < 2; ++ai)
#pragma unroll
            for (int m = 0; m < 4; ++m) { const int row = row0 + ai * HALF + m * 16;
                if (row < mreal) {
                    const float* bp = (row < msplit ? base0 + (size_t)row * ldc : base1 + (size_t)(row - msplit) * ldc) + col0; float* op = out + (size_t)row * ldc + col0;
                    f32x4 b[2][2];
#pragma unroll
                    for (int bj = 0; bj < 2; ++bj)
#pragma unroll
                        for (int n = 0; n < 2; ++n) b[bj][n] = *(const f32x4*)(bp + bj * HALF + n * 16);
#pragma unroll
                    for (int bj = 0; bj < 2; ++bj)
#pragma unroll
                        for (int n = 0; n < 2; ++n) *(f32x4*)(op + bj * HALF + n * 16) = b[bj][n] + acc[ai][bj][m][n];
                } }
    }
    __device__ __forceinline__ void partial(const f32x4 (&acc)[2][2][4][2], const Unit& u, int wr, int wc, int fr, int fq) const {
        float* pp = part + ((size_t)u.slot * HALF + wr * 64 + fr) * ldc + u.pn * BM + wc * 32 + 4 * fq;
#pragma unroll
        for (int m = 0; m < 4; ++m)
#pragma unroll
            for (int bj = 0; bj < 2; ++bj)
#pragma unroll
                for (int n = 0; n < 2; ++n) *(f32x4*)(pp + (size_t)(m * 16) * ldc + bj * HALF + n * 16) = acc[0][bj][m][n];
    }
};
struct TailSplitOrder : StaticOrder {
    static constexpr bool SK = true;
    int nkp, npieces, ntfull;
    __device__ __forceinline__ void init_ts(int Mfull, int N, int K, int G_, int c_, int nkp_) { init(Mfull, N, G_, c_); ntfull = K / BK; nkp = nkp_; npieces = nN * (ntfull / nkp_); }
    __device__ __forceinline__ bool next(int i, Unit& u) const {
        Unit t; t.pm = 0; t.pn = 0;
        const bool full = StaticOrder::next(i, t);
        const long p = (long)i * G + c - nwg; const bool piece = !full && p >= 0 && p < npieces;
        const int pp = piece ? (int)p : 0, ks = pp / nN;
        u.pm = full ? t.pm : nM; u.pn = full ? t.pn : pp - ks * nN; u.slot = full ? 0 : ks; u.k0 = full ? 0 : ks * nkp; u.nk = full ? ntfull : nkp; u.mode = full ? 0 : 3;
        return full || piece;
    }
};
#ifndef SKT_PUB
#define SKT_PUB 1
#endif
#ifndef SKT_COMB
#define SKT_COMB 1
#endif
template <class Epi, class Sched, bool ALIGN_EPI = false, bool SP2 = false>
__device__ __forceinline__ void gemm_phase(PG8_LAS unsigned char* lds, const Gemm g, const Sched& S, const Epi& E) {
    const int tid = threadIdx.x, wid = __builtin_amdgcn_readfirstlane(tid >> 6), lane = tid & 63, wr = wid >> 2, wc = wid & 3, fr = lane & 15, fq = lane >> 4;
    const int K = g.K, nt = K / BK;
    unsigned voffA[2], voffB[2];
#pragma unroll
    for (int i = 0; i < 2; ++i) { int R, C; stage_rc(tid * 16 + i * 8192, R, C); const int Rb = Epi::PERM ? ((R & ~31) + perm32(R & 31)) : R;
        voffA[i] = (unsigned)(R * K + C) * 2u; voffB[i] = (unsigned)(Rb * K + C) * 2u; }
    const size_t kstep = (size_t)(BK * 2);
    const size_t hstep = (size_t)HALF * K * 2;
    const size_t tstep = 2 * hstep;
    const unsigned ldsw = (unsigned)wid * 1024u;
    const int aoff = lds_byte(wr * 64 + fr, fq * 8), boff = lds_byte(wc * 32 + fr, fq * 8);
#define PG8_SA(b, h) (((b) * 2 + (h)) * HTB)
#define PG8_SB(b, h) ((4 + (b) * 2 + (h)) * HTB)
#define PG8_STAGE(bufoff, gbase, voff) do { _Pragma("unroll") for (int _i = 0; _i < 2; ++_i) \
        __builtin_amdgcn_global_load_lds((const unsigned*)((const char*)(gbase) + (voff)[_i]), (PG8_LAS unsigned*)(lds + (bufoff) + ldsw + _i * 8192), 16, 0, 0); } while (0)
#define PG8_LDA(dst, b, h) do { _Pragma("unroll") for (int m = 0; m < 4; ++m) _Pragma("unroll") for (int k = 0; k < 2; ++k) dst[m][k] = *(const PG8_LAS bf16x8*)(lds + PG8_SA(b, h) + aoff + m * 2048 + k * 1024); } while (0)
#define PG8_LDB(dst, b, h) do { _Pragma("unroll") for (int n = 0; n < 2; ++n) _Pragma("unroll") for (int k = 0; k < 2; ++k) dst[n][k] = *(const PG8_LAS bf16x8*)(lds + PG8_SB(b, h) + boff + n * 2048 + k * 1024); } while (0)
#define PG8_MMA(ai, bj, At, Bt) do { __builtin_amdgcn_s_setprio(1); _Pragma("unroll") for (int m = 0; m < 4; ++m) _Pragma("unroll") for (int n = 0; n < 2; ++n) _Pragma("unroll") for (int k = 0; k < 2; ++k) \
        acc[ai][bj][m][n] = __builtin_amdgcn_mfma_f32_16x16x32_bf16(Bt[n][k], At[m][k], acc[ai][bj][m][n], 0, 0, 0); __builtin_amdgcn_s_setprio(0); } while (0)
#define PG8_WAIT_V(n) asm volatile("s_waitcnt vmcnt(" #n ")" ::: "memory")
#define PG8_WAIT_L(n) asm volatile("s_waitcnt lgkmcnt(" #n ")" ::: "memory")
#define PG8_BAR __builtin_amdgcn_s_barrier()
#define PG8_SCHED __builtin_amdgcn_sched_barrier(0)
    Unit cur, nxt; int ui = 0;
    if (!S.next(0, cur)) return;
    if constexpr (!Sched::SK) { cur.k0 = 0; cur.nk = nt; cur.mode = 0; cur.slot = 0; }
    f32x4 acc[2][2][4][2];
#pragma unroll
    for (int a = 0; a < 2; ++a)
#pragma unroll
        for (int b = 0; b < 2; ++b)
#pragma unroll
            for (int m = 0; m < 4; ++m)
#pragma unroll
                for (int n = 0; n < 2; ++n) acc[a][b][m][n] = (f32x4){0.f, 0.f, 0.f, 0.f};
    bf16x8 At[4][2], B0[2][2], B1[2][2];
    const char* cA = (const char*)g.A + (size_t)cur.pm * tstep + (size_t)cur.k0 * kstep; const char* cB = (const char*)g.Bt + (size_t)cur.pn * tstep + (size_t)cur.k0 * kstep;
    S.a_ready(cur);
    if constexpr (SP2) {
        PG8_STAGE(PG8_SB(0, 0), cB, voffB); PG8_STAGE(PG8_SB(0, 1), cB + hstep, voffB); PG8_STAGE(PG8_SA(0, 0), cA, voffA); PG8_STAGE(PG8_SA(0, 1), cA + hstep, voffA);
        if (wr == 1) PG8_BAR;
        PG8_WAIT_V(2); PG8_BAR;
        PG8_STAGE(PG8_SB(1, 0), cB + kstep, voffB); PG8_STAGE(PG8_SA(1, 0), cA + kstep, voffA); PG8_STAGE(PG8_SB(1, 1), cB + hstep + kstep, voffB);
        PG8_WAIT_V(6); PG8_BAR;
    } else {
        PG8_STAGE(PG8_SB(0, 0), cB, voffB); PG8_STAGE(PG8_SA(0, 0), cA, voffA); PG8_STAGE(PG8_SB(0, 1), cB + hstep, voffB); PG8_STAGE(PG8_SA(0, 1), cA + hstep, voffA);
        if (wr == 1) PG8_BAR;
        PG8_WAIT_V(4); PG8_BAR;
        PG8_STAGE(PG8_SB(1, 0), cB + kstep, voffB); PG8_STAGE(PG8_SA(1, 0), cA + kstep, voffA); PG8_STAGE(PG8_SB(1, 1), cB + hstep + kstep, voffB);
        PG8_WAIT_V(6); PG8_BAR;
    }
    for (;;) {
        const bool has_next = S.next(ui + 1, nxt);
        if constexpr (!Sched::SK) { nxt.k0 = 0; nxt.nk = nt; nxt.mode = 0; nxt.slot = 0; }
        const int ntc = cur.nk;
        const char* nA = has_next ? (const char*)g.A + (size_t)nxt.pm * tstep + (size_t)nxt.k0 * kstep : cA; const char* nB = has_next ? (const char*)g.Bt + (size_t)nxt.pn * tstep + (size_t)nxt.k0 * kstep : cB;
        for (int t = 0; t < ntc; t += 2) {
            const bool last = (t == ntc - 2);
            const char* a1 = cA + (size_t)(t + 1) * kstep;
            const char* a2 = last ? nA : cA + (size_t)(t + 2) * kstep; const char* b2 = last ? nB : cB + (size_t)(t + 2) * kstep;
            const char* a3 = a2 + kstep; const char* b3 = b2 + kstep;
            if (last && has_next) S.a_ready(nxt);
            if constexpr (SP2) {
            PG8_LDB(B0, 0, 0); PG8_LDB(B1, 0, 1); PG8_SCHED; PG8_LDA(At, 0, 0); PG8_STAGE(PG8_SA(1, 1), a1 + hstep, voffA);
            PG8_WAIT_V(8); PG8_WAIT_L(0); PG8_BAR; PG8_MMA(0, 0, At, B0); PG8_MMA(0, 1, At, B1); PG8_BAR; PG8_SCHED;
            PG8_LDA(At, 0, 1); PG8_STAGE(PG8_SB(0, 0), b2, voffB); PG8_STAGE(PG8_SB(0, 1), b2 + hstep, voffB); PG8_STAGE(PG8_SA(0, 0), a2, voffA);
            PG8_WAIT_V(8); PG8_WAIT_L(0); PG8_BAR; PG8_MMA(1, 0, At, B0); PG8_MMA(1, 1, At, B1); PG8_BAR; PG8_SCHED;
            PG8_LDB(B0, 1, 0); PG8_LDB(B1, 1, 1); PG8_SCHED; PG8_LDA(At, 1, 0); PG8_STAGE(PG8_SA(0, 1), a2 + hstep, voffA);
            PG8_WAIT_V(8); PG8_WAIT_L(0); PG8_BAR; PG8_MMA(0, 0, At, B0); PG8_MMA(0, 1, At, B1); PG8_BAR; PG8_SCHED;
            PG8_LDA(At, 1, 1); PG8_STAGE(PG8_SB(1, 0), b3, voffB); PG8_STAGE(PG8_SB(1, 1), b3 + hstep, voffB); PG8_STAGE(PG8_SA(1, 0), a3, voffA);
            PG8_WAIT_V(8); PG8_WAIT_L(0); PG8_BAR; PG8_MMA(1, 0, At, B0); PG8_MMA(1, 1, At, B1); PG8_BAR; PG8_SCHED;
            } else {
            PG8_LDB(B0, 0, 0); PG8_SCHED; PG8_LDA(At, 0, 0); PG8_STAGE(PG8_SA(1, 1), a1 + hstep, voffA);
            PG8_WAIT_L(8); PG8_BAR; PG8_WAIT_L(0); PG8_MMA(0, 0, At, B0); PG8_BAR; PG8_SCHED;
            PG8_LDB(B1, 0, 1); PG8_STAGE(PG8_SB(0, 0), b2, voffB);
            PG8_BAR; PG8_WAIT_L(0); PG8_MMA(0, 1, At, B1); PG8_BAR;
            PG8_LDA(At, 0, 1); PG8_STAGE(PG8_SA(0, 0), a2, voffA);
            PG8_BAR; PG8_WAIT_L(0); PG8_MMA(1, 0, At, B0); PG8_BAR; PG8_SCHED;
            PG8_STAGE(PG8_SB(0, 1), b2 + hstep, voffB);
            PG8_WAIT_V(6); PG8_BAR; PG8_MMA(1, 1, At, B1); PG8_BAR;
            PG8_LDB(B0, 1, 0); PG8_SCHED; PG8_LDA(At, 1, 0); PG8_STAGE(PG8_SA(0, 1), a2 + hstep, voffA);
            PG8_WAIT_L(8); PG8_BAR; PG8_WAIT_L(0); PG8_MMA(0, 0, At, B0); PG8_BAR; PG8_SCHED;
            PG8_LDB(B1, 1, 1); PG8_STAGE(PG8_SB(1, 0), b3, voffB);
            PG8_BAR; PG8_WAIT_L(0); PG8_MMA(0, 1, At, B1); PG8_BAR;
            PG8_LDA(At, 1, 1); PG8_STAGE(PG8_SA(1, 0), a3, voffA);
            PG8_BAR; PG8_WAIT_L(0); PG8_MMA(1, 0, At, B0); PG8_BAR; PG8_SCHED;
            PG8_STAGE(PG8_SB(1, 1), b3 + hstep, voffB);
            PG8_WAIT_V(6); PG8_BAR; PG8_MMA(1, 1, At, B1); PG8_BAR;
            }
        }
        if constexpr (ALIGN_EPI) { if (wr == 0) PG8_BAR; }
        if constexpr (!Epi::AFTER_DRAIN) {
            if constexpr (Sched::SK) { if (cur.mode == 3) E.partial(acc, cur, wr, wc, fr, fq); else E(acc, cur, wr, wc, fr, fq); }
            else E(acc, cur, wr, wc, fr, fq);
            S.done(cur); }
        if (!has_next) break;
#pragma unroll
        for (int a = 0; a < 2; ++a)
#pragma unroll
            for (int b = 0; b < 2; ++b)
#pragma unroll
                for (int m = 0; m < 4; ++m)
#pragma unroll
                    for (int n = 0; n < 2; ++n) acc[a][b][m][n] = (f32x4){0.f, 0.f, 0.f, 0.f};
        cur = nxt; cA = nA; cB = nB; ++ui;
        if constexpr (ALIGN_EPI) { if (wr == 1) PG8_BAR; }
    }
    PG8_WAIT_V(0);
    if constexpr (!ALIGN_EPI) { if (wr == 0) PG8_BAR; }
    PG8_BAR;
    if constexpr (Epi::AFTER_DRAIN) { E.fused(acc, cur, wr, wc, fr, fq, lds, wid, lane); S.done(cur); }
#undef PG8_SA
#undef PG8_SB
#undef PG8_STAGE
#undef PG8_LDA
#undef PG8_LDB
#undef PG8_MMA
#undef PG8_WAIT_V
#undef PG8_WAIT_L
#undef PG8_BAR
#undef PG8_SCHED
}
}

constexpr int NWAVES = 8;
constexpr int DM = 2048, MP = 8192, MS = 128, MR = MP + MS  , MPAD = 8448  , SEQ = 2048, NB = 4;
constexpr int NH = 4, HK = 128, HV = 256, DK = 512, DA = 1024, DC_ = 1024, GR = 16, CW = 31, DFF = 5632;
constexpr int N1 = 5136, N1P = 5376;
constexpr int ZQ = 0, ZK = 512, ZV = 1024, ZGO = 2048, ZUA = 3072, ZUG = 4096, ZGL = 5120;
constexpr int CH = 64, NCH = SEQ / CH;
constexpr float RMS_EPS = 1e-6f, LN_EPS = 1e-5f;
constexpr size_t O_YP = 0, O_YS = (size_t)MP * DM, O_GP = O_YS + (size_t)MS * DM, O_CP = O_GP + (size_t)NB * NH * HK * HV, O_GS = O_CP + (size_t)NB * 30 * DC_,
                 O_CS = O_GS + (size_t)MS * NH * HK * HV, O_END = O_CS + (size_t)MS * 30 * DC_;
constexpr size_t MiB = 1u << 20;
constexpr size_t WS_CTL = 0, CTL_ZERO_BYTES = 1 * MiB;
constexpr size_t WS_W1 = 2 * MiB;
constexpr size_t WS_W2 = 23 * MiB;
constexpr size_t WS_W3 = 31 * MiB;
constexpr size_t WS_W4 = 75 * MiB;
constexpr size_t WS_H = 97 * MiB;
constexpr size_t WS_QT = WS_H, WS_KH = WS_H + 8 * MiB, WS_VT = WS_H + 16 * MiB;
constexpr size_t WS_Z = 130 * MiB;
constexpr size_t WS_MIX = 217 * MiB;
constexpr size_t WS_HID = 130 * MiB;
constexpr size_t WS_END = 250 * MiB;
static_assert(WS_Z + (size_t)MPAD * N1P * 2 <= WS_MIX && WS_HID + (size_t)MPAD * DFF * 2 <= WS_END && WS_W1 + (size_t)N1P * DM * 2 <= WS_W2 && WS_W3 + (size_t)2 * DFF * DM * 2 <= WS_W4 && WS_W4 + (size_t)DM * DFF * 2 <= WS_H, "d_ws map");
constexpr size_t DO_O32 = 0, DO_AM = 32 * MiB, DO_DC = 36 * MiB;
constexpr int CW_TMO = 0, CW_BAR = 4096, CW_SK2 = 16384, CW_SK4 = 16384 + 264 * 64;
constexpr size_t WS_SK2 = WS_Z, WS_SK4 = WS_W1;
static_assert((size_t)32 * 128 * DM * 4 <= WS_MIX - WS_Z && WS_SK4 + (size_t)44 * 128 * DM * 4 <= WS_W4, "K-split slabs");
constexpr int RING_OFF = 0, RING_BYTES = 131072;
constexpr int LDSCTL_OFF = RING_BYTES, MISC_OFF = LDSCTL_OFF + 320;
constexpr int LDS_BYTES = 147456;

#define GAS __attribute__((address_space(1)))
#define LAS __attribute__((address_space(3)))
typedef unsigned short bf16;
typedef unsigned v4u __attribute__((ext_vector_type(4)));
typedef unsigned v2u __attribute__((ext_vector_type(2)));
typedef float f32x4 __attribute__((ext_vector_type(4)));
typedef float f32x2 __attribute__((ext_vector_type(2)));
typedef short bf16x8 __attribute__((ext_vector_type(8)));
typedef GAS unsigned gu32;
typedef GAS unsigned long long gu64;
#define RLX_AGENT __ATOMIC_RELAXED, __HIP_MEMORY_SCOPE_AGENT
#define LDS_WAIT() asm volatile("s_waitcnt lgkmcnt(0)" ::: "memory")
#define VM_WAIT() asm volatile("s_waitcnt vmcnt(0)" ::: "memory")
__device__ __forceinline__ unsigned f2bf(float f) { unsigned u = __builtin_bit_cast(unsigned, f); return (u + 0x7fffu + ((u >> 16) & 1u)) >> 16; }
__device__ __forceinline__ unsigned pk2(float lo, float hi) { return f2bf(lo) | (f2bf(hi) << 16); }
__device__ __forceinline__ float bf2f(unsigned short b) { return __builtin_bit_cast(float, (unsigned)b << 16); }
__device__ __forceinline__ float bflo(unsigned w) { return __builtin_bit_cast(float, w << 16); }
__device__ __forceinline__ float bfhi(unsigned w) { return __builtin_bit_cast(float, w & 0xffff0000u); }
__device__ __forceinline__ float sigmoid_f(float x) { return __builtin_amdgcn_rcpf(1.0f + __expf(-x)); }
__device__ __forceinline__ float silu_f(float x) { return x * sigmoid_f(x); }
__device__ __forceinline__ float logsigmoid_f(float x) { return fminf(x, 0.f) - log1pf(__expf(-fabsf(x))); }
#define XB_TMO      128
#define XB_XCNT(j)  (256  + 64 * (j))
#define XB_XSUB(j)  (1280 + 64 * (j))
#define XB_XGEN(j)  (2304 + 64 * (j))
#define XB_TOP      3328
#define XB_TOPGEN   3392
#define XCD_BAR_WORDS 3456
#define XB_SPIN_CAP (1u << 18)

__device__ __forceinline__ unsigned xb_ld(unsigned* p)              { return __hip_atomic_load(p, __ATOMIC_RELAXED, __HIP_MEMORY_SCOPE_AGENT); }
__device__ __forceinline__ unsigned xb_add(unsigned* p, unsigned v) { return __hip_atomic_fetch_add(p, v, __ATOMIC_RELAXED, __HIP_MEMORY_SCOPE_AGENT); }
__device__ __forceinline__ unsigned xb_xcc_id() { return (unsigned)__builtin_amdgcn_s_getreg((3 << 11) | 20) & 0xFu; }
#define XB_SPIN(cond, bar) do { unsigned _sp = 0; while (cond) { __builtin_amdgcn_s_sleep(1); \
    if ((++_sp & 255u) == 0u) { if (xb_ld(&(bar)[XB_TMO])) break; if (_sp > XB_SPIN_CAP) { atomicAdd(&(bar)[XB_TMO], 1u); break; } } } } while (0)

struct XcdBarrier {
    unsigned* bar; unsigned x;
    volatile LAS unsigned* st;
};

__device__ __forceinline__ XcdBarrier xcd_barrier_post(unsigned* bar, volatile LAS unsigned* st) {
    XcdBarrier b; b.bar = bar; b.x = xb_xcc_id(); b.st = st;
    if (threadIdx.x == 0) (void)xb_add(&bar[XB_XCNT(b.x)], 1u);
    return b;
}
__device__ __forceinline__ void xcd_barrier_complete(unsigned* bar, unsigned x, unsigned& nloc, unsigned& nx) {
    const unsigned G = gridDim.x * gridDim.y * gridDim.z;
    unsigned sum, cnt, mine, sp = 0u;
    for (;;) {
        sum = 0u; cnt = 0u; mine = 0u;
#pragma unroll
        for (unsigned j = 0; j < 16; ++j) { const unsigned c = xb_ld(&bar[XB_XCNT(j)]); sum += c; cnt += (c > 0u) ? 1u : 0u; mine = (j == x) ? c : mine; }
        if (sum == G) break;
        __builtin_amdgcn_s_sleep(1);
        if ((++sp & 255u) == 0u) { if (xb_ld(&bar[XB_TMO])) break; if (sp > XB_SPIN_CAP) { atomicAdd(&bar[XB_TMO], 1u); break; } }
    }
    nloc = mine > 0u ? mine : 1u; nx = cnt > 0u ? cnt : 1u;
}

__device__ __forceinline__ void xcd_barrier(const XcdBarrier& b) {
    asm volatile("s_waitcnt vmcnt(0)" ::: "memory");
    __syncthreads();
    if (threadIdx.x == 0) {
        unsigned* bar = b.bar;
        __builtin_amdgcn_s_waitcnt(0);
        unsigned nloc = b.st[0], nx = b.st[1];
        if (nloc == 0u) { xcd_barrier_complete(bar, b.x, nloc, nx); b.st[0] = nloc; b.st[1] = nx; }
        const unsigned old = xb_add(&bar[XB_XSUB(b.x)], 1u);
        const unsigned gen = old / nloc;
        if (old + 1u == (gen + 1u) * nloc) {
            __builtin_amdgcn_fence(__ATOMIC_RELEASE, "agent");
            asm volatile("s_waitcnt vmcnt(0)" ::: "memory");
            const unsigned og = xb_add(&bar[XB_TOP], 1u);
            const unsigned tg = og / nx;
            if (og + 1u == (tg + 1u) * nx) xb_add(&bar[XB_TOPGEN], 1u);
            else XB_SPIN(xb_ld(&bar[XB_TOPGEN]) == tg, bar);
            __builtin_amdgcn_fence(__ATOMIC_ACQUIRE, "agent");
            xb_add(&bar[XB_XGEN(b.x)], 1u);
            asm volatile("s_waitcnt vmcnt(0)" ::: "memory");
        } else {
            XB_SPIN(xb_ld(&bar[XB_XGEN(b.x)]) == gen, bar);
            __builtin_amdgcn_fence(__ATOMIC_ACQUIRE, "agent");
            asm volatile("s_waitcnt vmcnt(0)" ::: "memory");
        }
    }
    __syncthreads();
}
struct Args { const float* in[18]; float* out; unsigned char* ws; int ph_lo, ph_hi; };
#define P_xp (A.in[0])
#define P_xs (A.in[1])
#define P_sgla (A.in[2])
#define P_sconv (A.in[3])
#define P_norm_mix (A.in[4])
#define P_w_in (A.in[5])
#define P_wgu (A.in[6])
#define P_bgate (A.in[7])
#define P_gla_norm (A.in[8])
#define P_conv_w (A.in[9])
#define P_conv_b (A.in[10])
#define P_ln_g (A.in[11])
#define P_ln_b (A.in[12])
#define P_w_out (A.in[13])
#define P_norm_ffn (A.in[14])
#define P_w_ffn_in (A.in[15])
#define P_w_ffn_out (A.in[16])
#define P_norm_final (A.in[17])
#define P_W1t ((bf16*)(A.ws + WS_W1))
#define P_W2t ((bf16*)(A.ws + WS_W2))
#define P_W3t ((bf16*)(A.ws + WS_W3))
#define P_W4t ((bf16*)(A.ws + WS_W4))
#define P_H ((bf16*)(A.ws + WS_H))
#define P_Z ((bf16*)(A.ws + WS_Z))
#define P_MIX ((bf16*)(A.ws + WS_MIX))
#define P_HID ((bf16*)(A.ws + WS_HID))
#define P_QT ((bf16*)(A.ws + WS_QT))
#define P_KH ((bf16*)(A.ws + WS_KH))
#define P_VT ((bf16*)(A.ws + WS_VT))
#define P_out (A.out)
#define P_O32 ((float*)((unsigned char*)A.out + DO_O32))
#define P_AM ((bf16*)((unsigned char*)A.out + DO_AM))
#define P_DCb ((float*)((unsigned char*)A.out + DO_DC))

struct Frame {
    LAS unsigned char* lds;
    volatile LAS unsigned* MISC;
    gu32* ctl;
    int tid, lane, wave, vcu, G;
};
__device__ __forceinline__ float wave_sum(float v) {
#pragma unroll
    for (int o = 1; o < 64; o <<= 1) v += __shfl_xor(v, o);
    return v;
}
__device__ __forceinline__ float dot4(f32x4 a, f32x4 b) { return (a.x * b.x + a.y * b.y) + (a.z * b.z + a.w * b.w); }

template <int MAP> __device__ __forceinline__ int srccol(int n) {
    if (MAP == 1) return n < 2048 ? n : (n < 5120 ? n + 16 : (n < 5136 ? n - 3072 : -1));
    if (MAP == 3) { const int t = n >> 8, r = n & 255; return r < 128 ? 128 * t + r : DFF + 128 * t + (r - 128); }
    return n;
}
template <int MAP> __device__ __forceinline__ void p0_transpose_item(const float* W, int K, int Nsrc, int Ndst, bf16* WT, LAS float* scr, int item, int lane) {
    const int nblk = Ndst / 32, kb = item / nblk, nb = item % nblk, k0 = 64 * kb, n0 = 32 * nb;
    const int sc = srccol<MAP>(n0 + (lane & 31));
    const float* src = W + (size_t)k0 * Nsrc + (sc >= 0 ? sc : 0);
#pragma unroll 8
    for (int i = 0; i < 32; ++i) { const int kk = 2 * i + (lane >> 5); const float v = src[(size_t)kk * Nsrc]; scr[kk * 33 + (lane & 31)] = sc >= 0 ? v : 0.f; }
    LDS_WAIT(); asm volatile("" ::: "memory");
    const int c = lane & 7;
#pragma unroll
    for (int j = 0; j < 4; ++j) { const int n = (lane >> 3) + 8 * j; const LAS float* s = scr + (8 * c) * 33 + n;
        v4u o; o.x = pk2(s[0 * 33], s[1 * 33]); o.y = pk2(s[2 * 33], s[3 * 33]); o.z = pk2(s[4 * 33], s[5 * 33]); o.w = pk2(s[6 * 33], s[7 * 33]);
        *(GAS v4u*)(WT + (size_t)(n0 + n) * K + k0 + 8 * c) = o; }
    LDS_WAIT(); asm volatile("" ::: "memory");
}
__device__ __forceinline__ void rms_row_to_bf16(const float* xrow, const float* gain, bf16* orow, int lane, const float* part = nullptr, int ns = 0, size_t pstride = 0, float* xout = nullptr) {
    const GAS f32x4* xr = (const GAS f32x4*)xrow + lane; const GAS f32x4* gr = (const GAS f32x4*)gain + lane;
    f32x4 v[8]; float s = 0.f;
#pragma unroll
    for (int j = 0; j < 8; ++j) v[j] = xr[64 * j];
    for (int k = 0; k < ns; k += 2) {
        const GAS f32x4* pr0 = (const GAS f32x4*)(part + (size_t)k * pstride) + lane; const GAS f32x4* pr1 = (const GAS f32x4*)(part + (size_t)(k + 1) * pstride) + lane;
        f32x4 t0[8], t1[8];
#pragma unroll
        for (int j = 0; j < 8; ++j) { t0[j] = pr0[64 * j]; t1[j] = pr1[64 * j]; }
#pragma unroll
        for (int j = 0; j < 8; ++j) v[j] += t0[j] + t1[j]; }
    if (xout) { GAS f32x4* xo = (GAS f32x4*)xout + lane;
#pragma unroll
        for (int j = 0; j < 8; ++j) xo[64 * j] = v[j]; }
#pragma unroll
    for (int j = 0; j < 8; ++j) s += dot4(v[j], v[j]);
    const float rstd = 1.0f / sqrtf(wave_sum(s) * (1.f / DM) + RMS_EPS);
    GAS v2u* o8 = (GAS v2u*)orow + lane;
#pragma unroll
    for (int j = 0; j < 8; ++j) { const f32x4 g = gr[64 * j]; v2u o; o.x = pk2(v[j].x * rstd * g.x, v[j].y * rstd * g.y); o.y = pk2(v[j].z * rstd * g.z, v[j].w * rstd * g.w); o8[64 * j] = o; }
}
__device__ __forceinline__ void rms_row_inplace(float* xrow, const float* gain, int lane, const float* part = nullptr, int ns = 0, size_t pstride = 0) {
    GAS f32x4* xr = (GAS f32x4*)xrow + lane; const GAS f32x4* gr = (const GAS f32x4*)gain + lane;
    f32x4 v[8]; float s = 0.f;
#pragma unroll
    for (int j = 0; j < 8; ++j) v[j] = xr[64 * j];
    for (int k = 0; k < ns; k += 2) {
        const GAS f32x4* pr0 = (const GAS f32x4*)(part + (size_t)k * pstride) + lane; const GAS f32x4* pr1 = (const GAS f32x4*)(part + (size_t)(k + 1) * pstride) + lane;
        f32x4 t0[8], t1[8];
#pragma unroll
        for (int j = 0; j < 8; ++j) { t0[j] = pr0[64 * j]; t1[j] = pr1[64 * j]; }
#pragma unroll
        for (int j = 0; j < 8; ++j) v[j] += t0[j] + t1[j]; }
#pragma unroll
    for (int j = 0; j < 8; ++j) s += dot4(v[j], v[j]);
    const float rstd = 1.0f / sqrtf(wave_sum(s) * (1.f / DM) + RMS_EPS);
#pragma unroll
    for (int j = 0; j < 8; ++j) { const f32x4 g = gr[64 * j]; xr[64 * j] = v[j] * rstd * g; }
}
template <int NS> __device__ __forceinline__ void sample_row_unit(const float* base, const float* part, size_t pstride, const float* gain, float* xout, bf16* obf, float* of32, LAS float* red, int wave, int lane) {
    const int col = 256 * wave + 4 * lane;
    f32x4 v = *(const GAS f32x4*)(base + col);
    f32x4 t[NS];
#pragma unroll
    for (int k = 0; k < NS; ++k) t[k] = *(const GAS f32x4*)(part + (size_t)k * pstride + col);
#pragma unroll
    for (int k = 0; k < NS; ++k) v += t[k];
    if (xout) *(GAS f32x4*)(xout + col) = v;
    const float s = wave_sum(dot4(v, v));
    if (lane == 0) red[wave] = s;
    __syncthreads();
    float tot = 0.f;
#pragma unroll
    for (int w = 0; w < 8; ++w) tot += red[w];
    const float rstd = 1.0f / sqrtf(tot * (1.f / DM) + RMS_EPS);
    const f32x4 g = *(const GAS f32x4*)(gain + col); const f32x4 r = v * rstd * g;
    if (obf) { v2u o; o.x = pk2(r.x, r.y); o.y = pk2(r.z, r.w); *(GAS v2u*)(obf + col) = o; }
    if (of32) *(GAS f32x4*)(of32 + col) = r;
    __syncthreads();
}
__device__ __forceinline__ void p0_prologue(Frame& F, const Args& A) {
    LAS float* scr = (LAS float*)(F.lds + RING_OFF + F.wave * 16384);
    const int gw = F.vcu * NWAVES + F.wave, NGW = F.G * NWAVES;
    constexpr int I_1 = (DM / 64) * (N1P / 32), I_2 = (DM / 64) * (DM / 32), I_3 = (DM / 64) * (2 * DFF / 32), I_4 = (DFF / 64) * (DM / 32);
    constexpr int NITEMS = I_1 + I_2 + I_3 + I_4;
    for (int it = gw; it < NITEMS; it += NGW) {
        int r = it;
        if (r < I_1) { p0_transpose_item<1>(P_w_in, DM, N1, N1P, P_W1t, scr, r, F.lane); continue; } r -= I_1;
        if (r < I_2) { p0_transpose_item<0>(P_w_out, DM, DM, DM, P_W2t, scr, r, F.lane); continue; } r -= I_2;
        if (r < I_3) { p0_transpose_item<3>(P_w_ffn_in, DM, 2 * DFF, 2 * DFF, P_W3t, scr, r, F.lane); continue; } r -= I_3;
        p0_transpose_item<0>(P_w_ffn_out, DFF, DM, DM, P_W4t, scr, r, F.lane);
    }
    for (int m = gw; m < MPAD; m += NGW) {
        if (m < MR) rms_row_to_bf16(m < MP ? P_xp + (size_t)m * DM : P_xs + (size_t)(m - MP) * DM, P_norm_mix, P_H + (size_t)m * DM, F.lane);
        else { GAS v4u* o = (GAS v4u*)(P_H + (size_t)m * DM) + F.lane;
#pragma unroll
            for (int j = 0; j < 4; ++j) o[64 * j] = (v4u){0u, 0u, 0u, 0u}; }
    }
}

__device__ __forceinline__ void gla_prep_unit(Frame& F, const Args& A, int bh, int c) {
    const int tid = F.tid, b = bh >> 2, h = bh & 3, row0 = b * SEQ + c * CH;
    LAS float* GL = (LAS float*)(F.lds + RING_OFF);
    LAS float* BL = (LAS float*)(F.lds + RING_OFF + 4608);
    LAS bf16* QS = (LAS bf16*)(F.lds + RING_OFF + 8192);
    LAS bf16* KS = (LAS bf16*)(F.lds + RING_OFF + 25600);
    LAS bf16* VR = (LAS bf16*)(F.lds + RING_OFF + 43008);
    const size_t uc = (size_t)bh * NCH + c;
    const bf16* Zc = P_Z + (size_t)row0 * N1P;
    {
        v4u pq[2], pk[2], pv[4];
#pragma unroll
        for (int k = 0; k < 2; ++k) { const int p = tid + 512 * k, i = p >> 4, ch = p & 15;
            pq[k] = *(const GAS v4u*)(Zc + (size_t)i * N1P + ZQ + h * HK + 8 * ch); pk[k] = *(const GAS v4u*)(Zc + (size_t)i * N1P + ZK + h * HK + 8 * ch); }
#pragma unroll
        for (int k = 0; k < 4; ++k) { const int p = tid + 512 * k, i = p >> 5, ch = p & 31; pv[k] = *(const GAS v4u*)(Zc + (size_t)i * N1P + ZV + h * HV + 8 * ch); }
        v4u pg = (v4u){0u, 0u, 0u, 0u};
        if (tid < 128) pg = *(const GAS v4u*)(Zc + (size_t)(tid >> 1) * N1P + ZGL + 8 * (tid & 1));
#pragma unroll
        for (int k = 0; k < 2; ++k) { const int p = tid + 512 * k, i = p >> 4, ch = p & 15; *(LAS v4u*)(QS + i * 136 + 8 * ch) = pq[k]; *(LAS v4u*)(KS + i * 136 + 8 * ch) = pk[k]; }
#pragma unroll
        for (int k = 0; k < 4; ++k) { const int p = tid + 512 * k, i = p >> 5, ch = p & 31; *(LAS v4u*)(VR + i * 264 + 8 * ch) = pv[k]; }
        if (tid < 128) { LAS float* gp = GL + (tid >> 1) * 17 + 8 * (tid & 1);
            gp[0] = bflo(pg.x); gp[1] = bfhi(pg.x); gp[2] = bflo(pg.y); gp[3] = bfhi(pg.y); gp[4] = bflo(pg.z); gp[5] = bfhi(pg.z); gp[6] = bflo(pg.w); gp[7] = bfhi(pg.w); }
    }
    const int d = tid & 127, g = tid >> 7;
    float wg[16];
#pragma unroll
    for (int r = 0; r < 16; ++r) wg[r] = P_wgu[r * DK + h * HK + d];
    const float bg = P_bgate[h * HK + d];
    __syncthreads();
    float bcum[16]; float run = 0.f;
#pragma unroll
    for (int ii = 0; ii < 16; ++ii) { const int i = g * 16 + ii; float x = bg;
#pragma unroll
        for (int r = 0; r < 16; ++r) x += GL[i * 17 + r] * wg[r];
        run += logsigmoid_f(x) * (1.0f / 16.0f); bcum[ii] = run; }
    BL[g * 128 + d] = run;
    __syncthreads();
    float off = 0.f, tot = 0.f;
#pragma unroll
    for (int gg = 0; gg < 4; ++gg) { const float t = BL[gg * 128 + d]; off += (gg < g) ? t : 0.f; tot += t; }
    const float scale = 0.08838834764831845f;
    unsigned khw[8];
#pragma unroll
    for (int ii = 0; ii < 16; ++ii) { const int i = g * 16 + ii; const float bb = bcum[ii] + off;
        const float q = bf2f(QS[i * 136 + d]) * scale * __expf(bb);
        const float kv = bf2f(KS[i * 136 + d]);
        const unsigned qb = f2bf(q), ktb = f2bf(kv * __expf(-bb)), khb = f2bf(kv * __expf(tot - bb));
        QS[i * 136 + d] = (bf16)qb; KS[i * 136 + d] = (bf16)ktb;
        if (ii & 1) khw[ii >> 1] |= khb << 16; else khw[ii >> 1] = khb; }
    { GAS v4u* kp = (GAS v4u*)(P_KH + (uc * 128 + d) * 64 + g * 16);
      kp[0] = (v4u){khw[0], khw[1], khw[2], khw[3]}; kp[1] = (v4u){khw[4], khw[5], khw[6], khw[7]}; }
    if (g == 0) P_DCb[uc * 128 + d] = __expf(tot);
    { const int n = tid & 255, jh = tid >> 8; unsigned vw[16];
#pragma unroll
      for (int jj = 0; jj < 32; ++jj) { const unsigned v = VR[(32 * jh + jj) * 264 + n];
          if (jj & 1) vw[jj >> 1] |= v << 16; else vw[jj >> 1] = v; }
      GAS v4u* vp = (GAS v4u*)(P_VT + (uc * 256 + n) * 64 + 32 * jh);
#pragma unroll
      for (int k = 0; k < 4; ++k) vp[k] = (v4u){vw[4 * k], vw[4 * k + 1], vw[4 * k + 2], vw[4 * k + 3]}; }
    __syncthreads();
    {
#pragma unroll
        for (int k = 0; k < 2; ++k) { const int p = tid + 512 * k, i = p >> 4, s = (p >> 2) & 3, fq = p & 3;
            const v2u lo = *(const LAS v2u*)(QS + i * 136 + 32 * s + 4 * fq), hi = *(const LAS v2u*)(QS + i * 136 + 32 * s + 16 + 4 * fq);
            *(GAS v4u*)(P_QT + (uc * 64 + i) * 128 + 32 * s + 8 * fq) = (v4u){lo.x, lo.y, hi.x, hi.y}; }
    }
    { const int fr = F.lane & 15, fq = F.lane >> 4;
#pragma unroll
      for (int tt = 0; tt < 2; ++tt) { const int id = 2 * F.wave + tt, it = id >> 2, jt = id & 3;
          f32x4 acc = (f32x4){0.f, 0.f, 0.f, 0.f};
          if (jt <= it) {
#pragma unroll
              for (int s = 0; s < 4; ++s) { const bf16x8 a = *(const LAS bf16x8*)(KS + (jt * 16 + fr) * 136 + 32 * s + 8 * fq); const bf16x8 bq = *(const LAS bf16x8*)(QS + (it * 16 + fr) * 136 + 32 * s + 8 * fq);
                  acc = __builtin_amdgcn_mfma_f32_16x16x32_bf16(a, bq, acc, 0, 0, 0); } }
          const int i = it * 16 + fr, j0 = jt * 16 + 4 * fq;
#pragma unroll
          for (int r = 0; r < 4; ++r) if (j0 + r > i) acc[r] = 0.f;
          v2u o; o.x = pk2(acc[0], acc[1]); o.y = pk2(acc[2], acc[3]);
          *(GAS v2u*)(P_AM + (uc * 64 + i) * 64 + j0) = o; } }
    __syncthreads();
}
__device__ __forceinline__ void ln_silu_row(const LAS float* cs, const float* lng, const float* lnb, bf16* orow, int lane) {
    f32x4 x[4]; float s = 0.f;
#pragma unroll
    for (int j = 0; j < 4; ++j) { x[j] = *(const LAS f32x4*)(cs + 256 * j + 4 * lane); s += (x[j].x + x[j].y) + (x[j].z + x[j].w); }
    const float mean = wave_sum(s) * (1.f / DC_); float q = 0.f;
#pragma unroll
    for (int j = 0; j < 4; ++j) { x[j] = x[j] - mean; q += dot4(x[j], x[j]); }
    const float rstd = 1.0f / sqrtf(wave_sum(q) * (1.f / DC_) + LN_EPS);
#pragma unroll
    for (int j = 0; j < 4; ++j) { const f32x4 g = *(const GAS f32x4*)(lng + 256 * j + 4 * lane), bb = *(const GAS f32x4*)(lnb + 256 * j + 4 * lane);
        const f32x4 y = x[j] * rstd * g + bb; v2u o; o.x = pk2(silu_f(y.x), silu_f(y.y)); o.y = pk2(silu_f(y.z), silu_f(y.w));
        *(GAS v2u*)(orow + 256 * j + 4 * lane) = o; }
}
__device__ __forceinline__ void conv_prompt_unit(Frame& F, const Args& A, int b, int tb) {
    LAS float* CS = (LAS float*)(F.lds + RING_OFF);
    const int t0 = tb * 16, c = 2 * F.tid;
    f32x2 wt[31];
#pragma unroll
    for (int w = 0; w < 31; ++w) wt[w] = *(const GAS f32x2*)(P_conv_w + w * DC_ + c);
    const f32x2 bias = *(const GAS f32x2*)(P_conv_b + c);
    f32x2 acc[16];
#pragma unroll
    for (int tt = 0; tt < 16; ++tt) acc[tt] = bias;
#pragma unroll
    for (int r = 0; r < 46; ++r) { const int t = t0 - 30 + r, tc = t < 0 ? 0 : t; const bf16* zr = P_Z + (size_t)(b * SEQ + tc) * N1P;
        const unsigned ua = *(const GAS unsigned*)(zr + ZUA + c), ug = *(const GAS unsigned*)(zr + ZUG + c);
        const float m = t >= 0 ? 1.f : 0.f;
        f32x2 g; g.x = m * bflo(ua) * sigmoid_f(bflo(ug)); g.y = m * bfhi(ua) * sigmoid_f(bfhi(ug));
#pragma unroll
        for (int tt = 0; tt < 16; ++tt) { if (r - tt >= 0 && r - tt < 31) acc[tt] += g * wt[(r - tt >= 0 && r - tt < 31) ? r - tt : 0]; }
        if ((r & 3) == 3) { asm volatile("" ::: "memory"); __builtin_amdgcn_sched_barrier(0); }
    }
#pragma unroll
    for (int tt = 0; tt < 16; ++tt) *(LAS f32x2*)(CS + tt * 1024 + c) = acc[tt];
    __syncthreads();
#pragma unroll
    for (int k = 0; k < 2; ++k) { const int tt = 2 * F.wave + k; ln_silu_row(CS + tt * 1024, P_ln_g, P_ln_b, P_MIX + (size_t)(b * SEQ + t0 + tt) * DM + DA, F.lane); }
    __syncthreads();
}
__device__ __forceinline__ void conv_state_prompt_row(Frame& F, const Args& A, int b, int rr) {
    const bf16* zr = P_Z + (size_t)(b * SEQ + SEQ - 30 + rr) * N1P; float* orow = P_out + O_CP + ((size_t)b * 30 + rr) * DC_;
#pragma unroll
    for (int j = 0; j < 4; ++j) { const int c = 256 * j + 4 * F.lane; const v2u ua = *(const GAS v2u*)(zr + ZUA + c), ug = *(const GAS v2u*)(zr + ZUG + c);
        f32x4 g; g.x = bflo(ua.x) * sigmoid_f(bflo(ug.x)); g.y = bfhi(ua.x) * sigmoid_f(bfhi(ug.x)); g.z = bflo(ua.y) * sigmoid_f(bflo(ug.y)); g.w = bfhi(ua.y) * sigmoid_f(bfhi(ug.y));
        *(GAS f32x4*)(orow + c) = g; }
}
__device__ __forceinline__ void conv_sample_unit(Frame& F, const Args& A, int b) {
    LAS float* CS = (LAS float*)(F.lds + RING_OFF);
    const bf16* zr = P_Z + (size_t)(MP + b) * N1P;
    const int c = 2 * F.tid;
    f32x2 acc = *(const GAS f32x2*)(P_conv_b + c);
    f32x2 hv[30];
#pragma unroll
    for (int w = 0; w < 30; ++w) hv[w] = *(const GAS f32x2*)(P_sconv + ((size_t)b * 30 + w) * DC_ + c);
    const unsigned ua = *(const GAS unsigned*)(zr + ZUA + c), ug = *(const GAS unsigned*)(zr + ZUG + c);
#pragma unroll
    for (int w = 0; w < 30; ++w) { acc += hv[w] * *(const GAS f32x2*)(P_conv_w + w * DC_ + c); if (w >= 1) *(GAS f32x2*)(P_out + O_CS + ((size_t)b * 30 + (w - 1)) * DC_ + c) = hv[w]; }
    f32x2 gl; gl.x = bflo(ua) * sigmoid_f(bflo(ug)); gl.y = bfhi(ua) * sigmoid_f(bfhi(ug));
    acc += gl * *(const GAS f32x2*)(P_conv_w + 30 * DC_ + c);
    *(GAS f32x2*)(P_out + O_CS + ((size_t)b * 30 + 29) * DC_ + c) = gl;
    *(LAS f32x2*)(CS + c) = acc;
    __syncthreads();
    if (F.wave == 0) ln_silu_row(CS, P_ln_g, P_ln_b, P_MIX + (size_t)(MP + b) * DM + DA, F.lane);
    __syncthreads();
}
__device__ __forceinline__ void gla_sample_item(Frame& F, const Args& A, int item) {
    const int b = item >> 2, h = item & 3, tid = F.tid;
    LAS float* AD = (LAS float*)(F.lds + RING_OFF);
    LAS float* KD = AD + 128; LAS float* QD = AD + 256; LAS float* VD = AD + 384;
    LAS float* OP = AD + 640;
    const bf16* zr = P_Z + (size_t)(MP + b) * N1P;
    const int n4 = 4 * F.lane;
    const float* Sin = P_sgla + (size_t)(b * NH + h) * HK * HV; float* Sout = P_out + O_GS + (size_t)(b * NH + h) * HK * HV;
    f32x4 s[16];
#pragma unroll
    for (int dd = 0; dd < 16; ++dd) s[dd] = *(const GAS f32x4*)(Sin + (size_t)(16 * F.wave + dd) * HV + n4);
    if (tid < 128) { const int d = tid; float x = P_bgate[h * HK + d];
#pragma unroll
        for (int r = 0; r < 16; ++r) x += bf2f(zr[ZGL + r]) * P_wgu[r * DK + h * HK + d];
        AD[d] = __expf(logsigmoid_f(x) * (1.0f / 16.0f)); KD[d] = bf2f(zr[ZK + h * HK + d]); QD[d] = bf2f(zr[ZQ + h * HK + d]) * 0.08838834764831845f; }
    else if (tid < 384) { const int n = tid - 128; VD[n] = bf2f(zr[ZV + h * HV + n]); }
    __syncthreads();
    const f32x4 v4 = *(const LAS f32x4*)(VD + n4);
    f32x4 oacc = (f32x4){0.f, 0.f, 0.f, 0.f};
#pragma unroll
    for (int dd = 0; dd < 16; ++dd) { const int d = 16 * F.wave + dd;
        const f32x4 sn = s[dd] * AD[d] + v4 * KD[d]; *(GAS f32x4*)(Sout + (size_t)d * HV + n4) = sn; oacc += sn * QD[d]; }
    *(LAS f32x4*)(OP + F.wave * 256 + n4) = oacc;
    __syncthreads();
    if (F.wave == 0) { f32x4 o4 = (f32x4){0.f, 0.f, 0.f, 0.f};
#pragma unroll
        for (int w = 0; w < 8; ++w) o4 += *(const LAS f32x4*)(OP + w * 256 + n4);
        const float rstd = 1.0f / sqrtf(wave_sum(dot4(o4, o4)) * (1.f / HV) + RMS_EPS);
        const f32x4 gn = *(const GAS f32x4*)(P_gla_norm + n4); const v2u go = *(const GAS v2u*)(zr + ZGO + h * HV + n4);
        v2u o; o.x = pk2(o4.x * rstd * gn.x * silu_f(bflo(go.x)), o4.y * rstd * gn.y * silu_f(bfhi(go.x))); o.y = pk2(o4.z * rstd * gn.z * silu_f(bflo(go.y)), o4.w * rstd * gn.w * silu_f(bfhi(go.y)));
        *(GAS v2u*)(P_MIX + (size_t)(MP + b) * DM + h * HV + n4) = o; }
    __syncthreads();
}
constexpr int SQ_AM = 0, SQ_QT = 9216, SQ_KH = 26624, SQ_VT = 45056, SQ_DC = 49664, SQ_BUF = 50176, SQ_NP = 2848, SQ_LT = 384;
__device__ __forceinline__ void seq_issue(v4u (&R)[8], const bf16* AMc, const bf16* QTc, const bf16* KHc, const bf16* VTc, const float* DCc, int lt) {
#pragma unroll
    for (int k = 0; k < 8; ++k) { const int P = lt + SQ_LT * k; const bf16* src = AMc;
        if (P < 512) src = AMc + (P >> 3) * 64 + (P & 7) * 8;
        else if (P < 1536) { const int q = P - 512; src = QTc + (q >> 4) * 128 + (q & 15) * 8; }
        else if (P < 2560) { const int q = P - 1536; src = KHc + (q >> 3) * 64 + (q & 7) * 8; }
        else if (P < 2816) { const int q = P - 2560; src = VTc + (q >> 3) * 64 + (q & 7) * 8; }
        else if (P < SQ_NP) { const int q = P - 2816; src = (const bf16*)DCc + q * 8; }
        R[k] = *(const GAS v4u*)src; }
}
__device__ __forceinline__ void seq_stash(const v4u (&R)[8], LAS unsigned char* buf, int lt) {
#pragma unroll
    for (int k = 0; k < 8; ++k) { const int P = lt + SQ_LT * k; int dst = 0;
        if (P < 512) dst = SQ_AM + (P >> 3) * 144 + (P & 7) * 16;
        else if (P < 1536) { const int q = P - 512; dst = SQ_QT + (q >> 4) * 272 + (q & 15) * 16; }
        else if (P < 2560) { const int q = P - 1536; dst = SQ_KH + (q >> 3) * 144 + (q & 7) * 16; }
        else if (P < 2816) { const int q = P - 2560; dst = SQ_VT + (q >> 3) * 144 + (q & 7) * 16; }
        else { const int q = P - 2816; dst = SQ_DC + q * 16; }
        if (P < SQ_NP) *(LAS v4u*)(buf + dst) = R[k]; }
}
__device__ __forceinline__ void gla_seq_wg(Frame& F, const Args& A, int item) {
    const int bh = item >> 3, grp = item & 7, b = bh >> 2, h = bh & 3, fr = F.lane & 15, fq = F.lane >> 4;
    LAS unsigned char* lds0 = F.lds + RING_OFF;
    const bool loader = F.wave >= 2; const int lt = F.tid - 128;
    const size_t uc0 = (size_t)bh * NCH;
    const bf16* AM0 = P_AM + uc0 * 64 * 64; const bf16* QT0 = P_QT + uc0 * 64 * 128; const bf16* KH0 = P_KH + uc0 * 128 * 64; const bf16* VT0 = P_VT + uc0 * 256 * 64 + (size_t)(grp * 32) * 64; const float* DC0 = P_DCb + uc0 * 128;
    v4u RA[8], RB[8];
    f32x4 S[8];
#pragma unroll
    for (int dt = 0; dt < 8; ++dt) S[dt] = (f32x4){0.f, 0.f, 0.f, 0.f};
#define SEQ_ISSUE(R, CC) do { const size_t o_ = (size_t)(CC); seq_issue(R, AM0 + o_ * 64 * 64, QT0 + o_ * 64 * 128, KH0 + o_ * 128 * 64, VT0 + o_ * 256 * 64, DC0 + o_ * 128, lt); } while (0)
    if (loader) { SEQ_ISSUE(RA, 0); SEQ_ISSUE(RB, 1); seq_stash(RA, lds0, lt); SEQ_ISSUE(RA, 2); }
    __syncthreads();
    const int n0 = grp * 32 + 16 * F.wave;
#define SEQ_COMPUTE(CC) do { \
            const LAS unsigned char* buf = lds0 + ((CC) & 1) * SQ_BUF; \
            bf16x8 vt[2]; \
_Pragma("unroll") \
            for (int ks = 0; ks < 2; ++ks) vt[ks] = *(const LAS bf16x8*)(buf + SQ_VT + (16 * F.wave + fr) * 144 + (32 * ks + 8 * fq) * 2); \
            f32x4 o[4]; \
_Pragma("unroll") \
            for (int m = 0; m < 4; ++m) { o[m] = (f32x4){0.f, 0.f, 0.f, 0.f}; \
_Pragma("unroll") \
                for (int ks = 0; ks < 2; ++ks) { const bf16x8 a = *(const LAS bf16x8*)(buf + SQ_AM + (16 * m + fr) * 144 + (32 * ks + 8 * fq) * 2); o[m] = __builtin_amdgcn_mfma_f32_16x16x32_bf16(vt[ks], a, o[m], 0, 0, 0); } } \
            bf16x8 sb[4]; \
_Pragma("unroll") \
            for (int s = 0; s < 4; ++s) { v4u w; w.x = pk2(S[2 * s][0], S[2 * s][1]); w.y = pk2(S[2 * s][2], S[2 * s][3]); w.z = pk2(S[2 * s + 1][0], S[2 * s + 1][1]); w.w = pk2(S[2 * s + 1][2], S[2 * s + 1][3]); sb[s] = __builtin_bit_cast(bf16x8, w); } \
_Pragma("unroll") \
            for (int m = 0; m < 4; ++m) \
_Pragma("unroll") \
                for (int s = 0; s < 4; ++s) { const bf16x8 a = *(const LAS bf16x8*)(buf + SQ_QT + (16 * m + fr) * 272 + (32 * s + 8 * fq) * 2); o[m] = __builtin_amdgcn_mfma_f32_16x16x32_bf16(sb[s], a, o[m], 0, 0, 0); } \
_Pragma("unroll") \
            for (int m = 0; m < 4; ++m) *(GAS f32x4*)(P_O32 + (size_t)(b * SEQ + (CC) * CH + 16 * m + fr) * DA + h * HV + n0 + 4 * fq) = o[m]; \
_Pragma("unroll") \
            for (int dt = 0; dt < 8; ++dt) { const f32x4 dc = *(const LAS f32x4*)(buf + SQ_DC + (16 * dt + 4 * fq) * 4); S[dt] = S[dt] * dc; \
_Pragma("unroll") \
                for (int ks = 0; ks < 2; ++ks) { const bf16x8 a = *(const LAS bf16x8*)(buf + SQ_KH + (16 * dt + fr) * 144 + (32 * ks + 8 * fq) * 2); S[dt] = __builtin_amdgcn_mfma_f32_16x16x32_bf16(a, vt[ks], S[dt], 0, 0, 0); } } \
        } while (0)
#pragma unroll 1
    for (int c = 0; c < NCH; c += 2) {
        if (loader) { seq_stash(RB, lds0 + SQ_BUF, lt); if (c + 3 < NCH) SEQ_ISSUE(RB, c + 3); }
        else SEQ_COMPUTE(c);
        __syncthreads();
        if (loader) { if (c + 2 < NCH) seq_stash(RA, lds0, lt); if (c + 4 < NCH) SEQ_ISSUE(RA, c + 4); }
        else SEQ_COMPUTE(c + 1);
        __syncthreads();
    }
#undef SEQ_COMPUTE
#undef SEQ_ISSUE
    if (!loader) {
#pragma unroll
        for (int dt = 0; dt < 8; ++dt)
#pragma unroll
            for (int r = 0; r < 4; ++r) P_out[O_GP + ((size_t)bh * HK + 16 * dt + 4 * fq + r) * HV + n0 + fr] = S[dt][r];
    }
}
__device__ __forceinline__ void gla_onorm_item(Frame& F, const Args& A, int row, int h) {
    const int n4 = 4 * F.lane;
    const f32x4 o4 = *(const GAS f32x4*)(P_O32 + (size_t)row * DA + h * HV + n4);
    const float rstd = 1.0f / sqrtf(wave_sum(dot4(o4, o4)) * (1.f / HV) + RMS_EPS);
    const f32x4 gn = *(const GAS f32x4*)(P_gla_norm + n4); const v2u go = *(const GAS v2u*)(P_Z + (size_t)row * N1P + ZGO + h * HV + n4);
    v2u o; o.x = pk2(o4.x * rstd * gn.x * silu_f(bflo(go.x)), o4.y * rstd * gn.y * silu_f(bfhi(go.x))); o.y = pk2(o4.z * rstd * gn.z * silu_f(bflo(go.y)), o4.w * rstd * gn.w * silu_f(bfhi(go.y)));
    *(GAS v2u*)(P_MIX + (size_t)row * DM + h * HV + n4) = o;
}
constexpr int NKP2 = 2, NKP4 = 4;

#ifdef EXTRA_PHASE
#define MK_N_LAUNCHES 10
#endif
#ifndef MK_N_LAUNCHES
#define MK_N_LAUNCHES 1
#endif
constexpr int N_PHASES = 10;
constexpr int N_LAUNCHES = MK_N_LAUNCHES;
__global__ void __launch_bounds__(NWAVES * 64, 2) hymba_fwd(Args args) {
    extern __shared__ __attribute__((aligned(16))) unsigned char lds[];
    Frame F;
    F.lds = (LAS unsigned char*)lds;
    F.MISC = (volatile LAS unsigned*)(F.lds + MISC_OFF);
    F.tid = threadIdx.x; F.lane = F.tid & 63; F.wave = __builtin_amdgcn_readfirstlane(F.tid >> 6);
    F.G = gridDim.x; { const int bx = blockIdx.x; F.vcu = (F.G % 8 == 0) ? (bx % 8) * (F.G / 8) + bx / 8 : bx; }
    const Args& A = args;
    F.ctl = (gu32*)(args.ws + WS_CTL);
    for (int u = F.tid; u < (LDS_BYTES - LDSCTL_OFF) / 4; u += NWAVES * 64) ((LAS unsigned*)(F.lds + LDSCTL_OFF))[u] = 0u;
    __syncthreads();
    XcdBarrier bar; bar.bar = (unsigned*)(F.ctl + CW_BAR); bar.x = 0; bar.st = nullptr;
    if (N_LAUNCHES == 1) bar = xcd_barrier_post((unsigned*)(F.ctl + CW_BAR), F.MISC + 8);
    const int lo = args.ph_lo, hi = args.ph_hi;
#ifndef REP_MASK
#define REP_MASK 0
#endif
#define REPS(k) (((REP_MASK >> (k)) & 1) ? 2 : 1)
#ifndef P2A_REP
#define P2A_REP 0
#endif
#ifndef P2A_MASK
#define P2A_MASK 15
#endif
#ifndef PH_MASK
#define PH_MASK 0x3ff
#endif
#define IN(k) (((PH_MASK >> (k)) & 1) && lo <= (k) && (k) < hi)
#define SEAM(k) do { if (IN(k) && IN((k) + 1)) xcd_barrier(bar); } while (0)
    const int gw = F.vcu * NWAVES + F.wave, NGW = F.G * NWAVES;

    if (IN(0)) for (int rep_ = 0; rep_ < REPS(0); ++rep_) { p0_prologue(F, A); }
    SEAM(0);
    if (IN(1)) for (int rep_ = 0; rep_ < REPS(1); ++rep_) {
        pg8::Gemm g{P_H, P_W1t, MPAD, N1P, DM}; pg8::StaticOrder S; S.init(MPAD, N1P, F.G, (int)blockIdx.x);
        pg8::EpiStoreBf16 E{P_Z, N1P};
        pg8::gemm_phase<pg8::EpiStoreBf16, pg8::StaticOrder, true, true>(F.lds + RING_OFF, g, S, E);
    }
    SEAM(1);
    if (IN(2)) for (int rep_ = 0; rep_ < REPS(2); ++rep_) {
        constexpr int U_PREP = NB * NH * NCH, U_CONVP = NB * (SEQ / 16), U_CONVS = MS;
        for (int q_ = 0; q_ < ((P2A_REP & 2) ? 2 : 1); ++q_) if (P2A_MASK & 2) { for (int r = F.vcu; r < U_PREP; r += F.G) gla_prep_unit(F, A, r / NCH, r % NCH); }
        for (int q_ = 0; q_ < ((P2A_REP & 4) ? 2 : 1); ++q_) if (P2A_MASK & 4) { for (int r = F.vcu; r < U_CONVP; r += F.G) conv_prompt_unit(F, A, r / (SEQ / 16), r % (SEQ / 16)); }
        { const int gw2 = F.vcu * NWAVES + F.wave; for (int r = gw2; r < NB * 30; r += F.G * NWAVES) conv_state_prompt_row(F, A, r / 30, r % 30); }
        for (int q_ = 0; q_ < ((P2A_REP & 8) ? 2 : 1); ++q_) if (P2A_MASK & 8) { for (int r = F.G - 1 - F.vcu; r < U_CONVS; r += F.G) conv_sample_unit(F, A, r); }
    }
    SEAM(2);
    if (IN(3)) for (int rep_ = 0; rep_ < REPS(3); ++rep_) {
        { const int bx = (int)blockIdx.x; if (bx < NB * NH * 8) gla_seq_wg(F, A, (bx & 7) * (NB * NH) + (bx >> 3));
          else { const int nrest = F.G - NB * NH * 8; for (int r = bx - NB * NH * 8; r < MS * NH; r += nrest) gla_sample_item(F, A, r); } }
    }
    SEAM(3);
    if (IN(4)) for (int rep_ = 0; rep_ < REPS(4); ++rep_) { for (int it = gw; it < MP * NH; it += NGW) gla_onorm_item(F, A, it >> 2, it & 3); }
    SEAM(4);
    if (IN(5)) for (int rep_ = 0; rep_ < REPS(5); ++rep_) {
        pg8::Gemm g{P_MIX, P_W2t, MPAD, DM, DM}; pg8::TailSplitOrder S; S.init_ts(MP, DM, DM, F.G, (int)blockIdx.x, NKP2);
        pg8::EpiResF32 E{P_xp, P_xs, P_out, DM, MP, MP, (float*)(A.ws + WS_SK2)};
        pg8::gemm_phase<pg8::EpiResF32, pg8::TailSplitOrder, true, true>(F.lds + RING_OFF, g, S, E);
    }
    SEAM(5);
    if (IN(6)) for (int rep_ = 0; rep_ < REPS(6); ++rep_) {
        for (int r = F.vcu; r < MS; r += F.G)
            sample_row_unit<(DM / 64) / NKP2>(P_xs + (size_t)r * DM, (const float*)(A.ws + WS_SK2) + (size_t)r * DM, (size_t)128 * DM, P_norm_ffn, P_out + (size_t)(MP + r) * DM, P_H + (size_t)(MP + r) * DM, nullptr, (LAS float*)(F.lds + RING_OFF), F.wave, F.lane);
        for (int m = NGW - 1 - gw; m < MP; m += NGW) rms_row_to_bf16(P_out + (size_t)m * DM, P_norm_ffn, P_H + (size_t)m * DM, F.lane); }
    SEAM(6);
    if (IN(7)) for (int rep_ = 0; rep_ < REPS(7); ++rep_) {
        pg8::Gemm g{P_H, P_W3t, MPAD, 2 * DFF, DM}; pg8::StaticOrder S; S.init(MPAD, 2 * DFF, F.G, (int)blockIdx.x);
        pg8::EpiSwiglu E{P_HID, DFF};
        pg8::gemm_phase<pg8::EpiSwiglu, pg8::StaticOrder, true, true>(F.lds + RING_OFF, g, S, E);
    }
    SEAM(7);
    if (IN(8)) for (int rep_ = 0; rep_ < REPS(8); ++rep_) {
        pg8::Gemm g{P_HID, P_W4t, MPAD, DM, DFF}; pg8::TailSplitOrder S; S.init_ts(MP, DM, DFF, F.G, (int)blockIdx.x, NKP4);
        pg8::EpiResF32 E{P_out, P_out, P_out, DM, MP, MP, (float*)(A.ws + WS_SK4)};
        pg8::gemm_phase<pg8::EpiResF32, pg8::TailSplitOrder, true, true>(F.lds + RING_OFF, g, S, E);
    }
    SEAM(8);
    if (IN(9)) for (int rep_ = 0; rep_ < REPS(9); ++rep_) {
        for (int r = F.vcu; r < MS; r += F.G)
            sample_row_unit<(DFF / 64) / NKP4>(P_out + (size_t)(MP + r) * DM, (const float*)(A.ws + WS_SK4) + (size_t)r * DM, (size_t)128 * DM, P_norm_final, nullptr, nullptr, P_out + (size_t)(MP + r) * DM, (LAS float*)(F.lds + RING_OFF), F.wave, F.lane);
        for (int m = NGW - 1 - gw; m < MP; m += NGW) rms_row_inplace(P_out + (size_t)m * DM, P_norm_final, F.lane); }
#undef IN
#undef SEAM
}

extern "C" void kernel_launch(void* const* d_in, const int* in_sizes, int n_in, void* d_out, int out_size, void* d_ws, size_t ws_size, hipStream_t stream) {
    static int grid = 0;
    if (grid == 0) {
        if (n_in != 18 || in_sizes[0] != MP * DM || (size_t)out_size != O_END || ws_size < WS_END) {
            fprintf(stderr, "kernel_launch: shape mismatch: n_in %d in0 %d out %d ws %zu (need %zu); nothing launched\n", n_in, n_in > 0 ? in_sizes[0] : -1, out_size, ws_size, (size_t)WS_END); grid = -1; return; }
        int dev = 0, cus = 0, per_cu = 0;
        if (hipGetDevice(&dev) != hipSuccess || hipDeviceGetAttribute(&cus, hipDeviceAttributeMultiprocessorCount, dev) != hipSuccess) { grid = -1; return; }
        if (hipFuncSetAttribute((const void*)hymba_fwd, hipFuncAttributeMaxDynamicSharedMemorySize, LDS_BYTES) != hipSuccess) { fprintf(stderr, "kernel_launch: hipFuncSetAttribute failed\n"); grid = -1; return; }
        if (hipOccupancyMaxActiveBlocksPerMultiprocessor(&per_cu, (const void*)hymba_fwd, NWAVES * 64, LDS_BYTES) != hipSuccess || per_cu < 1)
            fprintf(stderr, "kernel_launch: note: occupancy query reports %d workgroups per CU\n", per_cu);
        (void)hipGetLastError();
        grid = cus;
    }
    if (grid < 0) return;
    if (N_LAUNCHES == 1) { if (hipMemsetAsync((char*)d_ws + WS_CTL, 0, CTL_ZERO_BYTES, stream) != hipSuccess) return; }
    Args a{};
    for (int i = 0; i < 18; ++i) a.in[i] = (const float*)d_in[i];
    a.out = (float*)d_out; a.ws = (unsigned char*)d_ws;
    for (int li = 0; li < N_LAUNCHES; ++li) {
        a.ph_lo = (N_LAUNCHES == 1) ? 0 : li; a.ph_hi = (N_LAUNCHES == 1) ? N_PHASES : li + 1;
        hipLaunchKernelGGL(hymba_fwd, dim3(grid), dim3(NWAVES * 64), LDS_BYTES, stream, a);
        const hipError_t le = hipPeekAtLastError();
        if (le != hipSuccess) { fprintf(stderr, "kernel_launch: launch %d failed: %s\n", li, hipGetErrorName(le)); break; }
#ifdef EXTRA_PHASE
        if (N_LAUNCHES != 1 && li == EXTRA_PHASE) hipLaunchKernelGGL(hymba_fwd, dim3(grid), dim3(NWAVES * 64), LDS_BYTES, stream, a);
#endif
    }
}
```

```cpp
#include <hip/hip_runtime.h>
#include <cstdio>
#include <cstdint>
constexpr int PG8_DUMMY = 0;
namespace pg8 {
#define PG8_LAS __attribute__((address_space(3)))
typedef unsigned short bf16_t;
typedef short bf16x8 __attribute__((ext_vector_type(8)));
typedef float f32x4 __attribute__((ext_vector_type(4)));
typedef unsigned u32x4 __attribute__((ext_vector_type(4)));
constexpr int BM = 256, BK = 64, HALF = 128, HTB = HALF * BK * 2  , STAGE_BYTES = 8 * HTB, NXCD = 8, WGM = 8;

__host__ __device__ __forceinline__ int lds_byte(int r, int c) { const int st = (r >> 4) * 2 + (c >> 5), rr = r & 15, cc = c & 31, ob = rr * 64 + cc * 2; return st * 1024 + (ob ^ (((ob >> 9) & 1) << 5)); }
__host__ __device__ __forceinline__ void stage_rc(int b, int& R, int& C) { const int st = b / 1024, sb = b % 1024, swz = sb ^ (((sb >> 9) & 1) << 5); R = (st >> 1) * 16 + swz / 64; C = (st & 1) * 32 + (swz % 64) / 2; }
__host__ __device__ __forceinline__ int perm32(int rho) { const int n = rho >> 4, i = rho & 15; return 8 * (i >> 2) + 4 * n + (i & 3); }

struct Unit { int pm, pn, k0, nk, mode, slot; };
struct Gemm { const bf16_t* A; const bf16_t* Bt; int M, N, K; };

struct StaticOrder {
    static constexpr bool SK = false;
    int nM, nN, nwg, G, c;
    __host__ __device__ __forceinline__ void init(int M, int N, int G_, int c_) { nM = M / BM; nN = N / BM; nwg = nM * nN; G = G_; c = c_; }
    __host__ __device__ __forceinline__ bool next(int i, Unit& u) const {
        const long L = (long)i * G + c; const bool ok = L < nwg;
        int wgid = ok ? (int)L : 0; { const int q = nwg / NXCD, r = nwg % NXCD, xcd = wgid % NXCD, off = wgid / NXCD; wgid = (xcd < r ? xcd * (q + 1) : r * (q + 1) + (xcd - r) * q) + off; }
        const int nig = WGM * nN, gid = wgid / nig, fm = gid * WGM, gsz = (nM - fm) < WGM ? (nM - fm) : WGM;
        u.pm = fm + ((wgid % nig) % gsz); u.pn = (wgid % nig) / gsz; return ok;
    }
    __device__ __forceinline__ void a_ready(const Unit&) const {}
    __device__ __forceinline__ void done(const Unit&) const {}
};
__device__ __forceinline__ unsigned cvt_pk_bf16(float lo, float hi) { unsigned r; asm volatile("v_cvt_pk_bf16_f32 %0, %1, %2" : "=v"(r) : "v"(lo), "v"(hi)); return r; }
typedef float f32x2 __attribute__((ext_vector_type(2)));
typedef unsigned u32x2v __attribute__((ext_vector_type(2)));
__device__ __forceinline__ float silu_f(float x) { return x * __builtin_amdgcn_rcpf(1.0f + __expf(-x)); }
struct EpiStoreBf16 {
    static constexpr bool PERM = true, AFTER_DRAIN = false, HAS_INIT = false;
    bf16_t* O; int ldc;
    __device__ __forceinline__ void operator()(const f32x4 (&acc)[2][2][4][2], const Unit& u, int wr, int wc, int fr, int fq) const {
        const int row0 = u.pm * BM + wr * 64 + fr, col0 = u.pn * BM + wc * 32 + 8 * fq;
#pragma unroll
        for (int ai = 0; ai < 2; ++ai)
#pragma unroll
            for (int m = 0; m < 4; ++m) { bf16_t* rowp = O + (size_t)(row0 + ai * HALF + m * 16) * ldc + col0;
#pragma unroll
                for (int bj = 0; bj < 2; ++bj) { const f32x4 v0 = acc[ai][bj][m][0], v1 = acc[ai][bj][m][1];
                    u32x4 w; w.x = cvt_pk_bf16(v0[0], v0[1]); w.y = cvt_pk_bf16(v0[2], v0[3]); w.z = cvt_pk_bf16(v1[0], v1[1]); w.w = cvt_pk_bf16(v1[2], v1[3]);
                    *(u32x4*)(rowp + bj * HALF) = w; } }
    }
};
struct EpiSwiglu {
    static constexpr bool PERM = true, AFTER_DRAIN = false, HAS_INIT = false;
    bf16_t* O; int ldc;
    __device__ __forceinline__ void operator()(const f32x4 (&acc)[2][2][4][2], const Unit& u, int wr, int wc, int fr, int fq) const {
        const int row0 = u.pm * BM + wr * 64 + fr, col0 = u.pn * HALF + wc * 32 + 8 * fq;
#pragma unroll
        for (int ai = 0; ai < 2; ++ai)
#pragma unroll
            for (int m = 0; m < 4; ++m) { bf16_t* rowp = O + (size_t)(row0 + ai * HALF + m * 16) * ldc + col0;
                float h[8];
#pragma unroll
                for (int n = 0; n < 2; ++n)
#pragma unroll
                    for (int e = 0; e < 4; ++e) h[4 * n + e] = silu_f(acc[ai][0][m][n][e]) * acc[ai][1][m][n][e];
                u32x4 w; w.x = cvt_pk_bf16(h[0], h[1]); w.y = cvt_pk_bf16(h[2], h[3]); w.z = cvt_pk_bf16(h[4], h[5]); w.w = cvt_pk_bf16(h[6], h[7]);
                *(u32x4*)rowp = w; }
    }
};
struct EpiResF32 {
    static constexpr bool PERM = false, AFTER_DRAIN = false, HAS_INIT = false;
    const float* base0; const float* base1; float* out; int ldc, msplit, mreal; float* part; float sc;
    __device__ __forceinline__ void operator()(const f32x4 (&acc)[2][2][4][2], const Unit& u, int wr, int wc, int fr, int fq) const {
        const int row0 = u.pm * BM + wr * 64 + fr, col0 = u.pn * BM + wc * 32 + 4 * fq;
#pragma unroll
        for (int ai = 0; ai < 2; ++ai)
#pragma unroll
            for (int m = 0; m < 4; ++m) { const int row = row0 + ai * HALF + m * 16;
                if (row < mreal) {
                    const float* bp = (row < msplit ? base0 + (size_t)row * ldc : base1 + (size_t)(row - msplit) * ldc) + col0; float* op = out + (size_t)row * ldc + col0;
                    f32x4 b[2][2];
#pragma unroll
                    for (int bj = 0; bj < 2; ++bj)
#pragma unroll
                        for (int n = 0; n < 2; ++n) b[bj][n] = *(const f32x4*)(bp + bj * HALF + n * 16);
#pragma unroll
                    for (int bj = 0; bj < 2; ++bj)
#pragma unroll
                        for (int n = 0; n < 2; ++n) *(f32x4*)(op + bj * HALF + n * 16) = b[bj][n] + acc[ai][bj][m][n] * sc;
                } }
    }
    __device__ __forceinline__ void partial(const f32x4 (&acc)[2][2][4][2], const Unit& u, int wr, int wc, int fr, int fq) const {
        float* pp = part + ((size_t)u.slot * HALF + wr * 64 + fr) * ldc + u.pn * BM + wc * 32 + 4 * fq;
#pragma unroll
        for (int m = 0; m < 4; ++m)
#pragma unroll
            for (int bj = 0; bj < 2; ++bj)
#pragma unroll
                for (int n = 0; n < 2; ++n) *(f32x4*)(pp + (size_t)(m * 16) * ldc + bj * HALF + n * 16) = acc[0][bj][m][n];
    }
};
struct TailSplitOrder : StaticOrder {
    static constexpr bool SK = true;
    int nkp, npieces, ntfull; bool pieces_first;
    __device__ __forceinline__ void init_ts(int Mfull, int N, int K, int G_, int c_, int nkp_, bool pf = false) { init(Mfull, N, G_, c_); ntfull = K / BK; nkp = nkp_; npieces = nN * (ntfull / nkp_); pieces_first = pf; }
    __device__ __forceinline__ bool next(int i, Unit& u) const {
        const bool mine = pieces_first && c < npieces;
        const int is = pieces_first ? (mine ? i - 1 : i) : i;
        Unit t; t.pm = 0; t.pn = 0;
        const bool full = (is >= 0) && StaticOrder::next(is, t);
        const long p = pieces_first ? (long)c : (long)i * G + c - nwg; const bool piece = !full && (pieces_first ? (mine && i == 0) : (p >= 0 && p < npieces));
        const int pp = piece ? (int)p : 0, ks = pp / nN;
        u.pm = full ? t.pm : nM; u.pn = full ? t.pn : pp - ks * nN; u.slot = full ? 0 : ks; u.k0 = full ? 0 : ks * nkp; u.nk = full ? ntfull : nkp; u.mode = full ? 0 : 3;
        return full || piece;
    }
};
struct RowStats {
    float* xbuf; unsigned* cnt; float eps;
    __device__ __forceinline__ void run(const f32x4 (&v)[2][2][4][2], const Unit& u, int wr, int wc, int fr, int fq, PG8_LAS unsigned char* lds, int wid, int lane) const {
        PG8_LAS float* P = (PG8_LAS float*)lds;
        PG8_LAS float* S = (PG8_LAS float*)(lds + 4096);
#pragma unroll
        for (int ai = 0; ai < 2; ++ai)
#pragma unroll
            for (int m = 0; m < 4; ++m) { float s = 0.f;
#pragma unroll
                for (int bj = 0; bj < 2; ++bj)
#pragma unroll
                    for (int n = 0; n < 2; ++n) { const f32x4 x = v[ai][bj][m][n]; s += (x[0] * x[0] + x[1] * x[1]) + (x[2] * x[2] + x[3] * x[3]); }
                s += __shfl_xor(s, 16); s += __shfl_xor(s, 32);
                if (fq == 0) P[(ai * HALF + wr * 64 + m * 16 + fr) * 4 + wc] = s; }
        asm volatile("s_waitcnt lgkmcnt(0)" ::: "memory"); __builtin_amdgcn_s_barrier(); asm volatile("" ::: "memory");
        const int row = wid * 32 + (lane & 31);
        if (lane < 32) { const float t = (P[row * 4 + 0] + P[row * 4 + 1]) + (P[row * 4 + 2] + P[row * 4 + 3]);
            __hip_atomic_store(xbuf + ((size_t)(u.pm * BM + row) * 8 + u.pn), t, __ATOMIC_RELAXED, __HIP_MEMORY_SCOPE_AGENT); }
        asm volatile("s_waitcnt vmcnt(0)" ::: "memory");
        if (lane == 0) __hip_atomic_fetch_add(cnt + 64 * u.pm, 1u, __ATOMIC_RELAXED, __HIP_MEMORY_SCOPE_AGENT);
        if (wid == 0) { unsigned polls = 0;
            while ((unsigned)__builtin_amdgcn_readfirstlane(__hip_atomic_load(cnt + 64 * u.pm, __ATOMIC_RELAXED, __HIP_MEMORY_SCOPE_AGENT)) < 64u) { __builtin_amdgcn_s_sleep(2); if (++polls > (1u << 22)) break; }
            __builtin_amdgcn_fence(__ATOMIC_ACQUIRE, "agent"); }
        asm volatile("s_waitcnt vmcnt(0) lgkmcnt(0)" ::: "memory"); __builtin_amdgcn_s_barrier(); asm volatile("" ::: "memory");
        if (lane < 32) { const float* sl = xbuf + (size_t)(u.pm * BM + row) * 8; float tot = 0.f;
#pragma unroll
            for (int t = 0; t < 8; ++t) tot += __hip_atomic_load(sl + t, __ATOMIC_RELAXED, __HIP_MEMORY_SCOPE_AGENT);
            S[row] = 1.0f / sqrtf(tot * (1.0f / 2048.0f) + eps); }
        asm volatile("s_waitcnt vmcnt(0) lgkmcnt(0)" ::: "memory"); __builtin_amdgcn_s_barrier(); asm volatile("" ::: "memory");
    }
};
struct EpiResNormBf16 {
    static constexpr bool PERM = false, AFTER_DRAIN = true, HAS_INIT = true;
    const float* base; float* out; bf16_t* xn; const float* gain; int ldc; float* part; RowStats st;
    __device__ __forceinline__ void init(f32x4 (&acc)[2][2][4][2], const Unit& u, int wr, int wc, int fr, int fq) const {
        const bool piece = (u.mode == 3); const int col0 = u.pn * BM + wc * 32 + 4 * fq;
#pragma unroll
        for (int ai = 0; ai < 2; ++ai)
#pragma unroll
            for (int m = 0; m < 4; ++m) { const size_t off = (size_t)(u.pm * BM + ai * HALF + wr * 64 + m * 16 + fr) * ldc + col0;
#pragma unroll
                for (int bj = 0; bj < 2; ++bj)
#pragma unroll
                    for (int n = 0; n < 2; ++n) { f32x4 v = (f32x4){0.f, 0.f, 0.f, 0.f}; if (!piece) v = *(const f32x4*)(base + off + bj * HALF + n * 16); acc[ai][bj][m][n] = v; } }
    }
    __device__ __forceinline__ void partial(const f32x4 (&acc)[2][2][4][2], const Unit& u, int wr, int wc, int fr, int fq) const {
        float* pp = part + ((size_t)u.slot * HALF + wr * 64 + fr) * ldc + u.pn * BM + wc * 32 + 4 * fq;
#pragma unroll
        for (int m = 0; m < 4; ++m)
#pragma unroll
            for (int bj = 0; bj < 2; ++bj)
#pragma unroll
                for (int n = 0; n < 2; ++n) *(f32x4*)(pp + (size_t)(m * 16) * ldc + bj * HALF + n * 16) = acc[0][bj][m][n];
    }
    __device__ __forceinline__ void fused(f32x4 (&acc)[2][2][4][2], const Unit& u, int wr, int wc, int fr, int fq, PG8_LAS unsigned char* lds, int wid, int lane) const {
        const PG8_LAS float* S = (const PG8_LAS float*)(lds + 4096);
        const int col0 = u.pn * BM + wc * 32 + 4 * fq;
#pragma unroll
        for (int ai = 0; ai < 2; ++ai)
#pragma unroll
            for (int m = 0; m < 4; ++m) { const size_t off = (size_t)(u.pm * BM + ai * HALF + wr * 64 + m * 16 + fr) * ldc + col0;
#pragma unroll
                for (int bj = 0; bj < 2; ++bj)
#pragma unroll
                    for (int n = 0; n < 2; ++n) *(f32x4*)(out + off + bj * HALF + n * 16) = acc[ai][bj][m][n]; }
        st.run(acc, u, wr, wc, fr, fq, lds, wid, lane);
        f32x4 gv[2][2];
#pragma unroll
        for (int bj = 0; bj < 2; ++bj)
#pragma unroll
            for (int n = 0; n < 2; ++n) gv[bj][n] = *(const f32x4*)(gain + col0 + bj * HALF + n * 16);
#pragma unroll
        for (int ai = 0; ai < 2; ++ai)
#pragma unroll
            for (int m = 0; m < 4; ++m) { const int r = ai * HALF + wr * 64 + m * 16 + fr; const float rs = S[r]; const size_t off = (size_t)(u.pm * BM + r) * ldc + col0;
#pragma unroll
                for (int bj = 0; bj < 2; ++bj)
#pragma unroll
                    for (int n = 0; n < 2; ++n) { const f32x4 o = acc[ai][bj][m][n] * rs * gv[bj][n]; u32x2v w; w.x = cvt_pk_bf16(o[0], o[1]); w.y = cvt_pk_bf16(o[2], o[3]); *(u32x2v*)(xn + off + bj * HALF + n * 16) = w; } }
    }
};
struct EpiResNormF32 {
    static constexpr bool PERM = false, AFTER_DRAIN = true, HAS_INIT = true;
    float* out; const float* gain; int ldc; float* part; RowStats st;
    __device__ __forceinline__ void init(f32x4 (&acc)[2][2][4][2], const Unit& u, int wr, int wc, int fr, int fq) const {
        const bool piece = (u.mode == 3); const int col0 = u.pn * BM + wc * 32 + 4 * fq;
#pragma unroll
        for (int ai = 0; ai < 2; ++ai)
#pragma unroll
            for (int m = 0; m < 4; ++m) { const size_t off = (size_t)(u.pm * BM + ai * HALF + wr * 64 + m * 16 + fr) * ldc + col0;
#pragma unroll
                for (int bj = 0; bj < 2; ++bj)
#pragma unroll
                    for (int n = 0; n < 2; ++n) { f32x4 v = (f32x4){0.f, 0.f, 0.f, 0.f}; if (!piece) v = *(const f32x4*)(out + off + bj * HALF + n * 16); acc[ai][bj][m][n] = v; } }
    }
    __device__ __forceinline__ void partial(const f32x4 (&acc)[2][2][4][2], const Unit& u, int wr, int wc, int fr, int fq) const {
        float* pp = part + ((size_t)u.slot * HALF + wr * 64 + fr) * ldc + u.pn * BM + wc * 32 + 4 * fq;
#pragma unroll
        for (int m = 0; m < 4; ++m)
#pragma unroll
            for (int bj = 0; bj < 2; ++bj)
#pragma unroll
                for (int n = 0; n < 2; ++n) *(f32x4*)(pp + (size_t)(m * 16) * ldc + bj * HALF + n * 16) = acc[0][bj][m][n];
    }
    __device__ __forceinline__ void fused(f32x4 (&acc)[2][2][4][2], const Unit& u, int wr, int wc, int fr, int fq, PG8_LAS unsigned char* lds, int wid, int lane) const {
        const PG8_LAS float* S = (const PG8_LAS float*)(lds + 4096);
        const int col0 = u.pn * BM + wc * 32 + 4 * fq;
        st.run(acc, u, wr, wc, fr, fq, lds, wid, lane);
        f32x4 gv[2][2];
#pragma unroll
        for (int bj = 0; bj < 2; ++bj)
#pragma unroll
            for (int n = 0; n < 2; ++n) gv[bj][n] = *(const f32x4*)(gain + col0 + bj * HALF + n * 16);
#pragma unroll
        for (int ai = 0; ai < 2; ++ai)
#pragma unroll
            for (int m = 0; m < 4; ++m) { const int r = ai * HALF + wr * 64 + m * 16 + fr; const float rs = S[r]; const size_t off = (size_t)(u.pm * BM + r) * ldc + col0;
#pragma unroll
                for (int bj = 0; bj < 2; ++bj)
#pragma unroll
                    for (int n = 0; n < 2; ++n) *(f32x4*)(out + off + bj * HALF + n * 16) = acc[ai][bj][m][n] * rs * gv[bj][n]; }
    }
};
#ifndef SKT_PUB
#define SKT_PUB 1
#endif
#ifndef SKT_COMB
#define SKT_COMB 1
#endif
template <class Epi, class Sched, bool ALIGN_EPI = false, bool SP2 = false>
__device__ __forceinline__ void gemm_phase(PG8_LAS unsigned char* lds, const Gemm g, const Sched& S, const Epi& E) {
    const int tid = threadIdx.x, wid = __builtin_amdgcn_readfirstlane(tid >> 6), lane = tid & 63, wr = wid >> 2, wc = wid & 3, fr = lane & 15, fq = lane >> 4;
    const int K = g.K, nt = K / BK;
    unsigned voffA[2], voffB[2];
#pragma unroll
    for (int i = 0; i < 2; ++i) { int R, C; stage_rc(tid * 16 + i * 8192, R, C); const int Rb = Epi::PERM ? ((R & ~31) + perm32(R & 31)) : R;
        voffA[i] = (unsigned)(R * K + C) * 2u; voffB[i] = (unsigned)(Rb * K + C) * 2u; }
    const size_t kstep = (size_t)(BK * 2);
    const size_t hstep = (size_t)HALF * K * 2;
    const size_t tstep = 2 * hstep;
    const unsigned ldsw = (unsigned)wid * 1024u;
    const int aoff = lds_byte(wr * 64 + fr, fq * 8), boff = lds_byte(wc * 32 + fr, fq * 8);
#define PG8_SA(b, h) (((b) * 2 + (h)) * HTB)
#define PG8_SB(b, h) ((4 + (b) * 2 + (h)) * HTB)
#define PG8_STAGE(bufoff, gbase, voff) do { _Pragma("unroll") for (int _i = 0; _i < 2; ++_i) \
        __builtin_amdgcn_global_load_lds((const unsigned*)((const char*)(gbase) + (voff)[_i]), (PG8_LAS unsigned*)(lds + (bufoff) + ldsw + _i * 8192), 16, 0, 0); } while (0)
#define PG8_LDA(dst, b, h) do { _Pragma("unroll") for (int m = 0; m < 4; ++m) _Pragma("unroll") for (int k = 0; k < 2; ++k) dst[m][k] = *(const PG8_LAS bf16x8*)(lds + PG8_SA(b, h) + aoff + m * 2048 + k * 1024); } while (0)
#define PG8_LDB(dst, b, h) do { _Pragma("unroll") for (int n = 0; n < 2; ++n) _Pragma("unroll") for (int k = 0; k < 2; ++k) dst[n][k] = *(const PG8_LAS bf16x8*)(lds + PG8_SB(b, h) + boff + n * 2048 + k * 1024); } while (0)
#define PG8_MMA(ai, bj, At, Bt) do { __builtin_amdgcn_s_setprio(1); _Pragma("unroll") for (int m = 0; m < 4; ++m) _Pragma("unroll") for (int n = 0; n < 2; ++n) _Pragma("unroll") for (int k = 0; k < 2; ++k) \
        acc[ai][bj][m][n] = __builtin_amdgcn_mfma_f32_16x16x32_bf16(Bt[n][k], At[m][k], acc[ai][bj][m][n], 0, 0, 0); __builtin_amdgcn_s_setprio(0); } while (0)
#define PG8_WAIT_V(n) asm volatile("s_waitcnt vmcnt(" #n ")" ::: "memory")
#define PG8_WAIT_L(n) asm volatile("s_waitcnt lgkmcnt(" #n ")" ::: "memory")
#define PG8_BAR __builtin_amdgcn_s_barrier()
#define PG8_SCHED __builtin_amdgcn_sched_barrier(0)
    Unit cur, nxt; int ui = 0;
    if (!S.next(0, cur)) return;
    if constexpr (!Sched::SK) { cur.k0 = 0; cur.nk = nt; cur.mode = 0; cur.slot = 0; }
    f32x4 acc[2][2][4][2];
    if constexpr (Epi::HAS_INIT) E.init(acc, cur, wr, wc, fr, fq); else {
#pragma unroll
    for (int a = 0; a < 2; ++a)
#pragma unroll
        for (int b = 0; b < 2; ++b)
#pragma unroll
            for (int m = 0; m < 4; ++m)
#pragma unroll
                for (int n = 0; n < 2; ++n) acc[a][b][m][n] = (f32x4){0.f, 0.f, 0.f, 0.f};
    }
    bf16x8 At[4][2], B0[2][2], B1[2][2];
    const char* cA = (const char*)g.A + (size_t)cur.pm * tstep + (size_t)cur.k0 * kstep; const char* cB = (const char*)g.Bt + (size_t)cur.pn * tstep + (size_t)cur.k0 * kstep;
    S.a_ready(cur);
    if constexpr (SP2) {
        PG8_STAGE(PG8_SB(0, 0), cB, voffB); PG8_STAGE(PG8_SB(0, 1), cB + hstep, voffB); PG8_STAGE(PG8_SA(0, 0), cA, voffA); PG8_STAGE(PG8_SA(0, 1), cA + hstep, voffA);
        if (wr == 1) PG8_BAR;
        PG8_WAIT_V(2); PG8_BAR;
        PG8_STAGE(PG8_SB(1, 0), cB + kstep, voffB); PG8_STAGE(PG8_SA(1, 0), cA + kstep, voffA); PG8_STAGE(PG8_SB(1, 1), cB + hstep + kstep, voffB);
        PG8_WAIT_V(6); PG8_BAR;
    } else {
        PG8_STAGE(PG8_SB(0, 0), cB, voffB); PG8_STAGE(PG8_SA(0, 0), cA, voffA); PG8_STAGE(PG8_SB(0, 1), cB + hstep, voffB); PG8_STAGE(PG8_SA(0, 1), cA + hstep, voffA);
        if (wr == 1) PG8_BAR;
        PG8_WAIT_V(4); PG8_BAR;
        PG8_STAGE(PG8_SB(1, 0), cB + kstep, voffB); PG8_STAGE(PG8_SA(1, 0), cA + kstep, voffA); PG8_STAGE(PG8_SB(1, 1), cB + hstep + kstep, voffB);
        PG8_WAIT_V(6); PG8_BAR;
    }
    for (;;) {
        const bool has_next = S.next(ui + 1, nxt);
        if constexpr (!Sched::SK) { nxt.k0 = 0; nxt.nk = nt; nxt.mode = 0; nxt.slot = 0; }
        const int ntc = cur.nk;
        const char* nA = has_next ? (const char*)g.A + (size_t)nxt.pm * tstep + (size_t)nxt.k0 * kstep : cA; const char* nB = has_next ? (const char*)g.Bt + (size_t)nxt.pn * tstep + (size_t)nxt.k0 * kstep : cB;
        for (int t = 0; t < ntc; t += 2) {
            const bool last = (t == ntc - 2);
            const char* a1 = cA + (size_t)(t + 1) * kstep;
            const char* a2 = last ? nA : cA + (size_t)(t + 2) * kstep; const char* b2 = last ? nB : cB + (size_t)(t + 2) * kstep;
            const char* a3 = a2 + kstep; const char* b3 = b2 + kstep;
            if (last && has_next) S.a_ready(nxt);
            if constexpr (SP2) {
            PG8_LDB(B0, 0, 0); PG8_LDB(B1, 0, 1); PG8_SCHED; PG8_LDA(At, 0, 0); PG8_STAGE(PG8_SA(1, 1), a1 + hstep, voffA);
            PG8_WAIT_V(8); PG8_WAIT_L(0); PG8_BAR; PG8_MMA(0, 0, At, B0); PG8_MMA(0, 1, At, B1); PG8_BAR; PG8_SCHED;
            PG8_LDA(At, 0, 1); PG8_STAGE(PG8_SB(0, 0), b2, voffB); PG8_STAGE(PG8_SB(0, 1), b2 + hstep, voffB); PG8_STAGE(PG8_SA(0, 0), a2, voffA);
            PG8_WAIT_V(8); PG8_WAIT_L(0); PG8_BAR; PG8_MMA(1, 0, At, B0); PG8_MMA(1, 1, At, B1); PG8_BAR; PG8_SCHED;
            PG8_LDB(B0, 1, 0); PG8_LDB(B1, 1, 1); PG8_SCHED; PG8_LDA(At, 1, 0); PG8_STAGE(PG8_SA(0, 1), a2 + hstep, voffA);
            PG8_WAIT_V(8); PG8_WAIT_L(0); PG8_BAR; PG8_MMA(0, 0, At, B0); PG8_MMA(0, 1, At, B1); PG8_BAR; PG8_SCHED;
            PG8_LDA(At, 1, 1); PG8_STAGE(PG8_SB(1, 0), b3, voffB); PG8_STAGE(PG8_SB(1, 1), b3 + hstep, voffB); PG8_STAGE(PG8_SA(1, 0), a3, voffA);
            PG8_WAIT_V(8); PG8_WAIT_L(0); PG8_BAR; PG8_MMA(1, 0, At, B0); PG8_MMA(1, 1, At, B1); PG8_BAR; PG8_SCHED;
            } else {
            PG8_LDB(B0, 0, 0); PG8_SCHED; PG8_LDA(At, 0, 0); PG8_STAGE(PG8_SA(1, 1), a1 + hstep, voffA);
            PG8_WAIT_L(8); PG8_BAR; PG8_WAIT_L(0); PG8_MMA(0, 0, At, B0); PG8_BAR; PG8_SCHED;
            PG8_LDB(B1, 0, 1); PG8_STAGE(PG8_SB(0, 0), b2, voffB);
            PG8_BAR; PG8_WAIT_L(0); PG8_MMA(0, 1, At, B1); PG8_BAR;
            PG8_LDA(At, 0, 1); PG8_STAGE(PG8_SA(0, 0), a2, voffA);
            PG8_BAR; PG8_WAIT_L(0); PG8_MMA(1, 0, At, B0); PG8_BAR; PG8_SCHED;
            PG8_STAGE(PG8_SB(0, 1), b2 + hstep, voffB);
            PG8_WAIT_V(6); PG8_BAR; PG8_MMA(1, 1, At, B1); PG8_BAR;
            PG8_LDB(B0, 1, 0); PG8_SCHED; PG8_LDA(At, 1, 0); PG8_STAGE(PG8_SA(0, 1), a2 + hstep, voffA);
            PG8_WAIT_L(8); PG8_BAR; PG8_WAIT_L(0); PG8_MMA(0, 0, At, B0); PG8_BAR; PG8_SCHED;
            PG8_LDB(B1, 1, 1); PG8_STAGE(PG8_SB(1, 0), b3, voffB);
            PG8_BAR; PG8_WAIT_L(0); PG8_MMA(0, 1, At, B1); PG8_BAR;
            PG8_LDA(At, 1, 1); PG8_STAGE(PG8_SA(1, 0), a3, voffA);
            PG8_BAR; PG8_WAIT_L(0); PG8_MMA(1, 0, At, B0); PG8_BAR; PG8_SCHED;
            PG8_STAGE(PG8_SB(1, 1), b3 + hstep, voffB);
            PG8_WAIT_V(6); PG8_BAR; PG8_MMA(1, 1, At, B1); PG8_BAR;
            }
        }
        if constexpr (ALIGN_EPI) { if (wr == 0) PG8_BAR; }
        if constexpr (!Epi::AFTER_DRAIN) {
            if constexpr (Sched::SK) { if (cur.mode == 3) E.partial(acc, cur, wr, wc, fr, fq); else E(acc, cur, wr, wc, fr, fq); }
            else E(acc, cur, wr, wc, fr, fq);
            S.done(cur); }
        else { if constexpr (Sched::SK) { if (has_next) E.partial(acc, cur, wr, wc, fr, fq); } }
        if (!has_next) break;
        if constexpr (Epi::HAS_INIT) E.init(acc, nxt, wr, wc, fr, fq); else {
#pragma unroll
        for (int a = 0; a < 2; ++a)
#pragma unroll
            for (int b = 0; b < 2; ++b)
#pragma unroll
                for (int m = 0; m < 4; ++m)
#pragma unroll
                    for (int n = 0; n < 2; ++n) acc[a][b][m][n] = (f32x4){0.f, 0.f, 0.f, 0.f};
        }
        cur = nxt; cA = nA; cB = nB; ++ui;
        if constexpr (ALIGN_EPI) { if (wr == 1) PG8_BAR; }
    }
    PG8_WAIT_V(0);
    if constexpr (!ALIGN_EPI) { if (wr == 0) PG8_BAR; }
    PG8_BAR;
    if constexpr (Epi::AFTER_DRAIN) { E.fused(acc, cur, wr, wc, fr, fq, lds, wid, lane); S.done(cur); }
#undef PG8_SA
#undef PG8_SB
#undef PG8_STAGE
#undef PG8_LDA
#undef PG8_LDB
#undef PG8_MMA
#undef PG8_WAIT_V
#undef PG8_WAIT_L
#undef PG8_BAR
#undef PG8_SCHED
}
}

constexpr int NWAVES = 8;
constexpr int DM = 2048, MP = 8192, MS = 128, MR = MP + MS  , MPAD = 8448  , SEQ = 2048, NB = 4;
constexpr int NH = 4, HK = 128, HV = 256, DK = 512, DA = 1024, DC_ = 1024, GR = 16, CW = 31, DFF = 5632;
constexpr int N1 = 5136, N1P = 5376;
constexpr int ZQ = 0, ZK = 512, ZV = 1024, ZGO = 2048, ZUA = 3072, ZUG = 4096, ZGL = 5120;
constexpr int CH = 64, NCH = SEQ / CH;
constexpr float RMS_EPS = 1e-6f, LN_EPS = 1e-5f;
constexpr size_t O_YP = 0, O_YS = (size_t)MP * DM, O_GP = O_YS + (size_t)MS * DM, O_CP = O_GP + (size_t)NB * NH * HK * HV, O_GS = O_CP + (size_t)NB * 30 * DC_,
                 O_CS = O_GS + (size_t)MS * NH * HK * HV, O_END = O_CS + (size_t)MS * 30 * DC_;
constexpr size_t MiB = 1u << 20;
constexpr size_t WS_CTL = 0, CTL_ZERO_BYTES = 1 * MiB;
constexpr size_t WS_XB2 = 1 * MiB, WS_XB4 = 1 * MiB + 512 * 1024;
constexpr size_t WS_W1 = 2 * MiB;
constexpr size_t WS_W2 = 23 * MiB;
constexpr size_t WS_W3 = 31 * MiB;
constexpr size_t WS_W4 = 75 * MiB;
constexpr size_t WS_H = 97 * MiB;
constexpr size_t WS_QT = WS_H, WS_KH = WS_H + 8 * MiB, WS_VT = WS_H + 16 * MiB;
constexpr size_t WS_Z = 130 * MiB;
constexpr size_t WS_MIX = 217 * MiB;
constexpr size_t WS_HID = 130 * MiB;
constexpr size_t WS_END = 250 * MiB;
static_assert(WS_Z + (size_t)MPAD * N1P * 2 <= WS_MIX && WS_HID + (size_t)MPAD * DFF * 2 <= WS_END && WS_W1 + (size_t)N1P * DM * 2 <= WS_W2 && WS_W3 + (size_t)2 * DFF * DM * 2 <= WS_W4 && WS_W4 + (size_t)DM * DFF * 2 <= WS_H, "d_ws map");
constexpr size_t DO_O32 = 0, DO_AM = 32 * MiB, DO_DC = 36 * MiB;
constexpr int CW_TMO = 0, CW_BAR = 4096, CW_RB2 = 16384, CW_SP2 = CW_RB2 + 64 * 40, CW_RB4 = CW_RB2 + 64 * 64, CW_SP4 = CW_RB4 + 64 * 40;
constexpr size_t WS_SK2 = WS_Z, WS_SK4 = WS_W1;
static_assert((size_t)32 * 128 * DM * 4 <= WS_MIX - WS_Z && WS_SK4 + (size_t)44 * 128 * DM * 4 <= WS_W4, "K-split slabs");
constexpr int RING_OFF = 0, RING_BYTES = 131072;
constexpr int LDSCTL_OFF = RING_BYTES, MISC_OFF = LDSCTL_OFF + 320;
constexpr int LDS_BYTES = 147456;

#define GAS __attribute__((address_space(1)))
#define LAS __attribute__((address_space(3)))
typedef unsigned short bf16;
typedef unsigned v4u __attribute__((ext_vector_type(4)));
typedef unsigned v2u __attribute__((ext_vector_type(2)));
typedef float f32x4 __attribute__((ext_vector_type(4)));
typedef float f32x2 __attribute__((ext_vector_type(2)));
typedef short bf16x8 __attribute__((ext_vector_type(8)));
typedef GAS unsigned gu32;
typedef GAS unsigned long long gu64;
#define RLX_AGENT __ATOMIC_RELAXED, __HIP_MEMORY_SCOPE_AGENT
#define LDS_WAIT() asm volatile("s_waitcnt lgkmcnt(0)" ::: "memory")
#define VM_WAIT() asm volatile("s_waitcnt vmcnt(0)" ::: "memory")
__device__ __forceinline__ unsigned f2bf(float f) { unsigned u = __builtin_bit_cast(unsigned, f); return (u + 0x7fffu + ((u >> 16) & 1u)) >> 16; }
__device__ __forceinline__ unsigned pk2(float lo, float hi) { return f2bf(lo) | (f2bf(hi) << 16); }
__device__ __forceinline__ float bf2f(unsigned short b) { return __builtin_bit_cast(float, (unsigned)b << 16); }
__device__ __forceinline__ float bflo(unsigned w) { return __builtin_bit_cast(float, w << 16); }
__device__ __forceinline__ float bfhi(unsigned w) { return __builtin_bit_cast(float, w & 0xffff0000u); }
__device__ __forceinline__ float sigmoid_f(float x) { return __builtin_amdgcn_rcpf(1.0f + __expf(-x)); }
__device__ __forceinline__ float silu_f(float x) { return x * sigmoid_f(x); }
__device__ __forceinline__ float logsigmoid_f(float x) { return fminf(x, 0.f) - log1pf(__expf(-fabsf(x))); }
#define XB_TMO      128
#define XB_XCNT(j)  (256  + 64 * (j))
#define XB_XSUB(j)  (1280 + 64 * (j))
#define XB_XGEN(j)  (2304 + 64 * (j))
#define XB_TOP      3328
#define XB_TOPGEN   3392
#define XCD_BAR_WORDS 3456
#define XB_SPIN_CAP (1u << 18)

__device__ __forceinline__ unsigned xb_ld(unsigned* p)              { return __hip_atomic_load(p, __ATOMIC_RELAXED, __HIP_MEMORY_SCOPE_AGENT); }
__device__ __forceinline__ unsigned xb_add(unsigned* p, unsigned v) { return __hip_atomic_fetch_add(p, v, __ATOMIC_RELAXED, __HIP_MEMORY_SCOPE_AGENT); }
__device__ __forceinline__ unsigned xb_xcc_id() { return (unsigned)__builtin_amdgcn_s_getreg((3 << 11) | 20) & 0xFu; }
#define XB_SPIN(cond, bar) do { unsigned _sp = 0; while (cond) { __builtin_amdgcn_s_sleep(1); \
    if ((++_sp & 255u) == 0u) { if (xb_ld(&(bar)[XB_TMO])) break; if (_sp > XB_SPIN_CAP) { atomicAdd(&(bar)[XB_TMO], 1u); break; } } } } while (0)

struct XcdBarrier {
    unsigned* bar; unsigned x;
    volatile LAS unsigned* st;
};

__device__ __forceinline__ XcdBarrier xcd_barrier_post(unsigned* bar, volatile LAS unsigned* st) {
    XcdBarrier b; b.bar = bar; b.x = xb_xcc_id(); b.st = st;
    if (threadIdx.x == 0) (void)xb_add(&bar[XB_XCNT(b.x)], 1u);
    return b;
}
__device__ __forceinline__ void xcd_barrier_complete(unsigned* bar, unsigned x, unsigned& nloc, unsigned& nx) {
    const unsigned G = gridDim.x * gridDim.y * gridDim.z;
    unsigned sum, cnt, mine, sp = 0u;
    for (;;) {
        sum = 0u; cnt = 0u; mine = 0u;
#pragma unroll
        for (unsigned j = 0; j < 16; ++j) { const unsigned c = xb_ld(&bar[XB_XCNT(j)]); sum += c; cnt += (c > 0u) ? 1u : 0u; mine = (j == x) ? c : mine; }
        if (sum == G) break;
        __builtin_amdgcn_s_sleep(1);
        if ((++sp & 255u) == 0u) { if (xb_ld(&bar[XB_TMO])) break; if (sp > XB_SPIN_CAP) { atomicAdd(&bar[XB_TMO], 1u); break; } }
    }
    nloc = mine > 0u ? mine : 1u; nx = cnt > 0u ? cnt : 1u;
}

__device__ __forceinline__ void xcd_barrier(const XcdBarrier& b) {
    asm volatile("s_waitcnt vmcnt(0)" ::: "memory");
    __syncthreads();
    if (threadIdx.x == 0) {
        unsigned* bar = b.bar;
        __builtin_amdgcn_s_waitcnt(0);
        unsigned nloc = b.st[0], nx = b.st[1];
        if (nloc == 0u) { xcd_barrier_complete(bar, b.x, nloc, nx); b.st[0] = nloc; b.st[1] = nx; }
        const unsigned old = xb_add(&bar[XB_XSUB(b.x)], 1u);
        const unsigned gen = old / nloc;
        if (old + 1u == (gen + 1u) * nloc) {
            __builtin_amdgcn_fence(__ATOMIC_RELEASE, "agent");
            asm volatile("s_waitcnt vmcnt(0)" ::: "memory");
            const unsigned og = xb_add(&bar[XB_TOP], 1u);
            const unsigned tg = og / nx;
            if (og + 1u == (tg + 1u) * nx) xb_add(&bar[XB_TOPGEN], 1u);
            else XB_SPIN(xb_ld(&bar[XB_TOPGEN]) == tg, bar);
            __builtin_amdgcn_fence(__ATOMIC_ACQUIRE, "agent");
            xb_add(&bar[XB_XGEN(b.x)], 1u);
            asm volatile("s_waitcnt vmcnt(0)" ::: "memory");
        } else {
            XB_SPIN(xb_ld(&bar[XB_XGEN(b.x)]) == gen, bar);
            __builtin_amdgcn_fence(__ATOMIC_ACQUIRE, "agent");
            asm volatile("s_waitcnt vmcnt(0)" ::: "memory");
        }
    }
    __syncthreads();
}
struct Args { const float* in[18]; float* out; unsigned char* ws; int ph_lo, ph_hi, pad, pad2; };
#define P_xp (A.in[0])
#define P_xs (A.in[1])
#define P_sgla (A.in[2])
#define P_sconv (A.in[3])
#define P_norm_mix (A.in[4])
#define P_w_in (A.in[5])
#define P_wgu (A.in[6])
#define P_bgate (A.in[7])
#define P_gla_norm (A.in[8])
#define P_conv_w (A.in[9])
#define P_conv_b (A.in[10])
#define P_ln_g (A.in[11])
#define P_ln_b (A.in[12])
#define P_w_out (A.in[13])
#define P_norm_ffn (A.in[14])
#define P_w_ffn_in (A.in[15])
#define P_w_ffn_out (A.in[16])
#define P_norm_final (A.in[17])
#define P_W1t ((bf16*)(A.ws + WS_W1))
#define P_W2t ((bf16*)(A.ws + WS_W2))
#define P_W3t ((bf16*)(A.ws + WS_W3))
#define P_W4t ((bf16*)(A.ws + WS_W4))
#define P_H ((bf16*)(A.ws + WS_H))
#define P_Z ((bf16*)(A.ws + WS_Z))
#define P_MIX ((bf16*)(A.ws + WS_MIX))
#define P_HID ((bf16*)(A.ws + WS_HID))
#define P_QT ((bf16*)(A.ws + WS_QT))
#define P_KH ((bf16*)(A.ws + WS_KH))
#define P_VT ((bf16*)(A.ws + WS_VT))
#define P_out (A.out)
#define P_O32 ((float*)((unsigned char*)A.out + DO_O32))
#define P_AM ((bf16*)((unsigned char*)A.out + DO_AM))
#define P_DCb ((float*)((unsigned char*)A.out + DO_DC))

struct Frame {
    LAS unsigned char* lds;
    volatile LAS unsigned* MISC;
    gu32* ctl;
    int tid, lane, wave, vcu, G;
};
__device__ __forceinline__ float wave_sum(float v) {
#pragma unroll
    for (int o = 1; o < 64; o <<= 1) v += __shfl_xor(v, o);
    return v;
}
__device__ __forceinline__ float dot4(f32x4 a, f32x4 b) { return (a.x * b.x + a.y * b.y) + (a.z * b.z + a.w * b.w); }

template <int MAP> __device__ __forceinline__ int srccol(int n) {
    if (MAP == 1) return n < 2048 ? n : (n < 5120 ? n + 16 : (n < 5136 ? n - 3072 : -1));
    if (MAP == 3) { const int t = n >> 8, r = n & 255; return r < 128 ? 128 * t + r : DFF + 128 * t + (r - 128); }
    return n;
}
template <int MAP> __device__ __forceinline__ void tr_load(float (&tv)[32], const float* W, int Nsrc, int Ndst, int item, int lane) {
    const int nblk = Ndst / 32, kb = item / nblk, nb = item % nblk, k0 = 64 * kb, n0 = 32 * nb;
    const int sc = srccol<MAP>(n0 + (lane & 31));
    const float* src = W + (size_t)k0 * Nsrc + (sc >= 0 ? sc : 0);
#pragma unroll
    for (int i = 0; i < 32; ++i) { const int kk = 2 * i + (lane >> 5); tv[i] = src[(size_t)kk * Nsrc]; }
}
template <int MAP> __device__ __forceinline__ void tr_store(const float (&tv)[32], int K, int Ndst, bf16* WT, LAS float* scr, int item, int lane) {
    const int nblk = Ndst / 32, kb = item / nblk, nb = item % nblk, k0 = 64 * kb, n0 = 32 * nb;
    const int sc = srccol<MAP>(n0 + (lane & 31));
#pragma unroll
    for (int i = 0; i < 32; ++i) { const int kk = 2 * i + (lane >> 5); scr[kk * 33 + (lane & 31)] = sc >= 0 ? tv[i] : 0.f; }
    LDS_WAIT(); asm volatile("" ::: "memory");
    const int c = lane & 7;
#pragma unroll
    for (int j = 0; j < 4; ++j) { const int n = (lane >> 3) + 8 * j; const LAS float* s = scr + (8 * c) * 33 + n;
        v4u o; o.x = pk2(s[0 * 33], s[1 * 33]); o.y = pk2(s[2 * 33], s[3 * 33]); o.z = pk2(s[4 * 33], s[5 * 33]); o.w = pk2(s[6 * 33], s[7 * 33]);
        *(GAS v4u*)(WT + (size_t)(n0 + n) * K + k0 + 8 * c) = o; }
    LDS_WAIT(); asm volatile("" ::: "memory");
}
template <int MAP> __device__ __forceinline__ void transpose_items(const float* W, int K, int Nsrc, int Ndst, bf16* WT, LAS float* scr, int it0, int stride, int nitems, int lane) {
    float ta[32], tb[32];
    int it = it0;
    if (it < nitems) tr_load<MAP>(ta, W, Nsrc, Ndst, it, lane);
#pragma unroll 1
    while (it < nitems) {
        const int i2 = it + stride; if (i2 < nitems) tr_load<MAP>(tb, W, Nsrc, Ndst, i2, lane);
        tr_store<MAP>(ta, K, Ndst, WT, scr, it, lane);
        if (i2 >= nitems) break;
        const int i3 = i2 + stride; if (i3 < nitems) tr_load<MAP>(ta, W, Nsrc, Ndst, i3, lane);
        tr_store<MAP>(tb, K, Ndst, WT, scr, i2, lane);
        it = i3;
    }
}
__device__ __forceinline__ void rms_row_to_bf16(const float* xrow, const float* gain, bf16* orow, int lane, const float* part = nullptr, int ns = 0, size_t pstride = 0, float* xout = nullptr) {
    const GAS f32x4* xr = (const GAS f32x4*)xrow + lane; const GAS f32x4* gr = (const GAS f32x4*)gain + lane;
    f32x4 v[8]; float s = 0.f;
#pragma unroll
    for (int j = 0; j < 8; ++j) v[j] = xr[64 * j];
    for (int k = 0; k < ns; k += 2) {
        const GAS f32x4* pr0 = (const GAS f32x4*)(part + (size_t)k * pstride) + lane; const GAS f32x4* pr1 = (const GAS f32x4*)(part + (size_t)(k + 1) * pstride) + lane;
        f32x4 t0[8], t1[8];
#pragma unroll
        for (int j = 0; j < 8; ++j) { t0[j] = pr0[64 * j]; t1[j] = pr1[64 * j]; }
#pragma unroll
        for (int j = 0; j < 8; ++j) v[j] += t0[j] + t1[j]; }
    if (xout) { GAS f32x4* xo = (GAS f32x4*)xout + lane;
#pragma unroll
        for (int j = 0; j < 8; ++j) xo[64 * j] = v[j]; }
#pragma unroll
    for (int j = 0; j < 8; ++j) s += dot4(v[j], v[j]);
    const float rstd = 1.0f / sqrtf(wave_sum(s) * (1.f / DM) + RMS_EPS);
    GAS v2u* o8 = (GAS v2u*)orow + lane;
#pragma unroll
    for (int j = 0; j < 8; ++j) { const f32x4 g = gr[64 * j]; v2u o; o.x = pk2(v[j].x * rstd * g.x, v[j].y * rstd * g.y); o.y = pk2(v[j].z * rstd * g.z, v[j].w * rstd * g.w); o8[64 * j] = o; }
}
__device__ __forceinline__ void rms_row_inplace(float* xrow, const float* gain, int lane, const float* part = nullptr, int ns = 0, size_t pstride = 0) {
    GAS f32x4* xr = (GAS f32x4*)xrow + lane; const GAS f32x4* gr = (const GAS f32x4*)gain + lane;
    f32x4 v[8]; float s = 0.f;
#pragma unroll
    for (int j = 0; j < 8; ++j) v[j] = xr[64 * j];
    for (int k = 0; k < ns; k += 2) {
        const GAS f32x4* pr0 = (const GAS f32x4*)(part + (size_t)k * pstride) + lane; const GAS f32x4* pr1 = (const GAS f32x4*)(part + (size_t)(k + 1) * pstride) + lane;
        f32x4 t0[8], t1[8];
#pragma unroll
        for (int j = 0; j < 8; ++j) { t0[j] = pr0[64 * j]; t1[j] = pr1[64 * j]; }
#pragma unroll
        for (int j = 0; j < 8; ++j) v[j] += t0[j] + t1[j]; }
#pragma unroll
    for (int j = 0; j < 8; ++j) s += dot4(v[j], v[j]);
    const float rstd = 1.0f / sqrtf(wave_sum(s) * (1.f / DM) + RMS_EPS);
#pragma unroll
    for (int j = 0; j < 8; ++j) { const f32x4 g = gr[64 * j]; xr[64 * j] = v[j] * rstd * g; }
}
__device__ __forceinline__ void wg_publish(gu32* w0, gu32* w1, int tid) {
    if (tid == 0) { __builtin_amdgcn_fence(__ATOMIC_RELEASE, "agent"); asm volatile("s_waitcnt vmcnt(0)" ::: "memory");
        __hip_atomic_fetch_add(w0, 1u, RLX_AGENT); if (w1) __hip_atomic_fetch_add(w1, 1u, RLX_AGENT); }
}
__device__ __forceinline__ void wg_wait_ge(gu32* w, unsigned want, int tid) {
    if (tid < 64) { unsigned polls = 0;
        while ((unsigned)__builtin_amdgcn_readfirstlane(__hip_atomic_load(w, RLX_AGENT)) < want) { __builtin_amdgcn_s_sleep(2); if (++polls > (1u << 22)) break; }
        __builtin_amdgcn_fence(__ATOMIC_ACQUIRE, "agent"); asm volatile("s_waitcnt vmcnt(0)" ::: "memory"); }
    asm volatile("" ::: "memory"); __syncthreads(); asm volatile("" ::: "memory");
}
template <int NS> __device__ __forceinline__ void sample_row_unit(const float* base, const float* part, size_t pstride, const float* gain, float* xout, bf16* obf, float* of32, LAS float* red, int wave, int lane) {
    const int col = 256 * wave + 4 * lane;
    f32x4 v = *(const GAS f32x4*)(base + col);
    f32x4 t[NS];
#pragma unroll
    for (int k = 0; k < NS; ++k) t[k] = *(const GAS f32x4*)(part + (size_t)k * pstride + col);
#pragma unroll
    for (int k = 0; k < NS; ++k) v += t[k];
    if (xout) *(GAS f32x4*)(xout + col) = v;
    const float s = wave_sum(dot4(v, v));
    if (lane == 0) red[wave] = s;
    __syncthreads();
    float tot = 0.f;
#pragma unroll
    for (int w = 0; w < 8; ++w) tot += red[w];
    const float rstd = 1.0f / sqrtf(tot * (1.f / DM) + RMS_EPS);
    const f32x4 g = *(const GAS f32x4*)(gain + col); const f32x4 r = v * rstd * g;
    if (obf) { v2u o; o.x = pk2(r.x, r.y); o.y = pk2(r.z, r.w); *(GAS v2u*)(obf + col) = o; }
    if (of32) *(GAS f32x4*)(of32 + col) = r;
    __syncthreads();
}
__device__ __forceinline__ void p0_prologue(Frame& F, const Args& A) {
    LAS float* scr = (LAS float*)(F.lds + RING_OFF + F.wave * 16384);
    const int gw = F.vcu * NWAVES + F.wave, NGW = F.G * NWAVES;
    constexpr int I_1 = (DM / 64) * (N1P / 32), I_2 = (DM / 64) * (DM / 32);
    transpose_items<1>(P_w_in, DM, N1, N1P, P_W1t, scr, gw, NGW, I_1, F.lane);
    transpose_items<0>(P_w_out, DM, DM, DM, P_W2t, scr, NGW - 1 - gw, NGW, I_2, F.lane);
    for (int m = NGW - 1 - gw; m < MPAD; m += NGW) {
        if (m < MR) rms_row_to_bf16(m < MP ? P_xp + (size_t)m * DM : P_xs + (size_t)(m - MP) * DM, P_norm_mix, P_H + (size_t)m * DM, F.lane);
        else { GAS v4u* o = (GAS v4u*)(P_H + (size_t)m * DM) + F.lane;
#pragma unroll
            for (int j = 0; j < 4; ++j) o[64 * j] = (v4u){0u, 0u, 0u, 0u}; }
    }
}
__device__ __forceinline__ void convert_w3(Frame& F, const Args& A, int wg, int nwgs) {
    LAS float* scr = (LAS float*)(F.lds + RING_OFF + F.wave * 16384);
    constexpr int I_3 = (DM / 64) * (2 * DFF / 32);
    transpose_items<3>(P_w_ffn_in, DM, 2 * DFF, 2 * DFF, P_W3t, scr, wg * NWAVES + F.wave, nwgs * NWAVES, I_3, F.lane);
}
__device__ __forceinline__ void convert_w4(Frame& F, const Args& A, int wg, int nwgs) {
    LAS float* scr = (LAS float*)(F.lds + RING_OFF + F.wave * 16384);
    constexpr int I_4 = (DFF / 64) * (DM / 32);
    transpose_items<0>(P_w_ffn_out, DFF, DM, DM, P_W4t, scr, wg * NWAVES + F.wave, nwgs * NWAVES, I_4, F.lane);
}
__device__ __forceinline__ void gla_prep_unit(Frame& F, const Args& A, int bh, int c) {
    const int tid = F.tid, b = bh >> 2, h = bh & 3, row0 = b * SEQ + c * CH;
    LAS float* GL = (LAS float*)(F.lds + RING_OFF);
    LAS float* BL = (LAS float*)(F.lds + RING_OFF + 4608);
    LAS bf16* QS = (LAS bf16*)(F.lds + RING_OFF + 8192);
    LAS bf16* KS = (LAS bf16*)(F.lds + RING_OFF + 25600);
    LAS bf16* VR = (LAS bf16*)(F.lds + RING_OFF + 43008);
    const size_t uc = (size_t)bh * NCH + c;
    const bf16* Zc = P_Z + (size_t)row0 * N1P;
    {
        v4u pq[2], pk[2], pv[4];
#pragma unroll
        for (int k = 0; k < 2; ++k) { const int p = tid + 512 * k, i = p >> 4, ch = p & 15;
            pq[k] = *(const GAS v4u*)(Zc + (size_t)i * N1P + ZQ + h * HK + 8 * ch); pk[k] = *(const GAS v4u*)(Zc + (size_t)i * N1P + ZK + h * HK + 8 * ch); }
#pragma unroll
        for (int k = 0; k < 4; ++k) { const int p = tid + 512 * k, i = p >> 5, ch = p & 31; pv[k] = *(const GAS v4u*)(Zc + (size_t)i * N1P + ZV + h * HV + 8 * ch); }
        v4u pg = (v4u){0u, 0u, 0u, 0u};
        if (tid < 128) pg = *(const GAS v4u*)(Zc + (size_t)(tid >> 1) * N1P + ZGL + 8 * (tid & 1));
#pragma unroll
        for (int k = 0; k < 2; ++k) { const int p = tid + 512 * k, i = p >> 4, ch = p & 15; *(LAS v4u*)(QS + i * 136 + 8 * ch) = pq[k]; *(LAS v4u*)(KS + i * 136 + 8 * ch) = pk[k]; }
#pragma unroll
        for (int k = 0; k < 4; ++k) { const int p = tid + 512 * k, i = p >> 5, ch = p & 31; *(LAS v4u*)(VR + i * 264 + 8 * ch) = pv[k]; }
        if (tid < 128) { LAS float* gp = GL + (tid >> 1) * 17 + 8 * (tid & 1);
            gp[0] = bflo(pg.x); gp[1] = bfhi(pg.x); gp[2] = bflo(pg.y); gp[3] = bfhi(pg.y); gp[4] = bflo(pg.z); gp[5] = bfhi(pg.z); gp[6] = bflo(pg.w); gp[7] = bfhi(pg.w); }
    }
    const int d = tid & 127, g = tid >> 7;
    float wg[16];
#pragma unroll
    for (int r = 0; r < 16; ++r) wg[r] = P_wgu[r * DK + h * HK + d];
    const float bg = P_bgate[h * HK + d];
    __syncthreads();
    float bcum[16]; float run = 0.f;
#pragma unroll
    for (int ii = 0; ii < 16; ++ii) { const int i = g * 16 + ii; float x = bg;
#pragma unroll
        for (int r = 0; r < 16; ++r) x += GL[i * 17 + r] * wg[r];
        run += logsigmoid_f(x) * (1.0f / 16.0f); bcum[ii] = run; }
    BL[g * 128 + d] = run;
    __syncthreads();
    float off = 0.f, tot = 0.f;
#pragma unroll
    for (int gg = 0; gg < 4; ++gg) { const float t = BL[gg * 128 + d]; off += (gg < g) ? t : 0.f; tot += t; }
    const float scale = 0.08838834764831845f;
    unsigned khw[8];
#pragma unroll
    for (int ii = 0; ii < 16; ++ii) { const int i = g * 16 + ii; const float bb = bcum[ii] + off;
        const float q = bf2f(QS[i * 136 + d]) * scale * __expf(bb);
        const float kv = bf2f(KS[i * 136 + d]);
        const unsigned qb = f2bf(q), ktb = f2bf(kv * __expf(-bb)), khb = f2bf(kv * __expf(tot - bb));
        QS[i * 136 + d] = (bf16)qb; KS[i * 136 + d] = (bf16)ktb;
        if (ii & 1) khw[ii >> 1] |= khb << 16; else khw[ii >> 1] = khb; }
    { GAS v4u* kp = (GAS v4u*)(P_KH + (uc * 128 + d) * 64 + g * 16);
      kp[0] = (v4u){khw[0], khw[1], khw[2], khw[3]}; kp[1] = (v4u){khw[4], khw[5], khw[6], khw[7]}; }
    if (g == 0) P_DCb[uc * 128 + d] = __expf(tot);
    { const int n = tid & 255, jh = tid >> 8; unsigned vw[16];
#pragma unroll
      for (int jj = 0; jj < 32; ++jj) { const unsigned v = VR[(32 * jh + jj) * 264 + n];
          if (jj & 1) vw[jj >> 1] |= v << 16; else vw[jj >> 1] = v; }
      GAS v4u* vp = (GAS v4u*)(P_VT + (uc * 256 + n) * 64 + 32 * jh);
#pragma unroll
      for (int k = 0; k < 4; ++k) vp[k] = (v4u){vw[4 * k], vw[4 * k + 1], vw[4 * k + 2], vw[4 * k + 3]}; }
    __syncthreads();
    {
#pragma unroll
        for (int k = 0; k < 2; ++k) { const int p = tid + 512 * k, i = p >> 4, s = (p >> 2) & 3, fq = p & 3;
            const v2u lo = *(const LAS v2u*)(QS + i * 136 + 32 * s + 4 * fq), hi = *(const LAS v2u*)(QS + i * 136 + 32 * s + 16 + 4 * fq);
            *(GAS v4u*)(P_QT + (uc * 64 + i) * 128 + 32 * s + 8 * fq) = (v4u){lo.x, lo.y, hi.x, hi.y}; }
    }
    { const int fr = F.lane & 15, fq = F.lane >> 4;
#pragma unroll
      for (int tt = 0; tt < 2; ++tt) { const int id = 2 * F.wave + tt, it = id >> 2, jt = id & 3;
          f32x4 acc = (f32x4){0.f, 0.f, 0.f, 0.f};
          if (jt <= it) {
#pragma unroll
              for (int s = 0; s < 4; ++s) { const bf16x8 a = *(const LAS bf16x8*)(KS + (jt * 16 + fr) * 136 + 32 * s + 8 * fq); const bf16x8 bq = *(const LAS bf16x8*)(QS + (it * 16 + fr) * 136 + 32 * s + 8 * fq);
                  acc = __builtin_amdgcn_mfma_f32_16x16x32_bf16(a, bq, acc, 0, 0, 0); } }
          const int i = it * 16 + fr, j0 = jt * 16 + 4 * fq;
#pragma unroll
          for (int r = 0; r < 4; ++r) if (j0 + r > i) acc[r] = 0.f;
          v2u o; o.x = pk2(acc[0], acc[1]); o.y = pk2(acc[2], acc[3]);
          *(GAS v2u*)(P_AM + (uc * 64 + i) * 64 + j0) = o; } }
    __syncthreads();
}
__device__ __forceinline__ void ln_silu_row(const LAS float* cs, const float* lng, const float* lnb, bf16* orow, int lane) {
    f32x4 x[4]; float s = 0.f;
#pragma unroll
    for (int j = 0; j < 4; ++j) { x[j] = *(const LAS f32x4*)(cs + 256 * j + 4 * lane); s += (x[j].x + x[j].y) + (x[j].z + x[j].w); }
    const float mean = wave_sum(s) * (1.f / DC_); float q = 0.f;
#pragma unroll
    for (int j = 0; j < 4; ++j) { x[j] = x[j] - mean; q += dot4(x[j], x[j]); }
    const float rstd = 1.0f / sqrtf(wave_sum(q) * (1.f / DC_) + LN_EPS);
#pragma unroll
    for (int j = 0; j < 4; ++j) { const f32x4 g = *(const GAS f32x4*)(lng + 256 * j + 4 * lane), bb = *(const GAS f32x4*)(lnb + 256 * j + 4 * lane);
        const f32x4 y = x[j] * rstd * g + bb; v2u o; o.x = pk2(silu_f(y.x), silu_f(y.y)); o.y = pk2(silu_f(y.z), silu_f(y.w));
        *(GAS v2u*)(orow + 256 * j + 4 * lane) = o; }
}
__device__ __forceinline__ void conv_prompt_unit(Frame& F, const Args& A, int b, int tb) {
    LAS float* CS = (LAS float*)(F.lds + RING_OFF);
    const int t0 = tb * 16, c = 2 * F.tid;
    f32x2 wt[31];
#pragma unroll
    for (int w = 0; w < 31; ++w) wt[w] = *(const GAS f32x2*)(P_conv_w + w * DC_ + c);
    const f32x2 bias = *(const GAS f32x2*)(P_conv_b + c);
    f32x2 acc[16];
#pragma unroll
    for (int tt = 0; tt < 16; ++tt) acc[tt] = bias;
#pragma unroll
    for (int r = 0; r < 46; ++r) { const int t = t0 - 30 + r, tc = t < 0 ? 0 : t; const bf16* zr = P_Z + (size_t)(b * SEQ + tc) * N1P;
        const unsigned ua = *(const GAS unsigned*)(zr + ZUA + c), ug = *(const GAS unsigned*)(zr + ZUG + c);
        const float m = t >= 0 ? 1.f : 0.f;
        f32x2 g; g.x = m * bflo(ua) * sigmoid_f(bflo(ug)); g.y = m * bfhi(ua) * sigmoid_f(bfhi(ug));
#pragma unroll
        for (int tt = 0; tt < 16; ++tt) { if (r - tt >= 0 && r - tt < 31) acc[tt] += g * wt[(r - tt >= 0 && r - tt < 31) ? r - tt : 0]; }
        if ((r & 3) == 3) { asm volatile("" ::: "memory"); __builtin_amdgcn_sched_barrier(0); }
    }
#pragma unroll
    for (int tt = 0; tt < 16; ++tt) *(LAS f32x2*)(CS + tt * 1024 + c) = acc[tt];
    __syncthreads();
#pragma unroll
    for (int k = 0; k < 2; ++k) { const int tt = 2 * F.wave + k; ln_silu_row(CS + tt * 1024, P_ln_g, P_ln_b, P_MIX + (size_t)(b * SEQ + t0 + tt) * DM + DA, F.lane); }
    __syncthreads();
}
__device__ __forceinline__ void conv_state_prompt_row(Frame& F, const Args& A, int b, int rr) {
    const bf16* zr = P_Z + (size_t)(b * SEQ + SEQ - 30 + rr) * N1P; float* orow = P_out + O_CP + ((size_t)b * 30 + rr) * DC_;
#pragma unroll
    for (int j = 0; j < 4; ++j) { const int c = 256 * j + 4 * F.lane; const v2u ua = *(const GAS v2u*)(zr + ZUA + c), ug = *(const GAS v2u*)(zr + ZUG + c);
        f32x4 g; g.x = bflo(ua.x) * sigmoid_f(bflo(ug.x)); g.y = bfhi(ua.x) * sigmoid_f(bfhi(ug.x)); g.z = bflo(ua.y) * sigmoid_f(bflo(ug.y)); g.w = bfhi(ua.y) * sigmoid_f(bfhi(ug.y));
        *(GAS f32x4*)(orow + c) = g; }
}
__device__ __forceinline__ void conv_sample_unit(Frame& F, const Args& A, int b) {
    LAS float* CS = (LAS float*)(F.lds + RING_OFF);
    const bf16* zr = P_Z + (size_t)(MP + b) * N1P;
    const int c = 2 * F.tid;
    f32x2 acc = *(const GAS f32x2*)(P_conv_b + c);
    f32x2 hv[30];
#pragma unroll
    for (int w = 0; w < 30; ++w) hv[w] = *(const GAS f32x2*)(P_sconv + ((size_t)b * 30 + w) * DC_ + c);
    const unsigned ua = *(const GAS unsigned*)(zr + ZUA + c), ug = *(const GAS unsigned*)(zr + ZUG + c);
#pragma unroll
    for (int w = 0; w < 30; ++w) { acc += hv[w] * *(const GAS f32x2*)(P_conv_w + w * DC_ + c); if (w >= 1) *(GAS f32x2*)(P_out + O_CS + ((size_t)b * 30 + (w - 1)) * DC_ + c) = hv[w]; }
    f32x2 gl; gl.x = bflo(ua) * sigmoid_f(bflo(ug)); gl.y = bfhi(ua) * sigmoid_f(bfhi(ug));
    acc += gl * *(const GAS f32x2*)(P_conv_w + 30 * DC_ + c);
    *(GAS f32x2*)(P_out + O_CS + ((size_t)b * 30 + 29) * DC_ + c) = gl;
    *(LAS f32x2*)(CS + c) = acc;
    __syncthreads();
    if (F.wave == 0) ln_silu_row(CS, P_ln_g, P_ln_b, P_MIX + (size_t)(MP + b) * DM + DA, F.lane);
    __syncthreads();
}
__device__ __forceinline__ void gla_sample_item(Frame& F, const Args& A, int item) {
    const int b = item >> 2, h = item & 3, tid = F.tid;
    LAS float* AD = (LAS float*)(F.lds + RING_OFF);
    LAS float* KD = AD + 128; LAS float* QD = AD + 256; LAS float* VD = AD + 384;
    LAS float* OP = AD + 640;
    const bf16* zr = P_Z + (size_t)(MP + b) * N1P;
    const int n4 = 4 * F.lane;
    const float* Sin = P_sgla + (size_t)(b * NH + h) * HK * HV; float* Sout = P_out + O_GS + (size_t)(b * NH + h) * HK * HV;
    f32x4 s[16];
#pragma unroll
    for (int dd = 0; dd < 16; ++dd) s[dd] = *(const GAS f32x4*)(Sin + (size_t)(16 * F.wave + dd) * HV + n4);
    if (tid < 128) { const int d = tid; float x = P_bgate[h * HK + d];
#pragma unroll
        for (int r = 0; r < 16; ++r) x += bf2f(zr[ZGL + r]) * P_wgu[r * DK + h * HK + d];
        AD[d] = __expf(logsigmoid_f(x) * (1.0f / 16.0f)); KD[d] = bf2f(zr[ZK + h * HK + d]); QD[d] = bf2f(zr[ZQ + h * HK + d]) * 0.08838834764831845f; }
    else if (tid < 384) { const int n = tid - 128; VD[n] = bf2f(zr[ZV + h * HV + n]); }
    __syncthreads();
    const f32x4 v4 = *(const LAS f32x4*)(VD + n4);
    f32x4 oacc = (f32x4){0.f, 0.f, 0.f, 0.f};
#pragma unroll
    for (int dd = 0; dd < 16; ++dd) { const int d = 16 * F.wave + dd;
        const f32x4 sn = s[dd] * AD[d] + v4 * KD[d]; *(GAS f32x4*)(Sout + (size_t)d * HV + n4) = sn; oacc += sn * QD[d]; }
    *(LAS f32x4*)(OP + F.wave * 256 + n4) = oacc;
    __syncthreads();
    if (F.wave == 0) { f32x4 o4 = (f32x4){0.f, 0.f, 0.f, 0.f};
#pragma unroll
        for (int w = 0; w < 8; ++w) o4 += *(const LAS f32x4*)(OP + w * 256 + n4);
        const float rstd = 1.0f / sqrtf(wave_sum(dot4(o4, o4)) * (1.f / HV) + RMS_EPS);
        const f32x4 gn = *(const GAS f32x4*)(P_gla_norm + n4); const v2u go = *(const GAS v2u*)(zr + ZGO + h * HV + n4);
        v2u o; o.x = pk2(o4.x * rstd * gn.x * silu_f(bflo(go.x)), o4.y * rstd * gn.y * silu_f(bfhi(go.x))); o.y = pk2(o4.z * rstd * gn.z * silu_f(bflo(go.y)), o4.w * rstd * gn.w * silu_f(bfhi(go.y)));
        *(GAS v2u*)(P_MIX + (size_t)(MP + b) * DM + h * HV + n4) = o; }
    __syncthreads();
}
constexpr int SQ_AM = 0, SQ_QT = 9216, SQ_KH = 26624, SQ_VT = 45056, SQ_DC = 49664, SQ_BUF = 50176, SQ_NP = 2848, SQ_LT = 384;
__device__ __forceinline__ void seq_issue(v4u (&R)[8], const bf16* AMc, const bf16* QTc, const bf16* KHc, const bf16* VTc, const float* DCc, int lt) {
#pragma unroll
    for (int k = 0; k < 8; ++k) { const int P = lt + SQ_LT * k; const bf16* src = AMc;
        if (P < 512) src = AMc + (P >> 3) * 64 + (P & 7) * 8;
        else if (P < 1536) { const int q = P - 512; src = QTc + (q >> 4) * 128 + (q & 15) * 8; }
        else if (P < 2560) { const int q = P - 1536; src = KHc + (q >> 3) * 64 + (q & 7) * 8; }
        else if (P < 2816) { const int q = P - 2560; src = VTc + (q >> 3) * 64 + (q & 7) * 8; }
        else if (P < SQ_NP) { const int q = P - 2816; src = (const bf16*)DCc + q * 8; }
        R[k] = *(const GAS v4u*)src; }
}
__device__ __forceinline__ void seq_stash(const v4u (&R)[8], LAS unsigned char* buf, int lt) {
#pragma unroll
    for (int k = 0; k < 8; ++k) { const int P = lt + SQ_LT * k; int dst = 0;
        if (P < 512) dst = SQ_AM + (P >> 3) * 144 + (P & 7) * 16;
        else if (P < 1536) { const int q = P - 512; dst = SQ_QT + (q >> 4) * 272 + (q & 15) * 16; }
        else if (P < 2560) { const int q = P - 1536; dst = SQ_KH + (q >> 3) * 144 + (q & 7) * 16; }
        else if (P < 2816) { const int q = P - 2560; dst = SQ_VT + (q >> 3) * 144 + (q & 7) * 16; }
        else { const int q = P - 2816; dst = SQ_DC + q * 16; }
        if (P < SQ_NP) *(LAS v4u*)(buf + dst) = R[k]; }
}
__device__ __forceinline__ void gla_seq_wg(Frame& F, const Args& A, int item) {
    const int bh = item >> 3, grp = item & 7, b = bh >> 2, h = bh & 3, fr = F.lane & 15, fq = F.lane >> 4;
    LAS unsigned char* lds0 = F.lds + RING_OFF;
    const bool loader = F.wave >= 2; const int lt = F.tid - 128;
    const size_t uc0 = (size_t)bh * NCH;
    const bf16* AM0 = P_AM + uc0 * 64 * 64; const bf16* QT0 = P_QT + uc0 * 64 * 128; const bf16* KH0 = P_KH + uc0 * 128 * 64; const bf16* VT0 = P_VT + uc0 * 256 * 64 + (size_t)(grp * 32) * 64; const float* DC0 = P_DCb + uc0 * 128;
    v4u RA[8], RB[8];
    f32x4 S[8];
#pragma unroll
    for (int dt = 0; dt < 8; ++dt) S[dt] = (f32x4){0.f, 0.f, 0.f, 0.f};
#define SEQ_ISSUE(R, CC) do { const size_t o_ = (size_t)(CC); seq_issue(R, AM0 + o_ * 64 * 64, QT0 + o_ * 64 * 128, KH0 + o_ * 128 * 64, VT0 + o_ * 256 * 64, DC0 + o_ * 128, lt); } while (0)
    if (loader) { SEQ_ISSUE(RA, 0); SEQ_ISSUE(RB, 1); seq_stash(RA, lds0, lt); SEQ_ISSUE(RA, 2); }
    __syncthreads();
    const int n0 = grp * 32 + 16 * F.wave;
#define SEQ_COMPUTE(CC) do { \
            const LAS unsigned char* buf = lds0 + ((CC) & 1) * SQ_BUF; \
            bf16x8 vt[2]; \
_Pragma("unroll") \
            for (int ks = 0; ks < 2; ++ks) vt[ks] = *(const LAS bf16x8*)(buf + SQ_VT + (16 * F.wave + fr) * 144 + (32 * ks + 8 * fq) * 2); \
            f32x4 o[4]; \
_Pragma("unroll") \
            for (int m = 0; m < 4; ++m) { o[m] = (f32x4){0.f, 0.f, 0.f, 0.f}; \
_Pragma("unroll") \
                for (int ks = 0; ks < 2; ++ks) { const bf16x8 a = *(const LAS bf16x8*)(buf + SQ_AM + (16 * m + fr) * 144 + (32 * ks + 8 * fq) * 2); o[m] = __builtin_amdgcn_mfma_f32_16x16x32_bf16(vt[ks], a, o[m], 0, 0, 0); } } \
            bf16x8 sb[4]; \
_Pragma("unroll") \
            for (int s = 0; s < 4; ++s) { v4u w; w.x = pk2(S[2 * s][0], S[2 * s][1]); w.y = pk2(S[2 * s][2], S[2 * s][3]); w.z = pk2(S[2 * s + 1][0], S[2 * s + 1][1]); w.w = pk2(S[2 * s + 1][2], S[2 * s + 1][3]); sb[s] = __builtin_bit_cast(bf16x8, w); } \
_Pragma("unroll") \
            for (int m = 0; m < 4; ++m) \
_Pragma("unroll") \
                for (int s = 0; s < 4; ++s) { const bf16x8 a = *(const LAS bf16x8*)(buf + SQ_QT + (16 * m + fr) * 272 + (32 * s + 8 * fq) * 2); o[m] = __builtin_amdgcn_mfma_f32_16x16x32_bf16(sb[s], a, o[m], 0, 0, 0); } \
_Pragma("unroll") \
            for (int m = 0; m < 4; ++m) *(GAS f32x4*)(P_O32 + (size_t)(b * SEQ + (CC) * CH + 16 * m + fr) * DA + h * HV + n0 + 4 * fq) = o[m]; \
_Pragma("unroll") \
            for (int dt = 0; dt < 8; ++dt) { const f32x4 dc = *(const LAS f32x4*)(buf + SQ_DC + (16 * dt + 4 * fq) * 4); S[dt] = S[dt] * dc; \
_Pragma("unroll") \
                for (int ks = 0; ks < 2; ++ks) { const bf16x8 a = *(const LAS bf16x8*)(buf + SQ_KH + (16 * dt + fr) * 144 + (32 * ks + 8 * fq) * 2); S[dt] = __builtin_amdgcn_mfma_f32_16x16x32_bf16(a, vt[ks], S[dt], 0, 0, 0); } } \
        } while (0)
#pragma unroll 1
    for (int c = 0; c < NCH; c += 2) {
        if (loader) { seq_stash(RB, lds0 + SQ_BUF, lt); if (c + 3 < NCH) SEQ_ISSUE(RB, c + 3); }
        else SEQ_COMPUTE(c);
        __syncthreads();
        if (loader) { if (c + 2 < NCH) seq_stash(RA, lds0, lt); if (c + 4 < NCH) SEQ_ISSUE(RA, c + 4); }
        else SEQ_COMPUTE(c + 1);
        __syncthreads();
    }
#undef SEQ_COMPUTE
#undef SEQ_ISSUE
    if (!loader) {
#pragma unroll
        for (int dt = 0; dt < 8; ++dt)
#pragma unroll
            for (int r = 0; r < 4; ++r) P_out[O_GP + ((size_t)bh * HK + 16 * dt + 4 * fq + r) * HV + n0 + fr] = S[dt][r];
    }
}
__device__ __forceinline__ void gla_onorm_item(Frame& F, const Args& A, int row, int h) {
    const int n4 = 4 * F.lane;
    const f32x4 o4 = *(const GAS f32x4*)(P_O32 + (size_t)row * DA + h * HV + n4);
    const float rstd = 1.0f / sqrtf(wave_sum(dot4(o4, o4)) * (1.f / HV) + RMS_EPS);
    const f32x4 gn = *(const GAS f32x4*)(P_gla_norm + n4); const v2u go = *(const GAS v2u*)(P_Z + (size_t)row * N1P + ZGO + h * HV + n4);
    v2u o; o.x = pk2(o4.x * rstd * gn.x * silu_f(bflo(go.x)), o4.y * rstd * gn.y * silu_f(bfhi(go.x))); o.y = pk2(o4.z * rstd * gn.z * silu_f(bflo(go.y)), o4.w * rstd * gn.w * silu_f(bfhi(go.y)));
    *(GAS v2u*)(P_MIX + (size_t)row * DM + h * HV + n4) = o;
}
constexpr int G1_WGS = 231, G3_WGS = 242;
#ifndef FUSE_ROWS
#define FUSE_ROWS 1
#endif
constexpr int NKP2 = 2, NKP4 = 4;

#ifdef EXTRA_PHASE
#define MK_N_LAUNCHES 10
#endif
#ifndef MK_N_LAUNCHES
#define MK_N_LAUNCHES 1
#endif
constexpr int N_PHASES = 10;
constexpr int N_LAUNCHES = MK_N_LAUNCHES;
__global__ void __launch_bounds__(NWAVES * 64, 2) hymba_fwd(Args args) {
    extern __shared__ __attribute__((aligned(16))) unsigned char lds[];
    Frame F;
    F.lds = (LAS unsigned char*)lds;
    F.MISC = (volatile LAS unsigned*)(F.lds + MISC_OFF);
    F.tid = threadIdx.x; F.lane = F.tid & 63; F.wave = __builtin_amdgcn_readfirstlane(F.tid >> 6);
    F.G = gridDim.x; { const int bx = blockIdx.x; F.vcu = (F.G % 8 == 0) ? (bx % 8) * (F.G / 8) + bx / 8 : bx; }
    const Args& A = args;
    F.ctl = (gu32*)(args.ws + WS_CTL);
    for (int u = F.tid; u < (LDS_BYTES - LDSCTL_OFF) / 4; u += NWAVES * 64) ((LAS unsigned*)(F.lds + LDSCTL_OFF))[u] = 0u;
    __syncthreads();
    XcdBarrier bar; bar.bar = (unsigned*)(F.ctl + CW_BAR); bar.x = 0; bar.st = nullptr;
    if (N_LAUNCHES == 1) bar = xcd_barrier_post((unsigned*)(F.ctl + CW_BAR), F.MISC + 8);
    const int lo = args.ph_lo, hi = args.ph_hi;
#ifndef REP_MASK
#define REP_MASK 0
#endif
#define REPS(k) (((REP_MASK >> (k)) & 1) ? 2 : 1)
#ifndef P2A_REP
#define P2A_REP 0
#endif
#ifndef P2A_MASK
#define P2A_MASK 15
#endif
#ifndef PH_MASK
#define PH_MASK 0x3ff
#endif
#define IN(k) (((PH_MASK >> (k)) & 1) && lo <= (k) && (k) < hi)
#define SEAM(k) do { if (IN(k) && IN((k) + 1)) xcd_barrier(bar); } while (0)
    const int gw = F.vcu * NWAVES + F.wave, NGW = F.G * NWAVES;

    if (IN(0)) for (int rep_ = 0; rep_ < REPS(0); ++rep_) { p0_prologue(F, A); }
    SEAM(0);
    if (IN(1)) for (int rep_ = 0; rep_ < REPS(1); ++rep_) {
        const int geff = (F.G == 256) ? G1_WGS : F.G;
        if ((int)blockIdx.x < geff) { pg8::Gemm g{P_H, P_W1t, MPAD, N1P, DM}; pg8::StaticOrder S; S.init(MPAD, N1P, geff, (int)blockIdx.x);
            pg8::EpiStoreBf16 E{P_Z, N1P};
            pg8::gemm_phase<pg8::EpiStoreBf16, pg8::StaticOrder, true, true>(F.lds + RING_OFF, g, S, E); }
        if (geff == F.G) convert_w3(F, A, (int)blockIdx.x, F.G); else if ((int)blockIdx.x >= geff) convert_w3(F, A, (int)blockIdx.x - geff, F.G - geff);
    }
    SEAM(1);
    if (IN(2)) for (int rep_ = 0; rep_ < REPS(2); ++rep_) {
        constexpr int U_PREP = NB * NH * NCH, U_CONVP = NB * (SEQ / 16), U_CONVS = MS;
        for (int q_ = 0; q_ < ((P2A_REP & 2) ? 2 : 1); ++q_) if (P2A_MASK & 2) { for (int r = F.vcu; r < U_PREP; r += F.G) gla_prep_unit(F, A, r / NCH, r % NCH); }
        for (int q_ = 0; q_ < ((P2A_REP & 4) ? 2 : 1); ++q_) if (P2A_MASK & 4) { for (int r = F.vcu; r < U_CONVP; r += F.G) conv_prompt_unit(F, A, r / (SEQ / 16), r % (SEQ / 16)); }
        { const int gw2 = F.vcu * NWAVES + F.wave; for (int r = gw2; r < NB * 30; r += F.G * NWAVES) conv_state_prompt_row(F, A, r / 30, r % 30); }
        for (int q_ = 0; q_ < ((P2A_REP & 8) ? 2 : 1); ++q_) if (P2A_MASK & 8) { for (int r = F.G - 1 - F.vcu; r < U_CONVS; r += F.G) conv_sample_unit(F, A, r); }
    }
    SEAM(2);
    if (IN(3)) for (int rep_ = 0; rep_ < REPS(3); ++rep_) {
        { const int bx = (int)blockIdx.x; if (bx < NB * NH * 8) gla_seq_wg(F, A, (bx & 7) * (NB * NH) + (bx >> 3));
          else { const int nrest = F.G - NB * NH * 8; for (int r = bx - NB * NH * 8; r < MS * NH; r += nrest) gla_sample_item(F, A, r); } }
    }
    SEAM(3);
    if (IN(4)) for (int rep_ = 0; rep_ < REPS(4); ++rep_) { for (int it = gw; it < MP * NH; it += NGW) gla_onorm_item(F, A, it >> 2, it & 3); }
    SEAM(4);
    if (IN(5)) {
        pg8::Gemm g{P_MIX, P_W2t, MPAD, DM, DM}; pg8::TailSplitOrder S; S.init_ts(MP, DM, DM, F.G, (int)blockIdx.x, NKP2, true);
        pg8::RowStats st{(float*)(A.ws + WS_XB2), (unsigned*)(F.ctl + CW_RB2), RMS_EPS};
        pg8::EpiResNormBf16 E{P_xp, P_out, P_H, P_norm_ffn, DM, (float*)(A.ws + WS_SK2), st};
        pg8::gemm_phase<pg8::EpiResNormBf16, pg8::TailSplitOrder, false, true>(F.lds + RING_OFF, g, S, E);
        if ((int)blockIdx.x < S.npieces) wg_publish(F.ctl + CW_SP2, nullptr, F.tid);
        if ((int)blockIdx.x >= F.G - MS) { wg_wait_ge(F.ctl + CW_SP2, (unsigned)S.npieces, F.tid); const int r = (int)blockIdx.x - (F.G - MS);
            sample_row_unit<(DM / 64) / NKP2>(P_xs + (size_t)r * DM, (const float*)(A.ws + WS_SK2) + (size_t)r * DM, (size_t)128 * DM, P_norm_ffn, P_out + (size_t)(MP + r) * DM, P_H + (size_t)(MP + r) * DM, nullptr, (LAS float*)(F.lds + RING_OFF), F.wave, F.lane); }
    }
    SEAM(5);
    if (IN(7)) for (int rep_ = 0; rep_ < REPS(7); ++rep_) {
        const int geff = (F.G == 256) ? G3_WGS : F.G;
        if ((int)blockIdx.x < geff) { pg8::Gemm g{P_H, P_W3t, MPAD, 2 * DFF, DM}; pg8::StaticOrder S; S.init(MPAD, 2 * DFF, geff, (int)blockIdx.x);
            pg8::EpiSwiglu E{P_HID, DFF};
            pg8::gemm_phase<pg8::EpiSwiglu, pg8::StaticOrder, true, true>(F.lds + RING_OFF, g, S, E); }
        if (geff == F.G) convert_w4(F, A, (int)blockIdx.x, F.G); else if ((int)blockIdx.x >= geff) convert_w4(F, A, (int)blockIdx.x - geff, F.G - geff);
    }
    SEAM(7);
    if (IN(8)) {
        pg8::Gemm g{P_HID, P_W4t, MPAD, DM, DFF}; pg8::TailSplitOrder S; S.init_ts(MP, DM, DFF, F.G, (int)blockIdx.x, NKP4, true);
        pg8::RowStats st{(float*)(A.ws + WS_XB4), (unsigned*)(F.ctl + CW_RB4), RMS_EPS};
        pg8::EpiResNormF32 E{P_out, P_norm_final, DM, (float*)(A.ws + WS_SK4), st};
        pg8::gemm_phase<pg8::EpiResNormF32, pg8::TailSplitOrder, false, true>(F.lds + RING_OFF, g, S, E);
        if ((int)blockIdx.x < S.npieces) wg_publish(F.ctl + CW_SP4, nullptr, F.tid);
        if ((int)blockIdx.x >= F.G - MS) { wg_wait_ge(F.ctl + CW_SP4, (unsigned)S.npieces, F.tid); const int r = (int)blockIdx.x - (F.G - MS);
            sample_row_unit<(DFF / 64) / NKP4>(P_out + (size_t)(MP + r) * DM, (const float*)(A.ws + WS_SK4) + (size_t)r * DM, (size_t)128 * DM, P_norm_final, nullptr, nullptr, P_out + (size_t)(MP + r) * DM, (LAS float*)(F.lds + RING_OFF), F.wave, F.lane); }
    }
#undef IN
#undef SEAM
}

extern "C" void kernel_launch(void* const* d_in, const int* in_sizes, int n_in, void* d_out, int out_size, void* d_ws, size_t ws_size, hipStream_t stream) {
    static int grid = 0;
    if (grid == 0) {
        if (n_in != 18 || in_sizes[0] != MP * DM || (size_t)out_size != O_END || ws_size < WS_END) {
            fprintf(stderr, "kernel_launch: shape mismatch: n_in %d in0 %d out %d ws %zu (need %zu); nothing launched\n", n_in, n_in > 0 ? in_sizes[0] : -1, out_size, ws_size, (size_t)WS_END); grid = -1; return; }
        int dev = 0, cus = 0, per_cu = 0;
        if (hipGetDevice(&dev) != hipSuccess || hipDeviceGetAttribute(&cus, hipDeviceAttributeMultiprocessorCount, dev) != hipSuccess) { grid = -1; return; }
        if (hipFuncSetAttribute((const void*)hymba_fwd, hipFuncAttributeMaxDynamicSharedMemorySize, LDS_BYTES) != hipSuccess) { fprintf(stderr, "kernel_launch: hipFuncSetAttribute failed\n"); grid = -1; return; }
        if (hipOccupancyMaxActiveBlocksPerMultiprocessor(&per_cu, (const void*)hymba_fwd, NWAVES * 64, LDS_BYTES) != hipSuccess || per_cu < 1)
            fprintf(stderr, "kernel_launch: note: occupancy query reports %d workgroups per CU\n", per_cu);
        (void)hipGetLastError();
        grid = cus;
    }
    if (grid < 0) return;
    if (hipMemsetAsync((char*)d_ws + WS_CTL, 0, CTL_ZERO_BYTES, stream) != hipSuccess) return;
    Args a{};
    for (int i = 0; i < 18; ++i) a.in[i] = (const float*)d_in[i];
    a.out = (float*)d_out; a.ws = (unsigned char*)d_ws;
    for (int li = 0; li < N_LAUNCHES; ++li) {
        a.ph_lo = (N_LAUNCHES == 1) ? 0 : li; a.ph_hi = (N_LAUNCHES == 1) ? N_PHASES : li + 1;
        hipLaunchKernelGGL(hymba_fwd, dim3(grid), dim3(NWAVES * 64), LDS_BYTES, stream, a);
        const hipError_t le = hipPeekAtLastError();
        if (le != hipSuccess) { fprintf(stderr, "kernel_launch: launch %d failed: %s\n", li, hipGetErrorName(le)); break; }
#ifdef EXTRA_PHASE
        if (N_LAUNCHES != 1 && li == EXTRA_PHASE) { Args a2 = a; a2.pad = 1; hipLaunchKernelGGL(hymba_fwd, dim3(grid), dim3(NWAVES * 64), LDS_BYTES, stream, a2); }
#endif
    }
}
```

```cpp
#include <hip/hip_runtime.h>
#include <cstdio>
#include <cstdint>
constexpr int PG8_DUMMY = 0;
#ifndef WGM_V
#define WGM_V 8
#endif
namespace pg8 {
#define PG8_LAS __attribute__((address_space(3)))
typedef unsigned short bf16_t;
typedef short bf16x8 __attribute__((ext_vector_type(8)));
typedef float f32x4 __attribute__((ext_vector_type(4)));
typedef unsigned u32x4 __attribute__((ext_vector_type(4)));
constexpr int BM = 256, BK = 64, HALF = 128, HTB = HALF * BK * 2  , STAGE_BYTES = 8 * HTB, NXCD = 8, WGM = WGM_V;

__host__ __device__ __forceinline__ int lds_byte(int r, int c) { const int st = (r >> 4) * 2 + (c >> 5), rr = r & 15, cc = c & 31, ob = rr * 64 + cc * 2; return st * 1024 + (ob ^ (((ob >> 9) & 1) << 5)); }
__host__ __device__ __forceinline__ void stage_rc(int b, int& R, int& C) { const int st = b / 1024, sb = b % 1024, swz = sb ^ (((sb >> 9) & 1) << 5); R = (st >> 1) * 16 + swz / 64; C = (st & 1) * 32 + (swz % 64) / 2; }
__host__ __device__ __forceinline__ int perm32(int rho) { const int n = rho >> 4, i = rho & 15; return 8 * (i >> 2) + 4 * n + (i & 3); }

struct Unit { int pm, pn, k0, nk, mode, slot; };
struct Gemm { const bf16_t* A; const bf16_t* Bt; int M, N, K; };

struct StaticOrder {
    static constexpr bool SK = false;
    int nM, nN, nwg, G, c;
    __host__ __device__ __forceinline__ void init(int M, int N, int G_, int c_) { nM = M / BM; nN = N / BM; nwg = nM * nN; G = G_; c = c_; }
    __host__ __device__ __forceinline__ bool next(int i, Unit& u) const {
        const long L = (long)i * G + c; const bool ok = L < nwg;
        int wgid = ok ? (int)L : 0; { const int q = nwg / NXCD, r = nwg % NXCD, xcd = wgid % NXCD, off = wgid / NXCD; wgid = (xcd < r ? xcd * (q + 1) : r * (q + 1) + (xcd - r) * q) + off; }
        const int nig = WGM * nN, gid = wgid / nig, fm = gid * WGM, gsz = (nM - fm) < WGM ? (nM - fm) : WGM;
        u.pm = fm + ((wgid % nig) % gsz); u.pn = (wgid % nig) / gsz; return ok;
    }
    __device__ __forceinline__ void a_ready(const Unit&) const {}
    __device__ __forceinline__ void done(const Unit&) const {}
};
__device__ __forceinline__ unsigned cvt_pk_bf16(float lo, float hi) { unsigned r; asm volatile("v_cvt_pk_bf16_f32 %0, %1, %2" : "=v"(r) : "v"(lo), "v"(hi)); return r; }
typedef float f32x2 __attribute__((ext_vector_type(2)));
#ifndef NKP2_V
#define NKP2_V 4
#endif
#ifndef NKP4_V
#define NKP4_V 8
#endif
constexpr int NS_P3 = (2048 / 64) / NKP2_V, NS_P5 = (5632 / 64) / NKP4_V;
#ifndef HID_NT
#define HID_NT 0
#endif
typedef unsigned u32x2v __attribute__((ext_vector_type(2)));
__device__ __forceinline__ float silu_f(float x) { return x * __builtin_amdgcn_rcpf(1.0f + __expf(-x)); }
struct EpiStoreBf16 {
    static constexpr bool PERM = true, AFTER_DRAIN = false, HAS_INIT = false;
    bf16_t* O; int ldc; int glu_lo, glu_hi, glu_col;
    __device__ __forceinline__ void operator()(const f32x4 (&acc)[2][2][4][2], const Unit& u, int wr, int wc, int fr, int fq) const {
        const int row0 = u.pm * BM + wr * 64 + fr;
        if (u.pn >= glu_lo && u.pn < glu_hi) {
            const int col0 = glu_col + (u.pn - glu_lo) * HALF + wc * 32 + 8 * fq;
#pragma unroll
            for (int ai = 0; ai < 2; ++ai)
#pragma unroll
                for (int m = 0; m < 4; ++m) { bf16_t* rowp = O + (size_t)(row0 + ai * HALF + m * 16) * ldc + col0;
                    float h[8];
#pragma unroll
                    for (int n = 0; n < 2; ++n)
#pragma unroll
                        for (int e = 0; e < 4; ++e) h[4 * n + e] = acc[ai][0][m][n][e] * __builtin_amdgcn_rcpf(1.0f + __expf(-acc[ai][1][m][n][e]));
                    u32x4 w; w.x = cvt_pk_bf16(h[0], h[1]); w.y = cvt_pk_bf16(h[2], h[3]); w.z = cvt_pk_bf16(h[4], h[5]); w.w = cvt_pk_bf16(h[6], h[7]);
                    *(u32x4*)rowp = w; }
        } else {
            const int col0 = u.pn * BM + wc * 32 + 8 * fq;
#pragma unroll
            for (int ai = 0; ai < 2; ++ai)
#pragma unroll
                for (int m = 0; m < 4; ++m) { bf16_t* rowp = O + (size_t)(row0 + ai * HALF + m * 16) * ldc + col0;
#pragma unroll
                    for (int bj = 0; bj < 2; ++bj) { const f32x4 v0 = acc[ai][bj][m][0], v1 = acc[ai][bj][m][1];
                        u32x4 w; w.x = cvt_pk_bf16(v0[0], v0[1]); w.y = cvt_pk_bf16(v0[2], v0[3]); w.z = cvt_pk_bf16(v1[0], v1[1]); w.w = cvt_pk_bf16(v1[2], v1[3]);
                        *(u32x4*)(rowp + bj * HALF) = w; } }
        }
    }
};
struct EpiSwiglu {
    static constexpr bool PERM = true, AFTER_DRAIN = false, HAS_INIT = false;
    bf16_t* O; int ldc;
    __device__ __forceinline__ void operator()(const f32x4 (&acc)[2][2][4][2], const Unit& u, int wr, int wc, int fr, int fq) const {
        const int row0 = u.pm * BM + wr * 64 + fr, col0 = u.pn * HALF + wc * 32 + 8 * fq;
#pragma unroll
        for (int ai = 0; ai < 2; ++ai)
#pragma unroll
            for (int m = 0; m < 4; ++m) { bf16_t* rowp = O + (size_t)(row0 + ai * HALF + m * 16) * ldc + col0;
                float h[8];
#pragma unroll
                for (int n = 0; n < 2; ++n)
#pragma unroll
                    for (int e = 0; e < 4; ++e) h[4 * n + e] = silu_f(acc[ai][0][m][n][e]) * acc[ai][1][m][n][e];
                u32x4 w; w.x = cvt_pk_bf16(h[0], h[1]); w.y = cvt_pk_bf16(h[2], h[3]); w.z = cvt_pk_bf16(h[4], h[5]); w.w = cvt_pk_bf16(h[6], h[7]);
#if HID_NT
                __builtin_nontemporal_store(w, (u32x4*)rowp); }
#else
                *(u32x4*)rowp = w; }
#endif
    }
};
struct EpiResF32 {
    static constexpr bool PERM = false, AFTER_DRAIN = false, HAS_INIT = false;
    const float* base0; const float* base1; float* out; int ldc, msplit, mreal; float* part; float sc;
    __device__ __forceinline__ void operator()(const f32x4 (&acc)[2][2][4][2], const Unit& u, int wr, int wc, int fr, int fq) const {
        const int row0 = u.pm * BM + wr * 64 + fr, col0 = u.pn * BM + wc * 32 + 4 * fq;
#pragma unroll
        for (int ai = 0; ai < 2; ++ai)
#pragma unroll
            for (int m = 0; m < 4; ++m) { const int row = row0 + ai * HALF + m * 16;
                if (row < mreal) {
                    const float* bp = (row < msplit ? base0 + (size_t)row * ldc : base1 + (size_t)(row - msplit) * ldc) + col0; float* op = out + (size_t)row * ldc + col0;
                    f32x4 b[2][2];
#pragma unroll
                    for (int bj = 0; bj < 2; ++bj)
#pragma unroll
                        for (int n = 0; n < 2; ++n) b[bj][n] = *(const f32x4*)(bp + bj * HALF + n * 16);
#pragma unroll
                    for (int bj = 0; bj < 2; ++bj)
#pragma unroll
                        for (int n = 0; n < 2; ++n) *(f32x4*)(op + bj * HALF + n * 16) = b[bj][n] + acc[ai][bj][m][n] * sc;
                } }
    }
    __device__ __forceinline__ void partial(const f32x4 (&acc)[2][2][4][2], const Unit& u, int wr, int wc, int fr, int fq) const {
        float* pp = part + ((size_t)u.slot * HALF + wr * 64 + fr) * ldc + u.pn * BM + wc * 32 + 4 * fq;
#pragma unroll
        for (int m = 0; m < 4; ++m)
#pragma unroll
            for (int bj = 0; bj < 2; ++bj)
#pragma unroll
                for (int n = 0; n < 2; ++n) asm volatile("global_store_dwordx4 %0, %1, off sc1\n\ts_nop 1" :: "v"(pp + (size_t)(m * 16) * ldc + bj * HALF + n * 16), "v"(acc[0][bj][m][n]) : "memory");
    }
};
struct TailSplitOrder : StaticOrder {
    static constexpr bool SK = true;
    int nkp, npieces, ntfull; bool pieces_first; unsigned* piece_cnt;
    __device__ __forceinline__ void init_ts(int Mfull, int N, int K, int G_, int c_, int nkp_, bool pf = false) { init(Mfull, N, G_, c_); ntfull = K / BK; nkp = nkp_; npieces = nN * (ntfull / nkp_); pieces_first = pf; piece_cnt = nullptr; }
    __device__ __forceinline__ void done(const Unit& u) const {
        if (u.mode == 3 && piece_cnt) { asm volatile("s_waitcnt vmcnt(0)" ::: "memory"); if ((threadIdx.x & 63) == 0) __hip_atomic_fetch_add(piece_cnt, 1u, __ATOMIC_RELAXED, __HIP_MEMORY_SCOPE_AGENT); } }
    __device__ __forceinline__ bool next(int i, Unit& u) const {
        const int rankA = (c >> 3) * 4 + (c & 7); const bool mine = pieces_first && (c & 7) < 4 && rankA < npieces;
        const int is = pieces_first ? (mine ? i - 1 : i) : i;
        Unit t; t.pm = 0; t.pn = 0;
        const bool full = (is >= 0) && StaticOrder::next(is, t);
        const long p = pieces_first ? (long)rankA : (long)i * G + c - nwg; const bool piece = !full && (pieces_first ? (mine && i == 0) : (p >= 0 && p < npieces));
        const int pp = piece ? (int)p : 0, ks = pp / nN;
        u.pm = full ? t.pm : nM; u.pn = full ? t.pn : pp - ks * nN; u.slot = full ? 0 : ks; u.k0 = full ? 0 : ks * nkp; u.nk = full ? ntfull : nkp; u.mode = full ? 0 : 3;
        return full || piece;
    }
};
struct SampleJob { int row; const float* base; const float* part; const float* gain; float* xout; bf16_t* obf; float* of32; const unsigned* piece_cnt; unsigned want; };
template <int NS> __device__ __forceinline__ void sample_row_job(const SampleJob& j, PG8_LAS unsigned char* lds, int wid, int lane, float eps) {
    PG8_LAS float* red = (PG8_LAS float*)(lds + 8192);
    if (wid == 0) { unsigned polls = 0;
        while ((unsigned)__builtin_amdgcn_readfirstlane(__hip_atomic_load(j.piece_cnt, __ATOMIC_RELAXED, __HIP_MEMORY_SCOPE_AGENT)) < j.want) { __builtin_amdgcn_s_sleep(2); if (++polls > (1u << 22)) break; }
        __builtin_amdgcn_fence(__ATOMIC_ACQUIRE, "agent"); }
    asm volatile("s_waitcnt vmcnt(0) lgkmcnt(0)" ::: "memory"); __builtin_amdgcn_s_barrier(); asm volatile("" ::: "memory");
    const int col = 256 * wid + 4 * lane; const size_t ro = (size_t)j.row * 2048;
    f32x4 v = *(const f32x4*)(j.base + ro + col);
    f32x4 t[NS];
#pragma unroll
    for (int k = 0; k < NS; ++k) t[k] = *(const f32x4*)(j.part + (size_t)k * 128 * 2048 + ro + col);
#pragma unroll
    for (int k = 0; k < NS; ++k) v += t[k];
    if (j.xout) *(f32x4*)(j.xout + ro + col) = v;
    float s = (v[0] * v[0] + v[1] * v[1]) + (v[2] * v[2] + v[3] * v[3]);
#pragma unroll
    for (int o = 1; o < 64; o <<= 1) s += __shfl_xor(s, o);
    if (lane == 0) red[wid] = s;
    asm volatile("s_waitcnt lgkmcnt(0)" ::: "memory"); __builtin_amdgcn_s_barrier(); asm volatile("" ::: "memory");
    float tot = 0.f;
#pragma unroll
    for (int w = 0; w < 8; ++w) tot += red[w];
    const float rstd = 1.0f / sqrtf(tot * (1.0f / 2048.0f) + eps);
    const f32x4 g = *(const f32x4*)(j.gain + col); const f32x4 r = v * rstd * g;
    if (j.obf) { u32x2v o; o.x = cvt_pk_bf16(r[0], r[1]); o.y = cvt_pk_bf16(r[2], r[3]); *(u32x2v*)(j.obf + ro + col) = o; }
    if (j.of32) *(f32x4*)(j.of32 + ro + col) = r;
    asm volatile("s_waitcnt lgkmcnt(0)" ::: "memory"); __builtin_amdgcn_s_barrier(); asm volatile("" ::: "memory");
}
__device__ __forceinline__ f32x4 xchg1(f32x4 v) { f32x4 r; r[0] = __shfl_xor(v[0], 1); r[1] = __shfl_xor(v[1], 1); r[2] = __shfl_xor(v[2], 1); r[3] = __shfl_xor(v[3], 1); return r; }
template <bool NT> __device__ __forceinline__ void store_pair_rows(float* p, size_t rstride, bool odd, f32x4 v0, f32x4 v1) {
    const f32x4 r = xchg1(odd ? v0 : v1);
    const f32x4 a = odd ? r : v0, bq = odd ? v1 : r;
    if (NT) { __builtin_nontemporal_store(a, (f32x4*)p); __builtin_nontemporal_store(bq, (f32x4*)(p + rstride)); }
    else { *(f32x4*)p = a; *(f32x4*)(p + rstride) = bq; }
}
template <bool NT> __device__ __forceinline__ void load_pair_rows(const float* p, size_t rstride, bool odd, f32x4& v0, f32x4& v1) {
    f32x4 a, bq;
    if (NT) { a = __builtin_nontemporal_load((const f32x4*)p); bq = __builtin_nontemporal_load((const f32x4*)(p + rstride)); }
    else { a = *(const f32x4*)p; bq = *(const f32x4*)(p + rstride); }
    const f32x4 r = xchg1(odd ? a : bq);
    v0 = odd ? r : a; v1 = odd ? bq : r;
}
struct RowStats {
    float* xbuf; unsigned* cnt; float eps;
    __device__ __forceinline__ void run(const f32x4 (&v)[2][2][4][2], const Unit& u, int wr, int wc, int fr, int fq, PG8_LAS unsigned char* lds, int wid, int lane) const {
        PG8_LAS float* P = (PG8_LAS float*)lds;
        PG8_LAS float* S = (PG8_LAS float*)(lds + 4096);
#pragma unroll
        for (int ai = 0; ai < 2; ++ai)
#pragma unroll
            for (int m = 0; m < 4; ++m) { float s = 0.f;
#pragma unroll
                for (int bj = 0; bj < 2; ++bj)
#pragma unroll
                    for (int n = 0; n < 2; ++n) { const f32x4 x = v[ai][bj][m][n]; s += (x[0] * x[0] + x[1] * x[1]) + (x[2] * x[2] + x[3] * x[3]); }
                s += __shfl_xor(s, 16); s += __shfl_xor(s, 32);
                if (fq == 0) P[(ai * HALF + wr * 64 + m * 16 + fr) * 4 + wc] = s; }
        asm volatile("s_waitcnt lgkmcnt(0)" ::: "memory"); __builtin_amdgcn_s_barrier(); asm volatile("" ::: "memory");
        const int row = wid * 32 + (lane & 31);
        if (lane < 32) { const float t = (P[row * 4 + 0] + P[row * 4 + 1]) + (P[row * 4 + 2] + P[row * 4 + 3]);
            __hip_atomic_store(xbuf + ((size_t)(u.pm * BM + row) * 8 + u.pn), t, __ATOMIC_RELAXED, __HIP_MEMORY_SCOPE_AGENT); }
        asm volatile("s_waitcnt vmcnt(0)" ::: "memory");
        if (lane == 0) __hip_atomic_fetch_add(cnt + 64 * u.pm, 1u, __ATOMIC_RELAXED, __HIP_MEMORY_SCOPE_AGENT);
        if (wid == 0) { unsigned polls = 0;
            while ((unsigned)__builtin_amdgcn_readfirstlane(__hip_atomic_load(cnt + 64 * u.pm, __ATOMIC_RELAXED, __HIP_MEMORY_SCOPE_AGENT)) < 64u) { __builtin_amdgcn_s_sleep(2); if (++polls > (1u << 22)) break; }
            __builtin_amdgcn_fence(__ATOMIC_ACQUIRE, "agent"); }
        asm volatile("s_waitcnt vmcnt(0) lgkmcnt(0)" ::: "memory"); __builtin_amdgcn_s_barrier(); asm volatile("" ::: "memory");
        if (lane < 32) { const float* sl = xbuf + (size_t)(u.pm * BM + row) * 8; float tot = 0.f;
#pragma unroll
            for (int t = 0; t < 8; ++t) tot += __hip_atomic_load(sl + t, __ATOMIC_RELAXED, __HIP_MEMORY_SCOPE_AGENT);
            S[row] = 1.0f / sqrtf(tot * (1.0f / 2048.0f) + eps); }
        asm volatile("s_waitcnt vmcnt(0) lgkmcnt(0)" ::: "memory"); __builtin_amdgcn_s_barrier(); asm volatile("" ::: "memory");
    }
};
struct EpiResNormBf16 {
    static constexpr bool PERM = false, AFTER_DRAIN = true, HAS_INIT = true;
    const float* base; float* out; bf16_t* xn; const float* gain; int ldc; float* part; RowStats st; SampleJob job;
    __device__ __forceinline__ void init(f32x4 (&acc)[2][2][4][2], const Unit& u, int wr, int wc, int fr, int fq) const {
        const bool piece = (u.mode == 3), odd = (fr & 1) != 0; const int col0 = u.pn * BM + wc * 32 + 4 * fq + (odd ? 16 : 0);
#pragma unroll
        for (int ai = 0; ai < 2; ++ai)
#pragma unroll
            for (int m = 0; m < 4; ++m) { const size_t off = (size_t)(u.pm * BM + ai * HALF + wr * 64 + m * 16 + (fr & ~1)) * ldc + col0;
#pragma unroll
                for (int bj = 0; bj < 2; ++bj) { f32x4 v0 = (f32x4){0.f, 0.f, 0.f, 0.f}, v1 = v0; if (!piece) load_pair_rows<true>(base + off + bj * HALF, (size_t)ldc, odd, v0, v1); acc[ai][bj][m][0] = v0; acc[ai][bj][m][1] = v1; } }
    }
    __device__ __forceinline__ void partial(const f32x4 (&acc)[2][2][4][2], const Unit& u, int wr, int wc, int fr, int fq) const {
        float* pp = part + ((size_t)u.slot * HALF + wr * 64 + fr) * ldc + u.pn * BM + wc * 32 + 4 * fq;
#pragma unroll
        for (int m = 0; m < 4; ++m)
#pragma unroll
            for (int bj = 0; bj < 2; ++bj)
#pragma unroll
                for (int n = 0; n < 2; ++n) asm volatile("global_store_dwordx4 %0, %1, off sc1\n\ts_nop 1" :: "v"(pp + (size_t)(m * 16) * ldc + bj * HALF + n * 16), "v"(acc[0][bj][m][n]) : "memory");
    }
    __device__ __forceinline__ void fused(f32x4 (&acc)[2][2][4][2], const Unit& u, int wr, int wc, int fr, int fq, PG8_LAS unsigned char* lds, int wid, int lane) const {
        const PG8_LAS float* S = (const PG8_LAS float*)(lds + 4096);
        if (job.row >= 0) sample_row_job<NS_P3>(job, lds, wid, lane, st.eps);
        const int col0 = u.pn * BM + wc * 32 + 4 * fq;
        { const bool odd = (fr & 1) != 0;
#pragma unroll
          for (int ai = 0; ai < 2; ++ai)
#pragma unroll
            for (int m = 0; m < 4; ++m) { float* p = out + (size_t)(u.pm * BM + ai * HALF + wr * 64 + m * 16 + (fr & ~1)) * ldc + col0 + (odd ? 16 : 0);
#pragma unroll
                for (int bj = 0; bj < 2; ++bj) store_pair_rows<false>(p + bj * HALF, (size_t)ldc, odd, acc[ai][bj][m][0], acc[ai][bj][m][1]); } }
        st.run(acc, u, wr, wc, fr, fq, lds, wid, lane);
        f32x4 gv[2][2];
#pragma unroll
        for (int bj = 0; bj < 2; ++bj)
#pragma unroll
            for (int n = 0; n < 2; ++n) gv[bj][n] = *(const f32x4*)(gain + col0 + bj * HALF + n * 16);
#pragma unroll
        for (int ai = 0; ai < 2; ++ai)
#pragma unroll
            for (int m = 0; m < 4; ++m) { const int r = ai * HALF + wr * 64 + m * 16 + fr; const float rs = S[r]; const size_t off = (size_t)(u.pm * BM + r) * ldc + col0;
#pragma unroll
                for (int bj = 0; bj < 2; ++bj) {
                    const f32x4 o0 = acc[ai][bj][m][0] * rs * gv[bj][0], o1 = acc[ai][bj][m][1] * rs * gv[bj][1];
                    u32x2v w0, w1; w0.x = cvt_pk_bf16(o0[0], o0[1]); w0.y = cvt_pk_bf16(o0[2], o0[3]); w1.x = cvt_pk_bf16(o1[0], o1[1]); w1.y = cvt_pk_bf16(o1[2], o1[3]);
                    const bool ev = (fq & 1) == 0; const unsigned sx = ev ? w1.x : w0.x, sy = ev ? w1.y : w0.y;
                    const unsigned rx = (unsigned)__shfl_xor((int)sx, 16), ry = (unsigned)__shfl_xor((int)sy, 16);
                    const u32x4 w = ev ? (u32x4){w0.x, w0.y, rx, ry} : (u32x4){rx, ry, w1.x, w1.y};
                    *(u32x4*)(xn + off + bj * HALF + (ev ? 0 : 16 - 4)) = w; } }
    }
};
struct EpiResNormF32 {
    static constexpr bool PERM = false, AFTER_DRAIN = true, HAS_INIT = true;
    float* out; const float* gain; int ldc; float* part; RowStats st; SampleJob job;
    __device__ __forceinline__ void init(f32x4 (&acc)[2][2][4][2], const Unit& u, int wr, int wc, int fr, int fq) const {
        const bool piece = (u.mode == 3), odd = (fr & 1) != 0; const int col0 = u.pn * BM + wc * 32 + 4 * fq + (odd ? 16 : 0);
#pragma unroll
        for (int ai = 0; ai < 2; ++ai)
#pragma unroll
            for (int m = 0; m < 4; ++m) { const size_t off = (size_t)(u.pm * BM + ai * HALF + wr * 64 + m * 16 + (fr & ~1)) * ldc + col0;
#pragma unroll
                for (int bj = 0; bj < 2; ++bj) { f32x4 v0 = (f32x4){0.f, 0.f, 0.f, 0.f}, v1 = v0; if (!piece) load_pair_rows<false>(out + off + bj * HALF, (size_t)ldc, odd, v0, v1); acc[ai][bj][m][0] = v0; acc[ai][bj][m][1] = v1; } }
    }
    __device__ __forceinline__ void partial(const f32x4 (&acc)[2][2][4][2], const Unit& u, int wr, int wc, int fr, int fq) const {
        float* pp = part + ((size_t)u.slot * HALF + wr * 64 + fr) * ldc + u.pn * BM + wc * 32 + 4 * fq;
#pragma unroll
        for (int m = 0; m < 4; ++m)
#pragma unroll
            for (int bj = 0; bj < 2; ++bj)
#pragma unroll
                for (int n = 0; n < 2; ++n) asm volatile("global_store_dwordx4 %0, %1, off sc1\n\ts_nop 1" :: "v"(pp + (size_t)(m * 16) * ldc + bj * HALF + n * 16), "v"(acc[0][bj][m][n]) : "memory");
    }
    __device__ __forceinline__ void fused(f32x4 (&acc)[2][2][4][2], const Unit& u, int wr, int wc, int fr, int fq, PG8_LAS unsigned char* lds, int wid, int lane) const {
        const PG8_LAS float* S = (const PG8_LAS float*)(lds + 4096);
        if (job.row >= 0) sample_row_job<NS_P5>(job, lds, wid, lane, st.eps);
        const int col0 = u.pn * BM + wc * 32 + 4 * fq;
        st.run(acc, u, wr, wc, fr, fq, lds, wid, lane);
        f32x4 gv[2][2];
#pragma unroll
        for (int bj = 0; bj < 2; ++bj)
#pragma unroll
            for (int n = 0; n < 2; ++n) gv[bj][n] = *(const f32x4*)(gain + col0 + bj * HALF + n * 16);
        { const bool odd = (fr & 1) != 0;
#pragma unroll
          for (int ai = 0; ai < 2; ++ai)
#pragma unroll
            for (int m = 0; m < 4; ++m) { const int r = ai * HALF + wr * 64 + m * 16 + fr; const float rs = S[r]; float* p = out + (size_t)(u.pm * BM + (r & ~1)) * ldc + col0 + (odd ? 16 : 0);
#pragma unroll
                for (int bj = 0; bj < 2; ++bj) store_pair_rows<true>(p + bj * HALF, (size_t)ldc, odd, acc[ai][bj][m][0] * rs * gv[bj][0], acc[ai][bj][m][1] * rs * gv[bj][1]); } }
    }
};
#ifndef SKT_PUB
#define SKT_PUB 1
#endif
#ifndef SKT_COMB
#define SKT_COMB 1
#endif
template <class Epi, class Sched, bool ALIGN_EPI = false, bool SP2 = false>
__device__ __forceinline__ void gemm_phase(PG8_LAS unsigned char* lds, const Gemm g, const Sched& S, const Epi& E) {
    const int tid = threadIdx.x, wid = __builtin_amdgcn_readfirstlane(tid >> 6), lane = tid & 63, wr = wid >> 2, wc = wid & 3, fr = lane & 15, fq = lane >> 4;
    const int K = g.K, nt = K / BK;
    unsigned voffA[2], voffB[2];
#pragma unroll
    for (int i = 0; i < 2; ++i) { int R, C; stage_rc(tid * 16 + i * 8192, R, C); const int Rb = Epi::PERM ? ((R & ~31) + perm32(R & 31)) : R;
        voffA[i] = (unsigned)(R * K + C) * 2u; voffB[i] = (unsigned)(Rb * K + C) * 2u; }
    const size_t kstep = (size_t)(BK * 2);
    const size_t hstep = (size_t)HALF * K * 2;
    const size_t tstep = 2 * hstep;
    const unsigned ldsw = (unsigned)wid * 1024u;
    const int aoff = lds_byte(wr * 64 + fr, fq * 8), boff = lds_byte(wc * 32 + fr, fq * 8);
#define PG8_SA(b, h) (((b) * 2 + (h)) * HTB)
#define PG8_SB(b, h) ((4 + (b) * 2 + (h)) * HTB)
#define PG8_STAGE(bufoff, gbase, voff) do { _Pragma("unroll") for (int _i = 0; _i < 2; ++_i) \
        __builtin_amdgcn_global_load_lds((const unsigned*)((const char*)(gbase) + (voff)[_i]), (PG8_LAS unsigned*)(lds + (bufoff) + ldsw + _i * 8192), 16, 0, 0); } while (0)
#define PG8_LDA(dst, b, h) do { _Pragma("unroll") for (int m = 0; m < 4; ++m) _Pragma("unroll") for (int k = 0; k < 2; ++k) dst[m][k] = *(const PG8_LAS bf16x8*)(lds + PG8_SA(b, h) + aoff + m * 2048 + k * 1024); } while (0)
#define PG8_LDB(dst, b, h) do { _Pragma("unroll") for (int n = 0; n < 2; ++n) _Pragma("unroll") for (int k = 0; k < 2; ++k) dst[n][k] = *(const PG8_LAS bf16x8*)(lds + PG8_SB(b, h) + boff + n * 2048 + k * 1024); } while (0)
#define PG8_MMA(ai, bj, At, Bt) do { __builtin_amdgcn_s_setprio(1); _Pragma("unroll") for (int m = 0; m < 4; ++m) _Pragma("unroll") for (int n = 0; n < 2; ++n) _Pragma("unroll") for (int k = 0; k < 2; ++k) \
        acc[ai][bj][m][n] = __builtin_amdgcn_mfma_f32_16x16x32_bf16(Bt[n][k], At[m][k], acc[ai][bj][m][n], 0, 0, 0); __builtin_amdgcn_s_setprio(0); } while (0)
#define PG8_WAIT_V(n) asm volatile("s_waitcnt vmcnt(" #n ")" ::: "memory")
#define PG8_WAIT_L(n) asm volatile("s_waitcnt lgkmcnt(" #n ")" ::: "memory")
#define PG8_BAR __builtin_amdgcn_s_barrier()
#define PG8_SCHED __builtin_amdgcn_sched_barrier(0)
    Unit cur, nxt; int ui = 0;
    if (!S.next(0, cur)) return;
    if constexpr (!Sched::SK) { cur.k0 = 0; cur.nk = nt; cur.mode = 0; cur.slot = 0; }
    f32x4 acc[2][2][4][2];
    if constexpr (Epi::HAS_INIT) E.init(acc, cur, wr, wc, fr, fq); else {
#pragma unroll
    for (int a = 0; a < 2; ++a)
#pragma unroll
        for (int b = 0; b < 2; ++b)
#pragma unroll
            for (int m = 0; m < 4; ++m)
#pragma unroll
                for (int n = 0; n < 2; ++n) acc[a][b][m][n] = (f32x4){0.f, 0.f, 0.f, 0.f};
    }
    bf16x8 At[4][2], B0[2][2], B1[2][2];
    const char* cA = (const char*)g.A + (size_t)cur.pm * tstep + (size_t)cur.k0 * kstep; const char* cB = (const char*)g.Bt + (size_t)cur.pn * tstep + (size_t)cur.k0 * kstep;
    S.a_ready(cur);
    if constexpr (SP2) {
        PG8_STAGE(PG8_SB(0, 0), cB, voffB); PG8_STAGE(PG8_SB(0, 1), cB + hstep, voffB); PG8_STAGE(PG8_SA(0, 0), cA, voffA); PG8_STAGE(PG8_SA(0, 1), cA + hstep, voffA);
        if (wr == 1) PG8_BAR;
        PG8_WAIT_V(2); PG8_BAR;
        PG8_STAGE(PG8_SB(1, 0), cB + kstep, voffB); PG8_STAGE(PG8_SA(1, 0), cA + kstep, voffA); PG8_STAGE(PG8_SB(1, 1), cB + hstep + kstep, voffB);
        PG8_WAIT_V(6); PG8_BAR;
    } else {
        PG8_STAGE(PG8_SB(0, 0), cB, voffB); PG8_STAGE(PG8_SA(0, 0), cA, voffA); PG8_STAGE(PG8_SB(0, 1), cB + hstep, voffB); PG8_STAGE(PG8_SA(0, 1), cA + hstep, voffA);
        if (wr == 1) PG8_BAR;
        PG8_WAIT_V(4); PG8_BAR;
        PG8_STAGE(PG8_SB(1, 0), cB + kstep, voffB); PG8_STAGE(PG8_SA(1, 0), cA + kstep, voffA); PG8_STAGE(PG8_SB(1, 1), cB + hstep + kstep, voffB);
        PG8_WAIT_V(6); PG8_BAR;
    }
    for (;;) {
        const bool has_next = S.next(ui + 1, nxt);
        if constexpr (!Sched::SK) { nxt.k0 = 0; nxt.nk = nt; nxt.mode = 0; nxt.slot = 0; }
        const int ntc = cur.nk;
        const char* nA = has_next ? (const char*)g.A + (size_t)nxt.pm * tstep + (size_t)nxt.k0 * kstep : cA; const char* nB = has_next ? (const char*)g.Bt + (size_t)nxt.pn * tstep + (size_t)nxt.k0 * kstep : cB;
        for (int t = 0; t < ntc; t += 2) {
            const bool last = (t == ntc - 2);
            const char* a1 = cA + (size_t)(t + 1) * kstep;
            const char* a2 = last ? nA : cA + (size_t)(t + 2) * kstep; const char* b2 = last ? nB : cB + (size_t)(t + 2) * kstep;
            const char* a3 = a2 + kstep; const char* b3 = b2 + kstep;
            if (last && has_next) S.a_ready(nxt);
            if constexpr (SP2) {
            PG8_LDB(B0, 0, 0); PG8_LDB(B1, 0, 1); PG8_SCHED; PG8_LDA(At, 0, 0); PG8_STAGE(PG8_SA(1, 1), a1 + hstep, voffA);
            PG8_WAIT_V(8); PG8_WAIT_L(0); PG8_BAR; PG8_MMA(0, 0, At, B0); PG8_MMA(0, 1, At, B1); PG8_BAR; PG8_SCHED;
            PG8_LDA(At, 0, 1); PG8_STAGE(PG8_SB(0, 0), b2, voffB); PG8_STAGE(PG8_SB(0, 1), b2 + hstep, voffB); PG8_STAGE(PG8_SA(0, 0), a2, voffA);
            PG8_WAIT_V(8); PG8_WAIT_L(0); PG8_BAR; PG8_MMA(1, 0, At, B0); PG8_MMA(1, 1, At, B1); PG8_BAR; PG8_SCHED;
            PG8_LDB(B0, 1, 0); PG8_LDB(B1, 1, 1); PG8_SCHED; PG8_LDA(At, 1, 0); PG8_STAGE(PG8_SA(0, 1), a2 + hstep, voffA);
            PG8_WAIT_V(8); PG8_WAIT_L(0); PG8_BAR; PG8_MMA(0, 0, At, B0); PG8_MMA(0, 1, At, B1); PG8_BAR; PG8_SCHED;
            PG8_LDA(At, 1, 1); PG8_STAGE(PG8_SB(1, 0), b3, voffB); PG8_STAGE(PG8_SB(1, 1), b3 + hstep, voffB); PG8_STAGE(PG8_SA(1, 0), a3, voffA);
            PG8_WAIT_V(8); PG8_WAIT_L(0); PG8_BAR; PG8_MMA(1, 0, At, B0); PG8_MMA(1, 1, At, B1); PG8_BAR; PG8_SCHED;
            } else {
            PG8_LDB(B0, 0, 0); PG8_SCHED; PG8_LDA(At, 0, 0); PG8_STAGE(PG8_SA(1, 1), a1 + hstep, voffA);
            PG8_WAIT_L(8); PG8_BAR; PG8_WAIT_L(0); PG8_MMA(0, 0, At, B0); PG8_BAR; PG8_SCHED;
            PG8_LDB(B1, 0, 1); PG8_STAGE(PG8_SB(0, 0), b2, voffB);
            PG8_BAR; PG8_WAIT_L(0); PG8_MMA(0, 1, At, B1); PG8_BAR;
            PG8_LDA(At, 0, 1); PG8_STAGE(PG8_SA(0, 0), a2, voffA);
            PG8_BAR; PG8_WAIT_L(0); PG8_MMA(1, 0, At, B0); PG8_BAR; PG8_SCHED;
            PG8_STAGE(PG8_SB(0, 1), b2 + hstep, voffB);
            PG8_WAIT_V(6); PG8_BAR; PG8_MMA(1, 1, At, B1); PG8_BAR;
            PG8_LDB(B0, 1, 0); PG8_SCHED; PG8_LDA(At, 1, 0); PG8_STAGE(PG8_SA(0, 1), a2 + hstep, voffA);
            PG8_WAIT_L(8); PG8_BAR; PG8_WAIT_L(0); PG8_MMA(0, 0, At, B0); PG8_BAR; PG8_SCHED;
            PG8_LDB(B1, 1, 1); PG8_STAGE(PG8_SB(1, 0), b3, voffB);
            PG8_BAR; PG8_WAIT_L(0); PG8_MMA(0, 1, At, B1); PG8_BAR;
            PG8_LDA(At, 1, 1); PG8_STAGE(PG8_SA(1, 0), a3, voffA);
            PG8_BAR; PG8_WAIT_L(0); PG8_MMA(1, 0, At, B0); PG8_BAR; PG8_SCHED;
            PG8_STAGE(PG8_SB(1, 1), b3 + hstep, voffB);
            PG8_WAIT_V(6); PG8_BAR; PG8_MMA(1, 1, At, B1); PG8_BAR;
            }
        }
        if constexpr (ALIGN_EPI) { if (wr == 0) PG8_BAR; }
        if constexpr (!Epi::AFTER_DRAIN) {
            if constexpr (Sched::SK) { if (cur.mode == 3) E.partial(acc, cur, wr, wc, fr, fq); else E(acc, cur, wr, wc, fr, fq); }
            else E(acc, cur, wr, wc, fr, fq);
            S.done(cur); }
        else { if constexpr (Sched::SK) { if (has_next) { E.partial(acc, cur, wr, wc, fr, fq); S.done(cur); } } }
        if (!has_next) break;
        if constexpr (Epi::HAS_INIT) E.init(acc, nxt, wr, wc, fr, fq); else {
#pragma unroll
        for (int a = 0; a < 2; ++a)
#pragma unroll
            for (int b = 0; b < 2; ++b)
#pragma unroll
                for (int m = 0; m < 4; ++m)
#pragma unroll
                    for (int n = 0; n < 2; ++n) acc[a][b][m][n] = (f32x4){0.f, 0.f, 0.f, 0.f};
        }
        cur = nxt; cA = nA; cB = nB; ++ui;
        if constexpr (ALIGN_EPI) { if (wr == 1) PG8_BAR; }
    }
    PG8_WAIT_V(0);
    if constexpr (!ALIGN_EPI) { if (wr == 0) PG8_BAR; }
    PG8_BAR;
    if constexpr (Epi::AFTER_DRAIN) { E.fused(acc, cur, wr, wc, fr, fq, lds, wid, lane); S.done(cur); }
#undef PG8_SA
#undef PG8_SB
#undef PG8_STAGE
#undef PG8_LDA
#undef PG8_LDB
#undef PG8_MMA
#undef PG8_WAIT_V
#undef PG8_WAIT_L
#undef PG8_BAR
#undef PG8_SCHED
}
}

constexpr int NWAVES = 8;
constexpr int DM = 2048, MP = 8192, MS = 128, MR = MP + MS  , MPAD = 8448  , SEQ = 2048, NB = 4;
constexpr int NH = 4, HK = 128, HV = 256, DK = 512, DA = 1024, DC_ = 1024, GR = 16, CW = 31, DFF = 5632;
constexpr int N1 = 5136, N1P = 5376;
constexpr int ZQ = 0, ZK = 512, ZV = 1024, ZGO = 2048, ZGLU = 3072, ZGL = 5120;
constexpr int CH = 64, NCH = SEQ / CH;
constexpr float RMS_EPS = 1e-6f, LN_EPS = 1e-5f;
constexpr size_t O_YP = 0, O_YS = (size_t)MP * DM, O_GP = O_YS + (size_t)MS * DM, O_CP = O_GP + (size_t)NB * NH * HK * HV, O_GS = O_CP + (size_t)NB * 30 * DC_,
                 O_CS = O_GS + (size_t)MS * NH * HK * HV, O_END = O_CS + (size_t)MS * 30 * DC_;
constexpr size_t MiB = 1u << 20;
constexpr size_t WS_CTL = 0, CTL_ZERO_BYTES = 1 * MiB;
constexpr size_t WS_XB2 = 1 * MiB, WS_XB4 = 1 * MiB + 512 * 1024;
constexpr size_t WS_W1 = 2 * MiB;
constexpr size_t WS_W2 = 23 * MiB;
constexpr size_t WS_W3 = 31 * MiB;
constexpr size_t WS_W4 = 75 * MiB;
constexpr size_t WS_H = 97 * MiB;
constexpr size_t WS_QT = WS_H, WS_KH = WS_H + 8 * MiB, WS_VT = WS_H + 16 * MiB;
constexpr size_t WS_Z = 130 * MiB;
constexpr size_t WS_MIX = 217 * MiB;
constexpr size_t WS_HID = 130 * MiB;
constexpr size_t WS_END = 250 * MiB;
static_assert(WS_Z + (size_t)MPAD * N1P * 2 <= WS_MIX && WS_HID + (size_t)MPAD * DFF * 2 <= WS_END && WS_W1 + (size_t)N1P * DM * 2 <= WS_W2 && WS_W3 + (size_t)2 * DFF * DM * 2 <= WS_W4 && WS_W4 + (size_t)DM * DFF * 2 <= WS_H, "d_ws map");
constexpr size_t DO_O32 = 0, DO_AM = 32 * MiB, DO_DC = 36 * MiB;
constexpr int CW_TMO = 0, CW_BAR = 4096, CW_RB2 = 16384, CW_SP2 = CW_RB2 + 64 * 40, CW_RB4 = CW_RB2 + 64 * 64, CW_SP4 = CW_RB4 + 64 * 40, CW_PREP = CW_RB4 + 64 * 64, CW_SEQ = CW_PREP + 64 * 16;
constexpr size_t WS_SK2 = WS_Z, WS_SK4 = WS_W1;
static_assert((size_t)32 * 128 * DM * 4 <= WS_MIX - WS_Z && WS_SK4 + (size_t)44 * 128 * DM * 4 <= WS_W4, "K-split slabs");
constexpr int RING_OFF = 0, RING_BYTES = 131072;
constexpr int LDSCTL_OFF = RING_BYTES, MISC_OFF = LDSCTL_OFF + 320;
constexpr int LDS_BYTES = 147456;

#define GAS __attribute__((address_space(1)))
#define LAS __attribute__((address_space(3)))
typedef unsigned short bf16;
typedef unsigned v4u __attribute__((ext_vector_type(4)));
typedef unsigned v2u __attribute__((ext_vector_type(2)));
typedef float f32x4 __attribute__((ext_vector_type(4)));
typedef float f32x2 __attribute__((ext_vector_type(2)));
typedef short bf16x8 __attribute__((ext_vector_type(8)));
typedef GAS unsigned gu32;
typedef GAS unsigned long long gu64;
#define RLX_AGENT __ATOMIC_RELAXED, __HIP_MEMORY_SCOPE_AGENT
#define LDS_WAIT() asm volatile("s_waitcnt lgkmcnt(0)" ::: "memory")
#define LDS_BARRIER() do { asm volatile("s_waitcnt lgkmcnt(0)" ::: "memory"); __builtin_amdgcn_s_barrier(); asm volatile("" ::: "memory"); } while (0)
#define VM_WAIT() asm volatile("s_waitcnt vmcnt(0)" ::: "memory")
__device__ __forceinline__ void st_wt16(void* p, v4u v) { asm volatile("global_store_dwordx4 %0, %1, off sc1\n\ts_nop 1" :: "v"(p), "v"(v) : "memory"); }
__device__ __forceinline__ void st_wt16f(void* p, f32x4 v) { asm volatile("global_store_dwordx4 %0, %1, off sc1\n\ts_nop 1" :: "v"(p), "v"(v) : "memory"); }
__device__ __forceinline__ void st_wt8(void* p, v2u v) { asm volatile("global_store_dwordx2 %0, %1, off sc1\n\ts_nop 1" :: "v"(p), "v"(v) : "memory"); }
__device__ __forceinline__ void st_wt4f(void* p, float v) { asm volatile("global_store_dword %0, %1, off sc1\n\ts_nop 1" :: "v"(p), "v"(v) : "memory"); }
__device__ __forceinline__ unsigned f2bf(float f) { unsigned u = __builtin_bit_cast(unsigned, f); return (u + 0x7fffu + ((u >> 16) & 1u)) >> 16; }
__device__ __forceinline__ unsigned pk2(float lo, float hi) { return f2bf(lo) | (f2bf(hi) << 16); }
__device__ __forceinline__ float bf2f(unsigned short b) { return __builtin_bit_cast(float, (unsigned)b << 16); }
__device__ __forceinline__ float bflo(unsigned w) { return __builtin_bit_cast(float, w << 16); }
__device__ __forceinline__ float bfhi(unsigned w) { return __builtin_bit_cast(float, w & 0xffff0000u); }
__device__ __forceinline__ float sigmoid_f(float x) { return __builtin_amdgcn_rcpf(1.0f + __expf(-x)); }
__device__ __forceinline__ float silu_f(float x) { return x * sigmoid_f(x); }
__device__ __forceinline__ float logsigmoid_f(float x) { return fminf(x, 0.f) - __logf(1.0f + __expf(-fabsf(x))); }
#define XB_TMO      128
#define XB_XCNT(j)  (256  + 64 * (j))
#define XB_XSUB(j)  (1280 + 64 * (j))
#define XB_XGEN(j)  (2304 + 64 * (j))
#define XB_TOP      3328
#define XB_TOPGEN   3392
#define XCD_BAR_WORDS 3456
#define XB_SPIN_CAP (1u << 18)

__device__ __forceinline__ unsigned xb_ld(unsigned* p)              { return __hip_atomic_load(p, __ATOMIC_RELAXED, __HIP_MEMORY_SCOPE_AGENT); }
__device__ __forceinline__ unsigned xb_add(unsigned* p, unsigned v) { return __hip_atomic_fetch_add(p, v, __ATOMIC_RELAXED, __HIP_MEMORY_SCOPE_AGENT); }
__device__ __forceinline__ unsigned xb_xcc_id() { return (unsigned)__builtin_amdgcn_s_getreg((3 << 11) | 20) & 0xFu; }
#define XB_SPIN(cond, bar) do { unsigned _sp = 0; while (cond) { __builtin_amdgcn_s_sleep(1); \
    if ((++_sp & 255u) == 0u) { if (xb_ld(&(bar)[XB_TMO])) break; if (_sp > XB_SPIN_CAP) { atomicAdd(&(bar)[XB_TMO], 1u); break; } } } } while (0)

struct XcdBarrier {
    unsigned* bar; unsigned x;
    volatile LAS unsigned* st;
};

__device__ __forceinline__ XcdBarrier xcd_barrier_post(unsigned* bar, volatile LAS unsigned* st) {
    XcdBarrier b; b.bar = bar; b.x = xb_xcc_id(); b.st = st;
    if (threadIdx.x == 0) (void)xb_add(&bar[XB_XCNT(b.x)], 1u);
    return b;
}
__device__ __forceinline__ void xcd_barrier_complete(unsigned* bar, unsigned x, unsigned& nloc, unsigned& nx) {
    const unsigned G = gridDim.x * gridDim.y * gridDim.z;
    unsigned sum, cnt, mine, sp = 0u;
    for (;;) {
        sum = 0u; cnt = 0u; mine = 0u;
#pragma unroll
        for (unsigned j = 0; j < 16; ++j) { const unsigned c = xb_ld(&bar[XB_XCNT(j)]); sum += c; cnt += (c > 0u) ? 1u : 0u; mine = (j == x) ? c : mine; }
        if (sum == G) break;
        __builtin_amdgcn_s_sleep(1);
        if ((++sp & 255u) == 0u) { if (xb_ld(&bar[XB_TMO])) break; if (sp > XB_SPIN_CAP) { atomicAdd(&bar[XB_TMO], 1u); break; } }
    }
    nloc = mine > 0u ? mine : 1u; nx = cnt > 0u ? cnt : 1u;
}

__device__ __forceinline__ void xcd_barrier(const XcdBarrier& b) {
    asm volatile("s_waitcnt vmcnt(0)" ::: "memory");
    __syncthreads();
    if (threadIdx.x == 0) {
        unsigned* bar = b.bar;
        __builtin_amdgcn_s_waitcnt(0);
        unsigned nloc = b.st[0], nx = b.st[1];
        if (nloc == 0u) { xcd_barrier_complete(bar, b.x, nloc, nx); b.st[0] = nloc; b.st[1] = nx; }
        const unsigned old = xb_add(&bar[XB_XSUB(b.x)], 1u);
        const unsigned gen = old / nloc;
        if (old + 1u == (gen + 1u) * nloc) {
            __builtin_amdgcn_fence(__ATOMIC_RELEASE, "agent");
            asm volatile("s_waitcnt vmcnt(0)" ::: "memory");
            const unsigned og = xb_add(&bar[XB_TOP], 1u);
            const unsigned tg = og / nx;
            if (og + 1u == (tg + 1u) * nx) xb_add(&bar[XB_TOPGEN], 1u);
            else XB_SPIN(xb_ld(&bar[XB_TOPGEN]) == tg, bar);
            __builtin_amdgcn_fence(__ATOMIC_ACQUIRE, "agent");
            xb_add(&bar[XB_XGEN(b.x)], 1u);
            asm volatile("s_waitcnt vmcnt(0)" ::: "memory");
        } else {
            XB_SPIN(xb_ld(&bar[XB_XGEN(b.x)]) == gen, bar);
            __builtin_amdgcn_fence(__ATOMIC_ACQUIRE, "agent");
            asm volatile("s_waitcnt vmcnt(0)" ::: "memory");
        }
    }
    __syncthreads();
}
#ifndef W3_P0
#define W3_P0 2816
#endif
struct Args { const float* in[18]; float* out; unsigned char* ws; int ph_lo, ph_hi, pad, pad2; };
#define P_xp (A.in[0])
#define P_xs (A.in[1])
#define P_sgla (A.in[2])
#define P_sconv (A.in[3])
#define P_norm_mix (A.in[4])
#define P_w_in (A.in[5])
#define P_wgu (A.in[6])
#define P_bgate (A.in[7])
#define P_gla_norm (A.in[8])
#define P_conv_w (A.in[9])
#define P_conv_b (A.in[10])
#define P_ln_g (A.in[11])
#define P_ln_b (A.in[12])
#define P_w_out (A.in[13])
#define P_norm_ffn (A.in[14])
#define P_w_ffn_in (A.in[15])
#define P_w_ffn_out (A.in[16])
#define P_norm_final (A.in[17])
#define P_W1t ((bf16*)(A.ws + WS_W1))
#define P_W2t ((bf16*)(A.ws + WS_W2))
#define P_W3t ((bf16*)(A.ws + WS_W3))
#define P_W4t ((bf16*)(A.ws + WS_W4))
#define P_H ((bf16*)(A.ws + WS_H))
#define P_Z ((bf16*)(A.ws + WS_Z))
#define P_MIX ((bf16*)(A.ws + WS_MIX))
#define P_HID ((bf16*)(A.ws + WS_HID))
#define P_QT ((bf16*)(A.ws + WS_QT))
#define P_KH ((bf16*)(A.ws + WS_KH))
#define P_VT ((bf16*)(A.ws + WS_VT))
#define P_out (A.out)
#define P_O32 ((float*)((unsigned char*)A.out + DO_O32))
#define P_AM ((bf16*)((unsigned char*)A.out + DO_AM))
#define P_DCb ((float*)((unsigned char*)A.out + DO_DC))

struct Frame {
    LAS unsigned char* lds;
    volatile LAS unsigned* MISC;
    gu32* ctl;
    int tid, lane, wave, vcu, G;
};
__device__ __forceinline__ float wave_sum(float v) {
#pragma unroll
    for (int o = 1; o < 64; o <<= 1) v += __shfl_xor(v, o);
    return v;
}
__device__ __forceinline__ float dot4(f32x4 a, f32x4 b) { return (a.x * b.x + a.y * b.y) + (a.z * b.z + a.w * b.w); }

template <int MAP> __device__ __forceinline__ int srccol(int n) {
    if (MAP == 1) { if (n < 2048) return n; if (n < 3072) return n + 16;
        if (n < 5120) { const int t = (n - 3072) >> 8, r = (n - 3072) & 255; return r < 128 ? 3088 + 128 * t + r : 3088 + 1024 + 128 * t + (r - 128); }
        return n < 5136 ? n - 3072 : -1; }
    if (MAP == 3) { const int t = n >> 8, r = n & 255; return r < 128 ? 128 * t + r : DFF + 128 * t + (r - 128); }
    return n;
}
template <int MAP> __device__ __forceinline__ void tr_load(float (&tv)[32], const float* W, int Nsrc, int Ndst, int item, int lane) {
    const int nblk = Ndst / 32, kb = item / nblk, nb = item % nblk, k0 = 64 * kb, n0 = 32 * nb;
    const int sc = srccol<MAP>(n0 + (lane & 31));
    const float* src = W + (size_t)k0 * Nsrc + (sc >= 0 ? sc : 0);
#pragma unroll
    for (int i = 0; i < 32; ++i) { const int kk = 2 * i + (lane >> 5); tv[i] = __builtin_nontemporal_load(src + (size_t)kk * Nsrc); }
}
template <int MAP> __device__ __forceinline__ void tr_store(const float (&tv)[32], int K, int Ndst, bf16* WT, LAS float* scr, int item, int lane) {
    const int nblk = Ndst / 32, kb = item / nblk, nb = item % nblk, k0 = 64 * kb, n0 = 32 * nb;
    const int sc = srccol<MAP>(n0 + (lane & 31));
#pragma unroll
    for (int i = 0; i < 32; ++i) { const int kk = 2 * i + (lane >> 5); scr[kk * 33 + (lane & 31)] = sc >= 0 ? tv[i] : 0.f; }
    LDS_WAIT(); asm volatile("" ::: "memory");
    const int c = lane & 7;
#pragma unroll
    for (int j = 0; j < 4; ++j) { const int n = (lane >> 3) + 8 * j; const LAS float* s = scr + (8 * c) * 33 + n;
        v4u o; o.x = pk2(s[0 * 33], s[1 * 33]); o.y = pk2(s[2 * 33], s[3 * 33]); o.z = pk2(s[4 * 33], s[5 * 33]); o.w = pk2(s[6 * 33], s[7 * 33]);
        *(GAS v4u*)(WT + (size_t)(n0 + n) * K + k0 + 8 * c) = o; }
    LDS_WAIT(); asm volatile("" ::: "memory");
}
template <int MAP> __device__ __forceinline__ void transpose_items(const float* W, int K, int Nsrc, int Ndst, bf16* WT, LAS float* scr, int it0, int stride, int nitems, int lane, int ibase = 0) {
    float ta[32], tb[32];
    int it = it0;
    if (it >= nitems) return;
    const int last = it0 + ((nitems - 1 - it0) / stride) * stride;
    tr_load<MAP>(ta, W, Nsrc, Ndst, ibase + it, lane);
#pragma unroll 1
    while (true) {
        const int i2 = it + stride; tr_load<MAP>(tb, W, Nsrc, Ndst, ibase + (i2 <= last ? i2 : last), lane);
        tr_store<MAP>(ta, K, Ndst, WT, scr, ibase + it, lane);
        if (i2 > last) break;
        const int i3 = i2 + stride; tr_load<MAP>(ta, W, Nsrc, Ndst, ibase + (i3 <= last ? i3 : last), lane);
        tr_store<MAP>(tb, K, Ndst, WT, scr, ibase + i2, lane);
        if (i3 > last) break;
        it = i3;
    }
}
__device__ __forceinline__ void rms_row_to_bf16(const float* xrow, const float* gain, bf16* orow, int lane, const float* part = nullptr, int ns = 0, size_t pstride = 0, float* xout = nullptr) {
    const GAS f32x4* xr = (const GAS f32x4*)xrow + lane; const GAS f32x4* gr = (const GAS f32x4*)gain + lane;
    f32x4 v[8]; float s = 0.f;
#pragma unroll
    for (int j = 0; j < 8; ++j) v[j] = __builtin_nontemporal_load(xr + 64 * j);
    if (xout) { GAS f32x4* xo = (GAS f32x4*)xout + lane;
#pragma unroll
        for (int j = 0; j < 8; ++j) xo[64 * j] = v[j]; }
#pragma unroll
    for (int j = 0; j < 8; ++j) s += dot4(v[j], v[j]);
    const float rstd = 1.0f / sqrtf(wave_sum(s) * (1.f / DM) + RMS_EPS);
    GAS v2u* o8 = (GAS v2u*)orow + lane;
#pragma unroll
    for (int j = 0; j < 8; ++j) { const f32x4 g = gr[64 * j]; v2u o; o.x = pk2(v[j].x * rstd * g.x, v[j].y * rstd * g.y); o.y = pk2(v[j].z * rstd * g.z, v[j].w * rstd * g.w); o8[64 * j] = o; }
}
__device__ __forceinline__ void rms_row_inplace(float* xrow, const float* gain, int lane, const float* part = nullptr, int ns = 0, size_t pstride = 0) {
    GAS f32x4* xr = (GAS f32x4*)xrow + lane; const GAS f32x4* gr = (const GAS f32x4*)gain + lane;
    f32x4 v[8]; float s = 0.f;
#pragma unroll
    for (int j = 0; j < 8; ++j) v[j] = xr[64 * j];
    for (int k = 0; k < ns; k += 2) {
        const GAS f32x4* pr0 = (const GAS f32x4*)(part + (size_t)k * pstride) + lane; const GAS f32x4* pr1 = (const GAS f32x4*)(part + (size_t)(k + 1) * pstride) + lane;
        f32x4 t0[8], t1[8];
#pragma unroll
        for (int j = 0; j < 8; ++j) { t0[j] = pr0[64 * j]; t1[j] = pr1[64 * j]; }
#pragma unroll
        for (int j = 0; j < 8; ++j) v[j] += t0[j] + t1[j]; }
#pragma unroll
    for (int j = 0; j < 8; ++j) s += dot4(v[j], v[j]);
    const float rstd = 1.0f / sqrtf(wave_sum(s) * (1.f / DM) + RMS_EPS);
#pragma unroll
    for (int j = 0; j < 8; ++j) { const f32x4 g = gr[64 * j]; xr[64 * j] = v[j] * rstd * g; }
}
__device__ __forceinline__ void wg_publish_wt(gu32* w0, int tid) { if (tid == 0) __hip_atomic_fetch_add(w0, 1u, RLX_AGENT); }
__device__ __forceinline__ void wg_publish(gu32* w0, gu32* w1, int tid) {
    if (tid == 0) { __builtin_amdgcn_fence(__ATOMIC_RELEASE, "agent"); asm volatile("s_waitcnt vmcnt(0)" ::: "memory");
        __hip_atomic_fetch_add(w0, 1u, RLX_AGENT); if (w1) __hip_atomic_fetch_add(w1, 1u, RLX_AGENT); }
}
__device__ __forceinline__ void wg_wait_ge(gu32* w, unsigned want, int tid) {
    if (tid < 64) { unsigned polls = 0;
        while ((unsigned)__builtin_amdgcn_readfirstlane(__hip_atomic_load(w, RLX_AGENT)) < want) { __builtin_amdgcn_s_sleep(2); if (++polls > (1u << 22)) break; }
        __builtin_amdgcn_fence(__ATOMIC_ACQUIRE, "agent"); asm volatile("s_waitcnt vmcnt(0)" ::: "memory"); }
    asm volatile("" ::: "memory"); __syncthreads(); asm volatile("" ::: "memory");
}
template <int NS> __device__ __forceinline__ void sample_row_unit(const float* base, const float* part, size_t pstride, const float* gain, float* xout, bf16* obf, float* of32, LAS float* red, int wave, int lane) {
    const int col = 256 * wave + 4 * lane;
    f32x4 v = *(const GAS f32x4*)(base + col);
    f32x4 t[NS];
#pragma unroll
    for (int k = 0; k < NS; ++k) t[k] = *(const GAS f32x4*)(part + (size_t)k * pstride + col);
#pragma unroll
    for (int k = 0; k < NS; ++k) v += t[k];
    if (xout) *(GAS f32x4*)(xout + col) = v;
    const float s = wave_sum(dot4(v, v));
    if (lane == 0) red[wave] = s;
    LDS_BARRIER();
    float tot = 0.f;
#pragma unroll
    for (int w = 0; w < 8; ++w) tot += red[w];
    const float rstd = 1.0f / sqrtf(tot * (1.f / DM) + RMS_EPS);
    const f32x4 g = *(const GAS f32x4*)(gain + col); const f32x4 r = v * rstd * g;
    if (obf) { v2u o; o.x = pk2(r.x, r.y); o.y = pk2(r.z, r.w); *(GAS v2u*)(obf + col) = o; }
    if (of32) *(GAS f32x4*)(of32 + col) = r;
    LDS_BARRIER();
}
__device__ __forceinline__ void p0_prologue(Frame& F, const Args& A) {
    LAS float* scr = (LAS float*)(F.lds + RING_OFF + F.wave * 16384);
    const int gw = F.vcu * NWAVES + F.wave, NGW = F.G * NWAVES;
    constexpr int I_1 = (DM / 64) * (N1P / 32), I_2 = (DM / 64) * (DM / 32);
    transpose_items<1>(P_w_in, DM, N1, N1P, P_W1t, scr, gw, NGW, I_1, F.lane);
    transpose_items<0>(P_w_out, DM, DM, DM, P_W2t, scr, NGW - 1 - gw, NGW, I_2, F.lane);
    transpose_items<3>(P_w_ffn_in, DM, 2 * DFF, 2 * DFF, P_W3t, scr, gw, NGW, W3_P0, F.lane);
    {
        const int m0 = NGW - 1 - gw;
        const GAS f32x4* gr = (const GAS f32x4*)P_norm_mix + F.lane;
        f32x4 va[8], vb[8];
        auto rowp = [&](int m) -> const GAS f32x4* { const int mc = m < MR ? m : MR - 1; return (const GAS f32x4*)(mc < MP ? P_xp + (size_t)mc * DM : P_xs + (size_t)(mc - MP) * DM) + F.lane; };
        if (m0 < MPAD) {
            { const GAS f32x4* xr = rowp(m0);
#pragma unroll
              for (int j = 0; j < 8; ++j) va[j] = __builtin_nontemporal_load(xr + 64 * j); }
#pragma unroll 1
            for (int m = m0; m < MPAD; m += NGW) {
                { const GAS f32x4* xr = rowp(m + NGW);
#pragma unroll
                  for (int j = 0; j < 8; ++j) vb[j] = __builtin_nontemporal_load(xr + 64 * j); }
                float s = 0.f;
#pragma unroll
                for (int j = 0; j < 8; ++j) s += dot4(va[j], va[j]);
                const float rstd = (m < MR) ? 1.0f / sqrtf(wave_sum(s) * (1.f / DM) + RMS_EPS) : 0.f;
                GAS v2u* o8 = (GAS v2u*)(P_H + (size_t)m * DM) + F.lane;
#pragma unroll
                for (int j = 0; j < 8; ++j) { const f32x4 g = gr[64 * j]; v2u o; o.x = pk2(va[j].x * rstd * g.x, va[j].y * rstd * g.y); o.y = pk2(va[j].z * rstd * g.z, va[j].w * rstd * g.w); o8[64 * j] = o; }
#pragma unroll
                for (int j = 0; j < 8; ++j) va[j] = vb[j];
            }
        }
    }
}
__device__ __forceinline__ void convert_w3(Frame& F, const Args& A, int wg, int nwgs) {
    LAS float* scr = (LAS float*)(F.lds + RING_OFF + F.wave * 16384);
    constexpr int I_3 = (DM / 64) * (2 * DFF / 32);
    transpose_items<3>(P_w_ffn_in, DM, 2 * DFF, 2 * DFF, P_W3t, scr, wg * NWAVES + F.wave, nwgs * NWAVES, I_3 - W3_P0, F.lane, W3_P0);
}
__device__ __forceinline__ void convert_w4(Frame& F, const Args& A, int wg, int nwgs) {
    LAS float* scr = (LAS float*)(F.lds + RING_OFF + F.wave * 16384);
    constexpr int I_4 = (DFF / 64) * (DM / 32);
    transpose_items<0>(P_w_ffn_out, DFF, DM, DM, P_W4t, scr, wg * NWAVES + F.wave, nwgs * NWAVES, I_4, F.lane);
}
__device__ __forceinline__ void gla_prep_unit(Frame& F, const Args& A, int bh, int c) {
    const int tid = F.tid, b = bh >> 2, h = bh & 3, row0 = b * SEQ + c * CH;
    LAS float* GL = (LAS float*)(F.lds + RING_OFF);
    LAS float* BL = (LAS float*)(F.lds + RING_OFF + 4608);
    LAS bf16* QS = (LAS bf16*)(F.lds + RING_OFF + 8192);
    LAS bf16* KS = (LAS bf16*)(F.lds + RING_OFF + 25600);
    LAS bf16* VR = (LAS bf16*)(F.lds + RING_OFF + 43008);
    LAS bf16* KHS = (LAS bf16*)(F.lds + RING_OFF + 76800);
    const size_t uc = (size_t)bh * NCH + c;
    const bf16* Zc = P_Z + (size_t)row0 * N1P;
    {
        v4u pq[2], pk[2], pv[4];
#pragma unroll
        for (int k = 0; k < 2; ++k) { const int p = tid + 512 * k, i = p >> 4, ch = p & 15;
            pq[k] = *(const GAS v4u*)(Zc + (size_t)i * N1P + ZQ + h * HK + 8 * ch); pk[k] = *(const GAS v4u*)(Zc + (size_t)i * N1P + ZK + h * HK + 8 * ch); }
#pragma unroll
        for (int k = 0; k < 4; ++k) { const int p = tid + 512 * k, i = p >> 5, ch = p & 31; pv[k] = *(const GAS v4u*)(Zc + (size_t)i * N1P + ZV + h * HV + 8 * ch); }
        v4u pg = (v4u){0u, 0u, 0u, 0u};
        if (tid < 128) pg = *(const GAS v4u*)(Zc + (size_t)(tid >> 1) * N1P + ZGL + 8 * (tid & 1));
#pragma unroll
        for (int k = 0; k < 2; ++k) { const int p = tid + 512 * k, i = p >> 4, ch = p & 15; *(LAS v4u*)(QS + i * 136 + 8 * ch) = pq[k]; *(LAS v4u*)(KS + i * 136 + 8 * ch) = pk[k]; }
#pragma unroll
        for (int k = 0; k < 4; ++k) { const int p = tid + 512 * k, i = p >> 5, ch = p & 31; *(LAS v4u*)(VR + i * 264 + 8 * (ch ^ ((i >> 3) & 7))) = pv[k]; }
        if (tid < 128) { LAS float* gp = GL + (tid >> 1) * 16 + 8 * (tid & 1);
            gp[0] = bflo(pg.x); gp[1] = bfhi(pg.x); gp[2] = bflo(pg.y); gp[3] = bfhi(pg.y); gp[4] = bflo(pg.z); gp[5] = bfhi(pg.z); gp[6] = bflo(pg.w); gp[7] = bfhi(pg.w); }
    }
    const int d = tid & 127, g = tid >> 7;
    float wg[16];
#pragma unroll
    for (int r = 0; r < 16; ++r) wg[r] = P_wgu[r * DK + h * HK + d];
    const float bg = P_bgate[h * HK + d];
    LDS_BARRIER();
    float bcum[16]; float run = 0.f;
#pragma unroll
    for (int ii = 0; ii < 16; ++ii) { const int i = g * 16 + ii; float x = bg;
#pragma unroll
        for (int r4 = 0; r4 < 4; ++r4) { const f32x4 gl = *(const LAS f32x4*)(GL + i * 16 + 4 * r4);
            x += gl.x * wg[4 * r4] + gl.y * wg[4 * r4 + 1] + gl.z * wg[4 * r4 + 2] + gl.w * wg[4 * r4 + 3]; }
        run += logsigmoid_f(x) * (1.0f / 16.0f); bcum[ii] = run; }
    BL[g * 128 + d] = run;
    LDS_BARRIER();
    float off = 0.f, tot = 0.f;
#pragma unroll
    for (int gg = 0; gg < 4; ++gg) { const float t = BL[gg * 128 + d]; off += (gg < g) ? t : 0.f; tot += t; }
    const float scale = 0.08838834764831845f;
#pragma unroll
    for (int ii = 0; ii < 16; ++ii) { const int i = g * 16 + ii; const float bb = bcum[ii] + off;
        const float q = bf2f(QS[i * 136 + d]) * scale * __expf(bb);
        const float kv = bf2f(KS[i * 136 + d]);
        const unsigned qk = pg8::cvt_pk_bf16(q, kv * __expf(-bb)), qb = qk & 0xffffu, ktb = qk >> 16, khb = pg8::cvt_pk_bf16(kv * __expf(tot - bb), 0.f) & 0xffffu;
        QS[i * 136 + d] = (bf16)qb; KS[i * 136 + d] = (bf16)ktb; KHS[i * 136 + (d ^ (8 * ((i >> 3) & 7)))] = (bf16)khb; }
    {
#pragma unroll
      for (int k = 0; k < 4; ++k) { const int q = tid + 512 * k, n = q >> 3, pc = q & 7; unsigned vw[4];
#pragma unroll
          for (int e = 0; e < 8; ++e) { const unsigned v = VR[(8 * pc + e) * 264 + (n ^ (8 * pc))];
              if (e & 1) vw[e >> 1] |= v << 16; else vw[e >> 1] = v; }
          *(GAS v4u*)(P_VT + (uc * 256 + n) * 64 + 8 * pc) = (v4u){vw[0], vw[1], vw[2], vw[3]}; } }
    LDS_BARRIER();
    {
#pragma unroll
      for (int k = 0; k < 2; ++k) { const int q = tid + 512 * k, dd = q >> 3, pc = q & 7; unsigned kw[4];
#pragma unroll
          for (int e = 0; e < 8; ++e) { const unsigned v = KHS[(8 * pc + e) * 136 + (dd ^ (8 * pc))];
              if (e & 1) kw[e >> 1] |= v << 16; else kw[e >> 1] = v; }
          *(GAS v4u*)(P_KH + (uc * 128 + dd) * 64 + 8 * pc) = (v4u){kw[0], kw[1], kw[2], kw[3]}; } }
    {
#pragma unroll
        for (int k = 0; k < 2; ++k) { const int p = tid + 512 * k, i = p >> 4, s = (p >> 2) & 3, fq = p & 3;
            const v2u lo = *(const LAS v2u*)(QS + i * 136 + 32 * s + 4 * fq), hi = *(const LAS v2u*)(QS + i * 136 + 32 * s + 16 + 4 * fq);
            *(GAS v4u*)(P_QT + (uc * 64 + i) * 128 + 32 * s + 8 * fq) = (v4u){lo.x, lo.y, hi.x, hi.y}; }
    }
    { const int fr = F.lane & 15, fq = F.lane >> 4;
#pragma unroll
      for (int tt = 0; tt < 2; ++tt) { const int id = 2 * F.wave + tt, it = id >> 2, jt = id & 3;
          f32x4 acc = (f32x4){0.f, 0.f, 0.f, 0.f};
          if (jt <= it) {
#pragma unroll
              for (int s = 0; s < 4; ++s) { const bf16x8 a = *(const LAS bf16x8*)(KS + (jt * 16 + fr) * 136 + 32 * s + 8 * fq); const bf16x8 bq = *(const LAS bf16x8*)(QS + (it * 16 + fr) * 136 + 32 * s + 8 * fq);
                  acc = __builtin_amdgcn_mfma_f32_16x16x32_bf16(a, bq, acc, 0, 0, 0); } }
          const int i = it * 16 + fr, j0 = jt * 16 + 4 * fq;
#pragma unroll
          for (int r = 0; r < 4; ++r) if (j0 + r > i) acc[r] = 0.f;
          v2u o; o.x = pk2(acc[0], acc[1]); o.y = pk2(acc[2], acc[3]);
          *(LAS v2u*)(VR + i * 72 + j0) = o; } }
    if (g == 0) GL[d] = __expf(tot);
    LDS_BARRIER();
    { const int i = tid >> 3, ch = tid & 7; *(GAS v4u*)(P_AM + (uc * 64 + i) * 64 + 8 * ch) = *(const LAS v4u*)(VR + i * 72 + 8 * ch); }
    if (tid < 32) *(GAS f32x4*)(P_DCb + uc * 128 + 4 * tid) = *(const LAS f32x4*)(GL + 4 * tid);
    LDS_BARRIER();
}
__device__ __forceinline__ void ln_silu_row(const LAS float* cs, const float* lng, const float* lnb, bf16* orow, int lane) {
    f32x4 x[4]; float s = 0.f;
#pragma unroll
    for (int j = 0; j < 4; ++j) { x[j] = *(const LAS f32x4*)(cs + 256 * j + 4 * lane); s += (x[j].x + x[j].y) + (x[j].z + x[j].w); }
    const float mean = wave_sum(s) * (1.f / DC_); float q = 0.f;
#pragma unroll
    for (int j = 0; j < 4; ++j) { x[j] = x[j] - mean; q += dot4(x[j], x[j]); }
    const float rstd = 1.0f / sqrtf(wave_sum(q) * (1.f / DC_) + LN_EPS);
#pragma unroll
    for (int j = 0; j < 4; ++j) { const f32x4 g = *(const GAS f32x4*)(lng + 256 * j + 4 * lane), bb = *(const GAS f32x4*)(lnb + 256 * j + 4 * lane);
        const f32x4 y = x[j] * rstd * g + bb; v2u o; o.x = pk2(silu_f(y.x), silu_f(y.y)); o.y = pk2(silu_f(y.z), silu_f(y.w));
        *(GAS v2u*)(orow + 256 * j + 4 * lane) = o; }
}
__device__ __forceinline__ void ln_silu_rows2(const LAS float* cs, const float* lng, const float* lnb, bf16* orow, int lane) {
    f32x4 g[4], bb[4];
#pragma unroll
    for (int j = 0; j < 4; ++j) { g[j] = *(const GAS f32x4*)(lng + 256 * j + 4 * lane); bb[j] = *(const GAS f32x4*)(lnb + 256 * j + 4 * lane); }
    f32x4 x[2][4]; float s[2] = {0.f, 0.f};
#pragma unroll
    for (int k = 0; k < 2; ++k)
#pragma unroll
        for (int j = 0; j < 4; ++j) { x[k][j] = *(const LAS f32x4*)(cs + k * 1024 + 256 * j + 4 * lane); s[k] += (x[k][j].x + x[k][j].y) + (x[k][j].z + x[k][j].w); }
#pragma unroll
    for (int o = 1; o < 64; o <<= 1) { s[0] += __shfl_xor(s[0], o); s[1] += __shfl_xor(s[1], o); }
    float q[2] = {0.f, 0.f};
#pragma unroll
    for (int k = 0; k < 2; ++k) { const float mean = s[k] * (1.f / DC_);
#pragma unroll
        for (int j = 0; j < 4; ++j) { x[k][j] = x[k][j] - mean; q[k] += dot4(x[k][j], x[k][j]); } }
#pragma unroll
    for (int o = 1; o < 64; o <<= 1) { q[0] += __shfl_xor(q[0], o); q[1] += __shfl_xor(q[1], o); }
#pragma unroll
    for (int k = 0; k < 2; ++k) { const float rstd = 1.0f / sqrtf(q[k] * (1.f / DC_) + LN_EPS);
#pragma unroll
        for (int j = 0; j < 4; ++j) { const f32x4 y = x[k][j] * rstd * g[j] + bb[j]; v2u o; o.x = pk2(silu_f(y.x), silu_f(y.y)); o.y = pk2(silu_f(y.z), silu_f(y.w));
            *(GAS v2u*)(orow + (size_t)k * DM + 256 * j + 4 * lane) = o; } }
}
__device__ __forceinline__ void conv_prompt_unit(Frame& F, const Args& A, int b, int tb) {
    LAS bf16* GT = (LAS bf16*)(F.lds + RING_OFF);
    LAS float* CS = (LAS float*)(F.lds + RING_OFF);
    const int t0 = tb * 16;
    { v4u g8[12];
#pragma unroll
      for (int k = 0; k < 12; ++k) { const int p = F.tid + 512 * k, pc = p < 46 * 128 ? p : 0, r = pc >> 7, ch = pc & 127, t = t0 - 30 + r, tc = t < 0 ? 0 : t;
          g8[k] = *(const GAS v4u*)(P_Z + (size_t)(b * SEQ + tc) * N1P + ZGLU + 8 * ch); }
#pragma unroll
      for (int k = 0; k < 12; ++k) { const int p = F.tid + 512 * k, r = p >> 7, ch = p & 127, t = t0 - 30 + r;
          if (p < 46 * 128) *(LAS v4u*)(GT + r * 1024 + 8 * ch) = t < 0 ? (v4u){0u, 0u, 0u, 0u} : g8[k]; } }
    asm volatile("" ::: "memory");
    const int c = 2 * F.tid;
    const f32x2 bias = *(const GAS f32x2*)(P_conv_b + c);
    f32x2 acc[16];
#pragma unroll
    for (int tt = 0; tt < 16; ++tt) acc[tt] = bias;
    LDS_BARRIER();
#pragma unroll
    for (int half = 0; half < 2; ++half) {
        const int w0 = half * 16, nw = half ? 15 : 16;
        f32x2 wt[16];
#pragma unroll
        for (int w = 0; w < 16; ++w) wt[w] = (w < nw) ? *(const GAS f32x2*)(P_conv_w + (w0 + w) * DC_ + c) : (f32x2){0.f, 0.f};
#pragma unroll
        for (int r = 0; r < 46; ++r) { if (r >= w0 && r < w0 + nw + 15) { const unsigned gw_ = *(const LAS unsigned*)(GT + r * 1024 + c); f32x2 g; g.x = bflo(gw_); g.y = bfhi(gw_);
#pragma unroll
            for (int tt = 0; tt < 16; ++tt) { const int w = r - tt - w0; if (w >= 0 && w < nw) acc[tt] += g * wt[(w >= 0 && w < 16) ? w : 0]; } } }
        asm volatile("" ::: "memory");
    }
    LDS_BARRIER();
#pragma unroll
    for (int tt = 0; tt < 16; ++tt) *(LAS f32x2*)(CS + tt * 1024 + c) = acc[tt];
    LDS_BARRIER();
    ln_silu_rows2(CS + (2 * F.wave) * 1024, P_ln_g, P_ln_b, P_MIX + (size_t)(b * SEQ + t0 + 2 * F.wave) * DM + DA, F.lane);
    LDS_BARRIER();
}
__device__ __forceinline__ void conv_state_prompt_row(Frame& F, const Args& A, int b, int rr) {
    const bf16* zr = P_Z + (size_t)(b * SEQ + SEQ - 30 + rr) * N1P; float* orow = P_out + O_CP + ((size_t)b * 30 + rr) * DC_;
#pragma unroll
    for (int j = 0; j < 4; ++j) { const int c = 256 * j + 4 * F.lane; const v2u gg = *(const GAS v2u*)(zr + ZGLU + c);
        *(GAS f32x4*)(orow + c) = (f32x4){bflo(gg.x), bfhi(gg.x), bflo(gg.y), bfhi(gg.y)}; }
}
__device__ __forceinline__ void conv_sample_unit(Frame& F, const Args& A, int b) {
    LAS float* CS = (LAS float*)(F.lds + RING_OFF);
    const bf16* zr = P_Z + (size_t)(MP + b) * N1P;
    const int c = 2 * F.tid;
    f32x2 acc = *(const GAS f32x2*)(P_conv_b + c);
    f32x2 hv[30];
#pragma unroll
    for (int w = 0; w < 30; ++w) hv[w] = __builtin_nontemporal_load((const GAS f32x2*)(P_sconv + ((size_t)b * 30 + w) * DC_ + c));
    const unsigned gg = *(const GAS unsigned*)(zr + ZGLU + c);
#pragma unroll
    for (int w = 0; w < 30; ++w) { acc += hv[w] * *(const GAS f32x2*)(P_conv_w + w * DC_ + c); if (w >= 1) __builtin_nontemporal_store(hv[w], (GAS f32x2*)(P_out + O_CS + ((size_t)b * 30 + (w - 1)) * DC_ + c)); }
    f32x2 gl; gl.x = bflo(gg); gl.y = bfhi(gg);
    acc += gl * *(const GAS f32x2*)(P_conv_w + 30 * DC_ + c);
    *(GAS f32x2*)(P_out + O_CS + ((size_t)b * 30 + 29) * DC_ + c) = gl;
    *(LAS f32x2*)(CS + c) = acc;
    LDS_BARRIER();
    if (F.wave == 0) ln_silu_row(CS, P_ln_g, P_ln_b, P_MIX + (size_t)(MP + b) * DM + DA, F.lane);
    LDS_BARRIER();
}
__device__ __forceinline__ void gla_sample_items(Frame& F, const Args& A, int it0, int stride, int nitems) {
    const int tid = F.tid, n4 = 4 * F.lane;
    LAS float* TB = (LAS float*)(F.lds + RING_OFF);
    LAS float* OP = TB + 4 * 640;
    f32x4 s[16], sx[16];
    int it = it0;
    if (it < nitems) { const float* Sin = P_sgla + (size_t)it * HK * HV;
#pragma unroll
        for (int dd = 0; dd < 16; ++dd) s[dd] = __builtin_nontemporal_load((const GAS f32x4*)(Sin + (size_t)(16 * F.wave + dd) * HV + n4)); }
#pragma unroll 1
    for (int k = 0; k < 4; ++k) { const int ik = it0 + k * stride; if (ik < nitems) { const int b = ik >> 2, h = ik & 3; const bf16* zr = P_Z + (size_t)(MP + b) * N1P; LAS float* T = TB + k * 640;
        if (tid < 128) { const int d = tid; float x = P_bgate[h * HK + d];
#pragma unroll
            for (int r = 0; r < 16; ++r) x += bf2f(zr[ZGL + r]) * P_wgu[r * DK + h * HK + d];
            T[d] = __expf(logsigmoid_f(x) * (1.0f / 16.0f)); T[128 + d] = bf2f(zr[ZK + h * HK + d]); T[256 + d] = bf2f(zr[ZQ + h * HK + d]) * 0.08838834764831845f; }
        else if (tid < 384) { const int n = tid - 128; T[384 + n] = bf2f(zr[ZV + h * HV + n]); } } }
    LDS_BARRIER();
    int k = 0;
#pragma unroll 1
    while (it < nitems) {
        const int b = it >> 2, h = it & 3, nx = it + stride;
        const bf16* zr = P_Z + (size_t)(MP + b) * N1P;
        float* Sout = P_out + O_GS + (size_t)it * HK * HV;
        const LAS float* AD = TB + k * 640; const LAS float* KD = AD + 128; const LAS float* QD = AD + 256; const LAS float* VD = AD + 384;
        { const float* Sin = P_sgla + (size_t)(nx < nitems ? nx : it) * HK * HV;
#pragma unroll
            for (int dd = 0; dd < 16; ++dd) sx[dd] = __builtin_nontemporal_load((const GAS f32x4*)(Sin + (size_t)(16 * F.wave + dd) * HV + n4)); }
        const f32x4 v4 = *(const LAS f32x4*)(VD + n4);
        f32x4 oacc = (f32x4){0.f, 0.f, 0.f, 0.f};
#pragma unroll
        for (int dd = 0; dd < 16; ++dd) { const int d = 16 * F.wave + dd;
            const f32x4 sn = s[dd] * AD[d] + v4 * KD[d]; __builtin_nontemporal_store(sn, (GAS f32x4*)(Sout + (size_t)d * HV + n4)); oacc += sn * QD[d]; }
        *(LAS f32x4*)(OP + F.wave * 256 + n4) = oacc;
        LDS_BARRIER();
        if (F.wave == 0) { f32x4 o4 = (f32x4){0.f, 0.f, 0.f, 0.f};
#pragma unroll
            for (int w = 0; w < 8; ++w) o4 += *(const LAS f32x4*)(OP + w * 256 + n4);
            const float rstd = 1.0f / sqrtf(wave_sum(dot4(o4, o4)) * (1.f / HV) + RMS_EPS);
            const f32x4 gn = *(const GAS f32x4*)(P_gla_norm + n4); const v2u go = *(const GAS v2u*)(zr + ZGO + h * HV + n4);
            v2u o; o.x = pk2(o4.x * rstd * gn.x * silu_f(bflo(go.x)), o4.y * rstd * gn.y * silu_f(bfhi(go.x))); o.y = pk2(o4.z * rstd * gn.z * silu_f(bflo(go.y)), o4.w * rstd * gn.w * silu_f(bfhi(go.y)));
            *(GAS v2u*)(P_MIX + (size_t)(MP + b) * DM + h * HV + n4) = o; }
        LDS_BARRIER();
#pragma unroll
        for (int dd = 0; dd < 16; ++dd) s[dd] = sx[dd];
        it = nx; ++k;
    }
}
constexpr int SQ_AM = 0, SQ_QT = 9216, SQ_KH = 26624, SQ_VT = 45056, SQ_DC = 49664, SQ_BUF = 50176, SQ_NP = 2848, SQ_LT = 384;
__device__ __forceinline__ void seq_issue(f32x4 (&R)[8], const bf16* AMc, const bf16* QTc, const bf16* KHc, const bf16* VTc, const float* DCc, int lt) {
#pragma unroll
    for (int k = 0; k < 8; ++k) { const int P = lt + SQ_LT * k; const bf16* src = AMc;
        if (P < 512) src = AMc + (P >> 3) * 64 + (P & 7) * 8;
        else if (P < 1536) { const int q = P - 512; src = QTc + (q >> 4) * 128 + (q & 15) * 8; }
        else if (P < 2560) { const int q = P - 1536; src = KHc + (q >> 3) * 64 + (q & 7) * 8; }
        else if (P < 2816) { const int q = P - 2560; src = VTc + (q >> 3) * 64 + (q & 7) * 8; }
        else if (P < SQ_NP) { const int q = P - 2816; src = (const bf16*)DCc + q * 8; }
        R[k] = *(const GAS f32x4*)src; }
}
__device__ __forceinline__ void seq_stash(const f32x4 (&R)[8], LAS unsigned char* buf, int lt) {
#pragma unroll
    for (int k = 0; k < 8; ++k) { const int P = lt + SQ_LT * k; int dst = 0;
        if (P < 512) dst = SQ_AM + (P >> 3) * 144 + (P & 7) * 16;
        else if (P < 1536) { const int q = P - 512; dst = SQ_QT + (q >> 4) * 272 + (q & 15) * 16; }
        else if (P < 2560) { const int q = P - 1536; dst = SQ_KH + (q >> 3) * 144 + (q & 7) * 16; }
        else if (P < 2816) { const int q = P - 2560; dst = SQ_VT + (q >> 3) * 144 + (q & 7) * 16; }
        else { const int q = P - 2816; dst = SQ_DC + q * 16; }
        if (P < SQ_NP) *(LAS f32x4*)(buf + dst) = R[k]; }
}
__device__ __forceinline__ void gla_seq_wg(Frame& F, const Args& A, int item) {
    const int bh = item >> 3, grp = item & 7, b = bh >> 2, h = bh & 3, fr = F.lane & 15, fq = F.lane >> 4;
    LAS unsigned char* lds0 = F.lds + RING_OFF;
    const bool loader = F.wave >= 2; const int lt = F.tid - 128;
    const size_t uc0 = (size_t)bh * NCH;
    const bf16* AM0 = P_AM + uc0 * 64 * 64; const bf16* QT0 = P_QT + uc0 * 64 * 128; const bf16* KH0 = P_KH + uc0 * 128 * 64; const bf16* VT0 = P_VT + uc0 * 256 * 64 + (size_t)(grp * 32) * 64; const float* DC0 = P_DCb + uc0 * 128;
    f32x4 S[8], RB[8];
#define RA S
#pragma unroll
    for (int dt = 0; dt < 8; ++dt) S[dt] = (f32x4){0.f, 0.f, 0.f, 0.f};
#define SEQ_ISSUE(R, CC) do { const size_t o_ = (size_t)(CC); seq_issue(R, AM0 + o_ * 64 * 64, QT0 + o_ * 64 * 128, KH0 + o_ * 128 * 64, VT0 + o_ * 256 * 64, DC0 + o_ * 128, lt); } while (0)
    if (loader) { SEQ_ISSUE(RA, 0); SEQ_ISSUE(RB, 1); seq_stash(RA, lds0, lt); SEQ_ISSUE(RA, 2); }
    LDS_BARRIER();
    const int n0 = grp * 32 + 16 * F.wave;
#define SEQ_COMPUTE(CC) do { \
            const LAS unsigned char* buf = lds0 + ((CC) & 1) * SQ_BUF; \
            bf16x8 vt[2]; \
_Pragma("unroll") \
            for (int ks = 0; ks < 2; ++ks) vt[ks] = *(const LAS bf16x8*)(buf + SQ_VT + (16 * F.wave + fr) * 144 + (32 * ks + 8 * fq) * 2); \
            f32x4 o[4]; \
_Pragma("unroll") \
            for (int m = 0; m < 4; ++m) { o[m] = (f32x4){0.f, 0.f, 0.f, 0.f}; \
_Pragma("unroll") \
                for (int ks = 0; ks < 2; ++ks) { const bf16x8 a = *(const LAS bf16x8*)(buf + SQ_AM + (16 * m + fr) * 144 + (32 * ks + 8 * fq) * 2); o[m] = __builtin_amdgcn_mfma_f32_16x16x32_bf16(vt[ks], a, o[m], 0, 0, 0); } } \
            bf16x8 sb[4]; \
_Pragma("unroll") \
            for (int s = 0; s < 4; ++s) { v4u w; w.x = pg8::cvt_pk_bf16(S[2 * s][0], S[2 * s][1]); w.y = pg8::cvt_pk_bf16(S[2 * s][2], S[2 * s][3]); w.z = pg8::cvt_pk_bf16(S[2 * s + 1][0], S[2 * s + 1][1]); w.w = pg8::cvt_pk_bf16(S[2 * s + 1][2], S[2 * s + 1][3]); sb[s] = __builtin_bit_cast(bf16x8, w); } \
_Pragma("unroll") \
            for (int m = 0; m < 4; ++m) \
_Pragma("unroll") \
                for (int s = 0; s < 4; ++s) { const bf16x8 a = *(const LAS bf16x8*)(buf + SQ_QT + (16 * m + fr) * 272 + (32 * s + 8 * fq) * 2); o[m] = __builtin_amdgcn_mfma_f32_16x16x32_bf16(sb[s], a, o[m], 0, 0, 0); } \
_Pragma("unroll") \
            for (int m = 0; m < 4; ++m) *(GAS f32x4*)(P_O32 + (size_t)(b * SEQ + (CC) * CH + 16 * m + fr) * DA + h * HV + n0 + 4 * fq) = o[m]; \
_Pragma("unroll") \
            for (int dt = 0; dt < 8; ++dt) { const f32x4 dc = *(const LAS f32x4*)(buf + SQ_DC + (16 * dt + 4 * fq) * 4); S[dt] = S[dt] * dc; \
_Pragma("unroll") \
                for (int ks = 0; ks < 2; ++ks) { const bf16x8 a = *(const LAS bf16x8*)(buf + SQ_KH + (16 * dt + fr) * 144 + (32 * ks + 8 * fq) * 2); S[dt] = __builtin_amdgcn_mfma_f32_16x16x32_bf16(a, vt[ks], S[dt], 0, 0, 0); } } \
        } while (0)
    if (loader) {
#pragma unroll 1
        for (int c = 0; c < NCH; c += 2) {
            seq_stash(RB, lds0 + SQ_BUF, lt); SEQ_ISSUE(RB, (c + 3 < NCH ? c + 3 : NCH - 1));
            LDS_BARRIER();
            seq_stash(RA, lds0, lt); SEQ_ISSUE(RA, (c + 4 < NCH ? c + 4 : NCH - 1));
            LDS_BARRIER();
        }
    } else {
#pragma unroll 1
        for (int c = 0; c < NCH; c += 2) {
            SEQ_COMPUTE(c);
            LDS_BARRIER();
            SEQ_COMPUTE(c + 1);
            LDS_BARRIER();
        }
    }
#undef SEQ_COMPUTE
#undef SEQ_ISSUE
#undef RA
    if (!loader) {
#pragma unroll
        for (int dt = 0; dt < 8; ++dt)
#pragma unroll
            for (int r = 0; r < 4; ++r) P_out[O_GP + ((size_t)bh * HK + 16 * dt + 4 * fq + r) * HV + n0 + fr] = S[dt][r];
    }
}
template <int NR> __device__ __forceinline__ void gla_onorm_rows(Frame& F, const Args& A, int row, int rstride, int h) {
    const int n4 = 4 * F.lane;
    f32x4 o4[NR]; v2u go[NR];
#pragma unroll
    for (int j = 0; j < NR; ++j) { const int r = row + j * rstride; o4[j] = *(const GAS f32x4*)(P_O32 + (size_t)r * DA + h * HV + n4); go[j] = *(const GAS v2u*)(P_Z + (size_t)r * N1P + ZGO + h * HV + n4); }
    const f32x4 gn = *(const GAS f32x4*)(P_gla_norm + n4);
#pragma unroll
    for (int j = 0; j < NR; ++j) { const int r = row + j * rstride;
        const float rstd = 1.0f / sqrtf(wave_sum(dot4(o4[j], o4[j])) * (1.f / HV) + RMS_EPS);
        v2u o; o.x = pk2(o4[j].x * rstd * gn.x * silu_f(bflo(go[j].x)), o4[j].y * rstd * gn.y * silu_f(bfhi(go[j].x))); o.y = pk2(o4[j].z * rstd * gn.z * silu_f(bflo(go[j].y)), o4[j].w * rstd * gn.w * silu_f(bfhi(go[j].y)));
        *(GAS v2u*)(P_MIX + (size_t)r * DM + h * HV + n4) = o; }
}
__device__ __forceinline__ void gla_onorm_item(Frame& F, const Args& A, int row, int h) {
    const int n4 = 4 * F.lane;
    const f32x4 o4 = *(const GAS f32x4*)(P_O32 + (size_t)row * DA + h * HV + n4);
    const float rstd = 1.0f / sqrtf(wave_sum(dot4(o4, o4)) * (1.f / HV) + RMS_EPS);
    const f32x4 gn = *(const GAS f32x4*)(P_gla_norm + n4); const v2u go = *(const GAS v2u*)(P_Z + (size_t)row * N1P + ZGO + h * HV + n4);
    v2u o; o.x = pk2(o4.x * rstd * gn.x * silu_f(bflo(go.x)), o4.y * rstd * gn.y * silu_f(bfhi(go.x))); o.y = pk2(o4.z * rstd * gn.z * silu_f(bflo(go.y)), o4.w * rstd * gn.w * silu_f(bfhi(go.y)));
    *(GAS v2u*)(P_MIX + (size_t)row * DM + h * HV + n4) = o;
}
#ifndef G1_WGS_V
#define G1_WGS_V 231
#endif
#ifndef G3_WGS_V
#define G3_WGS_V 242
#endif
constexpr int G1_WGS = G1_WGS_V, G3_WGS = G3_WGS_V;
#ifndef FUSE_ROWS
#define FUSE_ROWS 1
#endif
#ifndef G1_SP2
#define G1_SP2 true
#endif
#ifndef G3_SP2
#define G3_SP2 true
#endif
#ifndef G1_ALIGN
#define G1_ALIGN true
#endif
#ifndef G3_ALIGN
#define G3_ALIGN true
#endif
#ifndef NKP2_V
#define NKP2_V 4
#endif
#ifndef NKP4_V
#define NKP4_V 8
#endif
constexpr int NKP2 = NKP2_V, NKP4 = NKP4_V;

#ifdef EXTRA_PHASE
#define MK_N_LAUNCHES 10
#endif
#ifndef MK_N_LAUNCHES
#define MK_N_LAUNCHES 1
#endif
constexpr int N_PHASES = 10;
constexpr int N_LAUNCHES = MK_N_LAUNCHES;
__global__ void __launch_bounds__(NWAVES * 64, 2) hymba_fwd(Args args) {
    extern __shared__ __attribute__((aligned(16))) unsigned char lds[];
    Frame F;
    F.lds = (LAS unsigned char*)lds;
    F.MISC = (volatile LAS unsigned*)(F.lds + MISC_OFF);
    F.tid = threadIdx.x; F.lane = F.tid & 63; F.wave = __builtin_amdgcn_readfirstlane(F.tid >> 6);
    F.G = gridDim.x; { const int bx = blockIdx.x; F.vcu = (F.G % 8 == 0) ? (bx % 8) * (F.G / 8) + bx / 8 : bx; }
    const Args& A = args;
    F.ctl = (gu32*)(args.ws + WS_CTL);
    for (int u = F.tid; u < (LDS_BYTES - LDSCTL_OFF) / 4; u += NWAVES * 64) ((LAS unsigned*)(F.lds + LDSCTL_OFF))[u] = 0u;
    __syncthreads();
    XcdBarrier bar; bar.bar = (unsigned*)(F.ctl + CW_BAR); bar.x = 0; bar.st = nullptr;
    if (N_LAUNCHES == 1) bar = xcd_barrier_post((unsigned*)(F.ctl + CW_BAR), F.MISC + 8);
    const int lo = args.ph_lo, hi = args.ph_hi;
#ifndef REP_MASK
#define REP_MASK 0
#endif
#define REPS(k) (((REP_MASK >> (k)) & 1) ? 2 : 1)
#ifndef P2A_REP
#define P2A_REP 0
#endif
#ifndef P2A_MASK
#define P2A_MASK 15
#endif
#ifndef PH_MASK
#define PH_MASK 0x3ff
#endif
#define IN(k) (((PH_MASK >> (k)) & 1) && lo <= (k) && (k) < hi)
#ifdef TS_PHASE
#ifndef TS_Q
#define TS_Q 8u
#endif
#ifndef TS_BLOCK
#define TS_BLOCK 0
#endif
#ifndef TS_OFF
#define TS_OFF 0u
#endif
    unsigned long long ts_prev = __builtin_amdgcn_s_memrealtime(); float ts_val = 0.f;
#define TS_MARK(k) do { const unsigned long long t_ = __builtin_amdgcn_s_memrealtime(); if ((k) == TS_PHASE) ts_val = (float)((((unsigned)(t_ - ts_prev) + TS_OFF * 100u) / (TS_Q * 100u)) * TS_Q); ts_prev = t_; } while (0)
#else
#define TS_MARK(k) do { } while (0)
#endif
#define SEAM(k) do { if (IN(k) && IN((k) + 1)) xcd_barrier(bar); TS_MARK(k); } while (0)
    const int gw = F.vcu * NWAVES + F.wave, NGW = F.G * NWAVES;

    if (IN(0)) for (int rep_ = 0; rep_ < REPS(0); ++rep_) { p0_prologue(F, A); }
    SEAM(0);
    if (IN(1)) for (int rep_ = 0; rep_ < REPS(1); ++rep_) {
        const int geff = (F.G == 256) ? G1_WGS : F.G;
        if ((int)blockIdx.x < geff) { pg8::Gemm g{P_H, P_W1t, MPAD, N1P, DM}; pg8::StaticOrder S; S.init(MPAD, N1P, geff, (int)blockIdx.x);
            pg8::EpiStoreBf16 E{P_Z, N1P, ZGLU / 256, ZGLU / 256 + 8, ZGLU};
            pg8::gemm_phase<pg8::EpiStoreBf16, pg8::StaticOrder, G1_ALIGN, G1_SP2>(F.lds + RING_OFF, g, S, E); }
        if (geff == F.G) convert_w3(F, A, (int)blockIdx.x, F.G); else if ((int)blockIdx.x >= geff) convert_w3(F, A, (int)blockIdx.x - geff, F.G - geff);
    }
    SEAM(1);
    if (IN(2)) {
        const int bx = (int)blockIdx.x;
        if (bx < NB * NH * 8) {
            const int item = (bx & 7) * (NB * NH) + (bx >> 3), bh = item >> 3, grp = item & 7;
#pragma unroll 1
            for (int k = 0; k < NCH / 8; ++k) gla_prep_unit(F, A, bh, grp * (NCH / 8) + k);
            VM_WAIT(); __syncthreads();
            wg_publish(F.ctl + CW_PREP + 64 * bh, nullptr, F.tid); wg_wait_ge(F.ctl + CW_PREP + 64 * bh, 8u, F.tid);
            TS_MARK(21);
            gla_seq_wg(F, A, item);
            TS_MARK(22);
            VM_WAIT(); __syncthreads();
            wg_publish(F.ctl + CW_SEQ + 64 * bh, nullptr, F.tid); wg_wait_ge(F.ctl + CW_SEQ + 64 * bh, 8u, F.tid);
            { const int b = bh >> 2, h = bh & 3, row0 = b * SEQ + grp * (SEQ / 8);
#pragma unroll 1
              for (int t = F.wave; t < SEQ / 8; t += 8 * NWAVES) gla_onorm_rows<8>(F, A, row0 + t, NWAVES, h); }
        } else {
            const int r0 = bx - NB * NH * 8, nr = F.G - NB * NH * 8;
            TS_MARK(23);
            for (int r = r0; r < NB * (SEQ / 16); r += nr) conv_prompt_unit(F, A, r / (SEQ / 16), r % (SEQ / 16));
            TS_MARK(24);
            for (int r = r0 * NWAVES + F.wave; r < NB * 30; r += nr * NWAVES) conv_state_prompt_row(F, A, r / 30, r % 30);
            for (int r = r0; r < MS; r += nr) conv_sample_unit(F, A, r);
            TS_MARK(25);
            gla_sample_items(F, A, r0, nr, MS * NH);
        }
    }
    TS_MARK(20);
    SEAM(2);
    if (IN(5)) {
        pg8::Gemm g{P_MIX, P_W2t, MPAD, DM, DM}; pg8::TailSplitOrder S; S.init_ts(MP, DM, DM, F.G, (int)blockIdx.x, NKP2, true); S.piece_cnt = (unsigned*)(F.ctl + CW_SP2);
        pg8::RowStats st{(float*)(A.ws + WS_XB2), (unsigned*)(F.ctl + CW_RB2), RMS_EPS};
        const int bx = (int)blockIdx.x, rk = (bx >> 3) * 4 + (bx & 3);
        pg8::SampleJob job{((bx & 7) >= 4 && rk < MS) ? rk : -1, P_xs, (const float*)(A.ws + WS_SK2), P_norm_ffn, P_out + (size_t)MP * DM, P_H + (size_t)MP * DM, nullptr, (const unsigned*)(F.ctl + CW_SP2), 8u * (unsigned)S.npieces};
        pg8::EpiResNormBf16 E{P_xp, P_out, P_H, P_norm_ffn, DM, (float*)(A.ws + WS_SK2), st, job};
        pg8::gemm_phase<pg8::EpiResNormBf16, pg8::TailSplitOrder, false, true>(F.lds + RING_OFF, g, S, E);
        TS_MARK(51);
        TS_MARK(52);
    }
    SEAM(5);
    if (IN(7)) for (int rep_ = 0; rep_ < REPS(7); ++rep_) {
        const int geff = (F.G == 256) ? G3_WGS : F.G;
        if ((int)blockIdx.x < geff) { pg8::Gemm g{P_H, P_W3t, MPAD, 2 * DFF, DM}; pg8::StaticOrder S; S.init(MPAD, 2 * DFF, geff, (int)blockIdx.x);
            pg8::EpiSwiglu E{P_HID, DFF};
            pg8::gemm_phase<pg8::EpiSwiglu, pg8::StaticOrder, G3_ALIGN, G3_SP2>(F.lds + RING_OFF, g, S, E); }
        if (geff == F.G) convert_w4(F, A, (int)blockIdx.x, F.G); else if ((int)blockIdx.x >= geff) convert_w4(F, A, (int)blockIdx.x - geff, F.G - geff);
    }
    SEAM(7);
    if (IN(8)) {
        pg8::Gemm g{P_HID, P_W4t, MPAD, DM, DFF}; pg8::TailSplitOrder S; S.init_ts(MP, DM, DFF, F.G, (int)blockIdx.x, NKP4, true); S.piece_cnt = (unsigned*)(F.ctl + CW_SP4);
        pg8::RowStats st{(float*)(A.ws + WS_XB4), (unsigned*)(F.ctl + CW_RB4), RMS_EPS};
        const int bx = (int)blockIdx.x, rk = (bx >> 3) * 4 + (bx & 3);
        pg8::SampleJob job{((bx & 7) >= 4 && rk < MS) ? rk : -1, P_out + (size_t)MP * DM, (const float*)(A.ws + WS_SK4), P_norm_final, nullptr, nullptr, P_out + (size_t)MP * DM, (const unsigned*)(F.ctl + CW_SP4), 8u * (unsigned)S.npieces};
        pg8::EpiResNormF32 E{P_out, P_norm_final, DM, (float*)(A.ws + WS_SK4), st, job};
        pg8::gemm_phase<pg8::EpiResNormF32, pg8::TailSplitOrder, false, true>(F.lds + RING_OFF, g, S, E);
        TS_MARK(81);
    }
#ifdef TS_PHASE
    TS_MARK(8);
    if (blockIdx.x == TS_BLOCK && F.tid == 0) atomicAdd(P_out + O_END - 1, ts_val);
#endif
#undef IN
#undef SEAM
}

extern "C" void kernel_launch(void* const* d_in, const int* in_sizes, int n_in, void* d_out, int out_size, void* d_ws, size_t ws_size, hipStream_t stream) {
    static int grid = 0;
    if (grid == 0) {
        if (n_in != 18 || in_sizes[0] != MP * DM || (size_t)out_size != O_END || ws_size < WS_END) {
            fprintf(stderr, "kernel_launch: shape mismatch: n_in %d in0 %d out %d ws %zu (need %zu); nothing launched\n", n_in, n_in > 0 ? in_sizes[0] : -1, out_size, ws_size, (size_t)WS_END); grid = -1; return; }
        int dev = 0, cus = 0, per_cu = 0;
        if (hipGetDevice(&dev) != hipSuccess || hipDeviceGetAttribute(&cus, hipDeviceAttributeMultiprocessorCount, dev) != hipSuccess) { grid = -1; return; }
        if (hipFuncSetAttribute((const void*)hymba_fwd, hipFuncAttributeMaxDynamicSharedMemorySize, LDS_BYTES) != hipSuccess) { fprintf(stderr, "kernel_launch: hipFuncSetAttribute failed\n"); grid = -1; return; }
        if (hipOccupancyMaxActiveBlocksPerMultiprocessor(&per_cu, (const void*)hymba_fwd, NWAVES * 64, LDS_BYTES) != hipSuccess || per_cu < 1)
            fprintf(stderr, "kernel_launch: note: occupancy query reports %d workgroups per CU\n", per_cu);
        (void)hipGetLastError();
        if (cus != 256) { fprintf(stderr, "kernel_launch: built for a 256-CU device (tile schedules and in-launch hand-offs assume 256 resident workgroups), found %d CUs; nothing launched\n", cus); grid = -1; return; }
        grid = cus;
    }
    if (grid < 0) return;
    if (hipMemsetAsync((char*)d_ws + WS_CTL, 0, CTL_ZERO_BYTES, stream) != hipSuccess) return;
    Args a{};
    for (int i = 0; i < 18; ++i) a.in[i] = (const float*)d_in[i];
    a.out = (float*)d_out; a.ws = (unsigned char*)d_ws;
    for (int li = 0; li < N_LAUNCHES; ++li) {
        a.ph_lo = (N_LAUNCHES == 1) ? 0 : li; a.ph_hi = (N_LAUNCHES == 1) ? N_PHASES : li + 1;
        hipLaunchKernelGGL(hymba_fwd, dim3(grid), dim3(NWAVES * 64), LDS_BYTES, stream, a);
        const hipError_t le = hipPeekAtLastError();
        if (le != hipSuccess) { fprintf(stderr, "kernel_launch: launch %d failed: %s\n", li, hipGetErrorName(le)); break; }
#ifdef EXTRA_PHASE
        if (N_LAUNCHES != 1 && li == EXTRA_PHASE) { Args a2 = a; a2.pad = 1; hipLaunchKernelGGL(hymba_fwd, dim3(grid), dim3(NWAVES * 64), LDS_BYTES, stream, a2); }
#endif
    }
}
```

```cpp
#include <hip/hip_runtime.h>
#include <cstdio>
#include <cstdint>
constexpr int PG8_DUMMY = 0;
#ifndef WGM_V
#define WGM_V 8
#endif
namespace pg8 {
#define PG8_LAS __attribute__((address_space(3)))
typedef unsigned short bf16_t;
typedef short bf16x8 __attribute__((ext_vector_type(8)));
typedef float f32x4 __attribute__((ext_vector_type(4)));
typedef unsigned u32x4 __attribute__((ext_vector_type(4)));
constexpr int BM = 256, BK = 64, HALF = 128, HTB = HALF * BK * 2  , STAGE_BYTES = 8 * HTB, NXCD = 8, WGM = WGM_V;

__host__ __device__ __forceinline__ int lds_byte(int r, int c) { const int st = (r >> 4) * 2 + (c >> 5), rr = r & 15, cc = c & 31, ob = rr * 64 + cc * 2; return st * 1024 + (ob ^ (((ob >> 9) & 1) << 5)); }
__host__ __device__ __forceinline__ void stage_rc(int b, int& R, int& C) { const int st = b / 1024, sb = b % 1024, swz = sb ^ (((sb >> 9) & 1) << 5); R = (st >> 1) * 16 + swz / 64; C = (st & 1) * 32 + (swz % 64) / 2; }
__host__ __device__ __forceinline__ int perm32(int rho) { const int n = rho >> 4, i = rho & 15; return 8 * (i >> 2) + 4 * n + (i & 3); }

struct Unit { int pm, pn, k0, nk, mode, slot; };
struct Gemm { const bf16_t* A; const bf16_t* Bt; int M, N, K; };

struct StaticOrder {
    static constexpr bool SK = false;
    int nM, nN, nwg, G, c;
    __host__ __device__ __forceinline__ void init(int M, int N, int G_, int c_) { nM = M / BM; nN = N / BM; nwg = nM * nN; G = G_; c = c_; }
    __host__ __device__ __forceinline__ bool next(int i, Unit& u) const {
        const long L = (long)i * G + c; const bool ok = L < nwg;
        int wgid = ok ? (int)L : 0; { const int q = nwg / NXCD, r = nwg % NXCD, xcd = wgid % NXCD, off = wgid / NXCD; wgid = (xcd < r ? xcd * (q + 1) : r * (q + 1) + (xcd - r) * q) + off; }
        const int nig = WGM * nN, gid = wgid / nig, fm = gid * WGM, gsz = (nM - fm) < WGM ? (nM - fm) : WGM;
        u.pm = fm + ((wgid % nig) % gsz); u.pn = (wgid % nig) / gsz; return ok;
    }
    __device__ __forceinline__ void a_ready(const Unit&) const {}
    __device__ __forceinline__ void done(const Unit&) const {}
};
__device__ __forceinline__ unsigned cvt_pk_bf16(float lo, float hi) { unsigned r; asm volatile("v_cvt_pk_bf16_f32 %0, %1, %2" : "=v"(r) : "v"(lo), "v"(hi)); return r; }
typedef float f32x2 __attribute__((ext_vector_type(2)));
#ifndef NKP2_V
#define NKP2_V 4
#endif
#ifndef NKP4_V
#define NKP4_V 8
#endif
constexpr int NS_P3 = (2048 / 64) / NKP2_V, NS_P5 = (5632 / 64) / NKP4_V;
#ifndef HID_NT
#define HID_NT 0
#endif
typedef unsigned u32x2v __attribute__((ext_vector_type(2)));
__device__ __forceinline__ float silu_f(float x) { return x * __builtin_amdgcn_rcpf(1.0f + __expf(-x)); }
struct EpiStoreBf16 {
    static constexpr bool PERM = true, AFTER_DRAIN = false, HAS_INIT = false;
    bf16_t* O; int ldc; int glu_lo, glu_hi, glu_col;
    __device__ __forceinline__ void operator()(const f32x4 (&acc)[2][2][4][2], const Unit& u, int wr, int wc, int fr, int fq) const {
        const int row0 = u.pm * BM + wr * 64 + fr;
        if (u.pn >= glu_lo && u.pn < glu_hi) {
            const int col0 = glu_col + (u.pn - glu_lo) * HALF + wc * 32 + 8 * fq;
#pragma unroll
            for (int ai = 0; ai < 2; ++ai)
#pragma unroll
                for (int m = 0; m < 4; ++m) { bf16_t* rowp = O + (size_t)(row0 + ai * HALF + m * 16) * ldc + col0;
                    float h[8];
#pragma unroll
                    for (int n = 0; n < 2; ++n)
#pragma unroll
                        for (int e = 0; e < 4; ++e) h[4 * n + e] = acc[ai][0][m][n][e] * __builtin_amdgcn_rcpf(1.0f + __expf(-acc[ai][1][m][n][e]));
                    u32x4 w; w.x = cvt_pk_bf16(h[0], h[1]); w.y = cvt_pk_bf16(h[2], h[3]); w.z = cvt_pk_bf16(h[4], h[5]); w.w = cvt_pk_bf16(h[6], h[7]);
                    *(u32x4*)rowp = w; }
        } else {
            const int col0 = u.pn * BM + wc * 32 + 8 * fq;
#pragma unroll
            for (int ai = 0; ai < 2; ++ai)
#pragma unroll
                for (int m = 0; m < 4; ++m) { bf16_t* rowp = O + (size_t)(row0 + ai * HALF + m * 16) * ldc + col0;
#pragma unroll
                    for (int bj = 0; bj < 2; ++bj) { const f32x4 v0 = acc[ai][bj][m][0], v1 = acc[ai][bj][m][1];
                        u32x4 w; w.x = cvt_pk_bf16(v0[0], v0[1]); w.y = cvt_pk_bf16(v0[2], v0[3]); w.z = cvt_pk_bf16(v1[0], v1[1]); w.w = cvt_pk_bf16(v1[2], v1[3]);
                        *(u32x4*)(rowp + bj * HALF) = w; } }
        }
    }
};
struct EpiSwiglu {
    static constexpr bool PERM = true, AFTER_DRAIN = false, HAS_INIT = false;
    bf16_t* O; int ldc;
    __device__ __forceinline__ void operator()(const f32x4 (&acc)[2][2][4][2], const Unit& u, int wr, int wc, int fr, int fq) const {
        const int row0 = u.pm * BM + wr * 64 + fr, col0 = u.pn * HALF + wc * 32 + 8 * fq;
#pragma unroll
        for (int ai = 0; ai < 2; ++ai)
#pragma unroll
            for (int m = 0; m < 4; ++m) { bf16_t* rowp = O + (size_t)(row0 + ai * HALF + m * 16) * ldc + col0;
                float h[8];
#pragma unroll
                for (int n = 0; n < 2; ++n)
#pragma unroll
                    for (int e = 0; e < 4; ++e) h[4 * n + e] = silu_f(acc[ai][0][m][n][e]) * acc[ai][1][m][n][e];
                u32x4 w; w.x = cvt_pk_bf16(h[0], h[1]); w.y = cvt_pk_bf16(h[2], h[3]); w.z = cvt_pk_bf16(h[4], h[5]); w.w = cvt_pk_bf16(h[6], h[7]);
#if HID_NT
                __builtin_nontemporal_store(w, (u32x4*)rowp); }
#else
                *(u32x4*)rowp = w; }
#endif
    }
};
struct EpiResF32 {
    static constexpr bool PERM = false, AFTER_DRAIN = false, HAS_INIT = false;
    const float* base0; const float* base1; float* out; int ldc, msplit, mreal; float* part; float sc;
    __device__ __forceinline__ void operator()(const f32x4 (&acc)[2][2][4][2], const Unit& u, int wr, int wc, int fr, int fq) const {
        const int row0 = u.pm * BM + wr * 64 + fr, col0 = u.pn * BM + wc * 32 + 4 * fq;
#pragma unroll
        for (int ai = 0; ai < 2; ++ai)
#pragma unroll
            for (int m = 0; m < 4; ++m) { const int row = row0 + ai * HALF + m * 16;
                if (row < mreal) {
                    const float* bp = (row < msplit ? base0 + (size_t)row * ldc : base1 + (size_t)(row - msplit) * ldc) + col0; float* op = out + (size_t)row * ldc + col0;
                    f32x4 b[2][2];
#pragma unroll
                    for (int bj = 0; bj < 2; ++bj)
#pragma unroll
                        for (int n = 0; n < 2; ++n) b[bj][n] = *(const f32x4*)(bp + bj * HALF + n * 16);
#pragma unroll
                    for (int bj = 0; bj < 2; ++bj)
#pragma unroll
                        for (int n = 0; n < 2; ++n) *(f32x4*)(op + bj * HALF + n * 16) = b[bj][n] + acc[ai][bj][m][n] * sc;
                } }
    }
    __device__ __forceinline__ void partial(const f32x4 (&acc)[2][2][4][2], const Unit& u, int wr, int wc, int fr, int fq) const {
        float* pp = part + ((size_t)u.slot * HALF + wr * 64 + fr) * ldc + u.pn * BM + wc * 32 + 4 * fq;
#pragma unroll
        for (int m = 0; m < 4; ++m)
#pragma unroll
            for (int bj = 0; bj < 2; ++bj)
#pragma unroll
                for (int n = 0; n < 2; ++n) asm volatile("global_store_dwordx4 %0, %1, off sc1\n\ts_nop 1" :: "v"(pp + (size_t)(m * 16) * ldc + bj * HALF + n * 16), "v"(acc[0][bj][m][n]) : "memory");
    }
};
struct TailSplitOrder : StaticOrder {
    static constexpr bool SK = true;
    int nkp, npieces, ntfull; bool pieces_first; unsigned* piece_cnt;
    __device__ __forceinline__ void init_ts(int Mfull, int N, int K, int G_, int c_, int nkp_, bool pf = false) { init(Mfull, N, G_, c_); ntfull = K / BK; nkp = nkp_; npieces = nN * (ntfull / nkp_); pieces_first = pf; piece_cnt = nullptr; }
    __device__ __forceinline__ void done(const Unit& u) const {
        if (u.mode == 3 && piece_cnt) { asm volatile("s_waitcnt vmcnt(0)" ::: "memory"); if ((threadIdx.x & 63) == 0) __hip_atomic_fetch_add(piece_cnt, 1u, __ATOMIC_RELAXED, __HIP_MEMORY_SCOPE_AGENT); } }
    __device__ __forceinline__ bool next(int i, Unit& u) const {
        const int rankA = (c >> 3) * 4 + (c & 7); const bool mine = pieces_first && (c & 7) < 4 && rankA < npieces;
        const int is = pieces_first ? (mine ? i - 1 : i) : i;
        Unit t; t.pm = 0; t.pn = 0;
        const bool full = (is >= 0) && StaticOrder::next(is, t);
        const long p = pieces_first ? (long)rankA : (long)i * G + c - nwg; const bool piece = !full && (pieces_first ? (mine && i == 0) : (p >= 0 && p < npieces));
        const int pp = piece ? (int)p : 0, ks = pp / nN;
        u.pm = full ? t.pm : nM; u.pn = full ? t.pn : pp - ks * nN; u.slot = full ? 0 : ks; u.k0 = full ? 0 : ks * nkp; u.nk = full ? ntfull : nkp; u.mode = full ? 0 : 3;
        return full || piece;
    }
};
struct SampleJob { int row; const float* base; const float* part; const float* gain; float* xout; bf16_t* obf; float* of32; const unsigned* piece_cnt; unsigned want; };
template <int NS> __device__ __forceinline__ void sample_row_job(const SampleJob& j, PG8_LAS unsigned char* lds, int wid, int lane, float eps) {
    PG8_LAS float* red = (PG8_LAS float*)(lds + 8192);
    if (wid == 0) { unsigned polls = 0;
        while ((unsigned)__builtin_amdgcn_readfirstlane(__hip_atomic_load(j.piece_cnt, __ATOMIC_RELAXED, __HIP_MEMORY_SCOPE_AGENT)) < j.want) { __builtin_amdgcn_s_sleep(2); if (++polls > (1u << 22)) break; }
        __builtin_amdgcn_fence(__ATOMIC_ACQUIRE, "agent"); }
    asm volatile("s_waitcnt vmcnt(0) lgkmcnt(0)" ::: "memory"); __builtin_amdgcn_s_barrier(); asm volatile("" ::: "memory");
    const int col = 256 * wid + 4 * lane; const size_t ro = (size_t)j.row * 2048;
    f32x4 v = *(const f32x4*)(j.base + ro + col);
    f32x4 t[NS];
#pragma unroll
    for (int k = 0; k < NS; ++k) t[k] = *(const f32x4*)(j.part + (size_t)k * 128 * 2048 + ro + col);
#pragma unroll
    for (int k = 0; k < NS; ++k) v += t[k];
    if (j.xout) *(f32x4*)(j.xout + ro + col) = v;
    float s = (v[0] * v[0] + v[1] * v[1]) + (v[2] * v[2] + v[3] * v[3]);
#pragma unroll
    for (int o = 1; o < 64; o <<= 1) s += __shfl_xor(s, o);
    if (lane == 0) red[wid] = s;
    asm volatile("s_waitcnt lgkmcnt(0)" ::: "memory"); __builtin_amdgcn_s_barrier(); asm volatile("" ::: "memory");
    float tot = 0.f;
#pragma unroll
    for (int w = 0; w < 8; ++w) tot += red[w];
    const float rstd = 1.0f / sqrtf(tot * (1.0f / 2048.0f) + eps);
    const f32x4 g = *(const f32x4*)(j.gain + col); const f32x4 r = v * rstd * g;
    if (j.obf) { u32x2v o; o.x = cvt_pk_bf16(r[0], r[1]); o.y = cvt_pk_bf16(r[2], r[3]); *(u32x2v*)(j.obf + ro + col) = o; }
    if (j.of32) *(f32x4*)(j.of32 + ro + col) = r;
    asm volatile("s_waitcnt lgkmcnt(0)" ::: "memory"); __builtin_amdgcn_s_barrier(); asm volatile("" ::: "memory");
}
__device__ __forceinline__ f32x4 xchg1(f32x4 v) { f32x4 r; r[0] = __shfl_xor(v[0], 1); r[1] = __shfl_xor(v[1], 1); r[2] = __shfl_xor(v[2], 1); r[3] = __shfl_xor(v[3], 1); return r; }
template <bool NT> __device__ __forceinline__ void store_pair_rows(float* p, size_t rstride, bool odd, f32x4 v0, f32x4 v1) {
    const f32x4 r = xchg1(odd ? v0 : v1);
    const f32x4 a = odd ? r : v0, bq = odd ? v1 : r;
    if (NT) { __builtin_nontemporal_store(a, (f32x4*)p); __builtin_nontemporal_store(bq, (f32x4*)(p + rstride)); }
    else { *(f32x4*)p = a; *(f32x4*)(p + rstride) = bq; }
}
template <bool NT> __device__ __forceinline__ void load_pair_rows(const float* p, size_t rstride, bool odd, f32x4& v0, f32x4& v1) {
    f32x4 a, bq;
    if (NT) { a = __builtin_nontemporal_load((const f32x4*)p); bq = __builtin_nontemporal_load((const f32x4*)(p + rstride)); }
    else { a = *(const f32x4*)p; bq = *(const f32x4*)(p + rstride); }
    const f32x4 r = xchg1(odd ? a : bq);
    v0 = odd ? r : a; v1 = odd ? bq : r;
}
struct RowStats {
    float* xbuf; unsigned* cnt; float eps;
    __device__ __forceinline__ void run(const f32x4 (&v)[2][2][4][2], const Unit& u, int wr, int wc, int fr, int fq, PG8_LAS unsigned char* lds, int wid, int lane) const {
        PG8_LAS float* P = (PG8_LAS float*)lds;
        PG8_LAS float* S = (PG8_LAS float*)(lds + 4096);
#pragma unroll
        for (int ai = 0; ai < 2; ++ai)
#pragma unroll
            for (int m = 0; m < 4; ++m) { float s = 0.f;
#pragma unroll
                for (int bj = 0; bj < 2; ++bj)
#pragma unroll
                    for (int n = 0; n < 2; ++n) { const f32x4 x = v[ai][bj][m][n]; s += (x[0] * x[0] + x[1] * x[1]) + (x[2] * x[2] + x[3] * x[3]); }
                s += __shfl_xor(s, 16); s += __shfl_xor(s, 32);
                if (fq == 0) P[(ai * HALF + wr * 64 + m * 16 + fr) * 4 + wc] = s; }
        asm volatile("s_waitcnt lgkmcnt(0)" ::: "memory"); __builtin_amdgcn_s_barrier(); asm volatile("" ::: "memory");
        const int row = wid * 32 + (lane & 31);
        if (lane < 32) { const float t = (P[row * 4 + 0] + P[row * 4 + 1]) + (P[row * 4 + 2] + P[row * 4 + 3]);
            __hip_atomic_store(xbuf + ((size_t)(u.pm * BM + row) * 8 + u.pn), t, __ATOMIC_RELAXED, __HIP_MEMORY_SCOPE_AGENT); }
        asm volatile("s_waitcnt vmcnt(0)" ::: "memory");
        if (lane == 0) __hip_atomic_fetch_add(cnt + 64 * u.pm, 1u, __ATOMIC_RELAXED, __HIP_MEMORY_SCOPE_AGENT);
        if (wid == 0) { unsigned polls = 0;
            while ((unsigned)__builtin_amdgcn_readfirstlane(__hip_atomic_load(cnt + 64 * u.pm, __ATOMIC_RELAXED, __HIP_MEMORY_SCOPE_AGENT)) < 64u) { __builtin_amdgcn_s_sleep(2); if (++polls > (1u << 22)) break; }
            __builtin_amdgcn_fence(__ATOMIC_ACQUIRE, "agent"); }
        asm volatile("s_waitcnt vmcnt(0) lgkmcnt(0)" ::: "memory"); __builtin_amdgcn_s_barrier(); asm volatile("" ::: "memory");
        if (lane < 32) { const float* sl = xbuf + (size_t)(u.pm * BM + row) * 8; float tot = 0.f;
#pragma unroll
            for (int t = 0; t < 8; ++t) tot += __hip_atomic_load(sl + t, __ATOMIC_RELAXED, __HIP_MEMORY_SCOPE_AGENT);
            S[row] = 1.0f / sqrtf(tot * (1.0f / 2048.0f) + eps); }
        asm volatile("s_waitcnt vmcnt(0) lgkmcnt(0)" ::: "memory"); __builtin_amdgcn_s_barrier(); asm volatile("" ::: "memory");
    }
};
struct EpiResNormBf16 {
    static constexpr bool PERM = false, AFTER_DRAIN = true, HAS_INIT = true;
    const float* base; float* out; bf16_t* xn; const float* gain; int ldc; float* part; RowStats st; SampleJob job;
    __device__ __forceinline__ void init(f32x4 (&acc)[2][2][4][2], const Unit& u, int wr, int wc, int fr, int fq) const {
        const bool piece = (u.mode == 3), odd = (fr & 1) != 0; const int col0 = u.pn * BM + wc * 32 + 4 * fq + (odd ? 16 : 0);
#pragma unroll
        for (int ai = 0; ai < 2; ++ai)
#pragma unroll
            for (int m = 0; m < 4; ++m) { const size_t off = (size_t)(u.pm * BM + ai * HALF + wr * 64 + m * 16 + (fr & ~1)) * ldc + col0;
#pragma unroll
                for (int bj = 0; bj < 2; ++bj) { f32x4 v0 = (f32x4){0.f, 0.f, 0.f, 0.f}, v1 = v0; if (!piece) load_pair_rows<true>(base + off + bj * HALF, (size_t)ldc, odd, v0, v1); acc[ai][bj][m][0] = v0; acc[ai][bj][m][1] = v1; } }
    }
    __device__ __forceinline__ void partial(const f32x4 (&acc)[2][2][4][2], const Unit& u, int wr, int wc, int fr, int fq) const {
        float* pp = part + ((size_t)u.slot * HALF + wr * 64 + fr) * ldc + u.pn * BM + wc * 32 + 4 * fq;
#pragma unroll
        for (int m = 0; m < 4; ++m)
#pragma unroll
            for (int bj = 0; bj < 2; ++bj)
#pragma unroll
                for (int n = 0; n < 2; ++n) asm volatile("global_store_dwordx4 %0, %1, off sc1\n\ts_nop 1" :: "v"(pp + (size_t)(m * 16) * ldc + bj * HALF + n * 16), "v"(acc[0][bj][m][n]) : "memory");
    }
    __device__ __forceinline__ void fused(f32x4 (&acc)[2][2][4][2], const Unit& u, int wr, int wc, int fr, int fq, PG8_LAS unsigned char* lds, int wid, int lane) const {
        const PG8_LAS float* S = (const PG8_LAS float*)(lds + 4096);
        if (job.row >= 0) sample_row_job<NS_P3>(job, lds, wid, lane, st.eps);
        const int col0 = u.pn * BM + wc * 32 + 4 * fq;
        { const bool odd = (fr & 1) != 0;
#pragma unroll
          for (int ai = 0; ai < 2; ++ai)
#pragma unroll
            for (int m = 0; m < 4; ++m) { float* p = out + (size_t)(u.pm * BM + ai * HALF + wr * 64 + m * 16 + (fr & ~1)) * ldc + col0 + (odd ? 16 : 0);
#pragma unroll
                for (int bj = 0; bj < 2; ++bj) store_pair_rows<false>(p + bj * HALF, (size_t)ldc, odd, acc[ai][bj][m][0], acc[ai][bj][m][1]); } }
        st.run(acc, u, wr, wc, fr, fq, lds, wid, lane);
        f32x4 gv[2][2];
#pragma unroll
        for (int bj = 0; bj < 2; ++bj)
#pragma unroll
            for (int n = 0; n < 2; ++n) gv[bj][n] = *(const f32x4*)(gain + col0 + bj * HALF + n * 16);
#pragma unroll
        for (int ai = 0; ai < 2; ++ai)
#pragma unroll
            for (int m = 0; m < 4; ++m) { const int r = ai * HALF + wr * 64 + m * 16 + fr; const float rs = S[r]; const size_t off = (size_t)(u.pm * BM + r) * ldc + col0;
#pragma unroll
                for (int bj = 0; bj < 2; ++bj) {
                    const f32x4 o0 = acc[ai][bj][m][0] * rs * gv[bj][0], o1 = acc[ai][bj][m][1] * rs * gv[bj][1];
                    u32x2v w0, w1; w0.x = cvt_pk_bf16(o0[0], o0[1]); w0.y = cvt_pk_bf16(o0[2], o0[3]); w1.x = cvt_pk_bf16(o1[0], o1[1]); w1.y = cvt_pk_bf16(o1[2], o1[3]);
                    const bool ev = (fq & 1) == 0; const unsigned sx = ev ? w1.x : w0.x, sy = ev ? w1.y : w0.y;
                    const unsigned rx = (unsigned)__shfl_xor((int)sx, 16), ry = (unsigned)__shfl_xor((int)sy, 16);
                    const u32x4 w = ev ? (u32x4){w0.x, w0.y, rx, ry} : (u32x4){rx, ry, w1.x, w1.y};
                    *(u32x4*)(xn + off + bj * HALF + (ev ? 0 : 16 - 4)) = w; } }
    }
};
struct EpiResNormF32 {
    static constexpr bool PERM = false, AFTER_DRAIN = true, HAS_INIT = true;
    float* out; const float* gain; int ldc; float* part; RowStats st; SampleJob job;
    __device__ __forceinline__ void init(f32x4 (&acc)[2][2][4][2], const Unit& u, int wr, int wc, int fr, int fq) const {
        const bool piece = (u.mode == 3), odd = (fr & 1) != 0; const int col0 = u.pn * BM + wc * 32 + 4 * fq + (odd ? 16 : 0);
#pragma unroll
        for (int ai = 0; ai < 2; ++ai)
#pragma unroll
            for (int m = 0; m < 4; ++m) { const size_t off = (size_t)(u.pm * BM + ai * HALF + wr * 64 + m * 16 + (fr & ~1)) * ldc + col0;
#pragma unroll
                for (int bj = 0; bj < 2; ++bj) { f32x4 v0 = (f32x4){0.f, 0.f, 0.f, 0.f}, v1 = v0; if (!piece) load_pair_rows<false>(out + off + bj * HALF, (size_t)ldc, odd, v0, v1); acc[ai][bj][m][0] = v0; acc[ai][bj][m][1] = v1; } }
    }
    __device__ __forceinline__ void partial(const f32x4 (&acc)[2][2][4][2], const Unit& u, int wr, int wc, int fr, int fq) const {
        float* pp = part + ((size_t)u.slot * HALF + wr * 64 + fr) * ldc + u.pn * BM + wc * 32 + 4 * fq;
#pragma unroll
        for (int m = 0; m < 4; ++m)
#pragma unroll
            for (int bj = 0; bj < 2; ++bj)
#pragma unroll
                for (int n = 0; n < 2; ++n) asm volatile("global_store_dwordx4 %0, %1, off sc1\n\ts_nop 1" :: "v"(pp + (size_t)(m * 16) * ldc + bj * HALF + n * 16), "v"(acc[0][bj][m][n]) : "memory");
    }
    __device__ __forceinline__ void fused(f32x4 (&acc)[2][2][4][2], const Unit& u, int wr, int wc, int fr, int fq, PG8_LAS unsigned char* lds, int wid, int lane) const {
        const PG8_LAS float* S = (const PG8_LAS float*)(lds + 4096);
        if (job.row >= 0) sample_row_job<NS_P5>(job, lds, wid, lane, st.eps);
        const int col0 = u.pn * BM + wc * 32 + 4 * fq;
        st.run(acc, u, wr, wc, fr, fq, lds, wid, lane);
        f32x4 gv[2][2];
#pragma unroll
        for (int bj = 0; bj < 2; ++bj)
#pragma unroll
            for (int n = 0; n < 2; ++n) gv[bj][n] = *(const f32x4*)(gain + col0 + bj * HALF + n * 16);
        { const bool odd = (fr & 1) != 0;
#pragma unroll
          for (int ai = 0; ai < 2; ++ai)
#pragma unroll
            for (int m = 0; m < 4; ++m) { const int r = ai * HALF + wr * 64 + m * 16 + fr; const float rs = S[r]; float* p = out + (size_t)(u.pm * BM + (r & ~1)) * ldc + col0 + (odd ? 16 : 0);
#pragma unroll
                for (int bj = 0; bj < 2; ++bj) store_pair_rows<true>(p + bj * HALF, (size_t)ldc, odd, acc[ai][bj][m][0] * rs * gv[bj][0], acc[ai][bj][m][1] * rs * gv[bj][1]); } }
    }
};
#ifndef SKT_PUB
#define SKT_PUB 1
#endif
#ifndef SKT_COMB
#define SKT_COMB 1
#endif
template <class Epi, class Sched, bool ALIGN_EPI = false, bool SP2 = false>
__device__ __forceinline__ void gemm_phase(PG8_LAS unsigned char* lds, const Gemm g, const Sched& S, const Epi& E) {
    const int tid = threadIdx.x, wid = __builtin_amdgcn_readfirstlane(tid >> 6), lane = tid & 63, wr = wid >> 2, wc = wid & 3, fr = lane & 15, fq = lane >> 4;
    const int K = g.K, nt = K / BK;
    unsigned voffA[2], voffB[2];
#pragma unroll
    for (int i = 0; i < 2; ++i) { int R, C; stage_rc(tid * 16 + i * 8192, R, C); const int Rb = Epi::PERM ? ((R & ~31) + perm32(R & 31)) : R;
        voffA[i] = (unsigned)(R * K + C) * 2u; voffB[i] = (unsigned)(Rb * K + C) * 2u; }
    const size_t kstep = (size_t)(BK * 2);
    const size_t hstep = (size_t)HALF * K * 2;
    const size_t tstep = 2 * hstep;
    const unsigned ldsw = (unsigned)wid * 1024u;
    const int aoff = lds_byte(wr * 64 + fr, fq * 8), boff = lds_byte(wc * 32 + fr, fq * 8);
#define PG8_SA(b, h) (((b) * 2 + (h)) * HTB)
#define PG8_SB(b, h) ((4 + (b) * 2 + (h)) * HTB)
#define PG8_STAGE(bufoff, gbase, voff) do { _Pragma("unroll") for (int _i = 0; _i < 2; ++_i) \
        __builtin_amdgcn_global_load_lds((const unsigned*)((const char*)(gbase) + (voff)[_i]), (PG8_LAS unsigned*)(lds + (bufoff) + ldsw + _i * 8192), 16, 0, 0); } while (0)
#define PG8_LDA(dst, b, h) do { _Pragma("unroll") for (int m = 0; m < 4; ++m) _Pragma("unroll") for (int k = 0; k < 2; ++k) dst[m][k] = *(const PG8_LAS bf16x8*)(lds + PG8_SA(b, h) + aoff + m * 2048 + k * 1024); } while (0)
#define PG8_LDB(dst, b, h) do { _Pragma("unroll") for (int n = 0; n < 2; ++n) _Pragma("unroll") for (int k = 0; k < 2; ++k) dst[n][k] = *(const PG8_LAS bf16x8*)(lds + PG8_SB(b, h) + boff + n * 2048 + k * 1024); } while (0)
#define PG8_MMA(ai, bj, At, Bt) do { __builtin_amdgcn_s_setprio(1); _Pragma("unroll") for (int m = 0; m < 4; ++m) _Pragma("unroll") for (int n = 0; n < 2; ++n) _Pragma("unroll") for (int k = 0; k < 2; ++k) \
        acc[ai][bj][m][n] = __builtin_amdgcn_mfma_f32_16x16x32_bf16(Bt[n][k], At[m][k], acc[ai][bj][m][n], 0, 0, 0); __builtin_amdgcn_s_setprio(0); } while (0)
#define PG8_WAIT_V(n) asm volatile("s_waitcnt vmcnt(" #n ")" ::: "memory")
#define PG8_WAIT_L(n) asm volatile("s_waitcnt lgkmcnt(" #n ")" ::: "memory")
#define PG8_BAR __builtin_amdgcn_s_barrier()
#define PG8_SCHED __builtin_amdgcn_sched_barrier(0)
    Unit cur, nxt; int ui = 0;
    if (!S.next(0, cur)) return;
    if constexpr (!Sched::SK) { cur.k0 = 0; cur.nk = nt; cur.mode = 0; cur.slot = 0; }
    f32x4 acc[2][2][4][2];
    if constexpr (Epi::HAS_INIT) E.init(acc, cur, wr, wc, fr, fq); else {
#pragma unroll
    for (int a = 0; a < 2; ++a)
#pragma unroll
        for (int b = 0; b < 2; ++b)
#pragma unroll
            for (int m = 0; m < 4; ++m)
#pragma unroll
                for (int n = 0; n < 2; ++n) acc[a][b][m][n] = (f32x4){0.f, 0.f, 0.f, 0.f};
    }
    bf16x8 At[4][2], B0[2][2], B1[2][2];
    const char* cA = (const char*)g.A + (size_t)cur.pm * tstep + (size_t)cur.k0 * kstep; const char* cB = (const char*)g.Bt + (size_t)cur.pn * tstep + (size_t)cur.k0 * kstep;
    S.a_ready(cur);
    if constexpr (SP2) {
        PG8_STAGE(PG8_SB(0, 0), cB, voffB); PG8_STAGE(PG8_SB(0, 1), cB + hstep, voffB); PG8_STAGE(PG8_SA(0, 0), cA, voffA); PG8_STAGE(PG8_SA(0, 1), cA + hstep, voffA);
        if (wr == 1) PG8_BAR;
        PG8_WAIT_V(2); PG8_BAR;
        PG8_STAGE(PG8_SB(1, 0), cB + kstep, voffB); PG8_STAGE(PG8_SA(1, 0), cA + kstep, voffA); PG8_STAGE(PG8_SB(1, 1), cB + hstep + kstep, voffB);
        PG8_WAIT_V(6); PG8_BAR;
    } else {
        PG8_STAGE(PG8_SB(0, 0), cB, voffB); PG8_STAGE(PG8_SA(0, 0), cA, voffA); PG8_STAGE(PG8_SB(0, 1), cB + hstep, voffB); PG8_STAGE(PG8_SA(0, 1), cA + hstep, voffA);
        if (wr == 1) PG8_BAR;
        PG8_WAIT_V(4); PG8_BAR;
        PG8_STAGE(PG8_SB(1, 0), cB + kstep, voffB); PG8_STAGE(PG8_SA(1, 0), cA + kstep, voffA); PG8_STAGE(PG8_SB(1, 1), cB + hstep + kstep, voffB);
        PG8_WAIT_V(6); PG8_BAR;
    }
    for (;;) {
        const bool has_next = S.next(ui + 1, nxt);
        if constexpr (!Sched::SK) { nxt.k0 = 0; nxt.nk = nt; nxt.mode = 0; nxt.slot = 0; }
        const int ntc = cur.nk;
        const char* nA = has_next ? (const char*)g.A + (size_t)nxt.pm * tstep + (size_t)nxt.k0 * kstep : cA; const char* nB = has_next ? (const char*)g.Bt + (size_t)nxt.pn * tstep + (size_t)nxt.k0 * kstep : cB;
        for (int t = 0; t < ntc; t += 2) {
            const bool last = (t == ntc - 2);
            const char* a1 = cA + (size_t)(t + 1) * kstep;
            const char* a2 = last ? nA : cA + (size_t)(t + 2) * kstep; const char* b2 = last ? nB : cB + (size_t)(t + 2) * kstep;
            const char* a3 = a2 + kstep; const char* b3 = b2 + kstep;
            if (last && has_next) S.a_ready(nxt);
            if constexpr (SP2) {
            PG8_LDB(B0, 0, 0); PG8_LDB(B1, 0, 1); PG8_SCHED; PG8_LDA(At, 0, 0); PG8_STAGE(PG8_SA(1, 1), a1 + hstep, voffA);
            PG8_WAIT_V(8); PG8_WAIT_L(0); PG8_BAR; PG8_MMA(0, 0, At, B0); PG8_MMA(0, 1, At, B1); PG8_BAR; PG8_SCHED;
            PG8_LDA(At, 0, 1); PG8_STAGE(PG8_SB(0, 0), b2, voffB); PG8_STAGE(PG8_SB(0, 1), b2 + hstep, voffB); PG8_STAGE(PG8_SA(0, 0), a2, voffA);
            PG8_WAIT_V(8); PG8_WAIT_L(0); PG8_BAR; PG8_MMA(1, 0, At, B0); PG8_MMA(1, 1, At, B1); PG8_BAR; PG8_SCHED;
            PG8_LDB(B0, 1, 0); PG8_LDB(B1, 1, 1); PG8_SCHED; PG8_LDA(At, 1, 0); PG8_STAGE(PG8_SA(0, 1), a2 + hstep, voffA);
            PG8_WAIT_V(8); PG8_WAIT_L(0); PG8_BAR; PG8_MMA(0, 0, At, B0); PG8_MMA(0, 1, At, B1); PG8_BAR; PG8_SCHED;
            PG8_LDA(At, 1, 1); PG8_STAGE(PG8_SB(1, 0), b3, voffB); PG8_STAGE(PG8_SB(1, 1), b3 + hstep, voffB); PG8_STAGE(PG8_SA(1, 0), a3, voffA);
            PG8_WAIT_V(8); PG8_WAIT_L(0); PG8_BAR; PG8_MMA(1, 0, At, B0); PG8_MMA(1, 1, At, B1); PG8_BAR; PG8_SCHED;
            } else {
            PG8_LDB(B0, 0, 0); PG8_SCHED; PG8_LDA(At, 0, 0); PG8_STAGE(PG8_SA(1, 1), a1 + hstep, voffA);
            PG8_WAIT_L(8); PG8_BAR; PG8_WAIT_L(0); PG8_MMA(0, 0, At, B0); PG8_BAR; PG8_SCHED;
            PG8_LDB(B1, 0, 1); PG8_STAGE(PG8_SB(0, 0), b2, voffB);
            PG8_BAR; PG8_WAIT_L(0); PG8_MMA(0, 1, At, B1); PG8_BAR;
            PG8_LDA(At, 0, 1); PG8_STAGE(PG8_SA(0, 0), a2, voffA);
            PG8_BAR; PG8_WAIT_L(0); PG8_MMA(1, 0, At, B0); PG8_BAR; PG8_SCHED;
            PG8_STAGE(PG8_SB(0, 1), b2 + hstep, voffB);
            PG8_WAIT_V(6); PG8_BAR; PG8_MMA(1, 1, At, B1); PG8_BAR;
            PG8_LDB(B0, 1, 0); PG8_SCHED; PG8_LDA(At, 1, 0); PG8_STAGE(PG8_SA(0, 1), a2 + hstep, voffA);
            PG8_WAIT_L(8); PG8_BAR; PG8_WAIT_L(0); PG8_MMA(0, 0, At, B0); PG8_BAR; PG8_SCHED;
            PG8_LDB(B1, 1, 1); PG8_STAGE(PG8_SB(1, 0), b3, voffB);
            PG8_BAR; PG8_WAIT_L(0); PG8_MMA(0, 1, At, B1); PG8_BAR;
            PG8_LDA(At, 1, 1); PG8_STAGE(PG8_SA(1, 0), a3, voffA);
            PG8_BAR; PG8_WAIT_L(0); PG8_MMA(1, 0, At, B0); PG8_BAR; PG8_SCHED;
            PG8_STAGE(PG8_SB(1, 1), b3 + hstep, voffB);
            PG8_WAIT_V(6); PG8_BAR; PG8_MMA(1, 1, At, B1); PG8_BAR;
            }
        }
        if constexpr (ALIGN_EPI) { if (wr == 0) PG8_BAR; }
        if constexpr (!Epi::AFTER_DRAIN) {
            if constexpr (Sched::SK) { if (cur.mode == 3) E.partial(acc, cur, wr, wc, fr, fq); else E(acc, cur, wr, wc, fr, fq); }
            else E(acc, cur, wr, wc, fr, fq);
            S.done(cur); }
        else { if constexpr (Sched::SK) { if (has_next) { E.partial(acc, cur, wr, wc, fr, fq); S.done(cur); } } }
        if (!has_next) break;
        if constexpr (Epi::HAS_INIT) E.init(acc, nxt, wr, wc, fr, fq); else {
#pragma unroll
        for (int a = 0; a < 2; ++a)
#pragma unroll
            for (int b = 0; b < 2; ++b)
#pragma unroll
                for (int m = 0; m < 4; ++m)
#pragma unroll
                    for (int n = 0; n < 2; ++n) acc[a][b][m][n] = (f32x4){0.f, 0.f, 0.f, 0.f};
        }
        cur = nxt; cA = nA; cB = nB; ++ui;
        if constexpr (ALIGN_EPI) { if (wr == 1) PG8_BAR; }
    }
    PG8_WAIT_V(0);
    if constexpr (!ALIGN_EPI) { if (wr == 0) PG8_BAR; }
    PG8_BAR;
    if constexpr (Epi::AFTER_DRAIN) { E.fused(acc, cur, wr, wc, fr, fq, lds, wid, lane); S.done(cur); }
#undef PG8_SA
#undef PG8_SB
#undef PG8_STAGE
#undef PG8_LDA
#undef PG8_LDB
#undef PG8_MMA
#undef PG8_WAIT_V
#undef PG8_WAIT_L
#undef PG8_BAR
#undef PG8_SCHED
}
}

constexpr int NWAVES = 8;
constexpr int DM = 2048, MP = 8192, MS = 128, MR = MP + MS  , MPAD = 8448  , SEQ = 2048, NB = 4;
constexpr int NH = 4, HK = 128, HV = 256, DK = 512, DA = 1024, DC_ = 1024, GR = 16, CW = 31, DFF = 5632;
constexpr int N1 = 5136, N1P = 5376;
constexpr int ZQ = 0, ZK = 512, ZV = 1024, ZGO = 2048, ZGLU = 3072, ZGL = 5120;
constexpr int CH = 64, NCH = SEQ / CH;
constexpr float RMS_EPS = 1e-6f, LN_EPS = 1e-5f;
constexpr size_t O_YP = 0, O_YS = (size_t)MP * DM, O_GP = O_YS + (size_t)MS * DM, O_CP = O_GP + (size_t)NB * NH * HK * HV, O_GS = O_CP + (size_t)NB * 30 * DC_,
                 O_CS = O_GS + (size_t)MS * NH * HK * HV, O_END = O_CS + (size_t)MS * 30 * DC_;
constexpr size_t MiB = 1u << 20;
constexpr size_t WS_CTL = 0, CTL_ZERO_BYTES = 128 * 1024;
static_assert(true, "");
constexpr size_t WS_XB2 = 1 * MiB, WS_XB4 = 1 * MiB + 512 * 1024;
constexpr size_t WS_W1 = 2 * MiB;
constexpr size_t WS_W2 = 23 * MiB;
constexpr size_t WS_W3 = 31 * MiB;
constexpr size_t WS_W4 = 75 * MiB;
constexpr size_t WS_H = 97 * MiB;
constexpr size_t WS_QT = WS_H, WS_KH = WS_H + 8 * MiB, WS_VT = WS_H + 16 * MiB;
constexpr size_t WS_Z = 130 * MiB;
constexpr size_t WS_MIX = 217 * MiB;
constexpr size_t WS_HID = 130 * MiB;
constexpr size_t WS_END = 250 * MiB;
static_assert(WS_Z + (size_t)MPAD * N1P * 2 <= WS_MIX && WS_HID + (size_t)MPAD * DFF * 2 <= WS_END && WS_W1 + (size_t)N1P * DM * 2 <= WS_W2 && WS_W3 + (size_t)2 * DFF * DM * 2 <= WS_W4 && WS_W4 + (size_t)DM * DFF * 2 <= WS_H, "d_ws map");
constexpr size_t DO_O32 = 0, DO_AM = 32 * MiB, DO_DC = 36 * MiB;
constexpr int CW_TMO = 0, CW_BAR = 4096, CW_RB2 = 16384, CW_SP2 = CW_RB2 + 64 * 40, CW_RB4 = CW_RB2 + 64 * 64, CW_SP4 = CW_RB4 + 64 * 40, CW_PREP = CW_RB4 + 64 * 64, CW_SEQ = CW_PREP + 64 * 16;
static_assert((size_t)(CW_SEQ + 64 * 16) * 4 <= CTL_ZERO_BYTES, "control words inside the per-call memset");
constexpr size_t WS_SK2 = WS_Z, WS_SK4 = WS_W1;
static_assert((size_t)32 * 128 * DM * 4 <= WS_MIX - WS_Z && WS_SK4 + (size_t)44 * 128 * DM * 4 <= WS_W4, "K-split slabs");
constexpr int RING_OFF = 0, RING_BYTES = 131072;
constexpr int LDSCTL_OFF = RING_BYTES, MISC_OFF = LDSCTL_OFF + 320;
constexpr int LDS_BYTES = 147456;

#define GAS __attribute__((address_space(1)))
#define LAS __attribute__((address_space(3)))
typedef unsigned short bf16;
typedef unsigned v4u __attribute__((ext_vector_type(4)));
typedef unsigned v2u __attribute__((ext_vector_type(2)));
typedef float f32x4 __attribute__((ext_vector_type(4)));
typedef float f32x2 __attribute__((ext_vector_type(2)));
typedef short bf16x8 __attribute__((ext_vector_type(8)));
typedef GAS unsigned gu32;
typedef GAS unsigned long long gu64;
#define RLX_AGENT __ATOMIC_RELAXED, __HIP_MEMORY_SCOPE_AGENT
#define LDS_WAIT() asm volatile("s_waitcnt lgkmcnt(0)" ::: "memory")
#define LDS_BARRIER() do { asm volatile("s_waitcnt lgkmcnt(0)" ::: "memory"); __builtin_amdgcn_s_barrier(); asm volatile("" ::: "memory"); } while (0)
#define VM_WAIT() asm volatile("s_waitcnt vmcnt(0)" ::: "memory")
__device__ __forceinline__ void st_wt16(void* p, v4u v) { asm volatile("global_store_dwordx4 %0, %1, off sc1\n\ts_nop 1" :: "v"(p), "v"(v) : "memory"); }
__device__ __forceinline__ void st_wt16f(void* p, f32x4 v) { asm volatile("global_store_dwordx4 %0, %1, off sc1\n\ts_nop 1" :: "v"(p), "v"(v) : "memory"); }
__device__ __forceinline__ void st_wt8(void* p, v2u v) { asm volatile("global_store_dwordx2 %0, %1, off sc1\n\ts_nop 1" :: "v"(p), "v"(v) : "memory"); }
__device__ __forceinline__ void st_wt4f(void* p, float v) { asm volatile("global_store_dword %0, %1, off sc1\n\ts_nop 1" :: "v"(p), "v"(v) : "memory"); }
__device__ __forceinline__ unsigned f2bf(float f) { unsigned u = __builtin_bit_cast(unsigned, f); return (u + 0x7fffu + ((u >> 16) & 1u)) >> 16; }
__device__ __forceinline__ unsigned pk2(float lo, float hi) { return f2bf(lo) | (f2bf(hi) << 16); }
__device__ __forceinline__ float bf2f(unsigned short b) { return __builtin_bit_cast(float, (unsigned)b << 16); }
__device__ __forceinline__ float bflo(unsigned w) { return __builtin_bit_cast(float, w << 16); }
__device__ __forceinline__ float bfhi(unsigned w) { return __builtin_bit_cast(float, w & 0xffff0000u); }
__device__ __forceinline__ float sigmoid_f(float x) { return __builtin_amdgcn_rcpf(1.0f + __expf(-x)); }
__device__ __forceinline__ float silu_f(float x) { return x * sigmoid_f(x); }
__device__ __forceinline__ float logsigmoid_f(float x) { return fminf(x, 0.f) - __logf(1.0f + __expf(-fabsf(x))); }
#define XB_TMO      128
#define XB_XCNT(j)  (256  + 64 * (j))
#define XB_XSUB(j)  (1280 + 64 * (j))
#define XB_XGEN(j)  (2304 + 64 * (j))
#define XB_TOP      3328
#define XB_TOPGEN   3392
#define XCD_BAR_WORDS 3456
#define XB_SPIN_CAP (1u << 18)

__device__ __forceinline__ unsigned xb_ld(unsigned* p)              { return __hip_atomic_load(p, __ATOMIC_RELAXED, __HIP_MEMORY_SCOPE_AGENT); }
__device__ __forceinline__ unsigned xb_add(unsigned* p, unsigned v) { return __hip_atomic_fetch_add(p, v, __ATOMIC_RELAXED, __HIP_MEMORY_SCOPE_AGENT); }
__device__ __forceinline__ unsigned xb_xcc_id() { return (unsigned)__builtin_amdgcn_s_getreg((3 << 11) | 20) & 0xFu; }
#define XB_SPIN(cond, bar) do { unsigned _sp = 0; while (cond) { __builtin_amdgcn_s_sleep(1); \
    if ((++_sp & 255u) == 0u) { if (xb_ld(&(bar)[XB_TMO])) break; if (_sp > XB_SPIN_CAP) { atomicAdd(&(bar)[XB_TMO], 1u); break; } } } } while (0)

struct XcdBarrier {
    unsigned* bar; unsigned x;
    volatile LAS unsigned* st;
};

__device__ __forceinline__ XcdBarrier xcd_barrier_post(unsigned* bar, volatile LAS unsigned* st) {
    XcdBarrier b; b.bar = bar; b.x = xb_xcc_id(); b.st = st;
    if (threadIdx.x == 0) (void)xb_add(&bar[XB_XCNT(b.x)], 1u);
    return b;
}
__device__ __forceinline__ void xcd_barrier_complete(unsigned* bar, unsigned x, unsigned& nloc, unsigned& nx) {
    const unsigned G = gridDim.x * gridDim.y * gridDim.z;
    unsigned sum, cnt, mine, sp = 0u;
    for (;;) {
        sum = 0u; cnt = 0u; mine = 0u;
#pragma unroll
        for (unsigned j = 0; j < 16; ++j) { const unsigned c = xb_ld(&bar[XB_XCNT(j)]); sum += c; cnt += (c > 0u) ? 1u : 0u; mine = (j == x) ? c : mine; }
        if (sum == G) break;
        __builtin_amdgcn_s_sleep(1);
        if ((++sp & 255u) == 0u) { if (xb_ld(&bar[XB_TMO])) break; if (sp > XB_SPIN_CAP) { atomicAdd(&bar[XB_TMO], 1u); break; } }
    }
    nloc = mine > 0u ? mine : 1u; nx = cnt > 0u ? cnt : 1u;
}

__device__ __forceinline__ void xcd_barrier(const XcdBarrier& b) {
    asm volatile("s_waitcnt vmcnt(0)" ::: "memory");
    __syncthreads();
    if (threadIdx.x == 0) {
        unsigned* bar = b.bar;
        __builtin_amdgcn_s_waitcnt(0);
        unsigned nloc = b.st[0], nx = b.st[1];
        if (nloc == 0u) { xcd_barrier_complete(bar, b.x, nloc, nx); b.st[0] = nloc; b.st[1] = nx; }
        const unsigned old = xb_add(&bar[XB_XSUB(b.x)], 1u);
        const unsigned gen = old / nloc;
        if (old + 1u == (gen + 1u) * nloc) {
            __builtin_amdgcn_fence(__ATOMIC_RELEASE, "agent");
            asm volatile("s_waitcnt vmcnt(0)" ::: "memory");
            const unsigned og = xb_add(&bar[XB_TOP], 1u);
            const unsigned tg = og / nx;
            if (og + 1u == (tg + 1u) * nx) xb_add(&bar[XB_TOPGEN], 1u);
            else XB_SPIN(xb_ld(&bar[XB_TOPGEN]) == tg, bar);
            __builtin_amdgcn_fence(__ATOMIC_ACQUIRE, "agent");
            xb_add(&bar[XB_XGEN(b.x)], 1u);
            asm volatile("s_waitcnt vmcnt(0)" ::: "memory");
        } else {
            XB_SPIN(xb_ld(&bar[XB_XGEN(b.x)]) == gen, bar);
            __builtin_amdgcn_fence(__ATOMIC_ACQUIRE, "agent");
            asm volatile("s_waitcnt vmcnt(0)" ::: "memory");
        }
    }
    __syncthreads();
}
#ifndef W3_P0
#define W3_P0 2816
#endif
struct Args { const float* in[18]; float* out; unsigned char* ws; int ph_lo, ph_hi, pad, pad2; };
#define P_xp (A.in[0])
#define P_xs (A.in[1])
#define P_sgla (A.in[2])
#define P_sconv (A.in[3])
#define P_norm_mix (A.in[4])
#define P_w_in (A.in[5])
#define P_wgu (A.in[6])
#define P_bgate (A.in[7])
#define P_gla_norm (A.in[8])
#define P_conv_w (A.in[9])
#define P_conv_b (A.in[10])
#define P_ln_g (A.in[11])
#define P_ln_b (A.in[12])
#define P_w_out (A.in[13])
#define P_norm_ffn (A.in[14])
#define P_w_ffn_in (A.in[15])
#define P_w_ffn_out (A.in[16])
#define P_norm_final (A.in[17])
#define P_W1t ((bf16*)(A.ws + WS_W1))
#define P_W2t ((bf16*)(A.ws + WS_W2))
#define P_W3t ((bf16*)(A.ws + WS_W3))
#define P_W4t ((bf16*)(A.ws + WS_W4))
#define P_H ((bf16*)(A.ws + WS_H))
#define P_Z ((bf16*)(A.ws + WS_Z))
#define P_MIX ((bf16*)(A.ws + WS_MIX))
#define P_HID ((bf16*)(A.ws + WS_HID))
#define P_QT ((bf16*)(A.ws + WS_QT))
#define P_KH ((bf16*)(A.ws + WS_KH))
#define P_VT ((bf16*)(A.ws + WS_VT))
#define P_out (A.out)
#define P_O32 ((float*)((unsigned char*)A.out + DO_O32))
#define P_AM ((bf16*)((unsigned char*)A.out + DO_AM))
#define P_DCb ((float*)((unsigned char*)A.out + DO_DC))

struct Frame {
    LAS unsigned char* lds;
    volatile LAS unsigned* MISC;
    gu32* ctl;
    int tid, lane, wave, vcu, G;
};
__device__ __forceinline__ float wave_sum(float v) {
#pragma unroll
    for (int o = 1; o < 64; o <<= 1) v += __shfl_xor(v, o);
    return v;
}
__device__ __forceinline__ float dot4(f32x4 a, f32x4 b) { return (a.x * b.x + a.y * b.y) + (a.z * b.z + a.w * b.w); }

template <int MAP> __device__ __forceinline__ int srccol(int n) {
    if (MAP == 1) { if (n < 2048) return n; if (n < 3072) return n + 16;
        if (n < 5120) { const int t = (n - 3072) >> 8, r = (n - 3072) & 255; return r < 128 ? 3088 + 128 * t + r : 3088 + 1024 + 128 * t + (r - 128); }
        return n < 5136 ? n - 3072 : -1; }
    if (MAP == 3) { const int t = n >> 8, r = n & 255; return r < 128 ? 128 * t + r : DFF + 128 * t + (r - 128); }
    return n;
}
template <int MAP> __device__ __forceinline__ void tr_load(float (&tv)[32], const float* W, int Nsrc, int Ndst, int item, int lane) {
    const int nblk = Ndst / 32, kb = item / nblk, nb = item % nblk, k0 = 64 * kb, n0 = 32 * nb;
    const int sc = srccol<MAP>(n0 + (lane & 31));
    const float* src = W + (size_t)k0 * Nsrc + (sc >= 0 ? sc : 0);
#pragma unroll
    for (int i = 0; i < 32; ++i) { const int kk = 2 * i + (lane >> 5); tv[i] = __builtin_nontemporal_load(src + (size_t)kk * Nsrc); }
}
template <int MAP> __device__ __forceinline__ void tr_store(const float (&tv)[32], int K, int Ndst, bf16* WT, LAS float* scr, int item, int lane) {
    const int nblk = Ndst / 32, kb = item / nblk, nb = item % nblk, k0 = 64 * kb, n0 = 32 * nb;
    const int sc = srccol<MAP>(n0 + (lane & 31));
#pragma unroll
    for (int i = 0; i < 32; ++i) { const int kk = 2 * i + (lane >> 5); scr[kk * 33 + (lane & 31)] = sc >= 0 ? tv[i] : 0.f; }
    LDS_WAIT(); asm volatile("" ::: "memory");
    const int c = lane & 7;
#pragma unroll
    for (int j = 0; j < 4; ++j) { const int n = (lane >> 3) + 8 * j; const LAS float* s = scr + (8 * c) * 33 + n;
        v4u o; o.x = pk2(s[0 * 33], s[1 * 33]); o.y = pk2(s[2 * 33], s[3 * 33]); o.z = pk2(s[4 * 33], s[5 * 33]); o.w = pk2(s[6 * 33], s[7 * 33]);
        *(GAS v4u*)(WT + (size_t)(n0 + n) * K + k0 + 8 * c) = o; }
    LDS_WAIT(); asm volatile("" ::: "memory");
}
template <int MAP> __device__ __forceinline__ void transpose_items(const float* W, int K, int Nsrc, int Ndst, bf16* WT, LAS float* scr, int it0, int stride, int nitems, int lane, int ibase = 0) {
    float ta[32], tb[32];
    int it = it0;
    if (it >= nitems) return;
    const int last = it0 + ((nitems - 1 - it0) / stride) * stride;
    tr_load<MAP>(ta, W, Nsrc, Ndst, ibase + it, lane);
#pragma unroll 1
    while (true) {
        const int i2 = it + stride; tr_load<MAP>(tb, W, Nsrc, Ndst, ibase + (i2 <= last ? i2 : last), lane);
        tr_store<MAP>(ta, K, Ndst, WT, scr, ibase + it, lane);
        if (i2 > last) break;
        const int i3 = i2 + stride; tr_load<MAP>(ta, W, Nsrc, Ndst, ibase + (i3 <= last ? i3 : last), lane);
        tr_store<MAP>(tb, K, Ndst, WT, scr, ibase + i2, lane);
        if (i3 > last) break;
        it = i3;
    }
}
__device__ __forceinline__ void rms_row_to_bf16(const float* xrow, const float* gain, bf16* orow, int lane, const float* part = nullptr, int ns = 0, size_t pstride = 0, float* xout = nullptr) {
    const GAS f32x4* xr = (const GAS f32x4*)xrow + lane; const GAS f32x4* gr = (const GAS f32x4*)gain + lane;
    f32x4 v[8]; float s = 0.f;
#pragma unroll
    for (int j = 0; j < 8; ++j) v[j] = __builtin_nontemporal_load(xr + 64 * j);
    if (xout) { GAS f32x4* xo = (GAS f32x4*)xout + lane;
#pragma unroll
        for (int j = 0; j < 8; ++j) xo[64 * j] = v[j]; }
#pragma unroll
    for (int j = 0; j < 8; ++j) s += dot4(v[j], v[j]);
    const float rstd = 1.0f / sqrtf(wave_sum(s) * (1.f / DM) + RMS_EPS);
    GAS v2u* o8 = (GAS v2u*)orow + lane;
#pragma unroll
    for (int j = 0; j < 8; ++j) { const f32x4 g = gr[64 * j]; v2u o; o.x = pk2(v[j].x * rstd * g.x, v[j].y * rstd * g.y); o.y = pk2(v[j].z * rstd * g.z, v[j].w * rstd * g.w); o8[64 * j] = o; }
}
__device__ __forceinline__ void rms_row_inplace(float* xrow, const float* gain, int lane, const float* part = nullptr, int ns = 0, size_t pstride = 0) {
    GAS f32x4* xr = (GAS f32x4*)xrow + lane; const GAS f32x4* gr = (const GAS f32x4*)gain + lane;
    f32x4 v[8]; float s = 0.f;
#pragma unroll
    for (int j = 0; j < 8; ++j) v[j] = xr[64 * j];
    for (int k = 0; k < ns; k += 2) {
        const GAS f32x4* pr0 = (const GAS f32x4*)(part + (size_t)k * pstride) + lane; const GAS f32x4* pr1 = (const GAS f32x4*)(part + (size_t)(k + 1) * pstride) + lane;
        f32x4 t0[8], t1[8];
#pragma unroll
        for (int j = 0; j < 8; ++j) { t0[j] = pr0[64 * j]; t1[j] = pr1[64 * j]; }
#pragma unroll
        for (int j = 0; j < 8; ++j) v[j] += t0[j] + t1[j]; }
#pragma unroll
    for (int j = 0; j < 8; ++j) s += dot4(v[j], v[j]);
    const float rstd = 1.0f / sqrtf(wave_sum(s) * (1.f / DM) + RMS_EPS);
#pragma unroll
    for (int j = 0; j < 8; ++j) { const f32x4 g = gr[64 * j]; xr[64 * j] = v[j] * rstd * g; }
}
__device__ __forceinline__ void wg_publish_wt(gu32* w0, int tid) { if (tid == 0) __hip_atomic_fetch_add(w0, 1u, RLX_AGENT); }
__device__ __forceinline__ void wg_publish(gu32* w0, gu32* w1, int tid) {
    if (tid == 0) { __builtin_amdgcn_fence(__ATOMIC_RELEASE, "agent"); asm volatile("s_waitcnt vmcnt(0)" ::: "memory");
        __hip_atomic_fetch_add(w0, 1u, RLX_AGENT); if (w1) __hip_atomic_fetch_add(w1, 1u, RLX_AGENT); }
}
__device__ __forceinline__ void wg_wait_ge(gu32* w, unsigned want, int tid) {
    if (tid < 64) { unsigned polls = 0;
        while ((unsigned)__builtin_amdgcn_readfirstlane(__hip_atomic_load(w, RLX_AGENT)) < want) { __builtin_amdgcn_s_sleep(2); if (++polls > (1u << 22)) break; }
        __builtin_amdgcn_fence(__ATOMIC_ACQUIRE, "agent"); asm volatile("s_waitcnt vmcnt(0)" ::: "memory"); }
    asm volatile("" ::: "memory"); __syncthreads(); asm volatile("" ::: "memory");
}
template <int NS> __device__ __forceinline__ void sample_row_unit(const float* base, const float* part, size_t pstride, const float* gain, float* xout, bf16* obf, float* of32, LAS float* red, int wave, int lane) {
    const int col = 256 * wave + 4 * lane;
    f32x4 v = *(const GAS f32x4*)(base + col);
    f32x4 t[NS];
#pragma unroll
    for (int k = 0; k < NS; ++k) t[k] = *(const GAS f32x4*)(part + (size_t)k * pstride + col);
#pragma unroll
    for (int k = 0; k < NS; ++k) v += t[k];
    if (xout) *(GAS f32x4*)(xout + col) = v;
    const float s = wave_sum(dot4(v, v));
    if (lane == 0) red[wave] = s;
    LDS_BARRIER();
    float tot = 0.f;
#pragma unroll
    for (int w = 0; w < 8; ++w) tot += red[w];
    const float rstd = 1.0f / sqrtf(tot * (1.f / DM) + RMS_EPS);
    const f32x4 g = *(const GAS f32x4*)(gain + col); const f32x4 r = v * rstd * g;
    if (obf) { v2u o; o.x = pk2(r.x, r.y); o.y = pk2(r.z, r.w); *(GAS v2u*)(obf + col) = o; }
    if (of32) *(GAS f32x4*)(of32 + col) = r;
    LDS_BARRIER();
}
__device__ __forceinline__ void p0_prologue(Frame& F, const Args& A) {
    LAS float* scr = (LAS float*)(F.lds + RING_OFF + F.wave * 16384);
    const int gw = F.vcu * NWAVES + F.wave, NGW = F.G * NWAVES;
    constexpr int I_1 = (DM / 64) * (N1P / 32), I_2 = (DM / 64) * (DM / 32);
    transpose_items<1>(P_w_in, DM, N1, N1P, P_W1t, scr, gw, NGW, I_1, F.lane);
    transpose_items<0>(P_w_out, DM, DM, DM, P_W2t, scr, NGW - 1 - gw, NGW, I_2, F.lane);
    transpose_items<3>(P_w_ffn_in, DM, 2 * DFF, 2 * DFF, P_W3t, scr, gw, NGW, W3_P0, F.lane);
    {
        const int m0 = NGW - 1 - gw;
        const GAS f32x4* gr = (const GAS f32x4*)P_norm_mix + F.lane;
        f32x4 va[8], vb[8];
        auto rowp = [&](int m) -> const GAS f32x4* { const int mc = m < MR ? m : MR - 1; return (const GAS f32x4*)(mc < MP ? P_xp + (size_t)mc * DM : P_xs + (size_t)(mc - MP) * DM) + F.lane; };
        if (m0 < MPAD) {
            { const GAS f32x4* xr = rowp(m0);
#pragma unroll
              for (int j = 0; j < 8; ++j) va[j] = __builtin_nontemporal_load(xr + 64 * j); }
#pragma unroll 1
            for (int m = m0; m < MPAD; m += NGW) {
                { const GAS f32x4* xr = rowp(m + NGW);
#pragma unroll
                  for (int j = 0; j < 8; ++j) vb[j] = __builtin_nontemporal_load(xr + 64 * j); }
                float s = 0.f;
#pragma unroll
                for (int j = 0; j < 8; ++j) s += dot4(va[j], va[j]);
                const float rstd = (m < MR) ? 1.0f / sqrtf(wave_sum(s) * (1.f / DM) + RMS_EPS) : 0.f;
                GAS v2u* o8 = (GAS v2u*)(P_H + (size_t)m * DM) + F.lane;
#pragma unroll
                for (int j = 0; j < 8; ++j) { const f32x4 g = gr[64 * j]; v2u o; o.x = pk2(va[j].x * rstd * g.x, va[j].y * rstd * g.y); o.y = pk2(va[j].z * rstd * g.z, va[j].w * rstd * g.w); o8[64 * j] = o; }
#pragma unroll
                for (int j = 0; j < 8; ++j) va[j] = vb[j];
            }
        }
    }
}
__device__ __forceinline__ void convert_w3(Frame& F, const Args& A, int wg, int nwgs) {
    LAS float* scr = (LAS float*)(F.lds + RING_OFF + F.wave * 16384);
    constexpr int I_3 = (DM / 64) * (2 * DFF / 32);
    transpose_items<3>(P_w_ffn_in, DM, 2 * DFF, 2 * DFF, P_W3t, scr, wg * NWAVES + F.wave, nwgs * NWAVES, I_3 - W3_P0, F.lane, W3_P0);
}
__device__ __forceinline__ void convert_w4(Frame& F, const Args& A, int wg, int nwgs) {
    LAS float* scr = (LAS float*)(F.lds + RING_OFF + F.wave * 16384);
    constexpr int I_4 = (DFF / 64) * (DM / 32);
    transpose_items<0>(P_w_ffn_out, DFF, DM, DM, P_W4t, scr, wg * NWAVES + F.wave, nwgs * NWAVES, I_4, F.lane);
}
__device__ __forceinline__ void gla_prep_unit(Frame& F, const Args& A, int bh, int c) {
    const int tid = F.tid, b = bh >> 2, h = bh & 3, row0 = b * SEQ + c * CH;
    LAS float* GL = (LAS float*)(F.lds + RING_OFF);
    LAS float* BL = (LAS float*)(F.lds + RING_OFF + 4608);
    LAS bf16* QS = (LAS bf16*)(F.lds + RING_OFF + 8192);
    LAS bf16* KS = (LAS bf16*)(F.lds + RING_OFF + 25600);
    LAS bf16* VR = (LAS bf16*)(F.lds + RING_OFF + 43008);
    LAS bf16* KHS = (LAS bf16*)(F.lds + RING_OFF + 76800);
    const size_t uc = (size_t)bh * NCH + c;
    const bf16* Zc = P_Z + (size_t)row0 * N1P;
    {
        v4u pq[2], pk[2], pv[4];
#pragma unroll
        for (int k = 0; k < 2; ++k) { const int p = tid + 512 * k, i = p >> 4, ch = p & 15;
            pq[k] = *(const GAS v4u*)(Zc + (size_t)i * N1P + ZQ + h * HK + 8 * ch); pk[k] = *(const GAS v4u*)(Zc + (size_t)i * N1P + ZK + h * HK + 8 * ch); }
#pragma unroll
        for (int k = 0; k < 4; ++k) { const int p = tid + 512 * k, i = p >> 5, ch = p & 31; pv[k] = *(const GAS v4u*)(Zc + (size_t)i * N1P + ZV + h * HV + 8 * ch); }
        v4u pg = (v4u){0u, 0u, 0u, 0u};
        if (tid < 128) pg = *(const GAS v4u*)(Zc + (size_t)(tid >> 1) * N1P + ZGL + 8 * (tid & 1));
#pragma unroll
        for (int k = 0; k < 2; ++k) { const int p = tid + 512 * k, i = p >> 4, ch = p & 15; *(LAS v4u*)(QS + i * 136 + 8 * ch) = pq[k]; *(LAS v4u*)(KS + i * 136 + 8 * ch) = pk[k]; }
#pragma unroll
        for (int k = 0; k < 4; ++k) { const int p = tid + 512 * k, i = p >> 5, ch = p & 31; *(LAS v4u*)(VR + i * 264 + 8 * (ch ^ ((i >> 3) & 7))) = pv[k]; }
        if (tid < 128) { LAS float* gp = GL + (tid >> 1) * 16 + 8 * (tid & 1);
            gp[0] = bflo(pg.x); gp[1] = bfhi(pg.x); gp[2] = bflo(pg.y); gp[3] = bfhi(pg.y); gp[4] = bflo(pg.z); gp[5] = bfhi(pg.z); gp[6] = bflo(pg.w); gp[7] = bfhi(pg.w); }
    }
    const int d = tid & 127, g = tid >> 7;
    float wg[16];
#pragma unroll
    for (int r = 0; r < 16; ++r) wg[r] = P_wgu[r * DK + h * HK + d];
    const float bg = P_bgate[h * HK + d];
    LDS_BARRIER();
    float bcum[16]; float run = 0.f;
#pragma unroll
    for (int ii = 0; ii < 16; ++ii) { const int i = g * 16 + ii; float x = bg;
#pragma unroll
        for (int r4 = 0; r4 < 4; ++r4) { const f32x4 gl = *(const LAS f32x4*)(GL + i * 16 + 4 * r4);
            x += gl.x * wg[4 * r4] + gl.y * wg[4 * r4 + 1] + gl.z * wg[4 * r4 + 2] + gl.w * wg[4 * r4 + 3]; }
        run += logsigmoid_f(x) * (1.0f / 16.0f); bcum[ii] = run; }
    BL[g * 128 + d] = run;
    LDS_BARRIER();
    float off = 0.f, tot = 0.f;
#pragma unroll
    for (int gg = 0; gg < 4; ++gg) { const float t = BL[gg * 128 + d]; off += (gg < g) ? t : 0.f; tot += t; }
    const float scale = 0.08838834764831845f;
#pragma unroll
    for (int ii = 0; ii < 16; ++ii) { const int i = g * 16 + ii; const float bb = bcum[ii] + off;
        const float q = bf2f(QS[i * 136 + d]) * scale * __expf(bb);
        const float kv = bf2f(KS[i * 136 + d]);
        const unsigned qk = pg8::cvt_pk_bf16(q, kv * __expf(-bb)), qb = qk & 0xffffu, ktb = qk >> 16, khb = pg8::cvt_pk_bf16(kv * __expf(tot - bb), 0.f) & 0xffffu;
        QS[i * 136 + d] = (bf16)qb; KS[i * 136 + d] = (bf16)ktb; KHS[i * 136 + (d ^ (8 * ((i >> 3) & 7)))] = (bf16)khb; }
    {
#pragma unroll
      for (int k = 0; k < 4; ++k) { const int q = tid + 512 * k, n = q >> 3, pc = q & 7; unsigned vw[4];
#pragma unroll
          for (int e = 0; e < 8; ++e) { const unsigned v = VR[(8 * pc + e) * 264 + (n ^ (8 * pc))];
              if (e & 1) vw[e >> 1] |= v << 16; else vw[e >> 1] = v; }
          *(GAS v4u*)(P_VT + (uc * 256 + n) * 64 + 8 * pc) = (v4u){vw[0], vw[1], vw[2], vw[3]}; } }
    LDS_BARRIER();
    {
#pragma unroll
      for (int k = 0; k < 2; ++k) { const int q = tid + 512 * k, dd = q >> 3, pc = q & 7; unsigned kw[4];
#pragma unroll
          for (int e = 0; e < 8; ++e) { const unsigned v = KHS[(8 * pc + e) * 136 + (dd ^ (8 * pc))];
              if (e & 1) kw[e >> 1] |= v << 16; else kw[e >> 1] = v; }
          *(GAS v4u*)(P_KH + (uc * 128 + dd) * 64 + 8 * pc) = (v4u){kw[0], kw[1], kw[2], kw[3]}; } }
    {
#pragma unroll
        for (int k = 0; k < 2; ++k) { const int p = tid + 512 * k, i = p >> 4, s = (p >> 2) & 3, fq = p & 3;
            const v2u lo = *(const LAS v2u*)(QS + i * 136 + 32 * s + 4 * fq), hi = *(const LAS v2u*)(QS + i * 136 + 32 * s + 16 + 4 * fq);
            *(GAS v4u*)(P_QT + (uc * 64 + i) * 128 + 32 * s + 8 * fq) = (v4u){lo.x, lo.y, hi.x, hi.y}; }
    }
    { const int fr = F.lane & 15, fq = F.lane >> 4;
#pragma unroll
      for (int tt = 0; tt < 2; ++tt) { const int id = 2 * F.wave + tt, it = id >> 2, jt = id & 3;
          f32x4 acc = (f32x4){0.f, 0.f, 0.f, 0.f};
          if (jt <= it) {
#pragma unroll
              for (int s = 0; s < 4; ++s) { const bf16x8 a = *(const LAS bf16x8*)(KS + (jt * 16 + fr) * 136 + 32 * s + 8 * fq); const bf16x8 bq = *(const LAS bf16x8*)(QS + (it * 16 + fr) * 136 + 32 * s + 8 * fq);
                  acc = __builtin_amdgcn_mfma_f32_16x16x32_bf16(a, bq, acc, 0, 0, 0); } }
          const int i = it * 16 + fr, j0 = jt * 16 + 4 * fq;
#pragma unroll
          for (int r = 0; r < 4; ++r) if (j0 + r > i) acc[r] = 0.f;
          v2u o; o.x = pk2(acc[0], acc[1]); o.y = pk2(acc[2], acc[3]);
          *(LAS v2u*)(VR + i * 72 + j0) = o; } }
    if (g == 0) GL[d] = __expf(tot);
    LDS_BARRIER();
    { const int i = tid >> 3, ch = tid & 7; *(GAS v4u*)(P_AM + (uc * 64 + i) * 64 + 8 * ch) = *(const LAS v4u*)(VR + i * 72 + 8 * ch); }
    if (tid < 32) *(GAS f32x4*)(P_DCb + uc * 128 + 4 * tid) = *(const LAS f32x4*)(GL + 4 * tid);
    LDS_BARRIER();
}
__device__ __forceinline__ void ln_silu_row(const LAS float* cs, const float* lng, const float* lnb, bf16* orow, int lane) {
    f32x4 x[4]; float s = 0.f;
#pragma unroll
    for (int j = 0; j < 4; ++j) { x[j] = *(const LAS f32x4*)(cs + 256 * j + 4 * lane); s += (x[j].x + x[j].y) + (x[j].z + x[j].w); }
    const float mean = wave_sum(s) * (1.f / DC_); float q = 0.f;
#pragma unroll
    for (int j = 0; j < 4; ++j) { x[j] = x[j] - mean; q += dot4(x[j], x[j]); }
    const float rstd = 1.0f / sqrtf(wave_sum(q) * (1.f / DC_) + LN_EPS);
#pragma unroll
    for (int j = 0; j < 4; ++j) { const f32x4 g = *(const GAS f32x4*)(lng + 256 * j + 4 * lane), bb = *(const GAS f32x4*)(lnb + 256 * j + 4 * lane);
        const f32x4 y = x[j] * rstd * g + bb; v2u o; o.x = pk2(silu_f(y.x), silu_f(y.y)); o.y = pk2(silu_f(y.z), silu_f(y.w));
        *(GAS v2u*)(orow + 256 * j + 4 * lane) = o; }
}
__device__ __forceinline__ void ln_silu_rows2(const LAS float* cs, const float* lng, const float* lnb, bf16* orow, int lane) {
    f32x4 g[4], bb[4];
#pragma unroll
    for (int j = 0; j < 4; ++j) { g[j] = *(const GAS f32x4*)(lng + 256 * j + 4 * lane); bb[j] = *(const GAS f32x4*)(lnb + 256 * j + 4 * lane); }
    f32x4 x[2][4]; float s[2] = {0.f, 0.f};
#pragma unroll
    for (int k = 0; k < 2; ++k)
#pragma unroll
        for (int j = 0; j < 4; ++j) { x[k][j] = *(const LAS f32x4*)(cs + k * 1024 + 256 * j + 4 * lane); s[k] += (x[k][j].x + x[k][j].y) + (x[k][j].z + x[k][j].w); }
#pragma unroll
    for (int o = 1; o < 64; o <<= 1) { s[0] += __shfl_xor(s[0], o); s[1] += __shfl_xor(s[1], o); }
    float q[2] = {0.f, 0.f};
#pragma unroll
    for (int k = 0; k < 2; ++k) { const float mean = s[k] * (1.f / DC_);
#pragma unroll
        for (int j = 0; j < 4; ++j) { x[k][j] = x[k][j] - mean; q[k] += dot4(x[k][j], x[k][j]); } }
#pragma unroll
    for (int o = 1; o < 64; o <<= 1) { q[0] += __shfl_xor(q[0], o); q[1] += __shfl_xor(q[1], o); }
#pragma unroll
    for (int k = 0; k < 2; ++k) { const float rstd = 1.0f / sqrtf(q[k] * (1.f / DC_) + LN_EPS);
#pragma unroll
        for (int j = 0; j < 4; ++j) { const f32x4 y = x[k][j] * rstd * g[j] + bb[j]; v2u o; o.x = pk2(silu_f(y.x), silu_f(y.y)); o.y = pk2(silu_f(y.z), silu_f(y.w));
            *(GAS v2u*)(orow + (size_t)k * DM + 256 * j + 4 * lane) = o; } }
}
__device__ __forceinline__ void conv_prompt_unit(Frame& F, const Args& A, int b, int tb) {
    LAS bf16* GT = (LAS bf16*)(F.lds + RING_OFF);
    LAS float* CS = (LAS float*)(F.lds + RING_OFF);
    const int t0 = tb * 16;
    { v4u g8[12];
#pragma unroll
      for (int k = 0; k < 12; ++k) { const int p = F.tid + 512 * k, pc = p < 46 * 128 ? p : 0, r = pc >> 7, ch = pc & 127, t = t0 - 30 + r, tc = t < 0 ? 0 : t;
          g8[k] = *(const GAS v4u*)(P_Z + (size_t)(b * SEQ + tc) * N1P + ZGLU + 8 * ch); }
#pragma unroll
      for (int k = 0; k < 12; ++k) { const int p = F.tid + 512 * k, r = p >> 7, ch = p & 127, t = t0 - 30 + r;
          if (p < 46 * 128) *(LAS v4u*)(GT + r * 1024 + 8 * ch) = t < 0 ? (v4u){0u, 0u, 0u, 0u} : g8[k]; } }
    asm volatile("" ::: "memory");
    const int c = 2 * F.tid;
    const f32x2 bias = *(const GAS f32x2*)(P_conv_b + c);
    f32x2 acc[16];
#pragma unroll
    for (int tt = 0; tt < 16; ++tt) acc[tt] = bias;
    LDS_BARRIER();
#pragma unroll
    for (int half = 0; half < 2; ++half) {
        const int w0 = half * 16, nw = half ? 15 : 16;
        f32x2 wt[16];
#pragma unroll
        for (int w = 0; w < 16; ++w) wt[w] = (w < nw) ? *(const GAS f32x2*)(P_conv_w + (w0 + w) * DC_ + c) : (f32x2){0.f, 0.f};
#pragma unroll
        for (int r = 0; r < 46; ++r) { if (r >= w0 && r < w0 + nw + 15) { const unsigned gw_ = *(const LAS unsigned*)(GT + r * 1024 + c); f32x2 g; g.x = bflo(gw_); g.y = bfhi(gw_);
#pragma unroll
            for (int tt = 0; tt < 16; ++tt) { const int w = r - tt - w0; if (w >= 0 && w < nw) acc[tt] += g * wt[(w >= 0 && w < 16) ? w : 0]; } } }
        asm volatile("" ::: "memory");
    }
    LDS_BARRIER();
#pragma unroll
    for (int tt = 0; tt < 16; ++tt) *(LAS f32x2*)(CS + tt * 1024 + c) = acc[tt];
    LDS_BARRIER();
    ln_silu_rows2(CS + (2 * F.wave) * 1024, P_ln_g, P_ln_b, P_MIX + (size_t)(b * SEQ + t0 + 2 * F.wave) * DM + DA, F.lane);
    LDS_BARRIER();
}
__device__ __forceinline__ void conv_state_prompt_row(Frame& F, const Args& A, int b, int rr) {
    const bf16* zr = P_Z + (size_t)(b * SEQ + SEQ - 30 + rr) * N1P; float* orow = P_out + O_CP + ((size_t)b * 30 + rr) * DC_;
#pragma unroll
    for (int j = 0; j < 4; ++j) { const int c = 256 * j + 4 * F.lane; const v2u gg = *(const GAS v2u*)(zr + ZGLU + c);
        *(GAS f32x4*)(orow + c) = (f32x4){bflo(gg.x), bfhi(gg.x), bflo(gg.y), bfhi(gg.y)}; }
}
__device__ __forceinline__ void conv_sample_unit(Frame& F, const Args& A, int b) {
    LAS float* CS = (LAS float*)(F.lds + RING_OFF);
    const bf16* zr = P_Z + (size_t)(MP + b) * N1P;
    const int c = 2 * F.tid;
    f32x2 acc = *(const GAS f32x2*)(P_conv_b + c);
    f32x2 hv[30];
#pragma unroll
    for (int w = 0; w < 30; ++w) hv[w] = __builtin_nontemporal_load((const GAS f32x2*)(P_sconv + ((size_t)b * 30 + w) * DC_ + c));
    const unsigned gg = *(const GAS unsigned*)(zr + ZGLU + c);
#pragma unroll
    for (int w = 0; w < 30; ++w) { acc += hv[w] * *(const GAS f32x2*)(P_conv_w + w * DC_ + c); if (w >= 1) __builtin_nontemporal_store(hv[w], (GAS f32x2*)(P_out + O_CS + ((size_t)b * 30 + (w - 1)) * DC_ + c)); }
    f32x2 gl; gl.x = bflo(gg); gl.y = bfhi(gg);
    acc += gl * *(const GAS f32x2*)(P_conv_w + 30 * DC_ + c);
    *(GAS f32x2*)(P_out + O_CS + ((size_t)b * 30 + 29) * DC_ + c) = gl;
    *(LAS f32x2*)(CS + c) = acc;
    LDS_BARRIER();
    if (F.wave == 0) ln_silu_row(CS, P_ln_g, P_ln_b, P_MIX + (size_t)(MP + b) * DM + DA, F.lane);
    LDS_BARRIER();
}
__device__ __forceinline__ void gla_sample_items(Frame& F, const Args& A, int it0, int stride, int nitems) {
    const int tid = F.tid, n4 = 4 * F.lane;
    LAS float* TB = (LAS float*)(F.lds + RING_OFF);
    LAS float* OP = TB + 4 * 640;
    f32x4 s[16], sx[16];
    int it = it0;
    if (it < nitems) { const float* Sin = P_sgla + (size_t)it * HK * HV;
#pragma unroll
        for (int dd = 0; dd < 16; ++dd) s[dd] = __builtin_nontemporal_load((const GAS f32x4*)(Sin + (size_t)(16 * F.wave + dd) * HV + n4)); }
#pragma unroll 1
    for (int k = 0; k < 4; ++k) { const int ik = it0 + k * stride; if (ik < nitems) { const int b = ik >> 2, h = ik & 3; const bf16* zr = P_Z + (size_t)(MP + b) * N1P; LAS float* T = TB + k * 640;
        if (tid < 128) { const int d = tid; float x = P_bgate[h * HK + d];
#pragma unroll
            for (int r = 0; r < 16; ++r) x += bf2f(zr[ZGL + r]) * P_wgu[r * DK + h * HK + d];
            T[d] = __expf(logsigmoid_f(x) * (1.0f / 16.0f)); T[128 + d] = bf2f(zr[ZK + h * HK + d]); T[256 + d] = bf2f(zr[ZQ + h * HK + d]) * 0.08838834764831845f; }
        else if (tid < 384) { const int n = tid - 128; T[384 + n] = bf2f(zr[ZV + h * HV + n]); } } }
    LDS_BARRIER();
    int k = 0;
#pragma unroll 1
    while (it < nitems) {
        const int b = it >> 2, h = it & 3, nx = it + stride;
        const bf16* zr = P_Z + (size_t)(MP + b) * N1P;
        float* Sout = P_out + O_GS + (size_t)it * HK * HV;
        const LAS float* AD = TB + k * 640; const LAS float* KD = AD + 128; const LAS float* QD = AD + 256; const LAS float* VD = AD + 384;
        { const float* Sin = P_sgla + (size_t)(nx < nitems ? nx : it) * HK * HV;
#pragma unroll
            for (int dd = 0; dd < 16; ++dd) sx[dd] = __builtin_nontemporal_load((const GAS f32x4*)(Sin + (size_t)(16 * F.wave + dd) * HV + n4)); }
        const f32x4 v4 = *(const LAS f32x4*)(VD + n4);
        f32x4 oacc = (f32x4){0.f, 0.f, 0.f, 0.f};
#pragma unroll
        for (int dd = 0; dd < 16; ++dd) { const int d = 16 * F.wave + dd;
            const f32x4 sn = s[dd] * AD[d] + v4 * KD[d]; __builtin_nontemporal_store(sn, (GAS f32x4*)(Sout + (size_t)d * HV + n4)); oacc += sn * QD[d]; }
        *(LAS f32x4*)(OP + F.wave * 256 + n4) = oacc;
        LDS_BARRIER();
        if (F.wave == 0) { f32x4 o4 = (f32x4){0.f, 0.f, 0.f, 0.f};
#pragma unroll
            for (int w = 0; w < 8; ++w) o4 += *(const LAS f32x4*)(OP + w * 256 + n4);
            const float rstd = 1.0f / sqrtf(wave_sum(dot4(o4, o4)) * (1.f / HV) + RMS_EPS);
            const f32x4 gn = *(const GAS f32x4*)(P_gla_norm + n4); const v2u go = *(const GAS v2u*)(zr + ZGO + h * HV + n4);
            v2u o; o.x = pk2(o4.x * rstd * gn.x * silu_f(bflo(go.x)), o4.y * rstd * gn.y * silu_f(bfhi(go.x))); o.y = pk2(o4.z * rstd * gn.z * silu_f(bflo(go.y)), o4.w * rstd * gn.w * silu_f(bfhi(go.y)));
            *(GAS v2u*)(P_MIX + (size_t)(MP + b) * DM + h * HV + n4) = o; }
        LDS_BARRIER();
#pragma unroll
        for (int dd = 0; dd < 16; ++dd) s[dd] = sx[dd];
        it = nx; ++k;
    }
}
constexpr int SQ_AM = 0, SQ_QT = 9216, SQ_KH = 26624, SQ_VT = 45056, SQ_DC = 49664, SQ_BUF = 50176, SQ_NP = 2848, SQ_LT = 384;
__device__ __forceinline__ void seq_issue(f32x4 (&R)[8], const bf16* AMc, const bf16* QTc, const bf16* KHc, const bf16* VTc, const float* DCc, int lt) {
#pragma unroll
    for (int k = 0; k < 8; ++k) { const int P = lt + SQ_LT * k; const bf16* src = AMc;
        if (P < 512) src = AMc + (P >> 3) * 64 + (P & 7) * 8;
        else if (P < 1536) { const int q = P - 512; src = QTc + (q >> 4) * 128 + (q & 15) * 8; }
        else if (P < 2560) { const int q = P - 1536; src = KHc + (q >> 3) * 64 + (q & 7) * 8; }
        else if (P < 2816) { const int q = P - 2560; src = VTc + (q >> 3) * 64 + (q & 7) * 8; }
        else if (P < SQ_NP) { const int q = P - 2816; src = (const bf16*)DCc + q * 8; }
        R[k] = *(const GAS f32x4*)src; }
}
__device__ __forceinline__ void seq_stash(const f32x4 (&R)[8], LAS unsigned char* buf, int lt) {
#pragma unroll
    for (int k = 0; k < 8; ++k) { const int P = lt + SQ_LT * k; int dst = 0;
        if (P < 512) dst = SQ_AM + (P >> 3) * 144 + (P & 7) * 16;
        else if (P < 1536) { const int q = P - 512; dst = SQ_QT + (q >> 4) * 272 + (q & 15) * 16; }
        else if (P < 2560) { const int q = P - 1536; dst = SQ_KH + (q >> 3) * 144 + (q & 7) * 16; }
        else if (P < 2816) { const int q = P - 2560; dst = SQ_VT + (q >> 3) * 144 + (q & 7) * 16; }
        else { const int q = P - 2816; dst = SQ_DC + q * 16; }
        if (P < SQ_NP) *(LAS f32x4*)(buf + dst) = R[k]; }
}
__device__ __forceinline__ void gla_seq_wg(Frame& F, const Args& A, int item) {
    const int bh = item >> 3, grp = item & 7, b = bh >> 2, h = bh & 3, fr = F.lane & 15, fq = F.lane >> 4;
    LAS unsigned char* lds0 = F.lds + RING_OFF;
    const bool loader = F.wave >= 2; const int lt = F.tid - 128;
    const size_t uc0 = (size_t)bh * NCH;
    const bf16* AM0 = P_AM + uc0 * 64 * 64; const bf16* QT0 = P_QT + uc0 * 64 * 128; const bf16* KH0 = P_KH + uc0 * 128 * 64; const bf16* VT0 = P_VT + uc0 * 256 * 64 + (size_t)(grp * 32) * 64; const float* DC0 = P_DCb + uc0 * 128;
    f32x4 S[8], RB[8];
#define RA S
#pragma unroll
    for (int dt = 0; dt < 8; ++dt) S[dt] = (f32x4){0.f, 0.f, 0.f, 0.f};
#define SEQ_ISSUE(R, CC) do { const size_t o_ = (size_t)(CC); seq_issue(R, AM0 + o_ * 64 * 64, QT0 + o_ * 64 * 128, KH0 + o_ * 128 * 64, VT0 + o_ * 256 * 64, DC0 + o_ * 128, lt); } while (0)
    if (loader) { SEQ_ISSUE(RA, 0); SEQ_ISSUE(RB, 1); seq_stash(RA, lds0, lt); SEQ_ISSUE(RA, 2); }
    LDS_BARRIER();
    const int n0 = grp * 32 + 16 * F.wave;
#define SEQ_COMPUTE(CC) do { \
            const LAS unsigned char* buf = lds0 + ((CC) & 1) * SQ_BUF; \
            bf16x8 vt[2]; \
_Pragma("unroll") \
            for (int ks = 0; ks < 2; ++ks) vt[ks] = *(const LAS bf16x8*)(buf + SQ_VT + (16 * F.wave + fr) * 144 + (32 * ks + 8 * fq) * 2); \
            f32x4 o[4]; \
_Pragma("unroll") \
            for (int m = 0; m < 4; ++m) { o[m] = (f32x4){0.f, 0.f, 0.f, 0.f}; \
_Pragma("unroll") \
                for (int ks = 0; ks < 2; ++ks) { const bf16x8 a = *(const LAS bf16x8*)(buf + SQ_AM + (16 * m + fr) * 144 + (32 * ks + 8 * fq) * 2); o[m] = __builtin_amdgcn_mfma_f32_16x16x32_bf16(vt[ks], a, o[m], 0, 0, 0); } } \
            bf16x8 sb[4]; \
_Pragma("unroll") \
            for (int s = 0; s < 4; ++s) { v4u w; w.x = pg8::cvt_pk_bf16(S[2 * s][0], S[2 * s][1]); w.y = pg8::cvt_pk_bf16(S[2 * s][2], S[2 * s][3]); w.z = pg8::cvt_pk_bf16(S[2 * s + 1][0], S[2 * s + 1][1]); w.w = pg8::cvt_pk_bf16(S[2 * s + 1][2], S[2 * s + 1][3]); sb[s] = __builtin_bit_cast(bf16x8, w); } \
_Pragma("unroll") \
            for (int m = 0; m < 4; ++m) \
_Pragma("unroll") \
                for (int s = 0; s < 4; ++s) { const bf16x8 a = *(const LAS bf16x8*)(buf + SQ_QT + (16 * m + fr) * 272 + (32 * s + 8 * fq) * 2); o[m] = __builtin_amdgcn_mfma_f32_16x16x32_bf16(sb[s], a, o[m], 0, 0, 0); } \
_Pragma("unroll") \
            for (int m = 0; m < 4; ++m) *(GAS f32x4*)(P_O32 + (size_t)(b * SEQ + (CC) * CH + 16 * m + fr) * DA + h * HV + n0 + 4 * fq) = o[m]; \
_Pragma("unroll") \
            for (int dt = 0; dt < 8; ++dt) { const f32x4 dc = *(const LAS f32x4*)(buf + SQ_DC + (16 * dt + 4 * fq) * 4); S[dt] = S[dt] * dc; \
_Pragma("unroll") \
                for (int ks = 0; ks < 2; ++ks) { const bf16x8 a = *(const LAS bf16x8*)(buf + SQ_KH + (16 * dt + fr) * 144 + (32 * ks + 8 * fq) * 2); S[dt] = __builtin_amdgcn_mfma_f32_16x16x32_bf16(a, vt[ks], S[dt], 0, 0, 0); } } \
        } while (0)
    if (loader) {
#pragma unroll 1
        for (int c = 0; c < NCH; c += 2) {
            seq_stash(RB, lds0 + SQ_BUF, lt); SEQ_ISSUE(RB, (c + 3 < NCH ? c + 3 : NCH - 1));
            LDS_BARRIER();
            seq_stash(RA, lds0, lt); SEQ_ISSUE(RA, (c + 4 < NCH ? c + 4 : NCH - 1));
            LDS_BARRIER();
        }
    } else {
#pragma unroll 1
        for (int c = 0; c < NCH; c += 2) {
            SEQ_COMPUTE(c);
            LDS_BARRIER();
            SEQ_COMPUTE(c + 1);
            LDS_BARRIER();
        }
    }
#undef SEQ_COMPUTE
#undef SEQ_ISSUE
#undef RA
    if (!loader) {
#pragma unroll
        for (int dt = 0; dt < 8; ++dt)
#pragma unroll
            for (int r = 0; r < 4; ++r) P_out[O_GP + ((size_t)bh * HK + 16 * dt + 4 * fq + r) * HV + n0 + fr] = S[dt][r];
    }
}
template <int NR> __device__ __forceinline__ void gla_onorm_rows(Frame& F, const Args& A, int row, int rstride, int h) {
    const int n4 = 4 * F.lane;
    f32x4 o4[NR]; v2u go[NR];
#pragma unroll
    for (int j = 0; j < NR; ++j) { const int r = row + j * rstride; o4[j] = *(const GAS f32x4*)(P_O32 + (size_t)r * DA + h * HV + n4); go[j] = *(const GAS v2u*)(P_Z + (size_t)r * N1P + ZGO + h * HV + n4); }
    const f32x4 gn = *(const GAS f32x4*)(P_gla_norm + n4);
#pragma unroll
    for (int j = 0; j < NR; ++j) { const int r = row + j * rstride;
        const float rstd = 1.0f / sqrtf(wave_sum(dot4(o4[j], o4[j])) * (1.f / HV) + RMS_EPS);
        v2u o; o.x = pk2(o4[j].x * rstd * gn.x * silu_f(bflo(go[j].x)), o4[j].y * rstd * gn.y * silu_f(bfhi(go[j].x))); o.y = pk2(o4[j].z * rstd * gn.z * silu_f(bflo(go[j].y)), o4[j].w * rstd * gn.w * silu_f(bfhi(go[j].y)));
        *(GAS v2u*)(P_MIX + (size_t)r * DM + h * HV + n4) = o; }
}
__device__ __forceinline__ void gla_onorm_item(Frame& F, const Args& A, int row, int h) {
    const int n4 = 4 * F.lane;
    const f32x4 o4 = *(const GAS f32x4*)(P_O32 + (size_t)row * DA + h * HV + n4);
    const float rstd = 1.0f / sqrtf(wave_sum(dot4(o4, o4)) * (1.f / HV) + RMS_EPS);
    const f32x4 gn = *(const GAS f32x4*)(P_gla_norm + n4); const v2u go = *(const GAS v2u*)(P_Z + (size_t)row * N1P + ZGO + h * HV + n4);
    v2u o; o.x = pk2(o4.x * rstd * gn.x * silu_f(bflo(go.x)), o4.y * rstd * gn.y * silu_f(bfhi(go.x))); o.y = pk2(o4.z * rstd * gn.z * silu_f(bflo(go.y)), o4.w * rstd * gn.w * silu_f(bfhi(go.y)));
    *(GAS v2u*)(P_MIX + (size_t)row * DM + h * HV + n4) = o;
}
#ifndef G1_WGS_V
#define G1_WGS_V 231
#endif
#ifndef G3_WGS_V
#define G3_WGS_V 242
#endif
constexpr int G1_WGS = G1_WGS_V, G3_WGS = G3_WGS_V;
#ifndef FUSE_ROWS
#define FUSE_ROWS 1
#endif
#ifndef G1_SP2
#define G1_SP2 true
#endif
#ifndef G3_SP2
#define G3_SP2 true
#endif
#ifndef G1_ALIGN
#define G1_ALIGN true
#endif
#ifndef G3_ALIGN
#define G3_ALIGN true
#endif
#ifndef NKP2_V
#define NKP2_V 4
#endif
#ifndef NKP4_V
#define NKP4_V 8
#endif
constexpr int NKP2 = NKP2_V, NKP4 = NKP4_V;

#ifdef EXTRA_PHASE
#define MK_N_LAUNCHES 10
#endif
#ifndef MK_N_LAUNCHES
#define MK_N_LAUNCHES 1
#endif
constexpr int N_PHASES = 10;
constexpr int N_LAUNCHES = MK_N_LAUNCHES;
__global__ void __launch_bounds__(NWAVES * 64, 2) hymba_fwd(Args args) {
    extern __shared__ __attribute__((aligned(16))) unsigned char lds[];
    Frame F;
    F.lds = (LAS unsigned char*)lds;
    F.MISC = (volatile LAS unsigned*)(F.lds + MISC_OFF);
    F.tid = threadIdx.x; F.lane = F.tid & 63; F.wave = __builtin_amdgcn_readfirstlane(F.tid >> 6);
    F.G = gridDim.x; { const int bx = blockIdx.x; F.vcu = (F.G % 8 == 0) ? (bx % 8) * (F.G / 8) + bx / 8 : bx; }
    const Args& A = args;
    F.ctl = (gu32*)(args.ws + WS_CTL);
    for (int u = F.tid; u < (LDS_BYTES - LDSCTL_OFF) / 4; u += NWAVES * 64) ((LAS unsigned*)(F.lds + LDSCTL_OFF))[u] = 0u;
    __syncthreads();
    XcdBarrier bar; bar.bar = (unsigned*)(F.ctl + CW_BAR); bar.x = 0; bar.st = nullptr;
    if (N_LAUNCHES == 1) bar = xcd_barrier_post((unsigned*)(F.ctl + CW_BAR), F.MISC + 8);
    const int lo = args.ph_lo, hi = args.ph_hi;
#ifndef REP_MASK
#define REP_MASK 0
#endif
#define REPS(k) (((REP_MASK >> (k)) & 1) ? 2 : 1)
#ifndef P2A_REP
#define P2A_REP 0
#endif
#ifndef P2A_MASK
#define P2A_MASK 15
#endif
#ifndef PH_MASK
#define PH_MASK 0x3ff
#endif
#define IN(k) (((PH_MASK >> (k)) & 1) && lo <= (k) && (k) < hi)
#ifdef TS_PHASE
#ifndef TS_Q
#define TS_Q 8u
#endif
#ifndef TS_BLOCK
#define TS_BLOCK 0
#endif
#ifndef TS_OFF
#define TS_OFF 0u
#endif
    unsigned long long ts_prev = __builtin_amdgcn_s_memrealtime(); float ts_val = 0.f;
#define TS_MARK(k) do { const unsigned long long t_ = __builtin_amdgcn_s_memrealtime(); if ((k) == TS_PHASE) ts_val = (float)((((unsigned)(t_ - ts_prev) + TS_OFF * 100u) / (TS_Q * 100u)) * TS_Q); ts_prev = t_; } while (0)
#else
#define TS_MARK(k) do { } while (0)
#endif
#define SEAM(k) do { if (IN(k) && IN((k) + 1)) xcd_barrier(bar); TS_MARK(k); } while (0)
    const int gw = F.vcu * NWAVES + F.wave, NGW = F.G * NWAVES;

    if (IN(0)) for (int rep_ = 0; rep_ < REPS(0); ++rep_) { p0_prologue(F, A); }
    SEAM(0);
    if (IN(1)) for (int rep_ = 0; rep_ < REPS(1); ++rep_) {
        const int geff = (F.G == 256) ? G1_WGS : F.G;
        if ((int)blockIdx.x < geff) { pg8::Gemm g{P_H, P_W1t, MPAD, N1P, DM}; pg8::StaticOrder S; S.init(MPAD, N1P, geff, (int)blockIdx.x);
            pg8::EpiStoreBf16 E{P_Z, N1P, ZGLU / 256, ZGLU / 256 + 8, ZGLU};
            pg8::gemm_phase<pg8::EpiStoreBf16, pg8::StaticOrder, G1_ALIGN, G1_SP2>(F.lds + RING_OFF, g, S, E); }
        if (geff == F.G) convert_w3(F, A, (int)blockIdx.x, F.G); else if ((int)blockIdx.x >= geff) convert_w3(F, A, (int)blockIdx.x - geff, F.G - geff);
    }
    SEAM(1);
    if (IN(2)) {
        const int bx = (int)blockIdx.x;
        if (bx < NB * NH * 8) {
            const int item = (bx & 7) * (NB * NH) + (bx >> 3), bh = item >> 3, grp = item & 7;
#pragma unroll 1
            for (int k = 0; k < NCH / 8; ++k) gla_prep_unit(F, A, bh, grp * (NCH / 8) + k);
            VM_WAIT(); __syncthreads();
            wg_publish(F.ctl + CW_PREP + 64 * bh, nullptr, F.tid); wg_wait_ge(F.ctl + CW_PREP + 64 * bh, 8u, F.tid);
            TS_MARK(21);
            gla_seq_wg(F, A, item);
            TS_MARK(22);
            VM_WAIT(); __syncthreads();
            wg_publish(F.ctl + CW_SEQ + 64 * bh, nullptr, F.tid); wg_wait_ge(F.ctl + CW_SEQ + 64 * bh, 8u, F.tid);
            { const int b = bh >> 2, h = bh & 3, row0 = b * SEQ + grp * (SEQ / 8);
#pragma unroll 1
              for (int t = F.wave; t < SEQ / 8; t += 8 * NWAVES) gla_onorm_rows<8>(F, A, row0 + t, NWAVES, h); }
        } else {
            const int r0 = bx - NB * NH * 8, nr = F.G - NB * NH * 8;
            TS_MARK(23);
            for (int r = r0; r < NB * (SEQ / 16); r += nr) conv_prompt_unit(F, A, r / (SEQ / 16), r % (SEQ / 16));
            TS_MARK(24);
            for (int r = r0 * NWAVES + F.wave; r < NB * 30; r += nr * NWAVES) conv_state_prompt_row(F, A, r / 30, r % 30);
            for (int r = r0; r < MS; r += nr) conv_sample_unit(F, A, r);
            TS_MARK(25);
            gla_sample_items(F, A, r0, nr, MS * NH);
        }
    }
    TS_MARK(20);
    SEAM(2);
    if (IN(5)) {
        pg8::Gemm g{P_MIX, P_W2t, MPAD, DM, DM}; pg8::TailSplitOrder S; S.init_ts(MP, DM, DM, F.G, (int)blockIdx.x, NKP2, true); S.piece_cnt = (unsigned*)(F.ctl + CW_SP2);
        pg8::RowStats st{(float*)(A.ws + WS_XB2), (unsigned*)(F.ctl + CW_RB2), RMS_EPS};
        const int bx = (int)blockIdx.x, rk = (bx >> 3) * 4 + (bx & 3);
        pg8::SampleJob job{((bx & 7) >= 4 && rk < MS) ? rk : -1, P_xs, (const float*)(A.ws + WS_SK2), P_norm_ffn, P_out + (size_t)MP * DM, P_H + (size_t)MP * DM, nullptr, (const unsigned*)(F.ctl + CW_SP2), 8u * (unsigned)S.npieces};
        pg8::EpiResNormBf16 E{P_xp, P_out, P_H, P_norm_ffn, DM, (float*)(A.ws + WS_SK2), st, job};
        pg8::gemm_phase<pg8::EpiResNormBf16, pg8::TailSplitOrder, false, true>(F.lds + RING_OFF, g, S, E);
        TS_MARK(51);
        TS_MARK(52);
    }
    SEAM(5);
    if (IN(7)) for (int rep_ = 0; rep_ < REPS(7); ++rep_) {
        const int geff = (F.G == 256) ? G3_WGS : F.G;
        if ((int)blockIdx.x < geff) { pg8::Gemm g{P_H, P_W3t, MPAD, 2 * DFF, DM}; pg8::StaticOrder S; S.init(MPAD, 2 * DFF, geff, (int)blockIdx.x);
            pg8::EpiSwiglu E{P_HID, DFF};
            pg8::gemm_phase<pg8::EpiSwiglu, pg8::StaticOrder, G3_ALIGN, G3_SP2>(F.lds + RING_OFF, g, S, E); }
        if (geff == F.G) convert_w4(F, A, (int)blockIdx.x, F.G); else if ((int)blockIdx.x >= geff) convert_w4(F, A, (int)blockIdx.x - geff, F.G - geff);
    }
#ifdef PG8_TS
    if (TS_PHASE >= 70 && TS_PHASE <= 79) { const unsigned v_ = F.MISC[16 + (TS_PHASE - 71)]; ts_val = (float)((v_ / (TS_Q * 100u)) * TS_Q); }
#endif
    SEAM(7);
    if (IN(8)) {
        pg8::Gemm g{P_HID, P_W4t, MPAD, DM, DFF}; pg8::TailSplitOrder S; S.init_ts(MP, DM, DFF, F.G, (int)blockIdx.x, NKP4, true); S.piece_cnt = (unsigned*)(F.ctl + CW_SP4);
        pg8::RowStats st{(float*)(A.ws + WS_XB4), (unsigned*)(F.ctl + CW_RB4), RMS_EPS};
        const int bx = (int)blockIdx.x, rk = (bx >> 3) * 4 + (bx & 3);
        pg8::SampleJob job{((bx & 7) >= 4 && rk < MS) ? rk : -1, P_out + (size_t)MP * DM, (const float*)(A.ws + WS_SK4), P_norm_final, nullptr, nullptr, P_out + (size_t)MP * DM, (const unsigned*)(F.ctl + CW_SP4), 8u * (unsigned)S.npieces};
        pg8::EpiResNormF32 E{P_out, P_norm_final, DM, (float*)(A.ws + WS_SK4), st, job};
        pg8::gemm_phase<pg8::EpiResNormF32, pg8::TailSplitOrder, false, true>(F.lds + RING_OFF, g, S, E);
        TS_MARK(81);
    }
#ifdef TS_PHASE
    TS_MARK(8);
    if (blockIdx.x == TS_BLOCK && F.tid == 0) {
        unsigned* sw = (unsigned*)(args.ws + WS_END); const unsigned w = __hip_atomic_load(sw, __ATOMIC_RELAXED, __HIP_MEMORY_SCOPE_AGENT); const bool fresh = (w == 0xAAAAAAAAu);
        if (fresh) __hip_atomic_store(sw, __builtin_bit_cast(unsigned, ts_val), __ATOMIC_RELAXED, __HIP_MEMORY_SCOPE_AGENT);
        atomicAdd(P_out + O_END - 1, fresh ? ts_val : __builtin_bit_cast(float, w)); }
#endif
#undef IN
#undef SEAM
}

extern "C" void kernel_launch(void* const* d_in, const int* in_sizes, int n_in, void* d_out, int out_size, void* d_ws, size_t ws_size, hipStream_t stream) {
    static int grid = 0;
    if (grid == 0) {
        if (n_in != 18 || in_sizes[0] != MP * DM || (size_t)out_size != O_END || ws_size < WS_END) {
            fprintf(stderr, "kernel_launch: shape mismatch: n_in %d in0 %d out %d ws %zu (need %zu); nothing launched\n", n_in, n_in > 0 ? in_sizes[0] : -1, out_size, ws_size, (size_t)WS_END); grid = -1; return; }
        int dev = 0, cus = 0, per_cu = 0;
        if (hipGetDevice(&dev) != hipSuccess || hipDeviceGetAttribute(&cus, hipDeviceAttributeMultiprocessorCount, dev) != hipSuccess) { grid = -1; return; }
        if (hipFuncSetAttribute((const void*)hymba_fwd, hipFuncAttributeMaxDynamicSharedMemorySize, LDS_BYTES) != hipSuccess) { fprintf(stderr, "kernel_launch: hipFuncSetAttribute failed\n"); grid = -1; return; }
        if (hipOccupancyMaxActiveBlocksPerMultiprocessor(&per_cu, (const void*)hymba_fwd, NWAVES * 64, LDS_BYTES) != hipSuccess || per_cu < 1)
            fprintf(stderr, "kernel_launch: note: occupancy query reports %d workgroups per CU\n", per_cu);
        (void)hipGetLastError();
        if (cus != 256) { fprintf(stderr, "kernel_launch: built for a 256-CU device (tile schedules and in-launch hand-offs assume 256 resident workgroups), found %d CUs; nothing launched\n", cus); grid = -1; return; }
        grid = cus;
    }
    if (grid < 0) return;
    if (hipMemsetAsync((char*)d_ws + WS_CTL, 0, CTL_ZERO_BYTES, stream) != hipSuccess) return;
    Args a{};
    for (int i = 0; i < 18; ++i) a.in[i] = (const float*)d_in[i];
    a.out = (float*)d_out; a.ws = (unsigned char*)d_ws;
    for (int li = 0; li < N_LAUNCHES; ++li) {
        a.ph_lo = (N_LAUNCHES == 1) ? 0 : li; a.ph_hi = (N_LAUNCHES == 1) ? N_PHASES : li + 1;
        hipLaunchKernelGGL(hymba_fwd, dim3(grid), dim3(NWAVES * 64), LDS_BYTES, stream, a);
        const hipError_t le = hipPeekAtLastError();
        if (le != hipSuccess) { fprintf(stderr, "kernel_launch: launch %d failed: %s\n", li, hipGetErrorName(le)); break; }
#ifdef EXTRA_PHASE
        if (N_LAUNCHES != 1 && li == EXTRA_PHASE) { Args a2 = a; a2.pad = 1; hipLaunchKernelGGL(hymba_fwd, dim3(grid), dim3(NWAVES * 64), LDS_BYTES, stream, a2); }
#endif
    }
}
```

```cpp
#include <hip/hip_runtime.h>
#include <cstdio>
#include <cstdint>
constexpr int PG8_DUMMY = 0;
#ifndef WGM_V
#define WGM_V 8
#endif
namespace pg8 {
#define PG8_LAS __attribute__((address_space(3)))
typedef unsigned short bf16_t;
typedef short bf16x8 __attribute__((ext_vector_type(8)));
typedef float f32x4 __attribute__((ext_vector_type(4)));
typedef unsigned u32x4 __attribute__((ext_vector_type(4)));
constexpr int BM = 256, BK = 64, HALF = 128, HTB = HALF * BK * 2  , STAGE_BYTES = 8 * HTB, NXCD = 8, WGM = WGM_V;

__host__ __device__ __forceinline__ int lds_byte(int r, int c) { const int st = (r >> 4) * 2 + (c >> 5), rr = r & 15, cc = c & 31, ob = rr * 64 + cc * 2; return st * 1024 + (ob ^ (((ob >> 9) & 1) << 5)); }
__host__ __device__ __forceinline__ void stage_rc(int b, int& R, int& C) { const int st = b / 1024, sb = b % 1024, swz = sb ^ (((sb >> 9) & 1) << 5); R = (st >> 1) * 16 + swz / 64; C = (st & 1) * 32 + (swz % 64) / 2; }
__host__ __device__ __forceinline__ int perm32(int rho) { const int n = rho >> 4, i = rho & 15; return 8 * (i >> 2) + 4 * n + (i & 3); }

struct Unit { int pm, pn, k0, nk, mode, slot; };
struct Gemm { const bf16_t* A; const bf16_t* Bt; int M, N, K; };

struct StaticOrder {
    static constexpr bool SK = false;
    int nM, nN, nwg, G, c;
    __host__ __device__ __forceinline__ void init(int M, int N, int G_, int c_) { nM = M / BM; nN = N / BM; nwg = nM * nN; G = G_; c = c_; }
    __host__ __device__ __forceinline__ bool next(int i, Unit& u) const {
        const long L = (long)i * G + c; const bool ok = L < nwg;
        int wgid = ok ? (int)L : 0; { const int q = nwg / NXCD, r = nwg % NXCD, xcd = wgid % NXCD, off = wgid / NXCD; wgid = (xcd < r ? xcd * (q + 1) : r * (q + 1) + (xcd - r) * q) + off; }
        const int nig = WGM * nN, gid = wgid / nig, fm = gid * WGM, gsz = (nM - fm) < WGM ? (nM - fm) : WGM;
        u.pm = fm + ((wgid % nig) % gsz); u.pn = (wgid % nig) / gsz; return ok;
    }
    __device__ __forceinline__ void a_ready(const Unit&) const {}
    __device__ __forceinline__ void done(const Unit&) const {}
};
__device__ __forceinline__ unsigned cvt_pk_bf16(float lo, float hi) { unsigned r; asm volatile("v_cvt_pk_bf16_f32 %0, %1, %2" : "=v"(r) : "v"(lo), "v"(hi)); return r; }
typedef float f32x2 __attribute__((ext_vector_type(2)));
#ifndef NKP2_V
#define NKP2_V 4
#endif
#ifndef NKP4_V
#define NKP4_V 8
#endif
constexpr int NS_P3 = (2048 / 64) / NKP2_V, NS_P5 = (5632 / 64) / NKP4_V;
#ifndef HID_NT
#define HID_NT 0
#endif
typedef unsigned u32x2v __attribute__((ext_vector_type(2)));
__device__ __forceinline__ float silu_f(float x) { return x * __builtin_amdgcn_rcpf(1.0f + __expf(-x)); }
struct EpiStoreBf16 {
    static constexpr bool PERM = true, AFTER_DRAIN = false, HAS_INIT = false;
    bf16_t* O; int ldc; int glu_lo, glu_hi, glu_col;
    __device__ __forceinline__ void operator()(const f32x4 (&acc)[2][2][4][2], const Unit& u, int wr, int wc, int fr, int fq) const {
        const int row0 = u.pm * BM + wr * 64 + fr;
        if (u.pn >= glu_lo && u.pn < glu_hi) {
            const int col0 = glu_col + (u.pn - glu_lo) * HALF + wc * 32 + 8 * fq;
#pragma unroll
            for (int ai = 0; ai < 2; ++ai)
#pragma unroll
                for (int m = 0; m < 4; ++m) { bf16_t* rowp = O + (size_t)(row0 + ai * HALF + m * 16) * ldc + col0;
                    float h[8];
#pragma unroll
                    for (int n = 0; n < 2; ++n)
#pragma unroll
                        for (int e = 0; e < 4; ++e) h[4 * n + e] = acc[ai][0][m][n][e] * __builtin_amdgcn_rcpf(1.0f + __expf(-acc[ai][1][m][n][e]));
                    u32x4 w; w.x = cvt_pk_bf16(h[0], h[1]); w.y = cvt_pk_bf16(h[2], h[3]); w.z = cvt_pk_bf16(h[4], h[5]); w.w = cvt_pk_bf16(h[6], h[7]);
                    *(u32x4*)rowp = w; }
        } else {
            const int col0 = u.pn * BM + wc * 32 + 8 * fq;
#pragma unroll
            for (int ai = 0; ai < 2; ++ai)
#pragma unroll
                for (int m = 0; m < 4; ++m) { bf16_t* rowp = O + (size_t)(row0 + ai * HALF + m * 16) * ldc + col0;
#pragma unroll
                    for (int bj = 0; bj < 2; ++bj) { const f32x4 v0 = acc[ai][bj][m][0], v1 = acc[ai][bj][m][1];
                        u32x4 w; w.x = cvt_pk_bf16(v0[0], v0[1]); w.y = cvt_pk_bf16(v0[2], v0[3]); w.z = cvt_pk_bf16(v1[0], v1[1]); w.w = cvt_pk_bf16(v1[2], v1[3]);
                        *(u32x4*)(rowp + bj * HALF) = w; } }
        }
    }
};
struct EpiSwiglu {
    static constexpr bool PERM = true, AFTER_DRAIN = false, HAS_INIT = false;
    bf16_t* O; int ldc; int wt_pm;
    __device__ __forceinline__ void operator()(const f32x4 (&acc)[2][2][4][2], const Unit& u, int wr, int wc, int fr, int fq) const {
        const int row0 = u.pm * BM + wr * 64 + fr, col0 = u.pn * HALF + wc * 32 + 8 * fq; const bool wt = (u.pm == wt_pm);
#pragma unroll
        for (int ai = 0; ai < 2; ++ai)
#pragma unroll
            for (int m = 0; m < 4; ++m) { bf16_t* rowp = O + (size_t)(row0 + ai * HALF + m * 16) * ldc + col0;
                float h[8];
#pragma unroll
                for (int n = 0; n < 2; ++n)
#pragma unroll
                    for (int e = 0; e < 4; ++e) h[4 * n + e] = silu_f(acc[ai][0][m][n][e]) * acc[ai][1][m][n][e];
                u32x4 w; w.x = cvt_pk_bf16(h[0], h[1]); w.y = cvt_pk_bf16(h[2], h[3]); w.z = cvt_pk_bf16(h[4], h[5]); w.w = cvt_pk_bf16(h[6], h[7]);
                if (wt) asm volatile("global_store_dwordx4 %0, %1, off sc1\n\ts_nop 1" :: "v"(rowp), "v"(w) : "memory"); else *(u32x4*)rowp = w; }
    }
};
struct EpiResF32 {
    static constexpr bool PERM = false, AFTER_DRAIN = false, HAS_INIT = false;
    const float* base0; const float* base1; float* out; int ldc, msplit, mreal; float* part; float sc;
    __device__ __forceinline__ void operator()(const f32x4 (&acc)[2][2][4][2], const Unit& u, int wr, int wc, int fr, int fq) const {
        const int row0 = u.pm * BM + wr * 64 + fr, col0 = u.pn * BM + wc * 32 + 4 * fq;
#pragma unroll
        for (int ai = 0; ai < 2; ++ai)
#pragma unroll
            for (int m = 0; m < 4; ++m) { const int row = row0 + ai * HALF + m * 16;
                if (row < mreal) {
                    const float* bp = (row < msplit ? base0 + (size_t)row * ldc : base1 + (size_t)(row - msplit) * ldc) + col0; float* op = out + (size_t)row * ldc + col0;
                    f32x4 b[2][2];
#pragma unroll
                    for (int bj = 0; bj < 2; ++bj)
#pragma unroll
                        for (int n = 0; n < 2; ++n) b[bj][n] = *(const f32x4*)(bp + bj * HALF + n * 16);
#pragma unroll
                    for (int bj = 0; bj < 2; ++bj)
#pragma unroll
                        for (int n = 0; n < 2; ++n) *(f32x4*)(op + bj * HALF + n * 16) = b[bj][n] + acc[ai][bj][m][n] * sc;
                } }
    }
    __device__ __forceinline__ void partial(const f32x4 (&acc)[2][2][4][2], const Unit& u, int wr, int wc, int fr, int fq) const {
        float* pp = part + ((size_t)u.slot * HALF + wr * 64 + fr) * ldc + u.pn * BM + wc * 32 + 4 * fq;
#pragma unroll
        for (int m = 0; m < 4; ++m)
#pragma unroll
            for (int bj = 0; bj < 2; ++bj)
#pragma unroll
                for (int n = 0; n < 2; ++n) asm volatile("global_store_dwordx4 %0, %1, off sc1\n\ts_nop 1" :: "v"(pp + (size_t)(m * 16) * ldc + bj * HALF + n * 16), "v"(acc[0][bj][m][n]) : "memory");
    }
};
struct TailSplitOrder : StaticOrder {
    static constexpr bool SK = true;
    int nkp, npieces, ntfull; bool pieces_first; unsigned* piece_cnt;
    __device__ __forceinline__ void init_ts(int Mfull, int N, int K, int G_, int c_, int nkp_, bool pf = false) { init(Mfull, N, G_, c_); ntfull = K / BK; nkp = nkp_; npieces = nN * (ntfull / nkp_); pieces_first = pf; piece_cnt = nullptr; }
    __device__ __forceinline__ void done(const Unit& u) const {
        if (u.mode == 3 && piece_cnt) { asm volatile("s_waitcnt vmcnt(0)" ::: "memory"); if ((threadIdx.x & 63) == 0) __hip_atomic_fetch_add(piece_cnt, 1u, __ATOMIC_RELAXED, __HIP_MEMORY_SCOPE_AGENT); } }
    __device__ __forceinline__ bool next(int i, Unit& u) const {
        const int rankA = (c >> 3) * 4 + (c & 7); const bool mine = pieces_first && (c & 7) < 4 && rankA < npieces;
        const int is = pieces_first ? (mine ? i - 1 : i) : i;
        Unit t; t.pm = 0; t.pn = 0;
        const bool full = (is >= 0) && StaticOrder::next(is, t);
        const long p = pieces_first ? (long)rankA : (long)i * G + c - nwg; const bool piece = !full && (pieces_first ? (mine && i == 0) : (p >= 0 && p < npieces));
        const int pp = piece ? (int)p : 0, ks = pp / nN;
        u.pm = full ? t.pm : nM; u.pn = full ? t.pn : pp - ks * nN; u.slot = full ? 0 : ks; u.k0 = full ? 0 : ks * nkp; u.nk = full ? ntfull : nkp; u.mode = full ? 0 : 3;
        return full || piece;
    }
};
struct RotOrder : StaticOrder {
    int rot; unsigned* cnt;
    __host__ __device__ __forceinline__ bool next(int i, Unit& u) const {
        const long L = (long)i * G + c; const bool ok = L < nwg;
        int wgid = ok ? (int)L : 0; { const int q = nwg / NXCD, r = nwg % NXCD, xcd = wgid % NXCD, off = wgid / NXCD; wgid = (xcd < r ? xcd * (q + 1) : r * (q + 1) + (xcd - r) * q) + off; }
        wgid = wgid >= rot ? wgid - rot : wgid + nwg - rot;
        const int nig = WGM * nN, gid = wgid / nig, fm = gid * WGM, gsz = (nM - fm) < WGM ? (nM - fm) : WGM;
        u.pm = fm + ((wgid % nig) % gsz); u.pn = (wgid % nig) / gsz; return ok;
    }
    __device__ __forceinline__ void done(const Unit& u) const {
        if (u.pm == nM - 1) { asm volatile("s_waitcnt vmcnt(0)" ::: "memory"); if ((threadIdx.x & 63) == 0) __hip_atomic_fetch_add(cnt, 1u, __ATOMIC_RELAXED, __HIP_MEMORY_SCOPE_AGENT); } }
};
struct OneUnitOrder {
    static constexpr bool SK = true;
    int pm, pn, nk;
    __device__ __forceinline__ bool next(int i, Unit& u) const { u.pm = pm; u.pn = pn; u.k0 = 0; u.nk = nk; u.mode = 0; u.slot = 0; return i == 0; }
    __device__ __forceinline__ void a_ready(const Unit&) const {}
    __device__ __forceinline__ void done(const Unit&) const {}
};
struct SampleJob { int row; const float* base; const float* part; const float* gain; float* xout; bf16_t* obf; float* of32; const unsigned* piece_cnt; unsigned want; };
template <int NS> __device__ __forceinline__ void sample_row_job(const SampleJob& j, PG8_LAS unsigned char* lds, int wid, int lane, float eps) {
    PG8_LAS float* red = (PG8_LAS float*)(lds + 8192);
    if (wid == 0) { unsigned polls = 0;
        while ((unsigned)__builtin_amdgcn_readfirstlane(__hip_atomic_load(j.piece_cnt, __ATOMIC_RELAXED, __HIP_MEMORY_SCOPE_AGENT)) < j.want) { __builtin_amdgcn_s_sleep(2); if (++polls > (1u << 22)) break; }
        __builtin_amdgcn_fence(__ATOMIC_ACQUIRE, "agent"); }
    asm volatile("s_waitcnt vmcnt(0) lgkmcnt(0)" ::: "memory"); __builtin_amdgcn_s_barrier(); asm volatile("" ::: "memory");
    const int col = 256 * wid + 4 * lane; const size_t ro = (size_t)j.row * 2048;
    f32x4 v = *(const f32x4*)(j.base + ro + col);
    f32x4 t[NS];
#pragma unroll
    for (int k = 0; k < NS; ++k) t[k] = *(const f32x4*)(j.part + (size_t)k * 128 * 2048 + ro + col);
#pragma unroll
    for (int k = 0; k < NS; ++k) v += t[k];
    if (j.xout) *(f32x4*)(j.xout + ro + col) = v;
    float s = (v[0] * v[0] + v[1] * v[1]) + (v[2] * v[2] + v[3] * v[3]);
#pragma unroll
    for (int o = 1; o < 64; o <<= 1) s += __shfl_xor(s, o);
    if (lane == 0) red[wid] = s;
    asm volatile("s_waitcnt lgkmcnt(0)" ::: "memory"); __builtin_amdgcn_s_barrier(); asm volatile("" ::: "memory");
    float tot = 0.f;
#pragma unroll
    for (int w = 0; w < 8; ++w) tot += red[w];
    const float rstd = 1.0f / sqrtf(tot * (1.0f / 2048.0f) + eps);
    const f32x4 g = *(const f32x4*)(j.gain + col); const f32x4 r = v * rstd * g;
    if (j.obf) { u32x2v o; o.x = cvt_pk_bf16(r[0], r[1]); o.y = cvt_pk_bf16(r[2], r[3]); *(u32x2v*)(j.obf + ro + col) = o; }
    if (j.of32) *(f32x4*)(j.of32 + ro + col) = r;
    asm volatile("s_waitcnt lgkmcnt(0)" ::: "memory"); __builtin_amdgcn_s_barrier(); asm volatile("" ::: "memory");
}
__device__ __forceinline__ f32x4 xchg1(f32x4 v) { f32x4 r; r[0] = __shfl_xor(v[0], 1); r[1] = __shfl_xor(v[1], 1); r[2] = __shfl_xor(v[2], 1); r[3] = __shfl_xor(v[3], 1); return r; }
template <bool NT> __device__ __forceinline__ void store_pair_rows(float* p, size_t rstride, bool odd, f32x4 v0, f32x4 v1) {
    const f32x4 r = xchg1(odd ? v0 : v1);
    const f32x4 a = odd ? r : v0, bq = odd ? v1 : r;
    if (NT) { __builtin_nontemporal_store(a, (f32x4*)p); __builtin_nontemporal_store(bq, (f32x4*)(p + rstride)); }
    else { *(f32x4*)p = a; *(f32x4*)(p + rstride) = bq; }
}
template <bool NT> __device__ __forceinline__ void load_pair_rows(const float* p, size_t rstride, bool odd, f32x4& v0, f32x4& v1) {
    f32x4 a, bq;
    if (NT) { a = __builtin_nontemporal_load((const f32x4*)p); bq = __builtin_nontemporal_load((const f32x4*)(p + rstride)); }
    else { a = *(const f32x4*)p; bq = *(const f32x4*)(p + rstride); }
    const f32x4 r = xchg1(odd ? a : bq);
    v0 = odd ? r : a; v1 = odd ? bq : r;
}
struct RowStats {
    float* xbuf; unsigned* cnt; float eps;
    __device__ __forceinline__ void run(const f32x4 (&v)[2][2][4][2], const Unit& u, int wr, int wc, int fr, int fq, PG8_LAS unsigned char* lds, int wid, int lane) const {
        PG8_LAS float* P = (PG8_LAS float*)lds;
        PG8_LAS float* S = (PG8_LAS float*)(lds + 4096);
#pragma unroll
        for (int ai = 0; ai < 2; ++ai)
#pragma unroll
            for (int m = 0; m < 4; ++m) { float s = 0.f;
#pragma unroll
                for (int bj = 0; bj < 2; ++bj)
#pragma unroll
                    for (int n = 0; n < 2; ++n) { const f32x4 x = v[ai][bj][m][n]; s += (x[0] * x[0] + x[1] * x[1]) + (x[2] * x[2] + x[3] * x[3]); }
                s += __shfl_xor(s, 16); s += __shfl_xor(s, 32);
                if (fq == 0) P[(ai * HALF + wr * 64 + m * 16 + fr) * 4 + wc] = s; }
        asm volatile("s_waitcnt lgkmcnt(0)" ::: "memory"); __builtin_amdgcn_s_barrier(); asm volatile("" ::: "memory");
        const int row = wid * 32 + (lane & 31);
        if (lane < 32) { const float t = (P[row * 4 + 0] + P[row * 4 + 1]) + (P[row * 4 + 2] + P[row * 4 + 3]);
            __hip_atomic_store(xbuf + ((size_t)(u.pm * BM + row) * 8 + u.pn), t, __ATOMIC_RELAXED, __HIP_MEMORY_SCOPE_AGENT); }
        asm volatile("s_waitcnt vmcnt(0)" ::: "memory");
        if (lane == 0) __hip_atomic_fetch_add(cnt + 64 * u.pm, 1u, __ATOMIC_RELAXED, __HIP_MEMORY_SCOPE_AGENT);
        if (wid == 0) { unsigned polls = 0;
            while ((unsigned)__builtin_amdgcn_readfirstlane(__hip_atomic_load(cnt + 64 * u.pm, __ATOMIC_RELAXED, __HIP_MEMORY_SCOPE_AGENT)) < 64u) { __builtin_amdgcn_s_sleep(2); if (++polls > (1u << 22)) break; }
            __builtin_amdgcn_fence(__ATOMIC_ACQUIRE, "agent"); }
        asm volatile("s_waitcnt vmcnt(0) lgkmcnt(0)" ::: "memory"); __builtin_amdgcn_s_barrier(); asm volatile("" ::: "memory");
        if (lane < 32) { const float* sl = xbuf + (size_t)(u.pm * BM + row) * 8; float tot = 0.f;
#pragma unroll
            for (int t = 0; t < 8; ++t) tot += __hip_atomic_load(sl + t, __ATOMIC_RELAXED, __HIP_MEMORY_SCOPE_AGENT);
            S[row] = 1.0f / sqrtf(tot * (1.0f / 2048.0f) + eps); }
        asm volatile("s_waitcnt vmcnt(0) lgkmcnt(0)" ::: "memory"); __builtin_amdgcn_s_barrier(); asm volatile("" ::: "memory");
    }
};
struct EpiResNormBf16 {
    static constexpr bool PERM = false, AFTER_DRAIN = true, HAS_INIT = true;
    const float* base; float* out; bf16_t* xn; const float* gain; int ldc; float* part; RowStats st; SampleJob job;
    __device__ __forceinline__ void init(f32x4 (&acc)[2][2][4][2], const Unit& u, int wr, int wc, int fr, int fq) const {
        const bool piece = (u.mode == 3), odd = (fr & 1) != 0; const int col0 = u.pn * BM + wc * 32 + 4 * fq + (odd ? 16 : 0);
#pragma unroll
        for (int ai = 0; ai < 2; ++ai)
#pragma unroll
            for (int m = 0; m < 4; ++m) { const size_t off = (size_t)(u.pm * BM + ai * HALF + wr * 64 + m * 16 + (fr & ~1)) * ldc + col0;
#pragma unroll
                for (int bj = 0; bj < 2; ++bj) { f32x4 v0 = (f32x4){0.f, 0.f, 0.f, 0.f}, v1 = v0; if (!piece) load_pair_rows<true>(base + off + bj * HALF, (size_t)ldc, odd, v0, v1); acc[ai][bj][m][0] = v0; acc[ai][bj][m][1] = v1; } }
    }
    __device__ __forceinline__ void partial(const f32x4 (&acc)[2][2][4][2], const Unit& u, int wr, int wc, int fr, int fq) const {
        float* pp = part + ((size_t)u.slot * HALF + wr * 64 + fr) * ldc + u.pn * BM + wc * 32 + 4 * fq;
#pragma unroll
        for (int m = 0; m < 4; ++m)
#pragma unroll
            for (int bj = 0; bj < 2; ++bj)
#pragma unroll
                for (int n = 0; n < 2; ++n) asm volatile("global_store_dwordx4 %0, %1, off sc1\n\ts_nop 1" :: "v"(pp + (size_t)(m * 16) * ldc + bj * HALF + n * 16), "v"(acc[0][bj][m][n]) : "memory");
    }
    __device__ __forceinline__ void fused(f32x4 (&acc)[2][2][4][2], const Unit& u, int wr, int wc, int fr, int fq, PG8_LAS unsigned char* lds, int wid, int lane) const {
        const PG8_LAS float* S = (const PG8_LAS float*)(lds + 4096);
        if (job.row >= 0) sample_row_job<NS_P3>(job, lds, wid, lane, st.eps);
        const int col0 = u.pn * BM + wc * 32 + 4 * fq;
        { const bool odd = (fr & 1) != 0;
#pragma unroll
          for (int ai = 0; ai < 2; ++ai)
#pragma unroll
            for (int m = 0; m < 4; ++m) { float* p = out + (size_t)(u.pm * BM + ai * HALF + wr * 64 + m * 16 + (fr & ~1)) * ldc + col0 + (odd ? 16 : 0);
#pragma unroll
                for (int bj = 0; bj < 2; ++bj) store_pair_rows<false>(p + bj * HALF, (size_t)ldc, odd, acc[ai][bj][m][0], acc[ai][bj][m][1]); } }
        st.run(acc, u, wr, wc, fr, fq, lds, wid, lane);
        f32x4 gv[2][2];
#pragma unroll
        for (int bj = 0; bj < 2; ++bj)
#pragma unroll
            for (int n = 0; n < 2; ++n) gv[bj][n] = *(const f32x4*)(gain + col0 + bj * HALF + n * 16);
#pragma unroll
        for (int ai = 0; ai < 2; ++ai)
#pragma unroll
            for (int m = 0; m < 4; ++m) { const int r = ai * HALF + wr * 64 + m * 16 + fr; const float rs = S[r]; const size_t off = (size_t)(u.pm * BM + r) * ldc + col0;
#pragma unroll
                for (int bj = 0; bj < 2; ++bj) {
                    const f32x4 o0 = acc[ai][bj][m][0] * rs * gv[bj][0], o1 = acc[ai][bj][m][1] * rs * gv[bj][1];
                    u32x2v w0, w1; w0.x = cvt_pk_bf16(o0[0], o0[1]); w0.y = cvt_pk_bf16(o0[2], o0[3]); w1.x = cvt_pk_bf16(o1[0], o1[1]); w1.y = cvt_pk_bf16(o1[2], o1[3]);
                    const bool ev = (fq & 1) == 0; const unsigned sx = ev ? w1.x : w0.x, sy = ev ? w1.y : w0.y;
                    const unsigned rx = (unsigned)__shfl_xor((int)sx, 16), ry = (unsigned)__shfl_xor((int)sy, 16);
                    const u32x4 w = ev ? (u32x4){w0.x, w0.y, rx, ry} : (u32x4){rx, ry, w1.x, w1.y};
                    *(u32x4*)(xn + off + bj * HALF + (ev ? 0 : 16 - 4)) = w; } }
    }
};
struct EpiResNormF32 {
    static constexpr bool PERM = false, AFTER_DRAIN = true, HAS_INIT = true;
    float* out; const float* gain; int ldc; float* part; RowStats st; SampleJob job; int mreal;
    __device__ __forceinline__ void init(f32x4 (&acc)[2][2][4][2], const Unit& u, int wr, int wc, int fr, int fq) const {
        const bool piece = (u.mode == 3), odd = (fr & 1) != 0; const int col0 = u.pn * BM + wc * 32 + 4 * fq + (odd ? 16 : 0);
#pragma unroll
        for (int ai = 0; ai < 2; ++ai)
#pragma unroll
            for (int m = 0; m < 4; ++m) { const size_t off = (size_t)(u.pm * BM + ai * HALF + wr * 64 + m * 16 + (fr & ~1)) * ldc + col0;
#pragma unroll
                for (int bj = 0; bj < 2; ++bj) { f32x4 v0 = (f32x4){0.f, 0.f, 0.f, 0.f}, v1 = v0; if (!piece && u.pm * BM + ai * HALF < mreal) load_pair_rows<false>(out + off + bj * HALF, (size_t)ldc, odd, v0, v1); acc[ai][bj][m][0] = v0; acc[ai][bj][m][1] = v1; } }
    }
    __device__ __forceinline__ void partial(const f32x4 (&acc)[2][2][4][2], const Unit& u, int wr, int wc, int fr, int fq) const {
        float* pp = part + ((size_t)u.slot * HALF + wr * 64 + fr) * ldc + u.pn * BM + wc * 32 + 4 * fq;
#pragma unroll
        for (int m = 0; m < 4; ++m)
#pragma unroll
            for (int bj = 0; bj < 2; ++bj)
#pragma unroll
                for (int n = 0; n < 2; ++n) asm volatile("global_store_dwordx4 %0, %1, off sc1\n\ts_nop 1" :: "v"(pp + (size_t)(m * 16) * ldc + bj * HALF + n * 16), "v"(acc[0][bj][m][n]) : "memory");
    }
    __device__ __forceinline__ void fused(f32x4 (&acc)[2][2][4][2], const Unit& u, int wr, int wc, int fr, int fq, PG8_LAS unsigned char* lds, int wid, int lane) const {
        const PG8_LAS float* S = (const PG8_LAS float*)(lds + 4096);
        if (job.row >= 0) sample_row_job<NS_P5>(job, lds, wid, lane, st.eps);
        const int col0 = u.pn * BM + wc * 32 + 4 * fq;
        st.run(acc, u, wr, wc, fr, fq, lds, wid, lane);
        f32x4 gv[2][2];
#pragma unroll
        for (int bj = 0; bj < 2; ++bj)
#pragma unroll
            for (int n = 0; n < 2; ++n) gv[bj][n] = *(const f32x4*)(gain + col0 + bj * HALF + n * 16);
        { const bool odd = (fr & 1) != 0;
#pragma unroll
          for (int ai = 0; ai < 2; ++ai)
#pragma unroll
            for (int m = 0; m < 4; ++m) { const int r = ai * HALF + wr * 64 + m * 16 + fr; const float rs = S[r]; float* p = out + (size_t)(u.pm * BM + (r & ~1)) * ldc + col0 + (odd ? 16 : 0);
#pragma unroll
                for (int bj = 0; bj < 2; ++bj) if (u.pm * BM + ai * HALF < mreal) store_pair_rows<true>(p + bj * HALF, (size_t)ldc, odd, acc[ai][bj][m][0] * rs * gv[bj][0], acc[ai][bj][m][1] * rs * gv[bj][1]); } }
    }
};
#ifndef SKT_PUB
#define SKT_PUB 1
#endif
#ifndef SKT_COMB
#define SKT_COMB 1
#endif
template <class Epi, class Sched, bool ALIGN_EPI = false, bool SP2 = false>
__device__ __forceinline__ void gemm_phase(PG8_LAS unsigned char* lds, const Gemm g, const Sched& S, const Epi& E) {
    const int tid = threadIdx.x, wid = __builtin_amdgcn_readfirstlane(tid >> 6), lane = tid & 63, wr = wid >> 2, wc = wid & 3, fr = lane & 15, fq = lane >> 4;
    const int K = g.K, nt = K / BK;
    unsigned voffA[2], voffB[2];
#pragma unroll
    for (int i = 0; i < 2; ++i) { int R, C; stage_rc(tid * 16 + i * 8192, R, C); const int Rb = Epi::PERM ? ((R & ~31) + perm32(R & 31)) : R;
        voffA[i] = (unsigned)(R * K + C) * 2u; voffB[i] = (unsigned)(Rb * K + C) * 2u; }
    const size_t kstep = (size_t)(BK * 2);
    const size_t hstep = (size_t)HALF * K * 2;
    const size_t tstep = 2 * hstep;
    const unsigned ldsw = (unsigned)wid * 1024u;
    const int aoff = lds_byte(wr * 64 + fr, fq * 8), boff = lds_byte(wc * 32 + fr, fq * 8);
#define PG8_SA(b, h) (((b) * 2 + (h)) * HTB)
#define PG8_SB(b, h) ((4 + (b) * 2 + (h)) * HTB)
#define PG8_STAGE(bufoff, gbase, voff) do { _Pragma("unroll") for (int _i = 0; _i < 2; ++_i) \
        __builtin_amdgcn_global_load_lds((const unsigned*)((const char*)(gbase) + (voff)[_i]), (PG8_LAS unsigned*)(lds + (bufoff) + ldsw + _i * 8192), 16, 0, 0); } while (0)
#define PG8_LDA(dst, b, h) do { _Pragma("unroll") for (int m = 0; m < 4; ++m) _Pragma("unroll") for (int k = 0; k < 2; ++k) dst[m][k] = *(const PG8_LAS bf16x8*)(lds + PG8_SA(b, h) + aoff + m * 2048 + k * 1024); } while (0)
#define PG8_LDB(dst, b, h) do { _Pragma("unroll") for (int n = 0; n < 2; ++n) _Pragma("unroll") for (int k = 0; k < 2; ++k) dst[n][k] = *(const PG8_LAS bf16x8*)(lds + PG8_SB(b, h) + boff + n * 2048 + k * 1024); } while (0)
#define PG8_MMA(ai, bj, At, Bt) do { __builtin_amdgcn_s_setprio(1); _Pragma("unroll") for (int m = 0; m < 4; ++m) _Pragma("unroll") for (int n = 0; n < 2; ++n) _Pragma("unroll") for (int k = 0; k < 2; ++k) \
        acc[ai][bj][m][n] = __builtin_amdgcn_mfma_f32_16x16x32_bf16(Bt[n][k], At[m][k], acc[ai][bj][m][n], 0, 0, 0); __builtin_amdgcn_s_setprio(0); } while (0)
#define PG8_WAIT_V(n) asm volatile("s_waitcnt vmcnt(" #n ")" ::: "memory")
#define PG8_WAIT_L(n) asm volatile("s_waitcnt lgkmcnt(" #n ")" ::: "memory")
#define PG8_BAR __builtin_amdgcn_s_barrier()
#define PG8_SCHED __builtin_amdgcn_sched_barrier(0)
    Unit cur, nxt; int ui = 0;
    if (!S.next(0, cur)) return;
    if constexpr (!Sched::SK) { cur.k0 = 0; cur.nk = nt; cur.mode = 0; cur.slot = 0; }
    f32x4 acc[2][2][4][2];
    if constexpr (Epi::HAS_INIT) E.init(acc, cur, wr, wc, fr, fq); else {
#pragma unroll
    for (int a = 0; a < 2; ++a)
#pragma unroll
        for (int b = 0; b < 2; ++b)
#pragma unroll
            for (int m = 0; m < 4; ++m)
#pragma unroll
                for (int n = 0; n < 2; ++n) acc[a][b][m][n] = (f32x4){0.f, 0.f, 0.f, 0.f};
    }
    bf16x8 At[4][2], B0[2][2], B1[2][2];
    const char* cA = (const char*)g.A + (size_t)cur.pm * tstep + (size_t)cur.k0 * kstep; const char* cB = (const char*)g.Bt + (size_t)cur.pn * tstep + (size_t)cur.k0 * kstep;
    S.a_ready(cur);
    if constexpr (SP2) {
        PG8_STAGE(PG8_SB(0, 0), cB, voffB); PG8_STAGE(PG8_SB(0, 1), cB + hstep, voffB); PG8_STAGE(PG8_SA(0, 0), cA, voffA); PG8_STAGE(PG8_SA(0, 1), cA + hstep, voffA);
        if (wr == 1) PG8_BAR;
        PG8_WAIT_V(2); PG8_BAR;
        PG8_STAGE(PG8_SB(1, 0), cB + kstep, voffB); PG8_STAGE(PG8_SA(1, 0), cA + kstep, voffA); PG8_STAGE(PG8_SB(1, 1), cB + hstep + kstep, voffB);
        PG8_WAIT_V(6); PG8_BAR;
    } else {
        PG8_STAGE(PG8_SB(0, 0), cB, voffB); PG8_STAGE(PG8_SA(0, 0), cA, voffA); PG8_STAGE(PG8_SB(0, 1), cB + hstep, voffB); PG8_STAGE(PG8_SA(0, 1), cA + hstep, voffA);
        if (wr == 1) PG8_BAR;
        PG8_WAIT_V(4); PG8_BAR;
        PG8_STAGE(PG8_SB(1, 0), cB + kstep, voffB); PG8_STAGE(PG8_SA(1, 0), cA + kstep, voffA); PG8_STAGE(PG8_SB(1, 1), cB + hstep + kstep, voffB);
        PG8_WAIT_V(6); PG8_BAR;
    }
    for (;;) {
        const bool has_next = S.next(ui + 1, nxt);
        if constexpr (!Sched::SK) { nxt.k0 = 0; nxt.nk = nt; nxt.mode = 0; nxt.slot = 0; }
        const int ntc = cur.nk;
        const char* nA = has_next ? (const char*)g.A + (size_t)nxt.pm * tstep + (size_t)nxt.k0 * kstep : cA; const char* nB = has_next ? (const char*)g.Bt + (size_t)nxt.pn * tstep + (size_t)nxt.k0 * kstep : cB;
        for (int t = 0; t < ntc; t += 2) {
            const bool last = (t == ntc - 2);
            const char* a1 = cA + (size_t)(t + 1) * kstep;
            const char* a2 = last ? nA : cA + (size_t)(t + 2) * kstep; const char* b2 = last ? nB : cB + (size_t)(t + 2) * kstep;
            const char* a3 = a2 + kstep; const char* b3 = b2 + kstep;
            if (last && has_next) S.a_ready(nxt);
            if constexpr (SP2) {
            PG8_LDB(B0, 0, 0); PG8_LDB(B1, 0, 1); PG8_SCHED; PG8_LDA(At, 0, 0); PG8_STAGE(PG8_SA(1, 1), a1 + hstep, voffA);
            PG8_WAIT_V(8); PG8_WAIT_L(0); PG8_BAR; PG8_MMA(0, 0, At, B0); PG8_MMA(0, 1, At, B1); PG8_BAR; PG8_SCHED;
            PG8_LDA(At, 0, 1); PG8_STAGE(PG8_SB(0, 0), b2, voffB); PG8_STAGE(PG8_SB(0, 1), b2 + hstep, voffB); PG8_STAGE(PG8_SA(0, 0), a2, voffA);
            PG8_WAIT_V(8); PG8_WAIT_L(0); PG8_BAR; PG8_MMA(1, 0, At, B0); PG8_MMA(1, 1, At, B1); PG8_BAR; PG8_SCHED;
            PG8_LDB(B0, 1, 0); PG8_LDB(B1, 1, 1); PG8_SCHED; PG8_LDA(At, 1, 0); PG8_STAGE(PG8_SA(0, 1), a2 + hstep, voffA);
            PG8_WAIT_V(8); PG8_WAIT_L(0); PG8_BAR; PG8_MMA(0, 0, At, B0); PG8_MMA(0, 1, At, B1); PG8_BAR; PG8_SCHED;
            PG8_LDA(At, 1, 1); PG8_STAGE(PG8_SB(1, 0), b3, voffB); PG8_STAGE(PG8_SB(1, 1), b3 + hstep, voffB); PG8_STAGE(PG8_SA(1, 0), a3, voffA);
            PG8_WAIT_V(8); PG8_WAIT_L(0); PG8_BAR; PG8_MMA(1, 0, At, B0); PG8_MMA(1, 1, At, B1); PG8_BAR; PG8_SCHED;
            } else {
            PG8_LDB(B0, 0, 0); PG8_SCHED; PG8_LDA(At, 0, 0); PG8_STAGE(PG8_SA(1, 1), a1 + hstep, voffA);
            PG8_WAIT_L(8); PG8_BAR; PG8_WAIT_L(0); PG8_MMA(0, 0, At, B0); PG8_BAR; PG8_SCHED;
            PG8_LDB(B1, 0, 1); PG8_STAGE(PG8_SB(0, 0), b2, voffB);
            PG8_BAR; PG8_WAIT_L(0); PG8_MMA(0, 1, At, B1); PG8_BAR;
            PG8_LDA(At, 0, 1); PG8_STAGE(PG8_SA(0, 0), a2, voffA);
            PG8_BAR; PG8_WAIT_L(0); PG8_MMA(1, 0, At, B0); PG8_BAR; PG8_SCHED;
            PG8_STAGE(PG8_SB(0, 1), b2 + hstep, voffB);
            PG8_WAIT_V(6); PG8_BAR; PG8_MMA(1, 1, At, B1); PG8_BAR;
            PG8_LDB(B0, 1, 0); PG8_SCHED; PG8_LDA(At, 1, 0); PG8_STAGE(PG8_SA(0, 1), a2 + hstep, voffA);
            PG8_WAIT_L(8); PG8_BAR; PG8_WAIT_L(0); PG8_MMA(0, 0, At, B0); PG8_BAR; PG8_SCHED;
            PG8_LDB(B1, 1, 1); PG8_STAGE(PG8_SB(1, 0), b3, voffB);
            PG8_BAR; PG8_WAIT_L(0); PG8_MMA(0, 1, At, B1); PG8_BAR;
            PG8_LDA(At, 1, 1); PG8_STAGE(PG8_SA(1, 0), a3, voffA);
            PG8_BAR; PG8_WAIT_L(0); PG8_MMA(1, 0, At, B0); PG8_BAR; PG8_SCHED;
            PG8_STAGE(PG8_SB(1, 1), b3 + hstep, voffB);
            PG8_WAIT_V(6); PG8_BAR; PG8_MMA(1, 1, At, B1); PG8_BAR;
            }
        }
        if constexpr (ALIGN_EPI) { if (wr == 0) PG8_BAR; }
        if constexpr (!Epi::AFTER_DRAIN) {
            if constexpr (Sched::SK) { if (cur.mode == 3) E.partial(acc, cur, wr, wc, fr, fq); else E(acc, cur, wr, wc, fr, fq); }
            else E(acc, cur, wr, wc, fr, fq);
            S.done(cur); }
        else { if constexpr (Sched::SK) { if (has_next) { E.partial(acc, cur, wr, wc, fr, fq); S.done(cur); } } }
        if (!has_next) break;
        if constexpr (Epi::HAS_INIT) E.init(acc, nxt, wr, wc, fr, fq); else {
#pragma unroll
        for (int a = 0; a < 2; ++a)
#pragma unroll
            for (int b = 0; b < 2; ++b)
#pragma unroll
                for (int m = 0; m < 4; ++m)
#pragma unroll
                    for (int n = 0; n < 2; ++n) acc[a][b][m][n] = (f32x4){0.f, 0.f, 0.f, 0.f};
        }
        cur = nxt; cA = nA; cB = nB; ++ui;
        if constexpr (ALIGN_EPI) { if (wr == 1) PG8_BAR; }
    }
    PG8_WAIT_V(0);
    if constexpr (!ALIGN_EPI) { if (wr == 0) PG8_BAR; }
    PG8_BAR;
    if constexpr (Epi::AFTER_DRAIN) { E.fused(acc, cur, wr, wc, fr, fq, lds, wid, lane); S.done(cur); }
#undef PG8_SA
#undef PG8_SB
#undef PG8_STAGE
#undef PG8_LDA
#undef PG8_LDB
#undef PG8_MMA
#undef PG8_WAIT_V
#undef PG8_WAIT_L
#undef PG8_BAR
#undef PG8_SCHED
}
}

constexpr int NWAVES = 8;
constexpr int DM = 2048, MP = 8192, MS = 128, MR = MP + MS  , MPAD = 8448  , SEQ = 2048, NB = 4;
constexpr int NH = 4, HK = 128, HV = 256, DK = 512, DA = 1024, DC_ = 1024, GR = 16, CW = 31, DFF = 5632;
constexpr int N1 = 5136, N1P = 5376;
constexpr int ZQ = 0, ZK = 512, ZV = 1024, ZGO = 2048, ZGLU = 3072, ZGL = 5120;
constexpr int CH = 64, NCH = SEQ / CH;
constexpr float RMS_EPS = 1e-6f, LN_EPS = 1e-5f;
constexpr size_t O_YP = 0, O_YS = (size_t)MP * DM, O_GP = O_YS + (size_t)MS * DM, O_CP = O_GP + (size_t)NB * NH * HK * HV, O_GS = O_CP + (size_t)NB * 30 * DC_,
                 O_CS = O_GS + (size_t)MS * NH * HK * HV, O_END = O_CS + (size_t)MS * 30 * DC_;
constexpr size_t MiB = 1u << 20;
constexpr size_t WS_CTL = 0, CTL_ZERO_BYTES = 128 * 1024;
constexpr size_t WS_XB2 = 1 * MiB, WS_XB4 = 1 * MiB + 512 * 1024;
constexpr size_t WS_W1 = 2 * MiB;
constexpr size_t WS_W2 = 23 * MiB;
constexpr size_t WS_W3 = 31 * MiB;
constexpr size_t WS_W4 = 75 * MiB;
constexpr size_t WS_H = 97 * MiB;
constexpr size_t WS_QT = WS_H, WS_KH = WS_H + 8 * MiB, WS_VT = WS_H + 16 * MiB;
constexpr size_t WS_Z = 130 * MiB;
constexpr size_t WS_MIX = 217 * MiB;
constexpr size_t WS_HID = 130 * MiB;
constexpr size_t WS_END = 250 * MiB;
static_assert(WS_Z + (size_t)MPAD * N1P * 2 <= WS_MIX && WS_HID + (size_t)MPAD * DFF * 2 <= WS_END && WS_W1 + (size_t)N1P * DM * 2 <= WS_W2 && WS_W3 + (size_t)2 * DFF * DM * 2 <= WS_W4 && WS_W4 + (size_t)DM * DFF * 2 <= WS_H, "d_ws map");
constexpr size_t DO_O32 = 0, DO_AM = 32 * MiB, DO_DC = 36 * MiB;
constexpr int CW_TMO = 0, CW_BAR = 4096, CW_RB2 = 16384, CW_SP2 = CW_RB2 + 64 * 40, CW_RB4 = CW_RB2 + 64 * 64, CW_SP4 = CW_RB4 + 64 * 40, CW_PREP = CW_RB4 + 64 * 64, CW_SEQ = CW_PREP + 64 * 16, CW_HS = CW_SEQ + 64 * 16, CW_W4 = CW_HS + 64;
static_assert((size_t)(CW_W4 + 64) * 4 <= CTL_ZERO_BYTES, "control words inside the per-call memset");
constexpr size_t WS_SK2 = WS_Z, WS_SK4 = WS_W1;
static_assert((size_t)32 * 128 * DM * 4 <= WS_MIX - WS_Z && WS_SK4 + (size_t)44 * 128 * DM * 4 <= WS_W4, "K-split slabs");
constexpr int RING_OFF = 0, RING_BYTES = 131072;
constexpr int LDSCTL_OFF = RING_BYTES, MISC_OFF = LDSCTL_OFF + 320;
constexpr int LDS_BYTES = 147456;

#define GAS __attribute__((address_space(1)))
#define LAS __attribute__((address_space(3)))
typedef unsigned short bf16;
typedef unsigned v4u __attribute__((ext_vector_type(4)));
typedef unsigned v2u __attribute__((ext_vector_type(2)));
typedef float f32x4 __attribute__((ext_vector_type(4)));
typedef float f32x2 __attribute__((ext_vector_type(2)));
typedef short bf16x8 __attribute__((ext_vector_type(8)));
typedef GAS unsigned gu32;
typedef GAS unsigned long long gu64;
#define RLX_AGENT __ATOMIC_RELAXED, __HIP_MEMORY_SCOPE_AGENT
#define LDS_WAIT() asm volatile("s_waitcnt lgkmcnt(0)" ::: "memory")
#define LDS_BARRIER() do { asm volatile("s_waitcnt lgkmcnt(0)" ::: "memory"); __builtin_amdgcn_s_barrier(); asm volatile("" ::: "memory"); } while (0)
#define VM_WAIT() asm volatile("s_waitcnt vmcnt(0)" ::: "memory")
__device__ __forceinline__ void st_wt16(void* p, v4u v) { asm volatile("global_store_dwordx4 %0, %1, off sc1\n\ts_nop 1" :: "v"(p), "v"(v) : "memory"); }
__device__ __forceinline__ void st_wt16f(void* p, f32x4 v) { asm volatile("global_store_dwordx4 %0, %1, off sc1\n\ts_nop 1" :: "v"(p), "v"(v) : "memory"); }
__device__ __forceinline__ void st_wt8(void* p, v2u v) { asm volatile("global_store_dwordx2 %0, %1, off sc1\n\ts_nop 1" :: "v"(p), "v"(v) : "memory"); }
__device__ __forceinline__ void st_wt4f(void* p, float v) { asm volatile("global_store_dword %0, %1, off sc1\n\ts_nop 1" :: "v"(p), "v"(v) : "memory"); }
__device__ __forceinline__ unsigned f2bf(float f) { unsigned u = __builtin_bit_cast(unsigned, f); return (u + 0x7fffu + ((u >> 16) & 1u)) >> 16; }
__device__ __forceinline__ unsigned pk2(float lo, float hi) { return f2bf(lo) | (f2bf(hi) << 16); }
__device__ __forceinline__ float bf2f(unsigned short b) { return __builtin_bit_cast(float, (unsigned)b << 16); }
__device__ __forceinline__ float bflo(unsigned w) { return __builtin_bit_cast(float, w << 16); }
__device__ __forceinline__ float bfhi(unsigned w) { return __builtin_bit_cast(float, w & 0xffff0000u); }
__device__ __forceinline__ float sigmoid_f(float x) { return __builtin_amdgcn_rcpf(1.0f + __expf(-x)); }
__device__ __forceinline__ float silu_f(float x) { return x * sigmoid_f(x); }
__device__ __forceinline__ float logsigmoid_f(float x) { return fminf(x, 0.f) - __logf(1.0f + __expf(-fabsf(x))); }
#define XB_TMO      128
#define XB_XCNT(j)  (256  + 64 * (j))
#define XB_XSUB(j)  (1280 + 64 * (j))
#define XB_XGEN(j)  (2304 + 64 * (j))
#define XB_TOP      3328
#define XB_TOPGEN   3392
#define XCD_BAR_WORDS 3456
#define XB_SPIN_CAP (1u << 18)

__device__ __forceinline__ unsigned xb_ld(unsigned* p)              { return __hip_atomic_load(p, __ATOMIC_RELAXED, __HIP_MEMORY_SCOPE_AGENT); }
__device__ __forceinline__ unsigned xb_add(unsigned* p, unsigned v) { return __hip_atomic_fetch_add(p, v, __ATOMIC_RELAXED, __HIP_MEMORY_SCOPE_AGENT); }
__device__ __forceinline__ unsigned xb_xcc_id() { return (unsigned)__builtin_amdgcn_s_getreg((3 << 11) | 20) & 0xFu; }
#define XB_SPIN(cond, bar) do { unsigned _sp = 0; while (cond) { __builtin_amdgcn_s_sleep(1); \
    if ((++_sp & 255u) == 0u) { if (xb_ld(&(bar)[XB_TMO])) break; if (_sp > XB_SPIN_CAP) { atomicAdd(&(bar)[XB_TMO], 1u); break; } } } } while (0)

struct XcdBarrier {
    unsigned* bar; unsigned x;
    volatile LAS unsigned* st;
};

__device__ __forceinline__ XcdBarrier xcd_barrier_post(unsigned* bar, volatile LAS unsigned* st) {
    XcdBarrier b; b.bar = bar; b.x = xb_xcc_id(); b.st = st;
    if (threadIdx.x == 0) (void)xb_add(&bar[XB_XCNT(b.x)], 1u);
    return b;
}
__device__ __forceinline__ void xcd_barrier_complete(unsigned* bar, unsigned x, unsigned& nloc, unsigned& nx) {
    const unsigned G = gridDim.x * gridDim.y * gridDim.z;
    unsigned sum, cnt, mine, sp = 0u;
    for (;;) {
        sum = 0u; cnt = 0u; mine = 0u;
#pragma unroll
        for (unsigned j = 0; j < 16; ++j) { const unsigned c = xb_ld(&bar[XB_XCNT(j)]); sum += c; cnt += (c > 0u) ? 1u : 0u; mine = (j == x) ? c : mine; }
        if (sum == G) break;
        __builtin_amdgcn_s_sleep(1);
        if ((++sp & 255u) == 0u) { if (xb_ld(&bar[XB_TMO])) break; if (sp > XB_SPIN_CAP) { atomicAdd(&bar[XB_TMO], 1u); break; } }
    }
    nloc = mine > 0u ? mine : 1u; nx = cnt > 0u ? cnt : 1u;
}

__device__ __forceinline__ void xcd_barrier(const XcdBarrier& b) {
    asm volatile("s_waitcnt vmcnt(0)" ::: "memory");
    __syncthreads();
    if (threadIdx.x == 0) {
        unsigned* bar = b.bar;
        __builtin_amdgcn_s_waitcnt(0);
        unsigned nloc = b.st[0], nx = b.st[1];
        if (nloc == 0u) { xcd_barrier_complete(bar, b.x, nloc, nx); b.st[0] = nloc; b.st[1] = nx; }
        const unsigned old = xb_add(&bar[XB_XSUB(b.x)], 1u);
        const unsigned gen = old / nloc;
        if (old + 1u == (gen + 1u) * nloc) {
            __builtin_amdgcn_fence(__ATOMIC_RELEASE, "agent");
            asm volatile("s_waitcnt vmcnt(0)" ::: "memory");
            const unsigned og = xb_add(&bar[XB_TOP], 1u);
            const unsigned tg = og / nx;
            if (og + 1u == (tg + 1u) * nx) xb_add(&bar[XB_TOPGEN], 1u);
            else XB_SPIN(xb_ld(&bar[XB_TOPGEN]) == tg, bar);
            __builtin_amdgcn_fence(__ATOMIC_ACQUIRE, "agent");
            xb_add(&bar[XB_XGEN(b.x)], 1u);
            asm volatile("s_waitcnt vmcnt(0)" ::: "memory");
        } else {
            XB_SPIN(xb_ld(&bar[XB_XGEN(b.x)]) == gen, bar);
            __builtin_amdgcn_fence(__ATOMIC_ACQUIRE, "agent");
            asm volatile("s_waitcnt vmcnt(0)" ::: "memory");
        }
    }
    __syncthreads();
}
#ifndef W3_P0
#define W3_P0 2816
#endif
struct Args { const float* in[18]; float* out; unsigned char* ws; int ph_lo, ph_hi, pad, pad2; };
#define P_xp (A.in[0])
#define P_xs (A.in[1])
#define P_sgla (A.in[2])
#define P_sconv (A.in[3])
#define P_norm_mix (A.in[4])
#define P_w_in (A.in[5])
#define P_wgu (A.in[6])
#define P_bgate (A.in[7])
#define P_gla_norm (A.in[8])
#define P_conv_w (A.in[9])
#define P_conv_b (A.in[10])
#define P_ln_g (A.in[11])
#define P_ln_b (A.in[12])
#define P_w_out (A.in[13])
#define P_norm_ffn (A.in[14])
#define P_w_ffn_in (A.in[15])
#define P_w_ffn_out (A.in[16])
#define P_norm_final (A.in[17])
#define P_W1t ((bf16*)(A.ws + WS_W1))
#define P_W2t ((bf16*)(A.ws + WS_W2))
#define P_W3t ((bf16*)(A.ws + WS_W3))
#define P_W4t ((bf16*)(A.ws + WS_W4))
#define P_H ((bf16*)(A.ws + WS_H))
#define P_Z ((bf16*)(A.ws + WS_Z))
#define P_MIX ((bf16*)(A.ws + WS_MIX))
#define P_HID ((bf16*)(A.ws + WS_HID))
#define P_QT ((bf16*)(A.ws + WS_QT))
#define P_KH ((bf16*)(A.ws + WS_KH))
#define P_VT ((bf16*)(A.ws + WS_VT))
#define P_out (A.out)
#define P_O32 ((float*)((unsigned char*)A.out + DO_O32))
#define P_AM ((bf16*)((unsigned char*)A.out + DO_AM))
#define P_DCb ((float*)((unsigned char*)A.out + DO_DC))

struct Frame {
    LAS unsigned char* lds;
    volatile LAS unsigned* MISC;
    gu32* ctl;
    int tid, lane, wave, vcu, G;
};
__device__ __forceinline__ float wave_sum(float v) {
#pragma unroll
    for (int o = 1; o < 64; o <<= 1) v += __shfl_xor(v, o);
    return v;
}
__device__ __forceinline__ float dot4(f32x4 a, f32x4 b) { return (a.x * b.x + a.y * b.y) + (a.z * b.z + a.w * b.w); }

template <int MAP> __device__ __forceinline__ int srccol(int n) {
    if (MAP == 1) { if (n < 2048) return n; if (n < 3072) return n + 16;
        if (n < 5120) { const int t = (n - 3072) >> 8, r = (n - 3072) & 255; return r < 128 ? 3088 + 128 * t + r : 3088 + 1024 + 128 * t + (r - 128); }
        return n < 5136 ? n - 3072 : -1; }
    if (MAP == 3) { const int t = n >> 8, r = n & 255; return r < 128 ? 128 * t + r : DFF + 128 * t + (r - 128); }
    return n;
}
template <int MAP> __device__ __forceinline__ void tr_load(float (&tv)[32], const float* W, int Nsrc, int Ndst, int item, int lane) {
    const int nblk = Ndst / 32, kb = item / nblk, nb = item % nblk, k0 = 64 * kb, n0 = 32 * nb;
    const int sc = srccol<MAP>(n0 + (lane & 31));
    const float* src = W + (size_t)k0 * Nsrc + (sc >= 0 ? sc : 0);
#pragma unroll
    for (int i = 0; i < 32; ++i) { const int kk = 2 * i + (lane >> 5); tv[i] = __builtin_nontemporal_load(src + (size_t)kk * Nsrc); }
}
template <int MAP> __device__ __forceinline__ void tr_store(const float (&tv)[32], int K, int Ndst, bf16* WT, LAS float* scr, int item, int lane) {
    const int nblk = Ndst / 32, kb = item / nblk, nb = item % nblk, k0 = 64 * kb, n0 = 32 * nb;
    const int sc = srccol<MAP>(n0 + (lane & 31));
#pragma unroll
    for (int i = 0; i < 32; ++i) { const int kk = 2 * i + (lane >> 5); scr[kk * 33 + (lane & 31)] = sc >= 0 ? tv[i] : 0.f; }
    LDS_WAIT(); asm volatile("" ::: "memory");
    const int c = lane & 7;
#pragma unroll
    for (int j = 0; j < 4; ++j) { const int n = (lane >> 3) + 8 * j; const LAS float* s = scr + (8 * c) * 33 + n;
        v4u o; o.x = pk2(s[0 * 33], s[1 * 33]); o.y = pk2(s[2 * 33], s[3 * 33]); o.z = pk2(s[4 * 33], s[5 * 33]); o.w = pk2(s[6 * 33], s[7 * 33]);
        *(GAS v4u*)(WT + (size_t)(n0 + n) * K + k0 + 8 * c) = o; }
    LDS_WAIT(); asm volatile("" ::: "memory");
}
template <int MAP> __device__ __forceinline__ void transpose_items(const float* W, int K, int Nsrc, int Ndst, bf16* WT, LAS float* scr, int it0, int stride, int nitems, int lane, int ibase = 0) {
    float ta[32], tb[32];
    int it = it0;
    if (it >= nitems) return;
    const int last = it0 + ((nitems - 1 - it0) / stride) * stride;
    tr_load<MAP>(ta, W, Nsrc, Ndst, ibase + it, lane);
#pragma unroll 1
    while (true) {
        const int i2 = it + stride; tr_load<MAP>(tb, W, Nsrc, Ndst, ibase + (i2 <= last ? i2 : last), lane);
        tr_store<MAP>(ta, K, Ndst, WT, scr, ibase + it, lane);
        if (i2 > last) break;
        const int i3 = i2 + stride; tr_load<MAP>(ta, W, Nsrc, Ndst, ibase + (i3 <= last ? i3 : last), lane);
        tr_store<MAP>(tb, K, Ndst, WT, scr, ibase + i2, lane);
        if (i3 > last) break;
        it = i3;
    }
}
__device__ __forceinline__ void rms_row_to_bf16(const float* xrow, const float* gain, bf16* orow, int lane, const float* part = nullptr, int ns = 0, size_t pstride = 0, float* xout = nullptr) {
    const GAS f32x4* xr = (const GAS f32x4*)xrow + lane; const GAS f32x4* gr = (const GAS f32x4*)gain + lane;
    f32x4 v[8]; float s = 0.f;
#pragma unroll
    for (int j = 0; j < 8; ++j) v[j] = __builtin_nontemporal_load(xr + 64 * j);
    if (xout) { GAS f32x4* xo = (GAS f32x4*)xout + lane;
#pragma unroll
        for (int j = 0; j < 8; ++j) xo[64 * j] = v[j]; }
#pragma unroll
    for (int j = 0; j < 8; ++j) s += dot4(v[j], v[j]);
    const float rstd = 1.0f / sqrtf(wave_sum(s) * (1.f / DM) + RMS_EPS);
    GAS v2u* o8 = (GAS v2u*)orow + lane;
#pragma unroll
    for (int j = 0; j < 8; ++j) { const f32x4 g = gr[64 * j]; v2u o; o.x = pk2(v[j].x * rstd * g.x, v[j].y * rstd * g.y); o.y = pk2(v[j].z * rstd * g.z, v[j].w * rstd * g.w); o8[64 * j] = o; }
}
__device__ __forceinline__ void rms_row_inplace(float* xrow, const float* gain, int lane, const float* part = nullptr, int ns = 0, size_t pstride = 0) {
    GAS f32x4* xr = (GAS f32x4*)xrow + lane; const GAS f32x4* gr = (const GAS f32x4*)gain + lane;
    f32x4 v[8]; float s = 0.f;
#pragma unroll
    for (int j = 0; j < 8; ++j) v[j] = xr[64 * j];
    for (int k = 0; k < ns; k += 2) {
        const GAS f32x4* pr0 = (const GAS f32x4*)(part + (size_t)k * pstride) + lane; const GAS f32x4* pr1 = (const GAS f32x4*)(part + (size_t)(k + 1) * pstride) + lane;
        f32x4 t0[8], t1[8];
#pragma unroll
        for (int j = 0; j < 8; ++j) { t0[j] = pr0[64 * j]; t1[j] = pr1[64 * j]; }
#pragma unroll
        for (int j = 0; j < 8; ++j) v[j] += t0[j] + t1[j]; }
#pragma unroll
    for (int j = 0; j < 8; ++j) s += dot4(v[j], v[j]);
    const float rstd = 1.0f / sqrtf(wave_sum(s) * (1.f / DM) + RMS_EPS);
#pragma unroll
    for (int j = 0; j < 8; ++j) { const f32x4 g = gr[64 * j]; xr[64 * j] = v[j] * rstd * g; }
}
__device__ __forceinline__ void wg_publish_wt(gu32* w0, int tid) { if (tid == 0) __hip_atomic_fetch_add(w0, 1u, RLX_AGENT); }
__device__ __forceinline__ void wg_publish(gu32* w0, gu32* w1, int tid) {
    if (tid == 0) { __builtin_amdgcn_fence(__ATOMIC_RELEASE, "agent"); asm volatile("s_waitcnt vmcnt(0)" ::: "memory");
        __hip_atomic_fetch_add(w0, 1u, RLX_AGENT); if (w1) __hip_atomic_fetch_add(w1, 1u, RLX_AGENT); }
}
__device__ __forceinline__ void wg_wait_ge(gu32* w, unsigned want, int tid) {
    if (tid < 64) { unsigned polls = 0;
        while ((unsigned)__builtin_amdgcn_readfirstlane(__hip_atomic_load(w, RLX_AGENT)) < want) { __builtin_amdgcn_s_sleep(2); if (++polls > (1u << 22)) break; }
        __builtin_amdgcn_fence(__ATOMIC_ACQUIRE, "agent"); asm volatile("s_waitcnt vmcnt(0)" ::: "memory"); }
    asm volatile("" ::: "memory"); __syncthreads(); asm volatile("" ::: "memory");
}
template <int NS> __device__ __forceinline__ void sample_row_unit(const float* base, const float* part, size_t pstride, const float* gain, float* xout, bf16* obf, float* of32, LAS float* red, int wave, int lane) {
    const int col = 256 * wave + 4 * lane;
    f32x4 v = *(const GAS f32x4*)(base + col);
    f32x4 t[NS];
#pragma unroll
    for (int k = 0; k < NS; ++k) t[k] = *(const GAS f32x4*)(part + (size_t)k * pstride + col);
#pragma unroll
    for (int k = 0; k < NS; ++k) v += t[k];
    if (xout) *(GAS f32x4*)(xout + col) = v;
    const float s = wave_sum(dot4(v, v));
    if (lane == 0) red[wave] = s;
    LDS_BARRIER();
    float tot = 0.f;
#pragma unroll
    for (int w = 0; w < 8; ++w) tot += red[w];
    const float rstd = 1.0f / sqrtf(tot * (1.f / DM) + RMS_EPS);
    const f32x4 g = *(const GAS f32x4*)(gain + col); const f32x4 r = v * rstd * g;
    if (obf) { v2u o; o.x = pk2(r.x, r.y); o.y = pk2(r.z, r.w); *(GAS v2u*)(obf + col) = o; }
    if (of32) *(GAS f32x4*)(of32 + col) = r;
    LDS_BARRIER();
}
__device__ __forceinline__ void p0_prologue(Frame& F, const Args& A) {
    LAS float* scr = (LAS float*)(F.lds + RING_OFF + F.wave * 16384);
    const int gw = F.vcu * NWAVES + F.wave, NGW = F.G * NWAVES;
    constexpr int I_1 = (DM / 64) * (N1P / 32), I_2 = (DM / 64) * (DM / 32);
    transpose_items<1>(P_w_in, DM, N1, N1P, P_W1t, scr, gw, NGW, I_1, F.lane);
    transpose_items<0>(P_w_out, DM, DM, DM, P_W2t, scr, NGW - 1 - gw, NGW, I_2, F.lane);
    transpose_items<3>(P_w_ffn_in, DM, 2 * DFF, 2 * DFF, P_W3t, scr, gw, NGW, W3_P0, F.lane);
    #ifndef X_NT
#define X_NT 1
#endif
#if X_NT
#define X_LOAD(p) __builtin_nontemporal_load(p)
#else
#define X_LOAD(p) (*(p))
#endif
    {
        const int m0 = NGW - 1 - gw;
        const GAS f32x4* gr = (const GAS f32x4*)P_norm_mix + F.lane;
        f32x4 va[8], vb[8];
        auto rowp = [&](int m) -> const GAS f32x4* { const int mc = m < MR ? m : MR - 1; return (const GAS f32x4*)(mc < MP ? P_xp + (size_t)mc * DM : P_xs + (size_t)(mc - MP) * DM) + F.lane; };
        if (m0 < MPAD) {
            { const GAS f32x4* xr = rowp(m0);
#pragma unroll
              for (int j = 0; j < 8; ++j) va[j] = X_LOAD(xr + 64 * j); }
#pragma unroll 1
            for (int m = m0; m < MPAD; m += NGW) {
                { const GAS f32x4* xr = rowp(m + NGW);
#pragma unroll
                  for (int j = 0; j < 8; ++j) vb[j] = X_LOAD(xr + 64 * j); }
                float s = 0.f;
#pragma unroll
                for (int j = 0; j < 8; ++j) s += dot4(va[j], va[j]);
                const float rstd = (m < MR) ? 1.0f / sqrtf(wave_sum(s) * (1.f / DM) + RMS_EPS) : 0.f;
                GAS v2u* o8 = (GAS v2u*)(P_H + (size_t)m * DM) + F.lane;
#pragma unroll
                for (int j = 0; j < 8; ++j) { const f32x4 g = gr[64 * j]; v2u o; o.x = pk2(va[j].x * rstd * g.x, va[j].y * rstd * g.y); o.y = pk2(va[j].z * rstd * g.z, va[j].w * rstd * g.w); o8[64 * j] = o; }
#pragma unroll
                for (int j = 0; j < 8; ++j) va[j] = vb[j];
            }
        }
    }
}
__device__ __forceinline__ void convert_w3(Frame& F, const Args& A, int wg, int nwgs) {
    LAS float* scr = (LAS float*)(F.lds + RING_OFF + F.wave * 16384);
    constexpr int I_3 = (DM / 64) * (2 * DFF / 32);
    transpose_items<3>(P_w_ffn_in, DM, 2 * DFF, 2 * DFF, P_W3t, scr, wg * NWAVES + F.wave, nwgs * NWAVES, I_3 - W3_P0, F.lane, W3_P0);
}
__device__ __forceinline__ void convert_w4(Frame& F, const Args& A, int wg, int nwgs) {
    LAS float* scr = (LAS float*)(F.lds + RING_OFF + F.wave * 16384);
    constexpr int I_4 = (DFF / 64) * (DM / 32);
    transpose_items<0>(P_w_ffn_out, DFF, DM, DM, P_W4t, scr, wg * NWAVES + F.wave, nwgs * NWAVES, I_4, F.lane);
}
__device__ __forceinline__ void gla_prep_unit(Frame& F, const Args& A, int bh, int c) {
    const int tid = F.tid, b = bh >> 2, h = bh & 3, row0 = b * SEQ + c * CH;
    LAS float* GL = (LAS float*)(F.lds + RING_OFF);
    LAS float* BL = (LAS float*)(F.lds + RING_OFF + 4608);
    LAS bf16* QS = (LAS bf16*)(F.lds + RING_OFF + 8192);
    LAS bf16* KS = (LAS bf16*)(F.lds + RING_OFF + 25600);
    LAS bf16* VR = (LAS bf16*)(F.lds + RING_OFF + 43008);
    LAS bf16* KHS = (LAS bf16*)(F.lds + RING_OFF + 76800);
    const size_t uc = (size_t)bh * NCH + c;
    const bf16* Zc = P_Z + (size_t)row0 * N1P;
    {
        v4u pq[2], pk[2], pv[4];
#pragma unroll
        for (int k = 0; k < 2; ++k) { const int p = tid + 512 * k, i = p >> 4, ch = p & 15;
            pq[k] = *(const GAS v4u*)(Zc + (size_t)i * N1P + ZQ + h * HK + 8 * ch); pk[k] = *(const GAS v4u*)(Zc + (size_t)i * N1P + ZK + h * HK + 8 * ch); }
#pragma unroll
        for (int k = 0; k < 4; ++k) { const int p = tid + 512 * k, i = p >> 5, ch = p & 31; pv[k] = *(const GAS v4u*)(Zc + (size_t)i * N1P + ZV + h * HV + 8 * ch); }
        v4u pg = (v4u){0u, 0u, 0u, 0u};
        if (tid < 128) pg = *(const GAS v4u*)(Zc + (size_t)(tid >> 1) * N1P + ZGL + 8 * (tid & 1));
#pragma unroll
        for (int k = 0; k < 2; ++k) { const int p = tid + 512 * k, i = p >> 4, ch = p & 15; *(LAS v4u*)(QS + i * 136 + 8 * ch) = pq[k]; *(LAS v4u*)(KS + i * 136 + 8 * ch) = pk[k]; }
#pragma unroll
        for (int k = 0; k < 4; ++k) { const int p = tid + 512 * k, i = p >> 5, ch = p & 31; *(LAS v4u*)(VR + i * 264 + 8 * (ch ^ ((i >> 3) & 7))) = pv[k]; }
        if (tid < 128) { LAS float* gp = GL + (tid >> 1) * 16 + 8 * (tid & 1);
            gp[0] = bflo(pg.x); gp[1] = bfhi(pg.x); gp[2] = bflo(pg.y); gp[3] = bfhi(pg.y); gp[4] = bflo(pg.z); gp[5] = bfhi(pg.z); gp[6] = bflo(pg.w); gp[7] = bfhi(pg.w); }
    }
    const int d = tid & 127, g = tid >> 7;
    float wg[16];
#pragma unroll
    for (int r = 0; r < 16; ++r) wg[r] = P_wgu[r * DK + h * HK + d];
    const float bg = P_bgate[h * HK + d];
    LDS_BARRIER();
    float bcum[16]; float run = 0.f;
#pragma unroll
    for (int ii = 0; ii < 16; ++ii) { const int i = g * 16 + ii; float x = bg;
#pragma unroll
        for (int r4 = 0; r4 < 4; ++r4) { const f32x4 gl = *(const LAS f32x4*)(GL + i * 16 + 4 * r4);
            x += gl.x * wg[4 * r4] + gl.y * wg[4 * r4 + 1] + gl.z * wg[4 * r4 + 2] + gl.w * wg[4 * r4 + 3]; }
        run += logsigmoid_f(x) * (1.0f / 16.0f); bcum[ii] = run; }
    BL[g * 128 + d] = run;
    LDS_BARRIER();
    float off = 0.f, tot = 0.f;
#pragma unroll
    for (int gg = 0; gg < 4; ++gg) { const float t = BL[gg * 128 + d]; off += (gg < g) ? t : 0.f; tot += t; }
    const float scale = 0.08838834764831845f;
#pragma unroll
    for (int ii = 0; ii < 16; ++ii) { const int i = g * 16 + ii; const float bb = bcum[ii] + off;
        const float q = bf2f(QS[i * 136 + d]) * scale * __expf(bb);
        const float kv = bf2f(KS[i * 136 + d]);
        const unsigned qk = pg8::cvt_pk_bf16(q, kv * __expf(-bb)), qb = qk & 0xffffu, ktb = qk >> 16, khb = pg8::cvt_pk_bf16(kv * __expf(tot - bb), 0.f) & 0xffffu;
        QS[i * 136 + d] = (bf16)qb; KS[i * 136 + d] = (bf16)ktb; KHS[i * 136 + (d ^ (8 * ((i >> 3) & 7)))] = (bf16)khb; }
    {
#pragma unroll
      for (int k = 0; k < 4; ++k) { const int q = tid + 512 * k, n = q >> 3, pc = q & 7; unsigned vw[4];
#pragma unroll
          for (int e = 0; e < 8; ++e) { const unsigned v = VR[(8 * pc + e) * 264 + (n ^ (8 * pc))];
              if (e & 1) vw[e >> 1] |= v << 16; else vw[e >> 1] = v; }
          *(GAS v4u*)(P_VT + (uc * 256 + n) * 64 + 8 * pc) = (v4u){vw[0], vw[1], vw[2], vw[3]}; } }
    LDS_BARRIER();
    {
#pragma unroll
      for (int k = 0; k < 2; ++k) { const int q = tid + 512 * k, dd = q >> 3, pc = q & 7; unsigned kw[4];
#pragma unroll
          for (int e = 0; e < 8; ++e) { const unsigned v = KHS[(8 * pc + e) * 136 + (dd ^ (8 * pc))];
              if (e & 1) kw[e >> 1] |= v << 16; else kw[e >> 1] = v; }
          *(GAS v4u*)(P_KH + (uc * 128 + dd) * 64 + 8 * pc) = (v4u){kw[0], kw[1], kw[2], kw[3]}; } }
    {
#pragma unroll
        for (int k = 0; k < 2; ++k) { const int p = tid + 512 * k, i = p >> 4, s = (p >> 2) & 3, fq = p & 3;
            const v2u lo = *(const LAS v2u*)(QS + i * 136 + 32 * s + 4 * fq), hi = *(const LAS v2u*)(QS + i * 136 + 32 * s + 16 + 4 * fq);
            *(GAS v4u*)(P_QT + (uc * 64 + i) * 128 + 32 * s + 8 * fq) = (v4u){lo.x, lo.y, hi.x, hi.y}; }
    }
    { const int fr = F.lane & 15, fq = F.lane >> 4;
#pragma unroll
      for (int tt = 0; tt < 2; ++tt) { const int id = 2 * F.wave + tt, it = id >> 2, jt = id & 3;
          f32x4 acc = (f32x4){0.f, 0.f, 0.f, 0.f};
          if (jt <= it) {
#pragma unroll
              for (int s = 0; s < 4; ++s) { const bf16x8 a = *(const LAS bf16x8*)(KS + (jt * 16 + fr) * 136 + 32 * s + 8 * fq); const bf16x8 bq = *(const LAS bf16x8*)(QS + (it * 16 + fr) * 136 + 32 * s + 8 * fq);
                  acc = __builtin_amdgcn_mfma_f32_16x16x32_bf16(a, bq, acc, 0, 0, 0); } }
          const int i = it * 16 + fr, j0 = jt * 16 + 4 * fq;
#pragma unroll
          for (int r = 0; r < 4; ++r) if (j0 + r > i) acc[r] = 0.f;
          v2u o; o.x = pk2(acc[0], acc[1]); o.y = pk2(acc[2], acc[3]);
          *(LAS v2u*)(VR + i * 72 + j0) = o; } }
    if (g == 0) GL[d] = __expf(tot);
    LDS_BARRIER();
    { const int i = tid >> 3, ch = tid & 7; *(GAS v4u*)(P_AM + (uc * 64 + i) * 64 + 8 * ch) = *(const LAS v4u*)(VR + i * 72 + 8 * ch); }
    if (tid < 32) *(GAS f32x4*)(P_DCb + uc * 128 + 4 * tid) = *(const LAS f32x4*)(GL + 4 * tid);
    LDS_BARRIER();
}
__device__ __forceinline__ void ln_silu_row(const LAS float* cs, const float* lng, const float* lnb, bf16* orow, int lane) {
    f32x4 x[4]; float s = 0.f;
#pragma unroll
    for (int j = 0; j < 4; ++j) { x[j] = *(const LAS f32x4*)(cs + 256 * j + 4 * lane); s += (x[j].x + x[j].y) + (x[j].z + x[j].w); }
    const float mean = wave_sum(s) * (1.f / DC_); float q = 0.f;
#pragma unroll
    for (int j = 0; j < 4; ++j) { x[j] = x[j] - mean; q += dot4(x[j], x[j]); }
    const float rstd = 1.0f / sqrtf(wave_sum(q) * (1.f / DC_) + LN_EPS);
#pragma unroll
    for (int j = 0; j < 4; ++j) { const f32x4 g = *(const GAS f32x4*)(lng + 256 * j + 4 * lane), bb = *(const GAS f32x4*)(lnb + 256 * j + 4 * lane);
        const f32x4 y = x[j] * rstd * g + bb; v2u o; o.x = pk2(silu_f(y.x), silu_f(y.y)); o.y = pk2(silu_f(y.z), silu_f(y.w));
        *(GAS v2u*)(orow + 256 * j + 4 * lane) = o; }
}
__device__ __forceinline__ void ln_silu_rows2(const LAS float* cs, const float* lng, const float* lnb, bf16* orow, int lane) {
    f32x4 g[4], bb[4];
#pragma unroll
    for (int j = 0; j < 4; ++j) { g[j] = *(const GAS f32x4*)(lng + 256 * j + 4 * lane); bb[j] = *(const GAS f32x4*)(lnb + 256 * j + 4 * lane); }
    f32x4 x[2][4]; float s[2] = {0.f, 0.f};
#pragma unroll
    for (int k = 0; k < 2; ++k)
#pragma unroll
        for (int j = 0; j < 4; ++j) { x[k][j] = *(const LAS f32x4*)(cs + k * 1024 + 256 * j + 4 * lane); s[k] += (x[k][j].x + x[k][j].y) + (x[k][j].z + x[k][j].w); }
#pragma unroll
    for (int o = 1; o < 64; o <<= 1) { s[0] += __shfl_xor(s[0], o); s[1] += __shfl_xor(s[1], o); }
    float q[2] = {0.f, 0.f};
#pragma unroll
    for (int k = 0; k < 2; ++k) { const float mean = s[k] * (1.f / DC_);
#pragma unroll
        for (int j = 0; j < 4; ++j) { x[k][j] = x[k][j] - mean; q[k] += dot4(x[k][j], x[k][j]); } }
#pragma unroll
    for (int o = 1; o < 64; o <<= 1) { q[0] += __shfl_xor(q[0], o); q[1] += __shfl_xor(q[1], o); }
#pragma unroll
    for (int k = 0; k < 2; ++k) { const float rstd = 1.0f / sqrtf(q[k] * (1.f / DC_) + LN_EPS);
#pragma unroll
        for (int j = 0; j < 4; ++j) { const f32x4 y = x[k][j] * rstd * g[j] + bb[j]; v2u o; o.x = pk2(silu_f(y.x), silu_f(y.y)); o.y = pk2(silu_f(y.z), silu_f(y.w));
            *(GAS v2u*)(orow + (size_t)k * DM + 256 * j + 4 * lane) = o; } }
}
__device__ __forceinline__ void conv_prompt_unit(Frame& F, const Args& A, int b, int tb) {
    LAS bf16* GT = (LAS bf16*)(F.lds + RING_OFF);
    LAS float* CS = (LAS float*)(F.lds + RING_OFF);
    const int t0 = tb * 16;
    { v4u g8[12];
#pragma unroll
      for (int k = 0; k < 12; ++k) { const int p = F.tid + 512 * k, pc = p < 46 * 128 ? p : 0, r = pc >> 7, ch = pc & 127, t = t0 - 30 + r, tc = t < 0 ? 0 : t;
          g8[k] = *(const GAS v4u*)(P_Z + (size_t)(b * SEQ + tc) * N1P + ZGLU + 8 * ch); }
#pragma unroll
      for (int k = 0; k < 12; ++k) { const int p = F.tid + 512 * k, r = p >> 7, ch = p & 127, t = t0 - 30 + r;
          if (p < 46 * 128) *(LAS v4u*)(GT + r * 1024 + 8 * ch) = t < 0 ? (v4u){0u, 0u, 0u, 0u} : g8[k]; } }
    asm volatile("" ::: "memory");
    const int c = 2 * F.tid;
    const f32x2 bias = *(const GAS f32x2*)(P_conv_b + c);
    f32x2 acc[16];
#pragma unroll
    for (int tt = 0; tt < 16; ++tt) acc[tt] = bias;
    LDS_BARRIER();
#pragma unroll
    for (int half = 0; half < 2; ++half) {
        const int w0 = half * 16, nw = half ? 15 : 16;
        f32x2 wt[16];
#pragma unroll
        for (int w = 0; w < 16; ++w) wt[w] = (w < nw) ? *(const GAS f32x2*)(P_conv_w + (w0 + w) * DC_ + c) : (f32x2){0.f, 0.f};
#pragma unroll
        for (int r = 0; r < 46; ++r) { if (r >= w0 && r < w0 + nw + 15) { const unsigned gw_ = *(const LAS unsigned*)(GT + r * 1024 + c); f32x2 g; g.x = bflo(gw_); g.y = bfhi(gw_);
#pragma unroll
            for (int tt = 0; tt < 16; ++tt) { const int w = r - tt - w0; if (w >= 0 && w < nw) acc[tt] += g * wt[(w >= 0 && w < 16) ? w : 0]; } } }
        asm volatile("" ::: "memory");
    }
    LDS_BARRIER();
#pragma unroll
    for (int tt = 0; tt < 16; ++tt) *(LAS f32x2*)(CS + tt * 1024 + c) = acc[tt];
    LDS_BARRIER();
    ln_silu_rows2(CS + (2 * F.wave) * 1024, P_ln_g, P_ln_b, P_MIX + (size_t)(b * SEQ + t0 + 2 * F.wave) * DM + DA, F.lane);
    LDS_BARRIER();
}
__device__ __forceinline__ void conv_state_prompt_row(Frame& F, const Args& A, int b, int rr) {
    const bf16* zr = P_Z + (size_t)(b * SEQ + SEQ - 30 + rr) * N1P; float* orow = P_out + O_CP + ((size_t)b * 30 + rr) * DC_;
#pragma unroll
    for (int j = 0; j < 4; ++j) { const int c = 256 * j + 4 * F.lane; const v2u gg = *(const GAS v2u*)(zr + ZGLU + c);
        *(GAS f32x4*)(orow + c) = (f32x4){bflo(gg.x), bfhi(gg.x), bflo(gg.y), bfhi(gg.y)}; }
}
__device__ __forceinline__ void conv_sample_unit(Frame& F, const Args& A, int b) {
    LAS float* CS = (LAS float*)(F.lds + RING_OFF);
    const bf16* zr = P_Z + (size_t)(MP + b) * N1P;
    const int c = 2 * F.tid;
    f32x2 acc = *(const GAS f32x2*)(P_conv_b + c);
    f32x2 hv[30];
#pragma unroll
    for (int w = 0; w < 30; ++w) hv[w] = __builtin_nontemporal_load((const GAS f32x2*)(P_sconv + ((size_t)b * 30 + w) * DC_ + c));
    const unsigned gg = *(const GAS unsigned*)(zr + ZGLU + c);
#pragma unroll
    for (int w = 0; w < 30; ++w) { acc += hv[w] * *(const GAS f32x2*)(P_conv_w + w * DC_ + c); if (w >= 1) __builtin_nontemporal_store(hv[w], (GAS f32x2*)(P_out + O_CS + ((size_t)b * 30 + (w - 1)) * DC_ + c)); }
    f32x2 gl; gl.x = bflo(gg); gl.y = bfhi(gg);
    acc += gl * *(const GAS f32x2*)(P_conv_w + 30 * DC_ + c);
    *(GAS f32x2*)(P_out + O_CS + ((size_t)b * 30 + 29) * DC_ + c) = gl;
    *(LAS f32x2*)(CS + c) = acc;
    LDS_BARRIER();
    if (F.wave == 0) ln_silu_row(CS, P_ln_g, P_ln_b, P_MIX + (size_t)(MP + b) * DM + DA, F.lane);
    LDS_BARRIER();
}
__device__ __forceinline__ void gla_sample_items(Frame& F, const Args& A, int it0, int stride, int nitems) {
    const int tid = F.tid, n4 = 4 * F.lane;
    LAS float* TB = (LAS float*)(F.lds + RING_OFF);
    LAS float* OP = TB + 4 * 640;
    f32x4 s[16], sx[16];
    int it = it0;
    if (it < nitems) { const float* Sin = P_sgla + (size_t)it * HK * HV;
#pragma unroll
        for (int dd = 0; dd < 16; ++dd) s[dd] = __builtin_nontemporal_load((const GAS f32x4*)(Sin + (size_t)(16 * F.wave + dd) * HV + n4)); }
#pragma unroll 1
    for (int k = 0; k < 4; ++k) { const int ik = it0 + k * stride; if (ik < nitems) { const int b = ik >> 2, h = ik & 3; const bf16* zr = P_Z + (size_t)(MP + b) * N1P; LAS float* T = TB + k * 640;
        if (tid < 128) { const int d = tid; float x = P_bgate[h * HK + d];
#pragma unroll
            for (int r = 0; r < 16; ++r) x += bf2f(zr[ZGL + r]) * P_wgu[r * DK + h * HK + d];
            T[d] = __expf(logsigmoid_f(x) * (1.0f / 16.0f)); T[128 + d] = bf2f(zr[ZK + h * HK + d]); T[256 + d] = bf2f(zr[ZQ + h * HK + d]) * 0.08838834764831845f; }
        else if (tid < 384) { const int n = tid - 128; T[384 + n] = bf2f(zr[ZV + h * HV + n]); } } }
    LDS_BARRIER();
    int k = 0;
#pragma unroll 1
    while (it < nitems) {
        const int b = it >> 2, h = it & 3, nx = it + stride;
        const bf16* zr = P_Z + (size_t)(MP + b) * N1P;
        float* Sout = P_out + O_GS + (size_t)it * HK * HV;
        const LAS float* AD = TB + k * 640; const LAS float* KD = AD + 128; const LAS float* QD = AD + 256; const LAS float* VD = AD + 384;
        { const float* Sin = P_sgla + (size_t)(nx < nitems ? nx : it) * HK * HV;
#pragma unroll
            for (int dd = 0; dd < 16; ++dd) sx[dd] = __builtin_nontemporal_load((const GAS f32x4*)(Sin + (size_t)(16 * F.wave + dd) * HV + n4)); }
        const f32x4 v4 = *(const LAS f32x4*)(VD + n4);
        f32x4 oacc = (f32x4){0.f, 0.f, 0.f, 0.f};
#pragma unroll
        for (int dd = 0; dd < 16; ++dd) { const int d = 16 * F.wave + dd;
            const f32x4 sn = s[dd] * AD[d] + v4 * KD[d]; __builtin_nontemporal_store(sn, (GAS f32x4*)(Sout + (size_t)d * HV + n4)); oacc += sn * QD[d]; }
        *(LAS f32x4*)(OP + F.wave * 256 + n4) = oacc;
        LDS_BARRIER();
        if (F.wave == 0) { f32x4 o4 = (f32x4){0.f, 0.f, 0.f, 0.f};
#pragma unroll
            for (int w = 0; w < 8; ++w) o4 += *(const LAS f32x4*)(OP + w * 256 + n4);
            const float rstd = 1.0f / sqrtf(wave_sum(dot4(o4, o4)) * (1.f / HV) + RMS_EPS);
            const f32x4 gn = *(const GAS f32x4*)(P_gla_norm + n4); const v2u go = *(const GAS v2u*)(zr + ZGO + h * HV + n4);
            v2u o; o.x = pk2(o4.x * rstd * gn.x * silu_f(bflo(go.x)), o4.y * rstd * gn.y * silu_f(bfhi(go.x))); o.y = pk2(o4.z * rstd * gn.z * silu_f(bflo(go.y)), o4.w * rstd * gn.w * silu_f(bfhi(go.y)));
            *(GAS v2u*)(P_MIX + (size_t)(MP + b) * DM + h * HV + n4) = o; }
        LDS_BARRIER();
#pragma unroll
        for (int dd = 0; dd < 16; ++dd) s[dd] = sx[dd];
        it = nx; ++k;
    }
}
constexpr int SQ_AM = 0, SQ_QT = 9216, SQ_KH = 26624, SQ_VT = 45056, SQ_DC = 49664, SQ_BUF = 50176, SQ_NP = 2848, SQ_LT = 384;
__device__ __forceinline__ void seq_issue(f32x4 (&R)[8], const bf16* AMc, const bf16* QTc, const bf16* KHc, const bf16* VTc, const float* DCc, int lt) {
#pragma unroll
    for (int k = 0; k < 8; ++k) { const int P = lt + SQ_LT * k; const bf16* src = AMc;
        if (P < 512) src = AMc + (P >> 3) * 64 + (P & 7) * 8;
        else if (P < 1536) { const int q = P - 512; src = QTc + (q >> 4) * 128 + (q & 15) * 8; }
        else if (P < 2560) { const int q = P - 1536; src = KHc + (q >> 3) * 64 + (q & 7) * 8; }
        else if (P < 2816) { const int q = P - 2560; src = VTc + (q >> 3) * 64 + (q & 7) * 8; }
        else if (P < SQ_NP) { const int q = P - 2816; src = (const bf16*)DCc + q * 8; }
        R[k] = *(const GAS f32x4*)src; }
}
__device__ __forceinline__ void seq_stash(const f32x4 (&R)[8], LAS unsigned char* buf, int lt) {
#pragma unroll
    for (int k = 0; k < 8; ++k) { const int P = lt + SQ_LT * k; int dst = 0;
        if (P < 512) dst = SQ_AM + (P >> 3) * 144 + (P & 7) * 16;
        else if (P < 1536) { const int q = P - 512; dst = SQ_QT + (q >> 4) * 272 + (q & 15) * 16; }
        else if (P < 2560) { const int q = P - 1536; dst = SQ_KH + (q >> 3) * 144 + (q & 7) * 16; }
        else if (P < 2816) { const int q = P - 2560; dst = SQ_VT + (q >> 3) * 144 + (q & 7) * 16; }
        else { const int q = P - 2816; dst = SQ_DC + q * 16; }
        if (P < SQ_NP) *(LAS f32x4*)(buf + dst) = R[k]; }
}
__device__ __forceinline__ void gla_seq_wg(Frame& F, const Args& A, int item) {
    const int bh = item >> 3, grp = item & 7, b = bh >> 2, h = bh & 3, fr = F.lane & 15, fq = F.lane >> 4;
    LAS unsigned char* lds0 = F.lds + RING_OFF;
    const bool loader = F.wave >= 2; const int lt = F.tid - 128;
    const size_t uc0 = (size_t)bh * NCH;
    const bf16* AM0 = P_AM + uc0 * 64 * 64; const bf16* QT0 = P_QT + uc0 * 64 * 128; const bf16* KH0 = P_KH + uc0 * 128 * 64; const bf16* VT0 = P_VT + uc0 * 256 * 64 + (size_t)(grp * 32) * 64; const float* DC0 = P_DCb + uc0 * 128;
    f32x4 S[8], RB[8];
#define RA S
#pragma unroll
    for (int dt = 0; dt < 8; ++dt) S[dt] = (f32x4){0.f, 0.f, 0.f, 0.f};
#define SEQ_ISSUE(R, CC) do { const size_t o_ = (size_t)(CC); seq_issue(R, AM0 + o_ * 64 * 64, QT0 + o_ * 64 * 128, KH0 + o_ * 128 * 64, VT0 + o_ * 256 * 64, DC0 + o_ * 128, lt); } while (0)
    if (loader) { SEQ_ISSUE(RA, 0); SEQ_ISSUE(RB, 1); seq_stash(RA, lds0, lt); SEQ_ISSUE(RA, 2); }
    LDS_BARRIER();
    const int n0 = grp * 32 + 16 * F.wave;
#define SEQ_COMPUTE(CC) do { \
            const LAS unsigned char* buf = lds0 + ((CC) & 1) * SQ_BUF; \
            bf16x8 vt[2]; \
_Pragma("unroll") \
            for (int ks = 0; ks < 2; ++ks) vt[ks] = *(const LAS bf16x8*)(buf + SQ_VT + (16 * F.wave + fr) * 144 + (32 * ks + 8 * fq) * 2); \
            f32x4 o[4]; \
_Pragma("unroll") \
            for (int m = 0; m < 4; ++m) { o[m] = (f32x4){0.f, 0.f, 0.f, 0.f}; \
_Pragma("unroll") \
                for (int ks = 0; ks < 2; ++ks) { const bf16x8 a = *(const LAS bf16x8*)(buf + SQ_AM + (16 * m + fr) * 144 + (32 * ks + 8 * fq) * 2); o[m] = __builtin_amdgcn_mfma_f32_16x16x32_bf16(vt[ks], a, o[m], 0, 0, 0); } } \
            bf16x8 sb[4]; \
_Pragma("unroll") \
            for (int s = 0; s < 4; ++s) { v4u w; w.x = pg8::cvt_pk_bf16(S[2 * s][0], S[2 * s][1]); w.y = pg8::cvt_pk_bf16(S[2 * s][2], S[2 * s][3]); w.z = pg8::cvt_pk_bf16(S[2 * s + 1][0], S[2 * s + 1][1]); w.w = pg8::cvt_pk_bf16(S[2 * s + 1][2], S[2 * s + 1][3]); sb[s] = __builtin_bit_cast(bf16x8, w); } \
_Pragma("unroll") \
            for (int m = 0; m < 4; ++m) \
_Pragma("unroll") \
                for (int s = 0; s < 4; ++s) { const bf16x8 a = *(const LAS bf16x8*)(buf + SQ_QT + (16 * m + fr) * 272 + (32 * s + 8 * fq) * 2); o[m] = __builtin_amdgcn_mfma_f32_16x16x32_bf16(sb[s], a, o[m], 0, 0, 0); } \
_Pragma("unroll") \
            for (int m = 0; m < 4; ++m) *(GAS f32x4*)(P_O32 + (size_t)(b * SEQ + (CC) * CH + 16 * m + fr) * DA + h * HV + n0 + 4 * fq) = o[m]; \
_Pragma("unroll") \
            for (int dt = 0; dt < 8; ++dt) { const f32x4 dc = *(const LAS f32x4*)(buf + SQ_DC + (16 * dt + 4 * fq) * 4); S[dt] = S[dt] * dc; \
_Pragma("unroll") \
                for (int ks = 0; ks < 2; ++ks) { const bf16x8 a = *(const LAS bf16x8*)(buf + SQ_KH + (16 * dt + fr) * 144 + (32 * ks + 8 * fq) * 2); S[dt] = __builtin_amdgcn_mfma_f32_16x16x32_bf16(a, vt[ks], S[dt], 0, 0, 0); } } \
        } while (0)
    if (loader) {
#pragma unroll 1
        for (int c = 0; c < NCH; c += 2) {
            seq_stash(RB, lds0 + SQ_BUF, lt); SEQ_ISSUE(RB, (c + 3 < NCH ? c + 3 : NCH - 1));
            LDS_BARRIER();
            seq_stash(RA, lds0, lt); SEQ_ISSUE(RA, (c + 4 < NCH ? c + 4 : NCH - 1));
            LDS_BARRIER();
        }
    } else {
#pragma unroll 1
        for (int c = 0; c < NCH; c += 2) {
            SEQ_COMPUTE(c);
            LDS_BARRIER();
            SEQ_COMPUTE(c + 1);
            LDS_BARRIER();
        }
    }
#undef SEQ_COMPUTE
#undef SEQ_ISSUE
#undef RA
    if (!loader) {
#pragma unroll
        for (int dt = 0; dt < 8; ++dt)
#pragma unroll
            for (int r = 0; r < 4; ++r) P_out[O_GP + ((size_t)bh * HK + 16 * dt + 4 * fq + r) * HV + n0 + fr] = S[dt][r];
    }
}
template <int NR> __device__ __forceinline__ void gla_onorm_rows(Frame& F, const Args& A, int row, int rstride, int h) {
    const int n4 = 4 * F.lane;
    f32x4 o4[NR]; v2u go[NR];
#pragma unroll
    for (int j = 0; j < NR; ++j) { const int r = row + j * rstride; o4[j] = *(const GAS f32x4*)(P_O32 + (size_t)r * DA + h * HV + n4); go[j] = *(const GAS v2u*)(P_Z + (size_t)r * N1P + ZGO + h * HV + n4); }
    const f32x4 gn = *(const GAS f32x4*)(P_gla_norm + n4);
#pragma unroll
    for (int j = 0; j < NR; ++j) { const int r = row + j * rstride;
        const float rstd = 1.0f / sqrtf(wave_sum(dot4(o4[j], o4[j])) * (1.f / HV) + RMS_EPS);
        v2u o; o.x = pk2(o4[j].x * rstd * gn.x * silu_f(bflo(go[j].x)), o4[j].y * rstd * gn.y * silu_f(bfhi(go[j].x))); o.y = pk2(o4[j].z * rstd * gn.z * silu_f(bflo(go[j].y)), o4[j].w * rstd * gn.w * silu_f(bfhi(go[j].y)));
        *(GAS v2u*)(P_MIX + (size_t)r * DM + h * HV + n4) = o; }
}
__device__ __forceinline__ void gla_onorm_item(Frame& F, const Args& A, int row, int h) {
    const int n4 = 4 * F.lane;
    const f32x4 o4 = *(const GAS f32x4*)(P_O32 + (size_t)row * DA + h * HV + n4);
    const float rstd = 1.0f / sqrtf(wave_sum(dot4(o4, o4)) * (1.f / HV) + RMS_EPS);
    const f32x4 gn = *(const GAS f32x4*)(P_gla_norm + n4); const v2u go = *(const GAS v2u*)(P_Z + (size_t)row * N1P + ZGO + h * HV + n4);
    v2u o; o.x = pk2(o4.x * rstd * gn.x * silu_f(bflo(go.x)), o4.y * rstd * gn.y * silu_f(bfhi(go.x))); o.y = pk2(o4.z * rstd * gn.z * silu_f(bflo(go.y)), o4.w * rstd * gn.w * silu_f(bfhi(go.y)));
    *(GAS v2u*)(P_MIX + (size_t)row * DM + h * HV + n4) = o;
}
#ifndef G1_WGS_V
#define G1_WGS_V 231
#endif
#ifndef G3_WGS_V
#define G3_WGS_V 242
#endif
constexpr int G1_WGS = G1_WGS_V, G3_WGS = G3_WGS_V;
#ifndef FUSE_ROWS
#define FUSE_ROWS 1
#endif
#ifndef G1_SP2
#define G1_SP2 true
#endif
#ifndef G3_SP2
#define G3_SP2 true
#endif
#ifndef G1_ALIGN
#define G1_ALIGN true
#endif
#ifndef G3_ALIGN
#define G3_ALIGN true
#endif
#ifndef NKP2_V
#define NKP2_V 4
#endif
#ifndef NKP4_V
#define NKP4_V 8
#endif
constexpr int NKP2 = NKP2_V, NKP4 = NKP4_V;

#ifdef EXTRA_PHASE
#define MK_N_LAUNCHES 10
#endif
#ifndef MK_N_LAUNCHES
#define MK_N_LAUNCHES 1
#endif
constexpr int N_PHASES = 10;
constexpr int N_LAUNCHES = MK_N_LAUNCHES;
__global__ void __launch_bounds__(NWAVES * 64, 2) hymba_fwd(Args args) {
    extern __shared__ __attribute__((aligned(16))) unsigned char lds[];
    Frame F;
    F.lds = (LAS unsigned char*)lds;
    F.MISC = (volatile LAS unsigned*)(F.lds + MISC_OFF);
    F.tid = threadIdx.x; F.lane = F.tid & 63; F.wave = __builtin_amdgcn_readfirstlane(F.tid >> 6);
    F.G = gridDim.x; { const int bx = blockIdx.x; F.vcu = (F.G % 8 == 0) ? (bx % 8) * (F.G / 8) + bx / 8 : bx; }
    const Args& A = args;
    F.ctl = (gu32*)(args.ws + WS_CTL);
    for (int u = F.tid; u < (LDS_BYTES - LDSCTL_OFF) / 4; u += NWAVES * 64) ((LAS unsigned*)(F.lds + LDSCTL_OFF))[u] = 0u;
    __syncthreads();
    XcdBarrier bar; bar.bar = (unsigned*)(F.ctl + CW_BAR); bar.x = 0; bar.st = nullptr;
    if (N_LAUNCHES == 1) bar = xcd_barrier_post((unsigned*)(F.ctl + CW_BAR), F.MISC + 8);
    const int lo = args.ph_lo, hi = args.ph_hi;
#ifndef REP_MASK
#define REP_MASK 0
#endif
#define REPS(k) (((REP_MASK >> (k)) & 1) ? 2 : 1)
#ifndef P2A_REP
#define P2A_REP 0
#endif
#ifndef P2A_MASK
#define P2A_MASK 15
#endif
#ifndef PH_MASK
#define PH_MASK 0x3ff
#endif
#define IN(k) (((PH_MASK >> (k)) & 1) && lo <= (k) && (k) < hi)
#ifdef TS_PHASE
#ifndef TS_Q
#define TS_Q 8u
#endif
#ifndef TS_BLOCK
#define TS_BLOCK 0
#endif
#ifndef TS_OFF
#define TS_OFF 0u
#endif
    unsigned long long ts_prev = __builtin_amdgcn_s_memrealtime(); float ts_val = 0.f;
#define TS_MARK(k) do { const unsigned long long t_ = __builtin_amdgcn_s_memrealtime(); if ((k) == TS_PHASE) ts_val = (float)((((unsigned)(t_ - ts_prev) + TS_OFF * 100u) / (TS_Q * 100u)) * TS_Q); ts_prev = t_; } while (0)
#else
#define TS_MARK(k) do { } while (0)
#endif
#define SEAM(k) do { if (IN(k) && IN((k) + 1)) xcd_barrier(bar); TS_MARK(k); } while (0)
    const int gw = F.vcu * NWAVES + F.wave, NGW = F.G * NWAVES;

    if (IN(0)) for (int rep_ = 0; rep_ < REPS(0); ++rep_) { p0_prologue(F, A); }
    SEAM(0);
    if (IN(1)) for (int rep_ = 0; rep_ < REPS(1); ++rep_) {
        const int geff = (F.G == 256) ? G1_WGS : F.G;
        if ((int)blockIdx.x < geff) { pg8::Gemm g{P_H, P_W1t, MPAD, N1P, DM}; pg8::StaticOrder S; S.init(MPAD, N1P, geff, (int)blockIdx.x);
            pg8::EpiStoreBf16 E{P_Z, N1P, ZGLU / 256, ZGLU / 256 + 8, ZGLU};
            pg8::gemm_phase<pg8::EpiStoreBf16, pg8::StaticOrder, G1_ALIGN, G1_SP2>(F.lds + RING_OFF, g, S, E); }
        if (geff == F.G) convert_w3(F, A, (int)blockIdx.x, F.G); else if ((int)blockIdx.x >= geff) convert_w3(F, A, (int)blockIdx.x - geff, F.G - geff);
    }
    SEAM(1);
    if (IN(2)) {
        const int bx = (int)blockIdx.x;
        if (bx < NB * NH * 8) {
            const int item = (bx & 7) * (NB * NH) + (bx >> 3), bh = item >> 3, grp = item & 7;
#pragma unroll 1
            for (int k = 0; k < NCH / 8; ++k) gla_prep_unit(F, A, bh, grp * (NCH / 8) + k);
            VM_WAIT(); __syncthreads();
            wg_publish(F.ctl + CW_PREP + 64 * bh, nullptr, F.tid); wg_wait_ge(F.ctl + CW_PREP + 64 * bh, 8u, F.tid);
            TS_MARK(21);
            gla_seq_wg(F, A, item);
            TS_MARK(22);
            VM_WAIT(); __syncthreads();
            wg_publish(F.ctl + CW_SEQ + 64 * bh, nullptr, F.tid); wg_wait_ge(F.ctl + CW_SEQ + 64 * bh, 8u, F.tid);
            { const int b = bh >> 2, h = bh & 3, row0 = b * SEQ + grp * (SEQ / 8);
#pragma unroll 1
              for (int t = F.wave; t < SEQ / 8; t += 8 * NWAVES) gla_onorm_rows<8>(F, A, row0 + t, NWAVES, h); }
        } else {
            const int r0 = bx - NB * NH * 8, nr = F.G - NB * NH * 8;
            TS_MARK(23);
            for (int r = r0; r < NB * (SEQ / 16); r += nr) conv_prompt_unit(F, A, r / (SEQ / 16), r % (SEQ / 16));
            TS_MARK(24);
            for (int r = r0 * NWAVES + F.wave; r < NB * 30; r += nr * NWAVES) conv_state_prompt_row(F, A, r / 30, r % 30);
            for (int r = r0; r < MS; r += nr) conv_sample_unit(F, A, r);
            TS_MARK(25);
            gla_sample_items(F, A, r0, nr, MS * NH);
        }
    }
    TS_MARK(20);
    SEAM(2);
    if (IN(5)) {
        pg8::Gemm g{P_MIX, P_W2t, MPAD, DM, DM}; pg8::TailSplitOrder S; S.init_ts(MP, DM, DM, F.G, (int)blockIdx.x, NKP2, true); S.piece_cnt = (unsigned*)(F.ctl + CW_SP2);
        pg8::RowStats st{(float*)(A.ws + WS_XB2), (unsigned*)(F.ctl + CW_RB2), RMS_EPS};
        const int bx = (int)blockIdx.x, rk = (bx >> 3) * 4 + (bx & 3);
        pg8::SampleJob job{((bx & 7) >= 4 && rk < MS) ? rk : -1, P_xs, (const float*)(A.ws + WS_SK2), P_norm_ffn, P_out + (size_t)MP * DM, P_H + (size_t)MP * DM, nullptr, (const unsigned*)(F.ctl + CW_SP2), 8u * (unsigned)S.npieces};
        pg8::EpiResNormBf16 E{P_xp, P_out, P_H, P_norm_ffn, DM, (float*)(A.ws + WS_SK2), st, job};
        pg8::gemm_phase<pg8::EpiResNormBf16, pg8::TailSplitOrder, false, true>(F.lds + RING_OFF, g, S, E);
        TS_MARK(51);
        TS_MARK(52);
    }
    SEAM(5);
    if (IN(7)) for (int rep_ = 0; rep_ < REPS(7); ++rep_) {
        const int geff = (F.G == 256) ? G3_WGS : F.G;
        if ((int)blockIdx.x < geff) { pg8::Gemm g{P_H, P_W3t, MPAD, 2 * DFF, DM}; pg8::RotOrder S; S.init(MPAD, 2 * DFF, geff, (int)blockIdx.x); S.rot = 2 * DFF / 256; S.cnt = (unsigned*)(F.ctl + CW_HS);
            pg8::EpiSwiglu E{P_HID, DFF, MPAD / 256 - 1};
            pg8::gemm_phase<pg8::EpiSwiglu, pg8::RotOrder, G3_ALIGN, G3_SP2>(F.lds + RING_OFF, g, S, E); }
        if (geff == F.G) convert_w4(F, A, (int)blockIdx.x, F.G);
        else if ((int)blockIdx.x >= geff) { const int fw = (int)blockIdx.x - geff, nfw = F.G - geff;
            convert_w4(F, A, fw, nfw);
            VM_WAIT(); __syncthreads(); wg_publish(F.ctl + CW_W4, nullptr, F.tid);
            if (fw < DM / 256) {
                wg_wait_ge(F.ctl + CW_W4, (unsigned)nfw, F.tid); wg_wait_ge(F.ctl + CW_HS, 8u * (2 * DFF / 256), F.tid);
                pg8::Gemm g{P_HID, P_W4t, MPAD, DM, DFF}; pg8::OneUnitOrder S{MPAD / 256 - 1, fw, DFF / 64};
                pg8::RowStats st{(float*)(A.ws + WS_XB4), (unsigned*)(F.ctl + CW_RB4), RMS_EPS};
                pg8::SampleJob job{-1, nullptr, nullptr, nullptr, nullptr, nullptr, nullptr, nullptr, 0u};
                pg8::EpiResNormF32 E{P_out, P_norm_final, DM, nullptr, st, job, MR};
                pg8::gemm_phase<pg8::EpiResNormF32, pg8::OneUnitOrder, false, true>(F.lds + RING_OFF, g, S, E); } }
    }
#ifdef PG8_TS
    if (TS_PHASE >= 70 && TS_PHASE <= 79) { const unsigned v_ = F.MISC[16 + (TS_PHASE - 71)]; ts_val = (float)((v_ / (TS_Q * 100u)) * TS_Q); }
#endif
    SEAM(7);
    if (IN(8)) {
        pg8::Gemm g{P_HID, P_W4t, MPAD, DM, DFF}; pg8::TailSplitOrder S; S.init_ts(MP, DM, DFF, F.G, (int)blockIdx.x, NKP4, true); S.npieces = 0;
        pg8::RowStats st{(float*)(A.ws + WS_XB4), (unsigned*)(F.ctl + CW_RB4), RMS_EPS};
        pg8::SampleJob job{-1, nullptr, nullptr, nullptr, nullptr, nullptr, nullptr, nullptr, 0u};
        pg8::EpiResNormF32 E{P_out, P_norm_final, DM, nullptr, st, job, MR};
        pg8::gemm_phase<pg8::EpiResNormF32, pg8::TailSplitOrder, false, true>(F.lds + RING_OFF, g, S, E);
        TS_MARK(81);
    }
#ifdef TS_PHASE
    TS_MARK(8);
    if (blockIdx.x == TS_BLOCK && F.tid == 0) {
        unsigned* sw = (unsigned*)(args.ws + WS_END); const unsigned w = __hip_atomic_load(sw, __ATOMIC_RELAXED, __HIP_MEMORY_SCOPE_AGENT); const bool fresh = (w == 0xAAAAAAAAu);
        if (fresh) __hip_atomic_store(sw, __builtin_bit_cast(unsigned, ts_val), __ATOMIC_RELAXED, __HIP_MEMORY_SCOPE_AGENT);
        atomicAdd(P_out + O_END - 1, fresh ? ts_val : __builtin_bit_cast(float, w)); }
#endif
#undef IN
#undef SEAM
}

extern "C" void kernel_launch(void* const* d_in, const int* in_sizes, int n_in, void* d_out, int out_size, void* d_ws, size_t ws_size, hipStream_t stream) {
    static int grid = 0;
    if (grid == 0) {
        if (n_in != 18 || in_sizes[0] != MP * DM || (size_t)out_size != O_END || ws_size < WS_END) {
            fprintf(stderr, "kernel_launch: shape mismatch: n_in %d in0 %d out %d ws %zu (need %zu); nothing launched\n", n_in, n_in > 0 ? in_sizes[0] : -1, out_size, ws_size, (size_t)WS_END); grid = -1; return; }
        int dev = 0, cus = 0, per_cu = 0;
        if (hipGetDevice(&dev) != hipSuccess || hipDeviceGetAttribute(&cus, hipDeviceAttributeMultiprocessorCount, dev) != hipSuccess) { grid = -1; return; }
        if (hipFuncSetAttribute((const void*)hymba_fwd, hipFuncAttributeMaxDynamicSharedMemorySize, LDS_BYTES) != hipSuccess) { fprintf(stderr, "kernel_launch: hipFuncSetAttribute failed\n"); grid = -1; return; }
        if (hipOccupancyMaxActiveBlocksPerMultiprocessor(&per_cu, (const void*)hymba_fwd, NWAVES * 64, LDS_BYTES) != hipSuccess || per_cu < 1)
            fprintf(stderr, "kernel_launch: note: occupancy query reports %d workgroups per CU\n", per_cu);
        (void)hipGetLastError();
        if (cus != 256) { fprintf(stderr, "kernel_launch: built for a 256-CU device (tile schedules and in-launch hand-offs assume 256 resident workgroups), found %d CUs; nothing launched\n", cus); grid = -1; return; }
        grid = cus;
    }
    if (grid < 0) return;
    if (hipMemsetAsync((char*)d_ws + WS_CTL, 0, CTL_ZERO_BYTES, stream) != hipSuccess) return;
    Args a{};
    for (int i = 0; i < 18; ++i) a.in[i] = (const float*)d_in[i];
    a.out = (float*)d_out; a.ws = (unsigned char*)d_ws;
    for (int li = 0; li < N_LAUNCHES; ++li) {
        a.ph_lo = (N_LAUNCHES == 1) ? 0 : li; a.ph_hi = (N_LAUNCHES == 1) ? N_PHASES : li + 1;
        hipLaunchKernelGGL(hymba_fwd, dim3(grid), dim3(NWAVES * 64), LDS_BYTES, stream, a);
        const hipError_t le = hipPeekAtLastError();
        if (le != hipSuccess) { fprintf(stderr, "kernel_launch: launch %d failed: %s\n", li, hipGetErrorName(le)); break; }
#ifdef EXTRA_PHASE
        if (N_LAUNCHES != 1 && li == EXTRA_PHASE) { Args a2 = a; a2.pad = 1; hipLaunchKernelGGL(hymba_fwd, dim3(grid), dim3(NWAVES * 64), LDS_BYTES, stream, a2); }
#endif
    }
}
```
